# Optimizing an MI355X kernel written in HIP

```python
import jax, jax.numpy as jnp
from jax import lax
import numpy as np

D_MODEL = 1024
BATCH = 32
SEQ = 2048
DEPTH = 1

MEM_LEN = 256
EPS = 1e-6
HEAD_DIM = 64
N_Q_HEADS = 16
N_KV_HEADS = 2
WINDOW = 128
ATT_BLOCK = 128
ROPE_THETA = 10000.0
GMLP_WIDTH = 512
GMLP_GROUPS = 4
GMLP_GROUP_DIM = GMLP_WIDTH // GMLP_GROUPS
GMLP_CHUNK = 128
X_HEADS = 4
X_HEAD_DIM = 128
N_BRANCHES = 3
N_EXPERTS = 32
TOP_K = 4
D_EXPERT = D_MODEL
SWIGLU_LIMIT = 7.0
SWIGLU_ALPHA = 1.702
MOE_BLOCK = 512

A_Q = N_Q_HEADS * HEAD_DIM
A_KV = N_KV_HEADS * HEAD_DIM
C_Q = X_HEADS * X_HEAD_DIM
IN_WIDTHS = [A_Q, A_KV, A_KV, GMLP_WIDTH, GMLP_WIDTH, C_Q, D_MODEL, D_MODEL, D_MODEL]
D_IN = int(sum(IN_WIDTHS))
IN_SPLITS = [int(s) for s in np.cumsum(IN_WIDTHS)[:-1]]

kernel_name = "hybrid_swa_gmlp_memxattn_moe_block"

F32 = jnp.float32


def rms_norm(x, g):
    xf = x.astype(F32)
    y = xf * lax.rsqrt(jnp.mean(xf * xf, axis=-1, keepdims=True) + EPS)
    return (y * g.astype(F32)).astype(x.dtype)


def layer_norm(x, g, b):
    xf = x.astype(F32)
    mu = jnp.mean(xf, axis=-1, keepdims=True)
    var = jnp.mean(jnp.square(xf - mu), axis=-1, keepdims=True)
    y = (xf - mu) * lax.rsqrt(var + EPS)
    return (y * g.astype(F32) + b.astype(F32)).astype(x.dtype)


def rope_tables(positions, dim):
    inv_freq = ROPE_THETA ** (-jnp.arange(0, dim, 2, dtype=F32) / dim)
    ang = positions.astype(F32)[..., None] * inv_freq
    return jnp.cos(ang)[:, :, None, :], jnp.sin(ang)[:, :, None, :]


def apply_rope(x, cos, sin):
    xf = x.astype(F32)
    x1, x2 = jnp.split(xf, 2, axis=-1)
    return jnp.concatenate([x1 * cos - x2 * sin, x2 * cos + x1 * sin], axis=-1).astype(x.dtype)


def sliding_window_sink_attention(q, k, v, sinks):
    B, S = q.shape[0], q.shape[1]
    nb = S // ATT_BLOCK
    R = N_Q_HEADS // N_KV_HEADS
    qb = q.reshape(B, nb, ATT_BLOCK, N_KV_HEADS, R, HEAD_DIM).transpose(1, 0, 2, 3, 4, 5)

    def band(t):
        tb = t.reshape(B, nb, ATT_BLOCK, N_KV_HEADS, HEAD_DIM)
        prev = jnp.pad(tb[:, :-1], ((0, 0), (1, 0), (0, 0), (0, 0), (0, 0)))
        return jnp.concatenate([prev, tb], axis=2).transpose(1, 0, 2, 3, 4)

    kb, vb = band(k), band(v)
    qi_idx = jnp.arange(ATT_BLOCK)[:, None]
    kj_idx = jnp.arange(2 * ATT_BLOCK)[None, :]
    rel = ATT_BLOCK + qi_idx - kj_idx
    band_mask = (rel >= 0) & (rel < WINDOW)
    sink = sinks.astype(F32).reshape(N_KV_HEADS, R)[None, :, :, None]
    scale = HEAD_DIM ** -0.5

    def one_block(args):
        blk, qi, ki, vi = args
        s = jnp.einsum('bqhrd,bkhd->bhrqk', qi, ki).astype(F32) * scale
        valid = band_mask & ((blk * ATT_BLOCK - ATT_BLOCK + kj_idx) >= 0)
        s = jnp.where(valid, s, -jnp.inf)
        m = jnp.maximum(jnp.max(s, axis=-1), sink)
        p = jnp.exp(s - m[..., None])
        denom = jnp.sum(p, axis=-1) + jnp.exp(sink - m)
        o = jnp.einsum('bhrqk,bkhd->bqhrd', p, vi.astype(F32))
        o = o / denom.transpose(0, 3, 1, 2)[..., None]
        return o.astype(q.dtype)

    out = lax.map(one_block, (jnp.arange(nb), qb, kb, vb))
    return out.transpose(1, 0, 2, 3, 4, 5).reshape(B, S, A_Q)


def chunked_spatial_gating(u, v, w_s, b_s, ln_g, ln_b):
    B, S = v.shape[0], v.shape[1]
    nc = S // GMLP_CHUNK
    vn = layer_norm(v, ln_g, ln_b)
    causal = jnp.tril(jnp.ones((GMLP_CHUNK, GMLP_CHUNK), dtype=bool))
    w = jnp.where(causal[None], w_s, jnp.zeros_like(w_s)).astype(v.dtype)
    vc = vn.reshape(B, nc, GMLP_CHUNK, GMLP_GROUPS, GMLP_GROUP_DIM)
    mixed = jnp.einsum('gts,bcsgd->bctgd', w, vc) + b_s.T.astype(v.dtype)[None, None, :, :, None]
    return u * mixed.reshape(B, S, GMLP_WIDTH)


def memory_cross_attention(q, k, v):
    B, S = q.shape[0], q.shape[1]
    s = jnp.einsum('bshd,bmhd->bhsm', q, k).astype(F32) * (X_HEAD_DIM ** -0.5)
    p = jax.nn.softmax(s, axis=-1)
    o = jnp.einsum('bhsm,bmhd->bshd', p, v.astype(F32))
    return o.astype(q.dtype).reshape(B, S, C_Q)


def clamped_swiglu_expert(xb, w_gu, b_gu, w_d, b_d):
    gu = xb @ w_gu + b_gu
    gate, up = gu[:, :D_EXPERT], gu[:, D_EXPERT:]
    gate = jnp.minimum(gate, SWIGLU_LIMIT)
    up = jnp.clip(up, -SWIGLU_LIMIT, SWIGLU_LIMIT)
    glu = gate * jax.nn.sigmoid(gate * SWIGLU_ALPHA)
    return ((up + 1.0) * glu) @ w_d + b_d


def moe_ffn(h, router_w, router_b, w_gate_up, b_gate_up, w_down, b_down):
    T, D = h.shape
    logits = (h @ router_w).astype(F32) + router_b.astype(F32)
    top_vals, top_idx = lax.top_k(logits, TOP_K)
    gates = jax.nn.softmax(top_vals, axis=-1)
    A = T * TOP_K
    flat_e = top_idx.reshape(A).astype(jnp.int32)
    flat_tok = jnp.arange(A, dtype=jnp.int32) // TOP_K
    flat_gate = gates.reshape(A)
    order = jnp.argsort(flat_e, stable=True)
    sorted_e = flat_e[order]
    counts = jnp.bincount(flat_e, length=N_EXPERTS).astype(jnp.int32)
    padded = (counts + MOE_BLOCK - 1) // MOE_BLOCK * MOE_BLOCK
    padded_end = jnp.cumsum(padded)
    padded_start = padded_end - padded
    group_start = jnp.cumsum(counts) - counts
    rank = jnp.arange(A, dtype=jnp.int32) - group_start[sorted_e]
    dest = padded_start[sorted_e] + rank
    n_blocks = -(-A // MOE_BLOCK) + N_EXPERTS
    P = n_blocks * MOE_BLOCK
    slot_tok = jnp.full((P,), T, dtype=jnp.int32).at[dest].set(flat_tok[order])
    slot_gate = jnp.zeros((P,), F32).at[dest].set(flat_gate[order])
    block_expert = jnp.minimum(
        jnp.searchsorted(padded_end, jnp.arange(n_blocks, dtype=jnp.int32) * MOE_BLOCK, side='right'),
        N_EXPERTS - 1)
    h_pad = jnp.concatenate([h, jnp.zeros((1, D), h.dtype)], axis=0)

    def run_block(args):
        tok, e = args
        return clamped_swiglu_expert(h_pad[tok], w_gate_up[e], b_gate_up[e], w_down[e], b_down[e])

    out = lax.map(run_block, (slot_tok.reshape(n_blocks, MOE_BLOCK), block_expert))
    out = out.reshape(P, D) * slot_gate[:, None].astype(out.dtype)
    return jnp.zeros((T + 1, D), h.dtype).at[slot_tok].add(out)[:T]


def setup_inputs(seed: int = 0) -> dict:
    key = jax.random.key(seed)
    ks = iter(jax.random.split(key, 40))
    nrm = lambda shape, scale: jax.random.normal(next(ks), shape, F32) * scale
    gain = lambda shape: 1.0 + nrm(shape, 0.05)
    L = DEPTH
    return {
        "x": nrm((BATCH, SEQ, D_MODEL), 1.0),
        "mem": nrm((BATCH, MEM_LEN, D_MODEL), 1.0),
        "positions": jnp.broadcast_to(jnp.arange(SEQ, dtype=jnp.int32)[None, :], (BATCH, SEQ)),
        "attn_norm_g": gain((L, D_MODEL)),
        "mem_norm_g": gain((L, D_MODEL)),
        "w_in": nrm((L, D_MODEL, D_IN), D_MODEL ** -0.5),
        "b_gates": nrm((L, N_BRANCHES, D_MODEL), 0.1),
        "a_q_norm_g": gain((L, HEAD_DIM)),
        "a_k_norm_g": gain((L, HEAD_DIM)),
        "a_sinks": nrm((L, N_Q_HEADS), 0.5),
        "w_o_a": nrm((L, A_Q, D_MODEL), A_Q ** -0.5),
        "gmlp_ln_g": gain((L, GMLP_WIDTH)),
        "gmlp_ln_b": nrm((L, GMLP_WIDTH), 0.02),
        "gmlp_w_s": nrm((L, GMLP_GROUPS, GMLP_CHUNK, GMLP_CHUNK), 0.5 * GMLP_CHUNK ** -0.5),
        "gmlp_b_s": gain((L, GMLP_GROUPS, GMLP_CHUNK)),
        "w_o_b": nrm((L, GMLP_WIDTH, D_MODEL), GMLP_WIDTH ** -0.5),
        "w_mem_kv": nrm((L, D_MODEL, 2 * C_Q), D_MODEL ** -0.5),
        "c_q_norm_g": gain((L, X_HEAD_DIM)),
        "c_k_norm_g": gain((L, X_HEAD_DIM)),
        "w_o_c": nrm((L, C_Q, D_MODEL), C_Q ** -0.5),
        "w_out": nrm((L, D_MODEL, D_MODEL), D_MODEL ** -0.5),
        "ffn_norm_g": gain((L, D_MODEL)),
        "router_w": nrm((L, D_MODEL, N_EXPERTS), D_MODEL ** -0.5),
        "router_b": nrm((L, N_EXPERTS), 0.01),
        "w_gate_up": nrm((L, N_EXPERTS, D_MODEL, 2 * D_EXPERT), D_MODEL ** -0.5),
        "b_gate_up": nrm((L, N_EXPERTS, 2 * D_EXPERT), 0.01),
        "w_down": nrm((L, N_EXPERTS, D_EXPERT, D_MODEL), D_EXPERT ** -0.5),
        "b_down": nrm((L, N_EXPERTS, D_MODEL), 0.01),
    }


def reference(x, mem, positions, attn_norm_g, mem_norm_g, w_in, b_gates, a_q_norm_g, a_k_norm_g,
              a_sinks, w_o_a, gmlp_ln_g, gmlp_ln_b, gmlp_w_s, gmlp_b_s, w_o_b, w_mem_kv,
              c_q_norm_g, c_k_norm_g, w_o_c, w_out, ffn_norm_g, router_w, router_b,
              w_gate_up, b_gate_up, w_down, b_down):
    B, S, D = x.shape
    M = mem.shape[1]
    cos, sin = rope_tables(positions, HEAD_DIM)
    for l in range(DEPTH):
        h = rms_norm(x, attn_norm_g[l])
        proj = h @ w_in[l]
        qa, ka, va, ub, vb, qc, ga, gb, gc = jnp.split(proj, IN_SPLITS, axis=-1)

        qa = apply_rope(rms_norm(qa.reshape(B, S, N_Q_HEADS, HEAD_DIM), a_q_norm_g[l]), cos, sin)
        ka = apply_rope(rms_norm(ka.reshape(B, S, N_KV_HEADS, HEAD_DIM), a_k_norm_g[l]), cos, sin)
        va = va.reshape(B, S, N_KV_HEADS, HEAD_DIM)
        ya = sliding_window_sink_attention(qa, ka, va, a_sinks[l]) @ w_o_a[l]

        yb = chunked_spatial_gating(jax.nn.gelu(ub, approximate=False), jax.nn.gelu(vb, approximate=False),
                                    gmlp_w_s[l], gmlp_b_s[l], gmlp_ln_g[l], gmlp_ln_b[l]) @ w_o_b[l]

        kv = rms_norm(mem, mem_norm_g[l]) @ w_mem_kv[l]
        kc, vc = jnp.split(kv, 2, axis=-1)
        kc = rms_norm(kc.reshape(B, M, X_HEADS, X_HEAD_DIM), c_k_norm_g[l])
        vc = vc.reshape(B, M, X_HEADS, X_HEAD_DIM)
        qc = rms_norm(qc.reshape(B, S, X_HEADS, X_HEAD_DIM), c_q_norm_g[l])
        yc = memory_cross_attention(qc, kc, vc) @ w_o_c[l]

        merged = (jax.nn.sigmoid(ga + b_gates[l, 0]) * ya
                  + jax.nn.sigmoid(gb + b_gates[l, 1]) * yb
                  + jax.nn.sigmoid(gc + b_gates[l, 2]) * yc)
        x = x + merged @ w_out[l]

        h2 = rms_norm(x, ffn_norm_g[l]).reshape(B * S, D)
        x = x + moe_ffn(h2, router_w[l], router_b[l], w_gate_up[l], b_gate_up[l],
                        w_down[l], b_down[l]).reshape(B, S, D)
    return x
```

```cpp
#include <hip/hip_runtime.h>
#include <cstdio>
#include <cstdint>

#ifndef MK_FUSED
#define MK_FUSED 0
#endif

namespace pg8 {
#define PG8_LAS __attribute__((address_space(3)))
typedef unsigned short bf16_t;
typedef short bf16x8 __attribute__((ext_vector_type(8)));
typedef float f32x4 __attribute__((ext_vector_type(4)));
typedef unsigned u32x4 __attribute__((ext_vector_type(4)));
typedef float f32x2 __attribute__((ext_vector_type(2)));
constexpr int BM = 256, BK = 64, HALF = 128, HTB = HALF * BK * 2, STAGE_BYTES = 8 * HTB, NXCD = 8, WGM = 8;

__host__ __device__ __forceinline__ int lds_byte(int r, int c) { const int st = (r >> 4) * 2 + (c >> 5), rr = r & 15, cc = c & 31, ob = rr * 64 + cc * 2; return st * 1024 + (ob ^ (((ob >> 9) & 1) << 5)); }
__host__ __device__ __forceinline__ void stage_rc(int b, int& R, int& C) { const int st = b / 1024, sb = b % 1024, swz = sb ^ (((sb >> 9) & 1) << 5); R = (st >> 1) * 16 + swz / 64; C = (st & 1) * 32 + (swz % 64) / 2; }
__host__ __device__ __forceinline__ int perm32(int rho) { const int n = rho >> 4, i = rho & 15; return 8 * (i >> 2) + 4 * n + (i & 3); }

struct Unit { int pm, pn; };
struct Gemm { const bf16_t* A; const bf16_t* Bt; int K, lda, ldb; };

struct StaticOrder {
    int nM, nN, nwg, G, c;
    __host__ __device__ void init(int M, int N, int G_, int c_) { nM = M / BM; nN = N / BM; nwg = nM * nN; G = G_; c = c_; }
    __host__ __device__ bool next(int i, Unit& u) const {
        const long L = (long)i * G + c; if (L >= nwg) return false;
        int wgid = (int)L; { const int q = nwg / NXCD, r = nwg % NXCD, xcd = wgid % NXCD, off = wgid / NXCD; wgid = (xcd < r ? xcd * (q + 1) : r * (q + 1) + (xcd - r) * q) + off; }
        const int nig = WGM * nN, gid = wgid / nig, fm = gid * WGM, gsz = (nM - fm) < WGM ? (nM - fm) : WGM;
        u.pm = fm + ((wgid % nig) % gsz); u.pn = (wgid % nig) / gsz; return true;
    }
};
struct GroupedOrder {
    const int* tile_e; int ntile, nN, G, c;
    __device__ bool next(int i, Unit& u) const {
        const unsigned L = (unsigned)i * (unsigned)G + (unsigned)c; if (L >= (unsigned)(ntile * nN)) return false;
        const int tile = (int)(L / (unsigned)nN), j = (int)(L % (unsigned)nN);
        u.pm = tile; u.pn = tile_e[tile] * nN + j; return true;
    }
};

__device__ __forceinline__ unsigned cvt_pk_bf16(float lo, float hi) { unsigned r; asm volatile("v_cvt_pk_bf16_f32 %0, %1, %2" : "=v"(r) : "v"(lo), "v"(hi)); return r; }
__device__ __forceinline__ float bflo(unsigned w) { return __uint_as_float(w << 16); }
__device__ __forceinline__ float bfhi(unsigned w) { return __uint_as_float(w & 0xffff0000u); }


struct EpiBf16 {
    static constexpr bool PERM = true;
    bf16_t* O; int ldc;
    __device__ __forceinline__ void operator()(const f32x4 (&acc)[2][2][4][2], const Unit& u, int wr, int wc, int fr, int fq) const {
        const int row0 = u.pm * BM + wr * 64 + fr, col0 = u.pn * BM + wc * 32 + 8 * fq;
#pragma unroll
        for (int ai = 0; ai < 2; ++ai)
#pragma unroll
            for (int m = 0; m < 4; ++m) { bf16_t* rowp = O + (size_t)(row0 + ai * HALF + m * 16) * ldc + col0;
#pragma unroll
                for (int bj = 0; bj < 2; ++bj) { const f32x4 v0 = acc[ai][bj][m][0], v1 = acc[ai][bj][m][1];
                    u32x4 w; w.x = cvt_pk_bf16(v0[0], v0[1]); w.y = cvt_pk_bf16(v0[2], v0[3]); w.z = cvt_pk_bf16(v1[0], v1[1]); w.w = cvt_pk_bf16(v1[2], v1[3]);
                    *(u32x4*)(rowp + bj * HALF) = w; } }
    }
};
template <int ACCUM> struct EpiMerge {
    static constexpr bool PERM = true;
    bf16_t* Mg; int ldm; const bf16_t* graw; int ldg; const float* gbias;
    __device__ __forceinline__ void operator()(const f32x4 (&acc)[2][2][4][2], const Unit& u, int wr, int wc, int fr, int fq) const {
        const int row0 = u.pm * BM + wr * 64 + fr, col0 = u.pn * BM + wc * 32 + 8 * fq;
#pragma unroll
        for (int bj = 0; bj < 2; ++bj) {
            const f32x4 b0 = *(const f32x4*)(gbias + col0 + bj * HALF), b1 = *(const f32x4*)(gbias + col0 + bj * HALF + 4);
#pragma unroll
            for (int ai = 0; ai < 2; ++ai)
#pragma unroll
                for (int m = 0; m < 4; ++m) {
                    const size_t r = (size_t)(row0 + ai * HALF + m * 16);
                    const u32x4 gw = *(const u32x4*)(graw + r * ldg + col0 + bj * HALF);
                    float g[8] = {bflo(gw.x) + b0[0], bfhi(gw.x) + b0[1], bflo(gw.y) + b0[2], bfhi(gw.y) + b0[3], bflo(gw.z) + b1[0], bfhi(gw.z) + b1[1], bflo(gw.w) + b1[2], bfhi(gw.w) + b1[3]};
                    float o[8];
#pragma unroll
                    for (int i = 0; i < 8; ++i) { const float sg = __builtin_amdgcn_rcpf(1.0f + __builtin_amdgcn_exp2f(-1.4426950408889634f * g[i])); o[i] = sg * (i < 4 ? acc[ai][bj][m][0][i] : acc[ai][bj][m][1][i - 4]); }
                    bf16_t* mp = Mg + r * ldm + col0 + bj * HALF;
                    if (ACCUM) { const u32x4 pw = *(const u32x4*)mp;
                        o[0] += bflo(pw.x); o[1] += bfhi(pw.x); o[2] += bflo(pw.y); o[3] += bfhi(pw.y); o[4] += bflo(pw.z); o[5] += bfhi(pw.z); o[6] += bflo(pw.w); o[7] += bfhi(pw.w); }
                    u32x4 w; w.x = cvt_pk_bf16(o[0], o[1]); w.y = cvt_pk_bf16(o[2], o[3]); w.z = cvt_pk_bf16(o[4], o[5]); w.w = cvt_pk_bf16(o[6], o[7]);
                    *(u32x4*)mp = w;
                }
        }
    }
};
struct EpiResF32 {
    static constexpr bool PERM = false;
    float* C; const float* R; int ldc;
    __device__ __forceinline__ void operator()(const f32x4 (&acc)[2][2][4][2], const Unit& u, int wr, int wc, int fr, int fq) const {
        const int row0 = u.pm * BM + wr * 64 + fr, col0 = u.pn * BM + wc * 32 + 4 * fq;
#pragma unroll
        for (int ai = 0; ai < 2; ++ai)
#pragma unroll
            for (int m = 0; m < 4; ++m) { const size_t ro = (size_t)(row0 + ai * HALF + m * 16) * ldc + col0;
#pragma unroll
                for (int bj = 0; bj < 2; ++bj)
#pragma unroll
                    for (int n = 0; n < 2; ++n) { const f32x4 rv = *(const f32x4*)(R + ro + bj * HALF + n * 16); *(f32x4*)(C + ro + bj * HALF + n * 16) = acc[ai][bj][m][n] + rv; } }
    }
};
struct EpiSwiglu {
    static constexpr bool PERM = true;
    bf16_t* act; const float* bgu;
    __device__ __forceinline__ void operator()(const f32x4 (&acc)[2][2][4][2], const Unit& u, int wr, int wc, int fr, int fq) const {
        const int e = u.pn >> 3, j = u.pn & 7;
        const int row0 = u.pm * BM + wr * 64 + fr, col0 = j * 128 + wc * 32 + 8 * fq;
        const float* bg = bgu + (size_t)e * 2048 + col0;
        const f32x4 g0 = *(const f32x4*)bg, g1 = *(const f32x4*)(bg + 4), u0 = *(const f32x4*)(bg + 1024), u1 = *(const f32x4*)(bg + 1028);
#pragma unroll
        for (int ai = 0; ai < 2; ++ai)
#pragma unroll
            for (int m = 0; m < 4; ++m) {
                float o[8];
#pragma unroll
                for (int i = 0; i < 8; ++i) {
                    float gt = (i < 4 ? acc[ai][0][m][0][i] + g0[i] : acc[ai][0][m][1][i - 4] + g1[i - 4]);
                    float up = (i < 4 ? acc[ai][1][m][0][i] + u0[i] : acc[ai][1][m][1][i - 4] + u1[i - 4]);
                    gt = fminf(gt, 7.0f); up = fminf(fmaxf(up, -7.0f), 7.0f);
                    const float sg = __builtin_amdgcn_rcpf(1.0f + __builtin_amdgcn_exp2f(-1.702f * 1.4426950408889634f * gt));
                    o[i] = (up + 1.0f) * (gt * sg);
                }
                u32x4 w; w.x = cvt_pk_bf16(o[0], o[1]); w.y = cvt_pk_bf16(o[2], o[3]); w.z = cvt_pk_bf16(o[4], o[5]); w.w = cvt_pk_bf16(o[6], o[7]);
                *(u32x4*)(act + (size_t)(row0 + ai * HALF + m * 16) * 1024 + col0) = w;
            }
    }
};
struct EpiDown {
    static constexpr bool PERM = true;
    bf16_t* Y; const float* bd; const float* sgate;
    __device__ __forceinline__ void operator()(const f32x4 (&acc)[2][2][4][2], const Unit& u, int wr, int wc, int fr, int fq) const {
        const int e = u.pn >> 2, j = u.pn & 3;
        const int row0 = u.pm * BM + wr * 64 + fr, col0 = j * 256 + wc * 32 + 8 * fq;
        const float* bp = bd + (size_t)e * 1024 + col0;
#pragma unroll
        for (int bj = 0; bj < 2; ++bj) {
            const f32x4 b0 = *(const f32x4*)(bp + bj * HALF), b1 = *(const f32x4*)(bp + bj * HALF + 4);
#pragma unroll
            for (int ai = 0; ai < 2; ++ai)
#pragma unroll
                for (int m = 0; m < 4; ++m) {
                    const int r = row0 + ai * HALF + m * 16; const float gs = sgate[r];
                    const f32x4 v0 = (acc[ai][bj][m][0] + b0) * gs, v1 = (acc[ai][bj][m][1] + b1) * gs;
                    u32x4 w; w.x = cvt_pk_bf16(v0[0], v0[1]); w.y = cvt_pk_bf16(v0[2], v0[3]); w.z = cvt_pk_bf16(v1[0], v1[1]); w.w = cvt_pk_bf16(v1[2], v1[3]);
                    *(u32x4*)(Y + (size_t)r * 1024 + col0 + bj * HALF) = w;
                }
        }
    }
};

template <class Epi, class Sched, bool ALIGN_EPI = true>
__device__ __forceinline__ void gemm_phase(PG8_LAS unsigned char* lds, const Gemm g, const Sched& S, const Epi& E, const int wid_in) {
    const int wid = __builtin_amdgcn_readfirstlane(wid_in), lane = (int)__builtin_amdgcn_mbcnt_hi(~0u, __builtin_amdgcn_mbcnt_lo(~0u, 0u)), tid = wid * 64 + lane, wr = wid >> 2, wc = wid & 3, fr = lane & 15, fq = lane >> 4;
    const int K = g.K, nt = K / BK;
    unsigned voffA[2], voffB[2];
#pragma unroll
    for (int i = 0; i < 2; ++i) { int R, C; stage_rc(tid * 16 + i * 8192, R, C); const int Rb = Epi::PERM ? ((R & ~31) + perm32(R & 31)) : R;
        voffA[i] = (unsigned)(R * g.lda + C) * 2u; voffB[i] = (unsigned)(Rb * g.ldb + C) * 2u; }
    const size_t kstep = (size_t)(BK * 2);
    const size_t hstepA = (size_t)HALF * g.lda * 2, hstepB = (size_t)HALF * g.ldb * 2;
    const size_t tstepA = 2 * hstepA, tstepB = 2 * hstepB;
    const unsigned ldsw = (unsigned)wid * 1024u;
    const int aoff = lds_byte(wr * 64 + fr, fq * 8), boff = lds_byte(wc * 32 + fr, fq * 8);
#define PG8_SA(b, h) (((b) * 2 + (h)) * HTB)
#define PG8_SB(b, h) ((4 + (b) * 2 + (h)) * HTB)
#define PG8_STAGE(bufoff, gbase, voff) do { _Pragma("unroll") for (int _i = 0; _i < 2; ++_i) \
        __builtin_amdgcn_global_load_lds((const unsigned*)((const char*)(gbase) + (voff)[_i]), (PG8_LAS unsigned*)(lds + (bufoff) + ldsw + _i * 8192), 16, 0, 0); } while (0)
#define PG8_LDA(dst, b, h) do { _Pragma("unroll") for (int m = 0; m < 4; ++m) _Pragma("unroll") for (int k = 0; k < 2; ++k) dst[m][k] = *(const PG8_LAS bf16x8*)(lds + PG8_SA(b, h) + aoff + m * 2048 + k * 1024); } while (0)
#define PG8_LDB(dst, b, h) do { _Pragma("unroll") for (int n = 0; n < 2; ++n) _Pragma("unroll") for (int k = 0; k < 2; ++k) dst[n][k] = *(const PG8_LAS bf16x8*)(lds + PG8_SB(b, h) + boff + n * 2048 + k * 1024); } while (0)
#define PG8_MMA(ai, bj, At, Bt) do { __builtin_amdgcn_s_setprio(1); _Pragma("unroll") for (int m = 0; m < 4; ++m) _Pragma("unroll") for (int n = 0; n < 2; ++n) _Pragma("unroll") for (int k = 0; k < 2; ++k) \
        acc[ai][bj][m][n] = __builtin_amdgcn_mfma_f32_16x16x32_bf16(Bt[n][k], At[m][k], acc[ai][bj][m][n], 0, 0, 0); __builtin_amdgcn_s_setprio(0); } while (0)
#define PG8_WAIT_V(n) asm volatile("s_waitcnt vmcnt(" #n ")" ::: "memory")
#define PG8_WAIT_L(n) asm volatile("s_waitcnt lgkmcnt(" #n ")" ::: "memory")
#define PG8_BAR __builtin_amdgcn_s_barrier()
#define PG8_SCHED __builtin_amdgcn_sched_barrier(0)
    Unit cur, nxt; int ui = 0;
    if (!S.next(0, cur)) return;
    f32x4 acc[2][2][4][2];
#pragma unroll
    for (int a = 0; a < 2; ++a)
#pragma unroll
        for (int b = 0; b < 2; ++b)
#pragma unroll
            for (int m = 0; m < 4; ++m)
#pragma unroll
                for (int n = 0; n < 2; ++n) acc[a][b][m][n] = (f32x4){0.f, 0.f, 0.f, 0.f};
    bf16x8 At[4][2], B0[2][2], B1[2][2];
    const char* cA = (const char*)g.A + (size_t)cur.pm * tstepA; const char* cB = (const char*)g.Bt + (size_t)cur.pn * tstepB;
    PG8_STAGE(PG8_SB(0, 0), cB, voffB); PG8_STAGE(PG8_SB(0, 1), cB + hstepB, voffB); PG8_STAGE(PG8_SA(0, 0), cA, voffA); PG8_STAGE(PG8_SA(0, 1), cA + hstepA, voffA);
    if (wr == 1) PG8_BAR;
    PG8_WAIT_V(2); PG8_BAR;
    PG8_STAGE(PG8_SB(1, 0), cB + kstep, voffB); PG8_STAGE(PG8_SA(1, 0), cA + kstep, voffA); PG8_STAGE(PG8_SB(1, 1), cB + hstepB + kstep, voffB);
    PG8_WAIT_V(6); PG8_BAR;
    for (;;) {
        const bool has_next = S.next(ui + 1, nxt);
        const char* nA = has_next ? (const char*)g.A + (size_t)nxt.pm * tstepA : cA; const char* nB = has_next ? (const char*)g.Bt + (size_t)nxt.pn * tstepB : cB;
        for (int t = 0; t < nt; t += 2) {
            const bool last = (t == nt - 2);
            const char* a1 = cA + (size_t)(t + 1) * kstep;
            const char* a2 = last ? nA : cA + (size_t)(t + 2) * kstep; const char* b2 = last ? nB : cB + (size_t)(t + 2) * kstep;
            const char* a3 = a2 + kstep; const char* b3 = b2 + kstep;
            PG8_LDB(B0, 0, 0); PG8_LDB(B1, 0, 1); PG8_SCHED; PG8_LDA(At, 0, 0); PG8_STAGE(PG8_SA(1, 1), a1 + hstepA, voffA);
            PG8_WAIT_V(8); PG8_WAIT_L(0); PG8_BAR; PG8_MMA(0, 0, At, B0); PG8_MMA(0, 1, At, B1); PG8_BAR; PG8_SCHED;
            PG8_LDA(At, 0, 1); PG8_STAGE(PG8_SB(0, 0), b2, voffB); PG8_STAGE(PG8_SB(0, 1), b2 + hstepB, voffB); PG8_STAGE(PG8_SA(0, 0), a2, voffA);
            PG8_WAIT_V(8); PG8_WAIT_L(0); PG8_BAR; PG8_MMA(1, 0, At, B0); PG8_MMA(1, 1, At, B1); PG8_BAR; PG8_SCHED;
            PG8_LDB(B0, 1, 0); PG8_LDB(B1, 1, 1); PG8_SCHED; PG8_LDA(At, 1, 0); PG8_STAGE(PG8_SA(0, 1), a2 + hstepA, voffA);
            PG8_WAIT_V(8); PG8_WAIT_L(0); PG8_BAR; PG8_MMA(0, 0, At, B0); PG8_MMA(0, 1, At, B1); PG8_BAR; PG8_SCHED;
            PG8_LDA(At, 1, 1); PG8_STAGE(PG8_SB(1, 0), b3, voffB); PG8_STAGE(PG8_SB(1, 1), b3 + hstepB, voffB); PG8_STAGE(PG8_SA(1, 0), a3, voffA);
            PG8_WAIT_V(8); PG8_WAIT_L(0); PG8_BAR; PG8_MMA(1, 0, At, B0); PG8_MMA(1, 1, At, B1); PG8_BAR; PG8_SCHED;
        }
        if constexpr (ALIGN_EPI) { if (wr == 0) PG8_BAR; }
        E(acc, cur, wr, wc, fr, fq);
        if (!has_next) break;
#pragma unroll
        for (int a = 0; a < 2; ++a)
#pragma unroll
            for (int b = 0; b < 2; ++b)
#pragma unroll
                for (int m = 0; m < 4; ++m)
#pragma unroll
                    for (int n = 0; n < 2; ++n) acc[a][b][m][n] = (f32x4){0.f, 0.f, 0.f, 0.f};
        cur = nxt; cA = nA; cB = nB; ++ui;
        if constexpr (ALIGN_EPI) { if (wr == 1) PG8_BAR; }
    }
    PG8_WAIT_V(0);
    if constexpr (!ALIGN_EPI) { if (wr == 0) PG8_BAR; }
    PG8_BAR;
#undef PG8_SA
#undef PG8_SB
#undef PG8_STAGE
#undef PG8_LDA
#undef PG8_LDB
#undef PG8_MMA
#undef PG8_WAIT_V
#undef PG8_WAIT_L
#undef PG8_BAR
#undef PG8_SCHED
}
}

constexpr int NWAVES = 8, NTHR = 512;
constexpr int BATCH = 32, SEQ = 2048, D = 1024, T = BATCH * SEQ, MEM = 256, TM = BATCH * MEM;
constexpr int DIN = 5888;
constexpr float EPS = 1e-6f;
constexpr int LDP = DIN, C_Q = 0, C_U = 1024, C_QC = 1536, C_K = 2048, C_V = 2176, C_VB = 2304, C_G = 2816;
constexpr int NEXP = 32, TOPK = 4, NHALF = 2, TH = T / NHALF;
constexpr int PH = TH * TOPK + NEXP * 256;
constexpr int MAXTILE = PH / 256;

constexpr size_t MiB = 1u << 20;
constexpr size_t WS_CTL = 0, CTL_ZERO_BYTES = 1 * MiB;
constexpr size_t WS_ROPE = 1 * MiB;
constexpr size_t WS_WIN = 17 * MiB;
constexpr size_t WS_WO = 29 * MiB;
constexpr size_t WS_WMKV = 33 * MiB;
constexpr size_t WS_WOUT = 35 * MiB;
constexpr size_t WS_MEMN = 37 * MiB;
constexpr size_t WS_KV = 53 * MiB;
constexpr size_t WS_META = 69 * MiB;
constexpr size_t WS_H = 77 * MiB;
constexpr size_t WS_PROJ = 205 * MiB;
constexpr size_t WS_WGU = 205 * MiB;
constexpr size_t WS_WD = 333 * MiB;
constexpr size_t WS_H2S = 397 * MiB;
constexpr size_t WS_ACT = 669 * MiB;
constexpr size_t WS_END = 941 * MiB;
static_assert(WS_PROJ + (size_t)T * LDP * 2 <= WS_END && WS_H2S + (size_t)PH * 2048 <= WS_ACT && WS_ACT + (size_t)PH * 2048 <= WS_END, "ws map");
constexpr size_t MT_IDX = 0;
constexpr size_t MT_GATE = 1 * MiB;
constexpr size_t MT_SLOTOF = 2 * MiB;
constexpr size_t MT_STOK = 3 * MiB;
constexpr size_t MT_SGATE = 4 * MiB + 512 * 1024;
constexpr size_t MT_TILEE = 6 * MiB;
constexpr int CW_BAR = 4096;
constexpr int CW_CNT = 1024;
constexpr int CW_CUR = 1024 + 64;
constexpr int CW_START = 1024 + 128;
constexpr int CW_NTILE = 1024 + 192;

constexpr int RING_OFF = 0, RING_BYTES = 131072;
constexpr int LDSCTL_OFF = RING_BYTES, MISC_OFF = LDSCTL_OFF + 320;
constexpr int LDS_BYTES = 147456;

#define GAS __attribute__((address_space(1)))
#define LAS __attribute__((address_space(3)))
typedef unsigned short bf16;
typedef unsigned v4u __attribute__((ext_vector_type(4)));
typedef unsigned v2u __attribute__((ext_vector_type(2)));
typedef float f32x4 __attribute__((ext_vector_type(4)));
typedef GAS unsigned gu32;
#define RLX_AGENT __ATOMIC_RELAXED, __HIP_MEMORY_SCOPE_AGENT
#define LDS_WAIT() asm volatile("s_waitcnt lgkmcnt(0)" ::: "memory")
#define VM_WAIT() asm volatile("s_waitcnt vmcnt(0)" ::: "memory")
__device__ __forceinline__ unsigned f2bf(float f) { unsigned u = __builtin_bit_cast(unsigned, f); return (u + 0x7fffu + ((u >> 16) & 1u)) >> 16; }
__device__ __forceinline__ unsigned pk2(float lo, float hi) { return f2bf(lo) | (f2bf(hi) << 16); }
__device__ __forceinline__ float bf2f(bf16 b) { return __uint_as_float(((unsigned)b) << 16); }
__device__ __forceinline__ float blo(unsigned w) { return __uint_as_float(w << 16); }
__device__ __forceinline__ float bhi(unsigned w) { return __uint_as_float(w & 0xffff0000u); }

#define XB_TMO      128
#define XB_XCNT(j)  (256  + 64 * (j))
#define XB_XSUB(j)  (1280 + 64 * (j))
#define XB_XGEN(j)  (2304 + 64 * (j))
#define XB_TOP      3328
#define XB_TOPGEN   3392
#define XCD_BAR_WORDS 3456
#define XB_SPIN_CAP (1u << 22)
__device__ __forceinline__ unsigned xb_ld(unsigned* p)              { return __hip_atomic_load(p, __ATOMIC_RELAXED, __HIP_MEMORY_SCOPE_AGENT); }
__device__ __forceinline__ unsigned xb_add(unsigned* p, unsigned v) { return __hip_atomic_fetch_add(p, v, __ATOMIC_RELAXED, __HIP_MEMORY_SCOPE_AGENT); }
__device__ __forceinline__ unsigned xb_xcc_id() { return (unsigned)__builtin_amdgcn_s_getreg((3 << 11) | 20) & 0xFu; }
#define XB_SPIN(cond, bar) do { unsigned _sp = 0; while (cond) { __builtin_amdgcn_s_sleep(1); \
    if ((++_sp & 255u) == 0u) { if (xb_ld(&(bar)[XB_TMO])) break; if (_sp > XB_SPIN_CAP) { atomicAdd(&(bar)[XB_TMO], 1u); break; } } } } while (0)
struct XcdBarrier { unsigned* bar; unsigned x; volatile LAS unsigned* st; };
__device__ __forceinline__ XcdBarrier xcd_barrier_post(unsigned* bar, volatile LAS unsigned* st, bool leader) {
    XcdBarrier b; b.bar = bar; b.x = xb_xcc_id(); b.st = st;
    if (leader) (void)xb_add(&bar[XB_XCNT(b.x)], 1u);
    return b;
}
__device__ __forceinline__ void xcd_barrier_complete(unsigned* bar, unsigned x, unsigned& nloc, unsigned& nx) {
    const unsigned G = gridDim.x * gridDim.y * gridDim.z;
    unsigned sum, cnt, mine, sp = 0u;
    for (;;) {
        sum = 0u; cnt = 0u; mine = 0u;
#pragma unroll
        for (unsigned j = 0; j < 16; ++j) { const unsigned c = xb_ld(&bar[XB_XCNT(j)]); sum += c; cnt += (c > 0u) ? 1u : 0u; mine = (j == x) ? c : mine; }
        if (sum == G) break;
        __builtin_amdgcn_s_sleep(1);
        if ((++sp & 255u) == 0u) { if (xb_ld(&bar[XB_TMO])) break; if (sp > XB_SPIN_CAP) { atomicAdd(&bar[XB_TMO], 1u); break; } }
    }
    nloc = mine > 0u ? mine : 1u; nx = cnt > 0u ? cnt : 1u;
}
__device__ __forceinline__ void xcd_barrier(const XcdBarrier& b, bool leader) {
    asm volatile("s_waitcnt vmcnt(0)" ::: "memory");
    __syncthreads();
    if (leader) {
        unsigned* bar = b.bar;
        __builtin_amdgcn_s_waitcnt(0);
        unsigned nloc = b.st[0], nx = b.st[1];
        if (nloc == 0u) { xcd_barrier_complete(bar, b.x, nloc, nx); b.st[0] = nloc; b.st[1] = nx; }
        const unsigned old = xb_add(&bar[XB_XSUB(b.x)], 1u);
        const unsigned gen = old / nloc;
        if (old + 1u == (gen + 1u) * nloc) {
            __builtin_amdgcn_fence(__ATOMIC_RELEASE, "agent");
            asm volatile("s_waitcnt vmcnt(0)" ::: "memory");
            const unsigned og = xb_add(&bar[XB_TOP], 1u);
            const unsigned tg = og / nx;
            if (og + 1u == (tg + 1u) * nx) xb_add(&bar[XB_TOPGEN], 1u);
            else XB_SPIN(xb_ld(&bar[XB_TOPGEN]) == tg, bar);
            __builtin_amdgcn_fence(__ATOMIC_ACQUIRE, "agent");
            xb_add(&bar[XB_XGEN(b.x)], 1u);
            asm volatile("s_waitcnt vmcnt(0)" ::: "memory");
        } else {
            XB_SPIN(xb_ld(&bar[XB_XGEN(b.x)]) == gen, bar);
            __builtin_amdgcn_fence(__ATOMIC_ACQUIRE, "agent");
            asm volatile("s_waitcnt vmcnt(0)" ::: "memory");
        }
    }
    __syncthreads();
}

__device__ __forceinline__ float wave_sum(float v) {
#pragma unroll
    for (int o = 1; o < 64; o <<= 1) v += __shfl_xor(v, o);
    return v;
}
__device__ __forceinline__ float wave_max(float v) {
#pragma unroll
    for (int o = 1; o < 64; o <<= 1) v = fmaxf(v, __shfl_xor(v, o));
    return v;
}
__device__ __forceinline__ float half_sum(float v) {
#pragma unroll
    for (int o = 1; o < 32; o <<= 1) v += __shfl_xor(v, o);
    return v;
}
__device__ __forceinline__ float gelu_erf(float x) { return 0.5f * x * (1.0f + erff(x * 0.70710678118654752f)); }

struct Args {
    const float* in[28]; float* out; unsigned char* ws; int ph_lo, ph_hi;
};
enum { I_X = 0, I_MEM, I_POS, I_ATTN_G, I_MEM_G, I_WIN, I_BGATES, I_AQG, I_AKG, I_SINKS, I_WOA, I_LNG, I_LNB, I_WS, I_BS, I_WOB, I_WMKV, I_CQG, I_CKG, I_WOC, I_WOUT, I_FFN_G,
       I_RW, I_RB, I_WGU, I_BGU, I_WD, I_BD };

__device__ __forceinline__ void tr_item(const float* W, int ldw, int k0, int sc, bf16* WT, int ldt, int dr, int dk, LAS float* scr, int lane) {
#pragma unroll 8
    for (int i = 0; i < 32; ++i) { const int kk = 2 * i + (lane >> 5); scr[kk * 33 + (lane & 31)] = W[(size_t)(k0 + kk) * ldw + sc + (lane & 31)]; }
    LDS_WAIT(); asm volatile("" ::: "memory");
    const int c = lane & 7;
#pragma unroll
    for (int j = 0; j < 4; ++j) { const int n = (lane >> 3) + 8 * j; const LAS float* s = scr + (8 * c) * 33 + n;
        v4u o; o.x = pk2(s[0 * 33], s[1 * 33]); o.y = pk2(s[2 * 33], s[3 * 33]); o.z = pk2(s[4 * 33], s[5 * 33]); o.w = pk2(s[6 * 33], s[7 * 33]);
        *(GAS v4u*)(WT + (size_t)(dr + n) * ldt + dk + k0 + 8 * c) = o; }
    LDS_WAIT(); asm volatile("" ::: "memory");
}
__device__ __forceinline__ int win_srccol(int r) {
    if (r < 1024) return r;
    if (r < 1536) return 1280 + (r - 1024);
    if (r < 2048) return 2304 + (r - 1536);
    if (r < 2176) return 1024 + (r - 2048);
    if (r < 2304) return 1152 + (r - 2176);
    if (r < 2816) return 1792 + (r - 2304);
    return r;
}
__device__ __forceinline__ void rms_row_to_bf16(const float* xrow, const float* g, bf16* orow, int lane) {
    const GAS f32x4* xr = (const GAS f32x4*)xrow + lane; const GAS f32x4* gr = (const GAS f32x4*)g + lane;
    f32x4 v[4]; float s = 0.f;
#pragma unroll
    for (int j = 0; j < 4; ++j) { v[j] = xr[64 * j]; s += (v[j].x * v[j].x + v[j].y * v[j].y) + (v[j].z * v[j].z + v[j].w * v[j].w); }
    const float rstd = 1.0f / sqrtf(wave_sum(s) * (1.f / 1024.f) + EPS);
    GAS v2u* o8 = (GAS v2u*)orow + lane;
#pragma unroll
    for (int j = 0; j < 4; ++j) { const f32x4 gg = gr[64 * j]; v2u o; o.x = pk2(v[j].x * rstd * gg.x, v[j].y * rstd * gg.y); o.y = pk2(v[j].z * rstd * gg.z, v[j].w * rstd * gg.w); o8[64 * j] = o; }
}

constexpr int NPHASE = 18;
__global__ void __launch_bounds__(NTHR, 2) fwd(Args args) {
    extern __shared__ __attribute__((aligned(16))) unsigned char lds[];
    LAS unsigned char* L = (LAS unsigned char*)lds;
    volatile LAS unsigned* MISC = (volatile LAS unsigned*)(L + MISC_OFF);
    const int wave_s = __builtin_amdgcn_readfirstlane((int)threadIdx.x >> 6);
    for (int u = threadIdx.x; u < (LDS_BYTES - LDSCTL_OFF) / 4; u += NTHR) ((LAS unsigned*)(L + LDSCTL_OFF))[u] = 0u;
    __syncthreads();
#define LANE_ID ((int)__builtin_amdgcn_mbcnt_hi(~0u, __builtin_amdgcn_mbcnt_lo(~0u, 0u)))
#if MK_FUSED
    XcdBarrier bar = xcd_barrier_post((unsigned*)(args.ws + WS_CTL) + CW_BAR, MISC + 8, wave_s == 0 && LANE_ID == 0);
#define GRID_BAR() xcd_barrier(bar, wave_s == 0 && LANE_ID == 0)
#else
    (void)MISC;
#define GRID_BAR() do {} while (0)
#endif
    const int lo = args.ph_lo, hi = args.ph_hi;
#define IN(k) (lo <= (k) && (k) < hi)
#define SEAM(k) do { if (IN(k) && IN((k) + 1)) GRID_BAR(); } while (0)
#define PV \
    int wave = wave_s; asm volatile("" : "+s"(wave)); int bid = blockIdx.x; asm volatile("" : "+s"(bid)); \
    const int lane = LANE_ID, tid = wave * 64 + lane; \
    const int G = gridDim.x, gw = bid * NWAVES + wave, NGW = G * NWAVES, gtid = bid * NTHR + tid, NT = G * NTHR; \
    unsigned char* ws = args.ws; asm volatile("" : "+s"(ws)); \
    gu32* ctl = (gu32*)(ws + WS_CTL); \
    LAS float* scr = (LAS float*)(L + RING_OFF + wave * 16384); \
    (void)lane; (void)tid; (void)bid; (void)gw; (void)NGW; (void)gtid; (void)NT; (void)ctl; (void)scr; (void)G;
#define Win_t ((bf16*)(ws + WS_WIN))
#define Wo_t ((bf16*)(ws + WS_WO))
#define Wmkv_t ((bf16*)(ws + WS_WMKV))
#define Wout_t ((bf16*)(ws + WS_WOUT))
#define Hb ((bf16*)(ws + WS_H))
#define proj ((bf16*)(ws + WS_PROJ))
#define memn ((bf16*)(ws + WS_MEMN))
#define kv ((bf16*)(ws + WS_KV))
#define rope ((float2*)(ws + WS_ROPE))
#define Wgu_t ((bf16*)(ws + WS_WGU))
#define Wd_t ((bf16*)(ws + WS_WD))
#define h2s ((bf16*)(ws + WS_H2S))
#define act ((bf16*)(ws + WS_ACT))
#define topk_idx ((int*)(ws + WS_META + MT_IDX))
#define topk_gate ((float*)(ws + WS_META + MT_GATE))
#define slot_of ((int*)(ws + WS_META + MT_SLOTOF))
#define slot_tok ((int*)(ws + WS_META + MT_STOK))
#define slot_gate ((float*)(ws + WS_META + MT_SGATE))
#define tile_e ((int*)(ws + WS_META + MT_TILEE))

    if (IN(0)) { PV
        const float* x = args.in[I_X]; (void)x;
        { const float* W = args.in[I_WIN]; constexpr int nrb = DIN / 32, nit = (D / 64) * nrb;
          for (int it = gw; it < nit; it += NGW) { const int kb = it / nrb, rb = it % nrb; tr_item(W, DIN, 64 * kb, win_srccol(32 * rb), Win_t, D, 32 * rb, 0, scr, lane); } }
        { const float* W = args.in[I_WOA]; constexpr int nrb = D / 32, nit = (1024 / 64) * nrb;
          for (int it = gw; it < nit; it += NGW) { const int kb = it / nrb, rb = it % nrb; tr_item(W, D, 64 * kb, 32 * rb, Wo_t, 2048, 32 * rb, 0, scr, lane); } }
        { const float* W = args.in[I_WOB]; constexpr int nrb = D / 32, nit = (512 / 64) * nrb;
          for (int it = gw; it < nit; it += NGW) { const int kb = it / nrb, rb = it % nrb; tr_item(W, D, 64 * kb, 32 * rb, Wo_t, 2048, 32 * rb, 1024, scr, lane); } }
        { const float* W = args.in[I_WOC]; constexpr int nrb = D / 32, nit = (512 / 64) * nrb;
          for (int it = gw; it < nit; it += NGW) { const int kb = it / nrb, rb = it % nrb; tr_item(W, D, 64 * kb, 32 * rb, Wo_t, 2048, 32 * rb, 1536, scr, lane); } }
        { const float* W = args.in[I_WMKV]; constexpr int nrb = D / 32, nit = (D / 64) * nrb;
          for (int it = gw; it < nit; it += NGW) { const int kb = it / nrb, rb = it % nrb; tr_item(W, D, 64 * kb, 32 * rb, Wmkv_t, D, 32 * rb, 0, scr, lane); } }
        { const float* W = args.in[I_WOUT]; constexpr int nrb = D / 32, nit = (D / 64) * nrb;
          for (int it = gw; it < nit; it += NGW) { const int kb = it / nrb, rb = it % nrb; tr_item(W, D, 64 * kb, 32 * rb, Wout_t, D, 32 * rb, 0, scr, lane); } }
        { const int* pos = (const int*)args.in[I_POS];
          for (int i = gtid; i < T * 32; i += NT) { const int t = i >> 5, f = i & 31;
              const float inv = powf(10000.0f, -(float)(2 * f) / 64.0f); const float ang = (float)pos[t] * inv;
              double sn, cs; sincos((double)ang, &sn, &cs); rope[i] = make_float2((float)cs, (float)sn); } }
        for (int m = gw; m < T; m += NGW) rms_row_to_bf16(x + (size_t)m * D, args.in[I_ATTN_G], Hb + (size_t)m * D, lane);
        for (int m = gw; m < TM; m += NGW) rms_row_to_bf16(args.in[I_MEM] + (size_t)m * D, args.in[I_MEM_G], memn + (size_t)m * D, lane);
    }
    SEAM(0);
    if (IN(1)) { PV
        { pg8::Gemm g{Hb, Win_t, D, D, D}; pg8::StaticOrder S; S.init(T, DIN, G, bid); pg8::EpiBf16 E{proj, LDP};
          pg8::gemm_phase<pg8::EpiBf16, pg8::StaticOrder>(L + RING_OFF, g, S, E, wave); }
        { pg8::Gemm g{memn, Wmkv_t, D, D, D}; pg8::StaticOrder S; S.init(TM, D, G, bid); pg8::EpiBf16 E{kv, D};
          pg8::gemm_phase<pg8::EpiBf16, pg8::StaticOrder>(L + RING_OFF, g, S, E, wave); }
    }
    SEAM(1);
    if (IN(2)) { PV
        const int hw = lane >> 5, hl = lane & 31;
        for (int t = gw; t < T; t += NGW) {
            bf16* row = proj + (size_t)t * LDP;
            const float2 cs = rope[t * 32 + hl];
#pragma unroll 1
            for (int it = 0; it < 9; ++it) {
                const int hd = 2 * it + hw; const bool isk = hd >= 16;
                bf16* hp = row + (isk ? C_K + 64 * (hd - 16) : C_Q + 64 * hd);
                const float* gn = isk ? args.in[I_AKG] : args.in[I_AQG];
                const float x1 = bf2f(hp[hl]), x2 = bf2f(hp[hl + 32]);
                const float ss = half_sum(x1 * x1 + x2 * x2);
                const float rstd = 1.0f / sqrtf(ss * (1.f / 64.f) + EPS);
                const float y1 = x1 * rstd * gn[hl], y2 = x2 * rstd * gn[hl + 32];
                hp[hl] = (bf16)f2bf(y1 * cs.x - y2 * cs.y); hp[hl + 32] = (bf16)f2bf(y2 * cs.x + y1 * cs.y);
            }
#pragma unroll 1
            for (int it = 0; it < 2; ++it) {
                const int hd = 2 * it + hw; bf16* hp = row + C_QC + 128 * hd + 4 * hl;
                const v2u w = *(const v2u*)hp; const float a = blo(w.x), b = bhi(w.x), c = blo(w.y), d = bhi(w.y);
                const float ss = half_sum((a * a + b * b) + (c * c + d * d));
                const float rstd = 1.0f / sqrtf(ss * (1.f / 128.f) + EPS);
                const f32x4 gg = *(const f32x4*)(args.in[I_CQG] + 4 * hl);
                v2u o; o.x = pk2(a * rstd * gg.x, b * rstd * gg.y); o.y = pk2(c * rstd * gg.z, d * rstd * gg.w); *(v2u*)hp = o;
            }
            { bf16* up = row + C_U + 8 * lane; const v4u w = *(const v4u*)up;
              v4u o; o.x = pk2(gelu_erf(blo(w.x)), gelu_erf(bhi(w.x))); o.y = pk2(gelu_erf(blo(w.y)), gelu_erf(bhi(w.y)));
              o.z = pk2(gelu_erf(blo(w.z)), gelu_erf(bhi(w.z))); o.w = pk2(gelu_erf(blo(w.w)), gelu_erf(bhi(w.w))); *(v4u*)up = o; }
            { bf16* vp = row + C_VB + 8 * lane; const v4u w = *(const v4u*)vp;
              float v[8] = {gelu_erf(blo(w.x)), gelu_erf(bhi(w.x)), gelu_erf(blo(w.y)), gelu_erf(bhi(w.y)), gelu_erf(blo(w.z)), gelu_erf(bhi(w.z)), gelu_erf(blo(w.w)), gelu_erf(bhi(w.w))};
              float s = 0.f;
#pragma unroll
              for (int i = 0; i < 8; ++i) s += v[i];
              const float mu = wave_sum(s) * (1.f / 512.f); float q = 0.f;
#pragma unroll
              for (int i = 0; i < 8; ++i) { v[i] -= mu; q += v[i] * v[i]; }
              const float rstd = 1.0f / sqrtf(wave_sum(q) * (1.f / 512.f) + EPS);
              const float* lg = args.in[I_LNG] + 8 * lane; const float* lb = args.in[I_LNB] + 8 * lane;
              float o[8];
#pragma unroll
              for (int i = 0; i < 8; ++i) o[i] = v[i] * rstd * lg[i] + lb[i];
              v4u ow; ow.x = pk2(o[0], o[1]); ow.y = pk2(o[2], o[3]); ow.z = pk2(o[4], o[5]); ow.w = pk2(o[6], o[7]); *(v4u*)vp = ow; }
        }
        for (int m = gw; m < TM; m += NGW) {
            bf16* row = kv + (size_t)m * D;
#pragma unroll 1
            for (int it = 0; it < 2; ++it) {
                const int hd = 2 * it + hw; bf16* hp = row + 128 * hd + 4 * hl;
                const v2u w = *(const v2u*)hp; const float a = blo(w.x), b = bhi(w.x), c = blo(w.y), d = bhi(w.y);
                const float ss = half_sum((a * a + b * b) + (c * c + d * d));
                const float rstd = 1.0f / sqrtf(ss * (1.f / 128.f) + EPS);
                const f32x4 gg = *(const f32x4*)(args.in[I_CKG] + 4 * hl);
                v2u o; o.x = pk2(a * rstd * gg.x, b * rstd * gg.y); o.y = pk2(c * rstd * gg.z, d * rstd * gg.w); *(v2u*)hp = o;
            }
        }
    }
    SEAM(2);
    if (IN(3)) { PV
        LAS float* pw = (LAS float*)(L + RING_OFF + wave * 2048);
        for (int item = gw; item < T * 16; item += NGW) {
            const int t = item >> 4, hd = item & 15, s = t & (SEQ - 1), kvh = hd >> 3;
            bf16* qp = proj + (size_t)t * LDP + C_Q + 64 * hd;
            float q[64];
#pragma unroll
            for (int j = 0; j < 8; ++j) { const v4u w = *(const v4u*)(qp + 8 * j); q[8 * j] = blo(w.x); q[8 * j + 1] = bhi(w.x); q[8 * j + 2] = blo(w.y); q[8 * j + 3] = bhi(w.y); q[8 * j + 4] = blo(w.z); q[8 * j + 5] = bhi(w.z); q[8 * j + 6] = blo(w.w); q[8 * j + 7] = bhi(w.w); }
            const int s0 = s >= 127 ? s - 127 : 0, nk = s - s0 + 1, t0 = t - (s - s0);
            float lg[2];
#pragma unroll
            for (int r = 0; r < 2; ++r) {
                const int kk = lane + 64 * r; float d = -INFINITY;
                if (kk < nk) { const bf16* kp = proj + (size_t)(t0 + kk) * LDP + C_K + 64 * kvh; d = 0.f;
#pragma unroll
                    for (int j = 0; j < 8; ++j) { const v4u w = *(const v4u*)(kp + 8 * j);
                        d += q[8 * j] * blo(w.x) + q[8 * j + 1] * bhi(w.x) + q[8 * j + 2] * blo(w.y) + q[8 * j + 3] * bhi(w.y) + q[8 * j + 4] * blo(w.z) + q[8 * j + 5] * bhi(w.z) + q[8 * j + 6] * blo(w.w) + q[8 * j + 7] * bhi(w.w); }
                    d *= 0.125f; }
                lg[r] = d;
            }
            const float sink = args.in[I_SINKS][hd];
            const float mx = fmaxf(wave_max(fmaxf(lg[0], lg[1])), sink);
            const float p0 = expf(lg[0] - mx), p1 = expf(lg[1] - mx);
            const float den = wave_sum(p0 + p1) + expf(sink - mx);
            pw[lane] = p0; pw[lane + 64] = p1;
            LDS_WAIT(); asm volatile("" ::: "memory");
            float o = 0.f;
            const bf16* vp = proj + (size_t)t0 * LDP + C_V + 64 * kvh + lane;
            for (int kk = 0; kk < nk; ++kk) o += pw[kk] * bf2f(vp[(size_t)kk * LDP]);
            qp[lane] = (bf16)f2bf(o / den);
            LDS_WAIT(); asm volatile("" ::: "memory");
        }
        for (int idx = gtid; idx < T * 512; idx += NT) {
            const int t = idx >> 9, c = idx & 511, ti = t & 127, g = c >> 7, tc0 = t - ti;
            const float* wrow = args.in[I_WS] + (size_t)(g * 128 + ti) * 128;
            float a = args.in[I_BS][g * 128 + ti];
            const bf16* vp = proj + (size_t)tc0 * LDP + C_VB + c;
            for (int sp = 0; sp <= ti; ++sp) a += wrow[sp] * bf2f(vp[(size_t)sp * LDP]);
            bf16* up = proj + (size_t)t * LDP + C_U + c;
            *up = (bf16)f2bf(bf2f(*up) * a);
        }
        for (int item = gw; item < T * 4; item += NGW) {
            const int t = item >> 2, hd = item & 3, b = t >> 11;
            bf16* qp = proj + (size_t)t * LDP + C_QC + 128 * hd;
            const bf16* kb = kv + (size_t)b * MEM * D + 128 * hd;
            float lg[4];
#pragma unroll
            for (int r = 0; r < 4; ++r) lg[r] = 0.f;
#pragma unroll 1
            for (int j = 0; j < 16; ++j) {
                const v4u w = *(const v4u*)(qp + 8 * j);
                const float q0 = blo(w.x), q1 = bhi(w.x), q2 = blo(w.y), q3 = bhi(w.y), q4 = blo(w.z), q5 = bhi(w.z), q6 = blo(w.w), q7 = bhi(w.w);
#pragma unroll
                for (int r = 0; r < 4; ++r) { const v4u k = *(const v4u*)(kb + (size_t)(lane + 64 * r) * D + 8 * j);
                    lg[r] += q0 * blo(k.x) + q1 * bhi(k.x) + q2 * blo(k.y) + q3 * bhi(k.y) + q4 * blo(k.z) + q5 * bhi(k.z) + q6 * blo(k.w) + q7 * bhi(k.w); }
            }
            const float sc = 0.08838834764831845f;
#pragma unroll
            for (int r = 0; r < 4; ++r) lg[r] *= sc;
            const float mx = wave_max(fmaxf(fmaxf(lg[0], lg[1]), fmaxf(lg[2], lg[3])));
            float p[4], ps = 0.f;
#pragma unroll
            for (int r = 0; r < 4; ++r) { p[r] = expf(lg[r] - mx); ps += p[r]; pw[lane + 64 * r] = p[r]; }
            const float den = wave_sum(ps);
            LDS_WAIT(); asm volatile("" ::: "memory");
            float o0 = 0.f, o1 = 0.f;
            const bf16* vb = kv + (size_t)b * MEM * D + 512 + 128 * hd + 2 * lane;
            for (int kk = 0; kk < MEM; ++kk) { const unsigned w = *(const unsigned*)(vb + (size_t)kk * D); const float pk = pw[kk]; o0 += pk * blo(w); o1 += pk * bhi(w); }
            *(unsigned*)(qp + 2 * lane) = pk2(o0 / den, o1 / den);
            LDS_WAIT(); asm volatile("" ::: "memory");
        }
    }
    SEAM(3);
    if (IN(4)) { PV
        pg8::StaticOrder S; S.init(T, D, G, bid);
        { pg8::Gemm g{proj + C_Q, Wo_t, 1024, LDP, 2048}; pg8::EpiMerge<0> E{Hb, D, proj + C_G, LDP, args.in[I_BGATES]};
          pg8::gemm_phase<pg8::EpiMerge<0>, pg8::StaticOrder>(L + RING_OFF, g, S, E, wave); }
        { pg8::Gemm g{proj + C_U, Wo_t + 1024, 512, LDP, 2048}; pg8::EpiMerge<1> E{Hb, D, proj + C_G + 1024, LDP, args.in[I_BGATES] + 1024};
          pg8::gemm_phase<pg8::EpiMerge<1>, pg8::StaticOrder>(L + RING_OFF, g, S, E, wave); }
        { pg8::Gemm g{proj + C_QC, Wo_t + 1536, 512, LDP, 2048}; pg8::EpiMerge<1> E{Hb, D, proj + C_G + 2048, LDP, args.in[I_BGATES] + 2048};
          pg8::gemm_phase<pg8::EpiMerge<1>, pg8::StaticOrder>(L + RING_OFF, g, S, E, wave); }
    }
    SEAM(4);
    if (IN(5)) { PV
        const float* x = args.in[I_X];
        pg8::Gemm g{Hb, Wout_t, D, D, D}; pg8::StaticOrder S; S.init(T, D, G, bid); pg8::EpiResF32 E{args.out, x, D};
        pg8::gemm_phase<pg8::EpiResF32, pg8::StaticOrder>(L + RING_OFF, g, S, E, wave);
    }
    SEAM(5);
    if (IN(6)) { PV
        for (int i = gtid; i < NHALF * PH; i += NT) { slot_tok[i] = -1; slot_gate[i] = 0.f; }
        const float* rw = args.in[I_RW]; const float* rb = args.in[I_RB]; const float* fg = args.in[I_FFN_G];
        for (int t = gw; t < T; t += NGW) {
            const GAS f32x4* xr = (const GAS f32x4*)(args.out + (size_t)t * D) + lane;
            f32x4 v[4]; float s = 0.f;
#pragma unroll
            for (int j = 0; j < 4; ++j) { v[j] = xr[64 * j]; s += (v[j].x * v[j].x + v[j].y * v[j].y) + (v[j].z * v[j].z + v[j].w * v[j].w); }
            const float rstd = 1.0f / sqrtf(wave_sum(s) * (1.f / 1024.f) + EPS);
            GAS v2u* o8 = (GAS v2u*)(Hb + (size_t)t * D) + lane;
            float lg[32];
#pragma unroll
            for (int e = 0; e < 32; ++e) lg[e] = 0.f;
#pragma unroll
            for (int j = 0; j < 4; ++j) { const f32x4 gg = *((const GAS f32x4*)fg + lane + 64 * j);
                v[j].x *= rstd * gg.x; v[j].y *= rstd * gg.y; v[j].z *= rstd * gg.z; v[j].w *= rstd * gg.w;
                v2u o; o.x = pk2(v[j].x, v[j].y); o.y = pk2(v[j].z, v[j].w); o8[64 * j] = o;
                const float* rwp = rw + (size_t)(4 * lane + 256 * j) * 32;
#pragma unroll
                for (int e4 = 0; e4 < 8; ++e4) {
                    const f32x4 w0 = *(const f32x4*)(rwp + 4 * e4), w1 = *(const f32x4*)(rwp + 32 + 4 * e4), w2 = *(const f32x4*)(rwp + 64 + 4 * e4), w3 = *(const f32x4*)(rwp + 96 + 4 * e4);
                    lg[4 * e4 + 0] += v[j].x * w0.x + v[j].y * w1.x + v[j].z * w2.x + v[j].w * w3.x;
                    lg[4 * e4 + 1] += v[j].x * w0.y + v[j].y * w1.y + v[j].z * w2.y + v[j].w * w3.y;
                    lg[4 * e4 + 2] += v[j].x * w0.z + v[j].y * w1.z + v[j].z * w2.z + v[j].w * w3.z;
                    lg[4 * e4 + 3] += v[j].x * w0.w + v[j].y * w1.w + v[j].z * w2.w + v[j].w * w3.w;
                } }
#pragma unroll
            for (int e = 0; e < 32; ++e) lg[e] = wave_sum(lg[e]) + rb[e];
            int bi[4]; float bv[4];
#pragma unroll
            for (int k = 0; k < 4; ++k) { float best = -INFINITY; int b = 0;
#pragma unroll
                for (int e = 0; e < 32; ++e) if (lg[e] > best) { best = lg[e]; b = e; }
                bi[k] = b; bv[k] = best;
#pragma unroll
                for (int e = 0; e < 32; ++e) lg[e] = (e == b) ? -INFINITY : lg[e]; }
            const float p1 = expf(bv[1] - bv[0]), p2 = expf(bv[2] - bv[0]), p3 = expf(bv[3] - bv[0]); const float inv = 1.0f / (1.0f + p1 + p2 + p3);
            if (lane < 4) { const int e = lane == 0 ? bi[0] : lane == 1 ? bi[1] : lane == 2 ? bi[2] : bi[3];
                const float gt = (lane == 0 ? 1.0f : lane == 1 ? p1 : lane == 2 ? p2 : p3) * inv;
                topk_idx[t * 4 + lane] = e; topk_gate[t * 4 + lane] = gt;
                atomicAdd((unsigned*)(ctl + CW_CNT) + (t / TH) * 32 + e, 1u); }
        }
        { const float* W = args.in[I_WGU]; constexpr int nrb = 2048 / 32, per = (D / 64) * nrb, nit = NEXP * per;
          for (int it = gw; it < nit; it += NGW) { const int e = it / per, r0 = it % per, kb = r0 / nrb, rb = r0 % nrb; const int r = 32 * rb, j = r >> 8, rr = r & 255;
              const int sc = rr < 128 ? 128 * j + rr : 1024 + 128 * j + (rr - 128);
              tr_item(W + (size_t)e * D * 2048, 2048, 64 * kb, sc, Wgu_t + (size_t)e * 2048 * D, D, r, 0, scr, lane); } }
        { const float* W = args.in[I_WD]; constexpr int nrb = D / 32, per = (D / 64) * nrb, nit = NEXP * per;
          for (int it = gw; it < nit; it += NGW) { const int e = it / per, r0 = it % per, kb = r0 / nrb, rb = r0 % nrb;
              tr_item(W + (size_t)e * D * D, D, 64 * kb, 32 * rb, Wd_t + (size_t)e * D * D, D, 32 * rb, 0, scr, lane); } }
    }
    SEAM(6);
    if (IN(7)) { PV
        if (bid == 0 && tid == 0) {
            for (int h = 0; h < NHALF; ++h) { int row = 0, ntile = 0;
                for (int e = 0; e < NEXP; ++e) { const int c = (int)__hip_atomic_load((unsigned*)(ctl + CW_CNT) + h * 32 + e, RLX_AGENT);
                    ((unsigned*)(ctl + CW_START))[h * 32 + e] = (unsigned)row; const int nt = (c + 255) >> 8;
                    for (int i = 0; i < nt; ++i) tile_e[h * 1024 + ntile + i] = e;
                    ntile += nt; row += nt * 256; }
                ((unsigned*)(ctl + CW_NTILE))[h] = (unsigned)ntile; }
        }
    }
    SEAM(7);
    for (int h = 0; h < NHALF; ++h) {
        const int pb = 8 + 5 * h;
#define stok (slot_tok + h * PH)
#define sgate (slot_gate + h * PH)
#define NTILE_H ((int)__hip_atomic_load((unsigned*)(ctl + CW_NTILE) + h, RLX_AGENT))
        if (IN(pb)) { PV
            for (int i = gtid; i < TH * TOPK; i += NT) { const int a = h * TH * TOPK + i; const int e = topk_idx[a];
                const unsigned pos = atomicAdd((unsigned*)(ctl + CW_CUR) + h * 32 + e, 1u);
                const int slot = (int)(((unsigned*)(ctl + CW_START))[h * 32 + e] + pos);
                stok[slot] = a >> 2; sgate[slot] = topk_gate[a]; slot_of[a] = slot; }
        }
        SEAM(pb);
        if (IN(pb + 1)) { PV const int ntile = NTILE_H;
            for (int r = gw; r < ntile * 256; r += NGW) { const int tok = stok[r];
                v4u a = {0u, 0u, 0u, 0u}, b = {0u, 0u, 0u, 0u};
                if (tok >= 0) { const GAS v4u* sp = (const GAS v4u*)(Hb + (size_t)tok * D) + lane; a = sp[0]; b = sp[64]; }
                GAS v4u* dp = (GAS v4u*)(h2s + (size_t)r * D) + lane; dp[0] = a; dp[64] = b; }
        }
        SEAM(pb + 1);
        if (IN(pb + 2)) { PV const int ntile = NTILE_H;
            pg8::Gemm g{h2s, Wgu_t, D, D, D}; pg8::GroupedOrder S{tile_e + h * 1024, ntile, 8, G, bid}; pg8::EpiSwiglu E{act, args.in[I_BGU]};
            pg8::gemm_phase<pg8::EpiSwiglu, pg8::GroupedOrder>(L + RING_OFF, g, S, E, wave);
        }
        SEAM(pb + 2);
        if (IN(pb + 3)) { PV const int ntile = NTILE_H;
            pg8::Gemm g{act, Wd_t, D, D, D}; pg8::GroupedOrder S{tile_e + h * 1024, ntile, 4, G, bid}; pg8::EpiDown E{h2s, args.in[I_BD], sgate};
            pg8::gemm_phase<pg8::EpiDown, pg8::GroupedOrder>(L + RING_OFF, g, S, E, wave);
        }
        SEAM(pb + 3);
        if (IN(pb + 4)) { PV
            for (int t = h * TH + gw; t < (h + 1) * TH; t += NGW) {
                const int s0 = slot_of[t * 4], s1 = slot_of[t * 4 + 1], s2 = slot_of[t * 4 + 2], s3 = slot_of[t * 4 + 3];
                GAS f32x4* op = (GAS f32x4*)(args.out + (size_t)t * D) + lane;
#pragma unroll
                for (int j = 0; j < 4; ++j) { f32x4 o = op[64 * j];
                    const v2u a = *((const GAS v2u*)(h2s + (size_t)s0 * D) + lane + 64 * j), b = *((const GAS v2u*)(h2s + (size_t)s1 * D) + lane + 64 * j);
                    const v2u c = *((const GAS v2u*)(h2s + (size_t)s2 * D) + lane + 64 * j), d = *((const GAS v2u*)(h2s + (size_t)s3 * D) + lane + 64 * j);
                    o.x += ((blo(a.x) + blo(b.x)) + blo(c.x)) + blo(d.x); o.y += ((bhi(a.x) + bhi(b.x)) + bhi(c.x)) + bhi(d.x);
                    o.z += ((blo(a.y) + blo(b.y)) + blo(c.y)) + blo(d.y); o.w += ((bhi(a.y) + bhi(b.y)) + bhi(c.y)) + bhi(d.y);
                    op[64 * j] = o; }
            }
        }
        if (h + 1 < NHALF) SEAM(pb + 4);
    }
#undef IN
#undef SEAM
}

extern "C" void kernel_launch(void* const* d_in, const int* in_sizes, int n_in, void* d_out, int out_size, void* d_ws, size_t ws_size, hipStream_t stream) {
    static int grid = 0;
    if (grid == 0) {
        if (n_in != 28 || out_size != T * D || ws_size < WS_END) { fprintf(stderr, "kernel_launch: unexpected shapes: n_in %d out %d ws %zu (need %zu)\n", n_in, out_size, ws_size, (size_t)WS_END); grid = -1; return; }
        int dev = 0, cus = 0, per_cu = 0;
        if (hipGetDevice(&dev) != hipSuccess || hipDeviceGetAttribute(&cus, hipDeviceAttributeMultiprocessorCount, dev) != hipSuccess) { grid = -1; return; }
        if (hipFuncSetAttribute((const void*)fwd, hipFuncAttributeMaxDynamicSharedMemorySize, LDS_BYTES) != hipSuccess) { fprintf(stderr, "kernel_launch: hipFuncSetAttribute failed\n"); grid = -1; return; }
        if (hipOccupancyMaxActiveBlocksPerMultiprocessor(&per_cu, (const void*)fwd, NTHR, LDS_BYTES) != hipSuccess || per_cu < 1) { fprintf(stderr, "kernel_launch: occupancy query says %d\n", per_cu); }
        (void)hipGetLastError();
        grid = cus;
    }
    if (grid < 0) return;
    if (hipMemsetAsync((char*)d_ws + WS_CTL, 0, CTL_ZERO_BYTES, stream) != hipSuccess) { fprintf(stderr, "kernel_launch: memset failed\n"); return; }
    Args a{};
    for (int i = 0; i < 28; ++i) a.in[i] = (const float*)d_in[i];
    a.out = (float*)d_out; a.ws = (unsigned char*)d_ws;
#if MK_FUSED
    a.ph_lo = 0; a.ph_hi = NPHASE;
    hipLaunchKernelGGL(fwd, dim3(grid), dim3(NTHR), LDS_BYTES, stream, a);
#else
    for (int p = 0; p < NPHASE; ++p) { a.ph_lo = p; a.ph_hi = p + 1; hipLaunchKernelGGL(fwd, dim3(grid), dim3(NTHR), LDS_BYTES, stream, a); }
#endif
    const hipError_t le = hipPeekAtLastError();
    if (le != hipSuccess) fprintf(stderr, "kernel_launch: launch failed: %s\n", hipGetErrorName(le));
}
```

```cpp
#include <hip/hip_runtime.h>
#include <cstdio>
#include <cstdint>

#ifndef MK_FUSED
#define MK_FUSED 1
#endif

namespace pg8 {
#define PG8_LAS __attribute__((address_space(3)))
typedef unsigned short bf16_t;
typedef short bf16x8 __attribute__((ext_vector_type(8)));
typedef float f32x4 __attribute__((ext_vector_type(4)));
typedef unsigned u32x4 __attribute__((ext_vector_type(4)));
typedef float f32x2 __attribute__((ext_vector_type(2)));
constexpr int BM = 256, BK = 64, HALF = 128, HTB = HALF * BK * 2, STAGE_BYTES = 8 * HTB, NXCD = 8, WGM = 8;

__host__ __device__ __forceinline__ int lds_byte(int r, int c) { const int st = (r >> 4) * 2 + (c >> 5), rr = r & 15, cc = c & 31, ob = rr * 64 + cc * 2; return st * 1024 + (ob ^ (((ob >> 9) & 1) << 5)); }
__host__ __device__ __forceinline__ void stage_rc(int b, int& R, int& C) { const int st = b / 1024, sb = b % 1024, swz = sb ^ (((sb >> 9) & 1) << 5); R = (st >> 1) * 16 + swz / 64; C = (st & 1) * 32 + (swz % 64) / 2; }
__host__ __device__ __forceinline__ int perm32(int rho) { const int n = rho >> 4, i = rho & 15; return 8 * (i >> 2) + 4 * n + (i & 3); }

struct Unit { int pm, pn; };
struct Gemm { const bf16_t* A; const bf16_t* Bt; int K, lda, ldb; };

struct StaticOrder {
    int nM, nN, nwg, G, c;
    __host__ __device__ void init(int M, int N, int G_, int c_) { nM = M / BM; nN = N / BM; nwg = nM * nN; G = G_; c = c_; }
    __host__ __device__ bool next(int i, Unit& u) const {
        const long L = (long)i * G + c; if (L >= nwg) return false;
        int wgid = (int)L; { const int q = nwg / NXCD, r = nwg % NXCD, xcd = wgid % NXCD, off = wgid / NXCD; wgid = (xcd < r ? xcd * (q + 1) : r * (q + 1) + (xcd - r) * q) + off; }
        const int nig = WGM * nN, gid = wgid / nig, fm = gid * WGM, gsz = (nM - fm) < WGM ? (nM - fm) : WGM;
        u.pm = fm + ((wgid % nig) % gsz); u.pn = (wgid % nig) / gsz; return true;
    }
};
struct GroupedOrder {
    const int* tile_e; int ntile, nN, G, c;
    __device__ bool next(int i, Unit& u) const {
        const unsigned L = (unsigned)i * (unsigned)G + (unsigned)c; if (L >= (unsigned)(ntile * nN)) return false;
        const int tile = (int)(L / (unsigned)nN), j = (int)(L % (unsigned)nN);
        u.pm = tile; u.pn = tile_e[tile] * nN + j; return true;
    }
};

__device__ __forceinline__ unsigned cvt_pk_bf16(float lo, float hi) { unsigned r; asm volatile("v_cvt_pk_bf16_f32 %0, %1, %2" : "=v"(r) : "v"(lo), "v"(hi)); return r; }
__device__ __forceinline__ float bflo(unsigned w) { return __uint_as_float(w << 16); }
__device__ __forceinline__ float bfhi(unsigned w) { return __uint_as_float(w & 0xffff0000u); }


struct EpiBf16 {
    static constexpr bool PERM = true;
    bf16_t* O; int ldc;
    __device__ __forceinline__ void operator()(const f32x4 (&acc)[2][2][4][2], const Unit& u, int wr, int wc, int fr, int fq) const {
        const int row0 = u.pm * BM + wr * 64 + fr, col0 = u.pn * BM + wc * 32 + 8 * fq;
#pragma unroll
        for (int ai = 0; ai < 2; ++ai)
#pragma unroll
            for (int m = 0; m < 4; ++m) { bf16_t* rowp = O + (size_t)(row0 + ai * HALF + m * 16) * ldc + col0;
#pragma unroll
                for (int bj = 0; bj < 2; ++bj) { const f32x4 v0 = acc[ai][bj][m][0], v1 = acc[ai][bj][m][1];
                    u32x4 w; w.x = cvt_pk_bf16(v0[0], v0[1]); w.y = cvt_pk_bf16(v0[2], v0[3]); w.z = cvt_pk_bf16(v1[0], v1[1]); w.w = cvt_pk_bf16(v1[2], v1[3]);
                    *(u32x4*)(rowp + bj * HALF) = w; } }
    }
};
template <int ACCUM> struct EpiMerge {
    static constexpr bool PERM = true;
    bf16_t* Mg; int ldm; const bf16_t* graw; int ldg; const float* gbias;
    __device__ __forceinline__ void operator()(const f32x4 (&acc)[2][2][4][2], const Unit& u, int wr, int wc, int fr, int fq) const {
        const int row0 = u.pm * BM + wr * 64 + fr, col0 = u.pn * BM + wc * 32 + 8 * fq;
#pragma unroll
        for (int bj = 0; bj < 2; ++bj) {
            const f32x4 b0 = *(const f32x4*)(gbias + col0 + bj * HALF), b1 = *(const f32x4*)(gbias + col0 + bj * HALF + 4);
#pragma unroll
            for (int ai = 0; ai < 2; ++ai)
#pragma unroll
                for (int m = 0; m < 4; ++m) {
                    const size_t r = (size_t)(row0 + ai * HALF + m * 16);
                    const u32x4 gw = *(const u32x4*)(graw + r * ldg + col0 + bj * HALF);
                    float g[8] = {bflo(gw.x) + b0[0], bfhi(gw.x) + b0[1], bflo(gw.y) + b0[2], bfhi(gw.y) + b0[3], bflo(gw.z) + b1[0], bfhi(gw.z) + b1[1], bflo(gw.w) + b1[2], bfhi(gw.w) + b1[3]};
                    float o[8];
#pragma unroll
                    for (int i = 0; i < 8; ++i) { const float sg = __builtin_amdgcn_rcpf(1.0f + __builtin_amdgcn_exp2f(-1.4426950408889634f * g[i])); o[i] = sg * (i < 4 ? acc[ai][bj][m][0][i] : acc[ai][bj][m][1][i - 4]); }
                    bf16_t* mp = Mg + r * ldm + col0 + bj * HALF;
                    if (ACCUM) { const u32x4 pw = *(const u32x4*)mp;
                        o[0] += bflo(pw.x); o[1] += bfhi(pw.x); o[2] += bflo(pw.y); o[3] += bfhi(pw.y); o[4] += bflo(pw.z); o[5] += bfhi(pw.z); o[6] += bflo(pw.w); o[7] += bfhi(pw.w); }
                    u32x4 w; w.x = cvt_pk_bf16(o[0], o[1]); w.y = cvt_pk_bf16(o[2], o[3]); w.z = cvt_pk_bf16(o[4], o[5]); w.w = cvt_pk_bf16(o[6], o[7]);
                    *(u32x4*)mp = w;
                }
        }
    }
};
struct EpiResF32 {
    static constexpr bool PERM = false;
    float* C; const float* R; int ldc;
    __device__ __forceinline__ void operator()(const f32x4 (&acc)[2][2][4][2], const Unit& u, int wr, int wc, int fr, int fq) const {
        const int row0 = u.pm * BM + wr * 64 + fr, col0 = u.pn * BM + wc * 32 + 4 * fq;
#pragma unroll
        for (int ai = 0; ai < 2; ++ai)
#pragma unroll
            for (int m = 0; m < 4; ++m) { const size_t ro = (size_t)(row0 + ai * HALF + m * 16) * ldc + col0;
#pragma unroll
                for (int bj = 0; bj < 2; ++bj)
#pragma unroll
                    for (int n = 0; n < 2; ++n) { const f32x4 rv = *(const f32x4*)(R + ro + bj * HALF + n * 16); *(f32x4*)(C + ro + bj * HALF + n * 16) = acc[ai][bj][m][n] + rv; } }
    }
};
struct EpiSwiglu {
    static constexpr bool PERM = true;
    bf16_t* act; const float* bgu;
    __device__ __forceinline__ void operator()(const f32x4 (&acc)[2][2][4][2], const Unit& u, int wr, int wc, int fr, int fq) const {
        const int e = u.pn >> 3, j = u.pn & 7;
        const int row0 = u.pm * BM + wr * 64 + fr, col0 = j * 128 + wc * 32 + 8 * fq;
        const float* bg = bgu + (size_t)e * 2048 + col0;
        const f32x4 g0 = *(const f32x4*)bg, g1 = *(const f32x4*)(bg + 4), u0 = *(const f32x4*)(bg + 1024), u1 = *(const f32x4*)(bg + 1028);
#pragma unroll
        for (int ai = 0; ai < 2; ++ai)
#pragma unroll
            for (int m = 0; m < 4; ++m) {
                float o[8];
#pragma unroll
                for (int i = 0; i < 8; ++i) {
                    float gt = (i < 4 ? acc[ai][0][m][0][i] + g0[i] : acc[ai][0][m][1][i - 4] + g1[i - 4]);
                    float up = (i < 4 ? acc[ai][1][m][0][i] + u0[i] : acc[ai][1][m][1][i - 4] + u1[i - 4]);
                    gt = fminf(gt, 7.0f); up = fminf(fmaxf(up, -7.0f), 7.0f);
                    const float sg = __builtin_amdgcn_rcpf(1.0f + __builtin_amdgcn_exp2f(-1.702f * 1.4426950408889634f * gt));
                    o[i] = (up + 1.0f) * (gt * sg);
                }
                u32x4 w; w.x = cvt_pk_bf16(o[0], o[1]); w.y = cvt_pk_bf16(o[2], o[3]); w.z = cvt_pk_bf16(o[4], o[5]); w.w = cvt_pk_bf16(o[6], o[7]);
                *(u32x4*)(act + (size_t)(row0 + ai * HALF + m * 16) * 1024 + col0) = w;
            }
    }
};
struct EpiDown {
    static constexpr bool PERM = true;
    bf16_t* Y; const float* bd; const float* sgate;
    __device__ __forceinline__ void operator()(const f32x4 (&acc)[2][2][4][2], const Unit& u, int wr, int wc, int fr, int fq) const {
        const int e = u.pn >> 2, j = u.pn & 3;
        const int row0 = u.pm * BM + wr * 64 + fr, col0 = j * 256 + wc * 32 + 8 * fq;
        const float* bp = bd + (size_t)e * 1024 + col0;
#pragma unroll
        for (int bj = 0; bj < 2; ++bj) {
            const f32x4 b0 = *(const f32x4*)(bp + bj * HALF), b1 = *(const f32x4*)(bp + bj * HALF + 4);
#pragma unroll
            for (int ai = 0; ai < 2; ++ai)
#pragma unroll
                for (int m = 0; m < 4; ++m) {
                    const int r = row0 + ai * HALF + m * 16; const float gs = sgate[r];
                    const f32x4 v0 = (acc[ai][bj][m][0] + b0) * gs, v1 = (acc[ai][bj][m][1] + b1) * gs;
                    u32x4 w; w.x = cvt_pk_bf16(v0[0], v0[1]); w.y = cvt_pk_bf16(v0[2], v0[3]); w.z = cvt_pk_bf16(v1[0], v1[1]); w.w = cvt_pk_bf16(v1[2], v1[3]);
                    *(u32x4*)(Y + (size_t)r * 1024 + col0 + bj * HALF) = w;
                }
        }
    }
};

template <class Epi, class Sched, bool ALIGN_EPI = true>
__device__ __forceinline__ void gemm_phase(PG8_LAS unsigned char* lds, const Gemm g, const Sched& S, const Epi& E, const int wid_in) {
    const int wid = __builtin_amdgcn_readfirstlane(wid_in), lane = (int)__builtin_amdgcn_mbcnt_hi(~0u, __builtin_amdgcn_mbcnt_lo(~0u, 0u)), tid = wid * 64 + lane, wr = wid >> 2, wc = wid & 3, fr = lane & 15, fq = lane >> 4;
    const int K = g.K, nt = K / BK;
    unsigned voffA[2], voffB[2];
#pragma unroll
    for (int i = 0; i < 2; ++i) { int R, C; stage_rc(tid * 16 + i * 8192, R, C); const int Rb = Epi::PERM ? ((R & ~31) + perm32(R & 31)) : R;
        voffA[i] = (unsigned)(R * g.lda + C) * 2u; voffB[i] = (unsigned)(Rb * g.ldb + C) * 2u; }
    const size_t kstep = (size_t)(BK * 2);
    const size_t hstepA = (size_t)HALF * g.lda * 2, hstepB = (size_t)HALF * g.ldb * 2;
    const size_t tstepA = 2 * hstepA, tstepB = 2 * hstepB;
    const unsigned ldsw = (unsigned)wid * 1024u;
    const int aoff = lds_byte(wr * 64 + fr, fq * 8), boff = lds_byte(wc * 32 + fr, fq * 8);
#define PG8_SA(b, h) (((b) * 2 + (h)) * HTB)
#define PG8_SB(b, h) ((4 + (b) * 2 + (h)) * HTB)
#define PG8_STAGE(bufoff, gbase, voff) do { _Pragma("unroll") for (int _i = 0; _i < 2; ++_i) \
        __builtin_amdgcn_global_load_lds((const unsigned*)((const char*)(gbase) + (voff)[_i]), (PG8_LAS unsigned*)(lds + (bufoff) + ldsw + _i * 8192), 16, 0, 0); } while (0)
#define PG8_LDA(dst, b, h) do { _Pragma("unroll") for (int m = 0; m < 4; ++m) _Pragma("unroll") for (int k = 0; k < 2; ++k) dst[m][k] = *(const PG8_LAS bf16x8*)(lds + PG8_SA(b, h) + aoff + m * 2048 + k * 1024); } while (0)
#define PG8_LDB(dst, b, h) do { _Pragma("unroll") for (int n = 0; n < 2; ++n) _Pragma("unroll") for (int k = 0; k < 2; ++k) dst[n][k] = *(const PG8_LAS bf16x8*)(lds + PG8_SB(b, h) + boff + n * 2048 + k * 1024); } while (0)
#define PG8_MMA(ai, bj, At, Bt) do { __builtin_amdgcn_s_setprio(1); _Pragma("unroll") for (int m = 0; m < 4; ++m) _Pragma("unroll") for (int n = 0; n < 2; ++n) _Pragma("unroll") for (int k = 0; k < 2; ++k) \
        acc[ai][bj][m][n] = __builtin_amdgcn_mfma_f32_16x16x32_bf16(Bt[n][k], At[m][k], acc[ai][bj][m][n], 0, 0, 0); __builtin_amdgcn_s_setprio(0); } while (0)
#define PG8_WAIT_V(n) asm volatile("s_waitcnt vmcnt(" #n ")" ::: "memory")
#define PG8_WAIT_L(n) asm volatile("s_waitcnt lgkmcnt(" #n ")" ::: "memory")
#define PG8_BAR __builtin_amdgcn_s_barrier()
#define PG8_SCHED __builtin_amdgcn_sched_barrier(0)
    Unit cur, nxt; int ui = 0;
    if (!S.next(0, cur)) return;
    f32x4 acc[2][2][4][2];
#pragma unroll
    for (int a = 0; a < 2; ++a)
#pragma unroll
        for (int b = 0; b < 2; ++b)
#pragma unroll
            for (int m = 0; m < 4; ++m)
#pragma unroll
                for (int n = 0; n < 2; ++n) acc[a][b][m][n] = (f32x4){0.f, 0.f, 0.f, 0.f};
    bf16x8 At[4][2], B0[2][2], B1[2][2];
    const char* cA = (const char*)g.A + (size_t)cur.pm * tstepA; const char* cB = (const char*)g.Bt + (size_t)cur.pn * tstepB;
    PG8_STAGE(PG8_SB(0, 0), cB, voffB); PG8_STAGE(PG8_SB(0, 1), cB + hstepB, voffB); PG8_STAGE(PG8_SA(0, 0), cA, voffA); PG8_STAGE(PG8_SA(0, 1), cA + hstepA, voffA);
    if (wr == 1) PG8_BAR;
    PG8_WAIT_V(2); PG8_BAR;
    PG8_STAGE(PG8_SB(1, 0), cB + kstep, voffB); PG8_STAGE(PG8_SA(1, 0), cA + kstep, voffA); PG8_STAGE(PG8_SB(1, 1), cB + hstepB + kstep, voffB);
    PG8_WAIT_V(6); PG8_BAR;
    for (;;) {
        const bool has_next = S.next(ui + 1, nxt);
        const char* nA = has_next ? (const char*)g.A + (size_t)nxt.pm * tstepA : cA; const char* nB = has_next ? (const char*)g.Bt + (size_t)nxt.pn * tstepB : cB;
        for (int t = 0; t < nt; t += 2) {
            const bool last = (t == nt - 2);
            const char* a1 = cA + (size_t)(t + 1) * kstep;
            const char* a2 = last ? nA : cA + (size_t)(t + 2) * kstep; const char* b2 = last ? nB : cB + (size_t)(t + 2) * kstep;
            const char* a3 = a2 + kstep; const char* b3 = b2 + kstep;
            PG8_LDB(B0, 0, 0); PG8_LDB(B1, 0, 1); PG8_SCHED; PG8_LDA(At, 0, 0); PG8_STAGE(PG8_SA(1, 1), a1 + hstepA, voffA);
            PG8_WAIT_V(8); PG8_WAIT_L(0); PG8_BAR; PG8_MMA(0, 0, At, B0); PG8_MMA(0, 1, At, B1); PG8_BAR; PG8_SCHED;
            PG8_LDA(At, 0, 1); PG8_STAGE(PG8_SB(0, 0), b2, voffB); PG8_STAGE(PG8_SB(0, 1), b2 + hstepB, voffB); PG8_STAGE(PG8_SA(0, 0), a2, voffA);
            PG8_WAIT_V(8); PG8_WAIT_L(0); PG8_BAR; PG8_MMA(1, 0, At, B0); PG8_MMA(1, 1, At, B1); PG8_BAR; PG8_SCHED;
            PG8_LDB(B0, 1, 0); PG8_LDB(B1, 1, 1); PG8_SCHED; PG8_LDA(At, 1, 0); PG8_STAGE(PG8_SA(0, 1), a2 + hstepA, voffA);
            PG8_WAIT_V(8); PG8_WAIT_L(0); PG8_BAR; PG8_MMA(0, 0, At, B0); PG8_MMA(0, 1, At, B1); PG8_BAR; PG8_SCHED;
            PG8_LDA(At, 1, 1); PG8_STAGE(PG8_SB(1, 0), b3, voffB); PG8_STAGE(PG8_SB(1, 1), b3 + hstepB, voffB); PG8_STAGE(PG8_SA(1, 0), a3, voffA);
            PG8_WAIT_V(8); PG8_WAIT_L(0); PG8_BAR; PG8_MMA(1, 0, At, B0); PG8_MMA(1, 1, At, B1); PG8_BAR; PG8_SCHED;
        }
        if constexpr (ALIGN_EPI) { if (wr == 0) PG8_BAR; }
        E(acc, cur, wr, wc, fr, fq);
        if (!has_next) break;
#pragma unroll
        for (int a = 0; a < 2; ++a)
#pragma unroll
            for (int b = 0; b < 2; ++b)
#pragma unroll
                for (int m = 0; m < 4; ++m)
#pragma unroll
                    for (int n = 0; n < 2; ++n) acc[a][b][m][n] = (f32x4){0.f, 0.f, 0.f, 0.f};
        cur = nxt; cA = nA; cB = nB; ++ui;
        if constexpr (ALIGN_EPI) { if (wr == 1) PG8_BAR; }
    }
    PG8_WAIT_V(0);
    if constexpr (!ALIGN_EPI) { if (wr == 0) PG8_BAR; }
    PG8_BAR;
#undef PG8_SA
#undef PG8_SB
#undef PG8_STAGE
#undef PG8_LDA
#undef PG8_LDB
#undef PG8_MMA
#undef PG8_WAIT_V
#undef PG8_WAIT_L
#undef PG8_BAR
#undef PG8_SCHED
}
}

constexpr int NWAVES = 8, NTHR = 512;
constexpr int BATCH = 32, SEQ = 2048, D = 1024, T = BATCH * SEQ, MEM = 256, TM = BATCH * MEM;
constexpr int DIN = 5888;
constexpr float EPS = 1e-6f;
constexpr int LDP = DIN, C_Q = 0, C_U = 1024, C_QC = 1536, C_K = 2048, C_V = 2176, C_VB = 2304, C_G = 2816;
constexpr int NEXP = 32, TOPK = 4, NHALF = 2, TH = T / NHALF;
constexpr int PH = TH * TOPK + NEXP * 256;
constexpr int MAXTILE = PH / 256;

constexpr size_t MiB = 1u << 20;
constexpr size_t WS_CTL = 0, CTL_ZERO_BYTES = 1 * MiB;
constexpr size_t WS_ROPE = 1 * MiB;
constexpr size_t WS_WIN = 17 * MiB;
constexpr size_t WS_WO = 29 * MiB;
constexpr size_t WS_WMKV = 33 * MiB;
constexpr size_t WS_WOUT = 35 * MiB;
constexpr size_t WS_MEMN = 37 * MiB;
constexpr size_t WS_KV = 53 * MiB;
constexpr size_t WS_META = 69 * MiB;
constexpr size_t WS_H = 77 * MiB;
constexpr size_t WS_PROJ = 205 * MiB;
constexpr size_t WS_WGU = 205 * MiB;
constexpr size_t WS_WD = 333 * MiB;
constexpr size_t WS_H2S = 397 * MiB;
constexpr size_t WS_ACT = 669 * MiB;
constexpr size_t WS_END = 941 * MiB;
static_assert(WS_PROJ + (size_t)T * LDP * 2 <= WS_END && WS_H2S + (size_t)PH * 2048 <= WS_ACT && WS_ACT + (size_t)PH * 2048 <= WS_END, "ws map");
constexpr size_t MT_IDX = 0;
constexpr size_t MT_GATE = 1 * MiB;
constexpr size_t MT_SLOTOF = 2 * MiB;
constexpr size_t MT_STOK = 3 * MiB;
constexpr size_t MT_SGATE = 4 * MiB + 512 * 1024;
constexpr size_t MT_TILEE = 6 * MiB;
constexpr size_t MT_WSB = 7 * MiB;
constexpr int CW_BAR = 4096;
constexpr int CW_CNT = 1024;
constexpr int CW_CUR = 1024 + 64;
constexpr int CW_START = 1024 + 128;
constexpr int CW_NTILE = 1024 + 192;

constexpr int RING_OFF = 0, RING_BYTES = 131072;
constexpr int LDS_BYTES = 147456;
constexpr int LDSCTL_OFF = LDS_BYTES - 1024, MISC_OFF = LDSCTL_OFF + 320;

#define GAS __attribute__((address_space(1)))
#define LAS __attribute__((address_space(3)))
typedef unsigned short bf16;
typedef unsigned v4u __attribute__((ext_vector_type(4)));
typedef unsigned v2u __attribute__((ext_vector_type(2)));
typedef float f32x4 __attribute__((ext_vector_type(4)));
typedef GAS unsigned gu32;
#define RLX_AGENT __ATOMIC_RELAXED, __HIP_MEMORY_SCOPE_AGENT
#define LDS_WAIT() asm volatile("s_waitcnt lgkmcnt(0)" ::: "memory")
#define VM_WAIT() asm volatile("s_waitcnt vmcnt(0)" ::: "memory")
__device__ __forceinline__ unsigned f2bf(float f) { unsigned u = __builtin_bit_cast(unsigned, f); return (u + 0x7fffu + ((u >> 16) & 1u)) >> 16; }
__device__ __forceinline__ unsigned pk2(float lo, float hi) { return f2bf(lo) | (f2bf(hi) << 16); }
__device__ __forceinline__ float bf2f(bf16 b) { return __uint_as_float(((unsigned)b) << 16); }
__device__ __forceinline__ float blo(unsigned w) { return __uint_as_float(w << 16); }
__device__ __forceinline__ float bhi(unsigned w) { return __uint_as_float(w & 0xffff0000u); }

#define XB_TMO      128
#define XB_XCNT(j)  (256  + 64 * (j))
#define XB_XSUB(j)  (1280 + 64 * (j))
#define XB_XGEN(j)  (2304 + 64 * (j))
#define XB_TOP      3328
#define XB_TOPGEN   3392
#define XCD_BAR_WORDS 3456
#define XB_SPIN_CAP (1u << 22)
__device__ __forceinline__ unsigned xb_ld(unsigned* p)              { return __hip_atomic_load(p, __ATOMIC_RELAXED, __HIP_MEMORY_SCOPE_AGENT); }
__device__ __forceinline__ unsigned xb_add(unsigned* p, unsigned v) { return __hip_atomic_fetch_add(p, v, __ATOMIC_RELAXED, __HIP_MEMORY_SCOPE_AGENT); }
__device__ __forceinline__ unsigned xb_xcc_id() { return (unsigned)__builtin_amdgcn_s_getreg((3 << 11) | 20) & 0xFu; }
#define XB_SPIN(cond, bar) do { unsigned _sp = 0; while (cond) { __builtin_amdgcn_s_sleep(1); \
    if ((++_sp & 255u) == 0u) { if (xb_ld(&(bar)[XB_TMO])) break; if (_sp > XB_SPIN_CAP) { atomicAdd(&(bar)[XB_TMO], 1u); break; } } } } while (0)
struct XcdBarrier { unsigned* bar; unsigned x; volatile LAS unsigned* st; };
__device__ __forceinline__ XcdBarrier xcd_barrier_post(unsigned* bar, volatile LAS unsigned* st, bool leader) {
    XcdBarrier b; b.bar = bar; b.x = xb_xcc_id(); b.st = st;
    if (leader) (void)xb_add(&bar[XB_XCNT(b.x)], 1u);
    return b;
}
__device__ __forceinline__ void xcd_barrier_complete(unsigned* bar, unsigned x, unsigned& nloc, unsigned& nx) {
    const unsigned G = gridDim.x * gridDim.y * gridDim.z;
    unsigned sum, cnt, mine, sp = 0u;
    for (;;) {
        sum = 0u; cnt = 0u; mine = 0u;
#pragma unroll
        for (unsigned j = 0; j < 16; ++j) { const unsigned c = xb_ld(&bar[XB_XCNT(j)]); sum += c; cnt += (c > 0u) ? 1u : 0u; mine = (j == x) ? c : mine; }
        if (sum == G) break;
        __builtin_amdgcn_s_sleep(1);
        if ((++sp & 255u) == 0u) { if (xb_ld(&bar[XB_TMO])) break; if (sp > XB_SPIN_CAP) { atomicAdd(&bar[XB_TMO], 1u); break; } }
    }
    nloc = mine > 0u ? mine : 1u; nx = cnt > 0u ? cnt : 1u;
}
__device__ __forceinline__ void xcd_barrier(const XcdBarrier& b, bool leader) {
    asm volatile("s_waitcnt vmcnt(0)" ::: "memory");
    __syncthreads();
    if (leader) {
        unsigned* bar = b.bar;
        __builtin_amdgcn_s_waitcnt(0);
        unsigned nloc = b.st[0], nx = b.st[1];
        if (nloc == 0u) { xcd_barrier_complete(bar, b.x, nloc, nx); b.st[0] = nloc; b.st[1] = nx; }
        const unsigned old = xb_add(&bar[XB_XSUB(b.x)], 1u);
        const unsigned gen = old / nloc;
        if (old + 1u == (gen + 1u) * nloc) {
            __builtin_amdgcn_fence(__ATOMIC_RELEASE, "agent");
            asm volatile("s_waitcnt vmcnt(0)" ::: "memory");
            const unsigned og = xb_add(&bar[XB_TOP], 1u);
            const unsigned tg = og / nx;
            if (og + 1u == (tg + 1u) * nx) xb_add(&bar[XB_TOPGEN], 1u);
            else XB_SPIN(xb_ld(&bar[XB_TOPGEN]) == tg, bar);
            __builtin_amdgcn_fence(__ATOMIC_ACQUIRE, "agent");
            xb_add(&bar[XB_XGEN(b.x)], 1u);
            asm volatile("s_waitcnt vmcnt(0)" ::: "memory");
        } else {
            XB_SPIN(xb_ld(&bar[XB_XGEN(b.x)]) == gen, bar);
            __builtin_amdgcn_fence(__ATOMIC_ACQUIRE, "agent");
            asm volatile("s_waitcnt vmcnt(0)" ::: "memory");
        }
    }
    __syncthreads();
}

__device__ __forceinline__ float wave_sum(float v) {
#pragma unroll
    for (int o = 1; o < 64; o <<= 1) v += __shfl_xor(v, o);
    return v;
}
__device__ __forceinline__ float wave_max(float v) {
#pragma unroll
    for (int o = 1; o < 64; o <<= 1) v = fmaxf(v, __shfl_xor(v, o));
    return v;
}
__device__ __forceinline__ float half_sum(float v) {
#pragma unroll
    for (int o = 1; o < 32; o <<= 1) v += __shfl_xor(v, o);
    return v;
}
__device__ __forceinline__ float gelu_erf(float x) { return 0.5f * x * (1.0f + erff(x * 0.70710678118654752f)); }

struct Args {
    const float* in[28]; float* out; unsigned char* ws; int ph_lo, ph_hi;
};
enum { I_X = 0, I_MEM, I_POS, I_ATTN_G, I_MEM_G, I_WIN, I_BGATES, I_AQG, I_AKG, I_SINKS, I_WOA, I_LNG, I_LNB, I_WS, I_BS, I_WOB, I_WMKV, I_CQG, I_CKG, I_WOC, I_WOUT, I_FFN_G,
       I_RW, I_RB, I_WGU, I_BGU, I_WD, I_BD };

__device__ __forceinline__ void tr_item(const float* W, int ldw, int k0, int sc, bf16* WT, int ldt, int dr, int dk, LAS float* scr, int lane) {
#pragma unroll 8
    for (int i = 0; i < 32; ++i) { const int kk = 2 * i + (lane >> 5); scr[kk * 33 + (lane & 31)] = W[(size_t)(k0 + kk) * ldw + sc + (lane & 31)]; }
    LDS_WAIT(); asm volatile("" ::: "memory");
    const int c = lane & 7;
#pragma unroll
    for (int j = 0; j < 4; ++j) { const int n = (lane >> 3) + 8 * j; const LAS float* s = scr + (8 * c) * 33 + n;
        v4u o; o.x = pk2(s[0 * 33], s[1 * 33]); o.y = pk2(s[2 * 33], s[3 * 33]); o.z = pk2(s[4 * 33], s[5 * 33]); o.w = pk2(s[6 * 33], s[7 * 33]);
        *(GAS v4u*)(WT + (size_t)(dr + n) * ldt + dk + k0 + 8 * c) = o; }
    LDS_WAIT(); asm volatile("" ::: "memory");
}
__device__ __forceinline__ int win_srccol(int r) {
    if (r < 1024) return r;
    if (r < 1536) return 1280 + (r - 1024);
    if (r < 2048) return 2304 + (r - 1536);
    if (r < 2176) return 1024 + (r - 2048);
    if (r < 2304) return 1152 + (r - 2176);
    if (r < 2816) return 1792 + (r - 2304);
    return r;
}
__device__ __forceinline__ void rms_row_to_bf16(const float* xrow, const float* g, bf16* orow, int lane) {
    const GAS f32x4* xr = (const GAS f32x4*)xrow + lane; const GAS f32x4* gr = (const GAS f32x4*)g + lane;
    f32x4 v[4]; float s = 0.f;
#pragma unroll
    for (int j = 0; j < 4; ++j) { v[j] = xr[64 * j]; s += (v[j].x * v[j].x + v[j].y * v[j].y) + (v[j].z * v[j].z + v[j].w * v[j].w); }
    const float rstd = 1.0f / sqrtf(wave_sum(s) * (1.f / 1024.f) + EPS);
    GAS v2u* o8 = (GAS v2u*)orow + lane;
#pragma unroll
    for (int j = 0; j < 4; ++j) { const f32x4 gg = gr[64 * j]; v2u o; o.x = pk2(v[j].x * rstd * gg.x, v[j].y * rstd * gg.y); o.y = pk2(v[j].z * rstd * gg.z, v[j].w * rstd * gg.w); o8[64 * j] = o; }
}

namespace att {
typedef short bf16x8 __attribute__((ext_vector_type(8)));
typedef short s16x4 __attribute__((ext_vector_type(4)));
typedef short v4i16_t __attribute__((ext_vector_type(4)));
typedef float f32x16 __attribute__((ext_vector_type(16)));
typedef float f32x2_t __attribute__((ext_vector_type(2)));
typedef __bf16 bf16x2_t __attribute__((ext_vector_type(2)));
#define ATT_MFMA(a, b, c) __builtin_amdgcn_mfma_f32_32x32x16_bf16((a), (b), (c), 0, 0, 0)
__device__ __forceinline__ unsigned cvtpk(float lo, float hi) { f32x2_t v = {lo, hi}; bf16x2_t b = __builtin_convertvector(v, bf16x2_t); return __builtin_bit_cast(unsigned, b); }
__device__ __forceinline__ s16x4 vtr(const LAS unsigned char* p) { return __builtin_bit_cast(s16x4, __builtin_amdgcn_ds_read_tr16_b64_v4i16((LAS v4i16_t*)p)); }
__device__ __forceinline__ int crow(int r, int h) { return (r & 3) + 8 * (r >> 2) + 4 * h; }
__device__ __forceinline__ bf16x8 pack8(float a0, float a1, float a2, float a3, float a4, float a5, float a6, float a7) {
    v4u w; w.x = cvtpk(a0, a1); w.y = cvtpk(a2, a3); w.z = cvtpk(a4, a5); w.w = cvtpk(a6, a7); return __builtin_bit_cast(bf16x8, w); }
constexpr float LOG2E = 1.4426950408889634f;
constexpr int SWA_KP = 144, SWA_VP = 192, SWA_K_OFF = 0, SWA_V_OFF = 256 * SWA_KP;

__device__ __forceinline__ void swa_phase(LAS unsigned char* L, bf16* projp, const float* sinks, const float* gq, const float* gk, int bid, int G, int wave, int lane) {
    const int tid = wave * 64 + lane, r32 = lane & 31, h = lane >> 5, blk16 = (lane >> 4) & 1, q4 = (lane & 15) >> 2, p4 = lane & 3;
    const float bnd = 8.0f * wave_max(fabsf(gq[lane])) * wave_max(fabsf(gk[lane]));
    for (int unit = bid; unit < 1024; unit += G) {
        const int blk = unit & 15, kvh = (unit >> 4) & 1, b = unit >> 5;
        const int tok0 = b * SEQ + blk * 128;
        __syncthreads();
        for (int it = (blk == 0 ? 2 : 0); it < 4; ++it) {
            const int row = (tid >> 3) + 64 * it, ch = tid & 7;
            const bf16* src = projp + (size_t)(tok0 - 128 + row) * LDP + 64 * kvh + 8 * ch;
            const v4u kx = *(const GAS v4u*)(src + C_K), vx = *(const GAS v4u*)(src + C_V);
            *(LAS v4u*)(L + SWA_K_OFF + row * SWA_KP + ch * 16) = kx;
            *(LAS v4u*)(L + SWA_V_OFF + row * SWA_VP + ch * 16) = vx;
        }
        __syncthreads();
        const int hd = kvh * 8 + wave;
        const float sink = sinks[hd];
        const float m2 = fmaxf(bnd, sink) * LOG2E;
        const float esink = __builtin_amdgcn_exp2f(sink * LOG2E - m2);
#pragma unroll 1
        for (int qi = 0; qi < 4; ++qi) {
            bf16* qrow = projp + (size_t)(tok0 + 32 * qi + r32) * LDP + C_Q + 64 * hd;
            bf16x8 qf[4];
#pragma unroll
            for (int ks = 0; ks < 4; ++ks) qf[ks] = *(const GAS bf16x8*)(qrow + 16 * ks + 8 * h);
            f32x16 o0, o1;
#pragma unroll
            for (int r = 0; r < 16; ++r) { o0[r] = 0.f; o1[r] = 0.f; }
            float lsum = 0.f;
            const int kt0 = (blk == 0) ? 4 : qi;
#pragma unroll 1
            for (int kt = kt0; kt <= qi + 4; ++kt) {
                f32x16 s;
#pragma unroll
                for (int r = 0; r < 16; ++r) s[r] = 0.f;
                const LAS unsigned char* kp = L + SWA_K_OFF + (32 * kt + r32) * SWA_KP + 16 * h;
#pragma unroll
                for (int ks = 0; ks < 4; ++ks) { const bf16x8 kf = *(const LAS bf16x8*)(kp + 32 * ks); s = ATT_MFMA(kf, qf[ks], s); }
                float p[16];
                const bool first = (kt == qi), lastt = (kt == qi + 4);
#pragma unroll
                for (int r = 0; r < 16; ++r) { const float e = __builtin_amdgcn_exp2f(s[r] * (0.125f * LOG2E) - m2); const int cr = crow(r, h);
                    const bool ok = (!first || cr > r32) && (!lastt || cr <= r32); p[r] = ok ? e : 0.f; lsum += p[r]; }
#pragma unroll
                for (int s2 = 0; s2 < 2; ++s2) {
                    const bf16x8 pb = pack8(p[8 * s2], p[8 * s2 + 1], p[8 * s2 + 2], p[8 * s2 + 3], p[8 * s2 + 4], p[8 * s2 + 5], p[8 * s2 + 6], p[8 * s2 + 7]);
                    const LAS unsigned char* vp = L + SWA_V_OFF + (32 * kt + 16 * s2 + 4 * h + q4) * SWA_VP + (16 * blk16 + 4 * p4) * 2;
                    { const s16x4 lo = vtr(vp), hi = vtr(vp + 8 * SWA_VP); const bf16x8 vf = __builtin_shufflevector(lo, hi, 0, 1, 2, 3, 4, 5, 6, 7); o0 = ATT_MFMA(vf, pb, o0); }
                    { const s16x4 lo = vtr(vp + 64), hi = vtr(vp + 64 + 8 * SWA_VP); const bf16x8 vf = __builtin_shufflevector(lo, hi, 0, 1, 2, 3, 4, 5, 6, 7); o1 = ATT_MFMA(vf, pb, o1); }
                }
            }
            const float tot = lsum + __shfl_xor(lsum, 32); const float inv = 1.0f / (tot + esink);
#pragma unroll
            for (int g4 = 0; g4 < 4; ++g4) {
                v2u w0; w0.x = cvtpk(o0[4 * g4] * inv, o0[4 * g4 + 1] * inv); w0.y = cvtpk(o0[4 * g4 + 2] * inv, o0[4 * g4 + 3] * inv);
                v2u w1; w1.x = cvtpk(o1[4 * g4] * inv, o1[4 * g4 + 1] * inv); w1.y = cvtpk(o1[4 * g4 + 2] * inv, o1[4 * g4 + 3] * inv);
                *(GAS v2u*)(qrow + 8 * g4 + 4 * h) = w0; *(GAS v2u*)(qrow + 32 + 8 * g4 + 4 * h) = w1;
            }
        }
    }
}

constexpr int GM_P = 1088;
__device__ __forceinline__ void gmlp_phase(LAS unsigned char* L, bf16* projp, const bf16* Wb, const float* lng, const float* lnb, const float* bs, int bid, int G, int wave, int lane) {
    const int r32 = lane & 31, h = lane >> 5, blk16 = (lane >> 4) & 1, q4 = (lane & 15) >> 2, p4 = lane & 3;
    float lg[8], lb[8];
    { const f32x4 a = *(const f32x4*)(lng + 8 * lane), b = *(const f32x4*)(lng + 8 * lane + 4), c = *(const f32x4*)(lnb + 8 * lane), d = *(const f32x4*)(lnb + 8 * lane + 4);
      lg[0] = a.x; lg[1] = a.y; lg[2] = a.z; lg[3] = a.w; lg[4] = b.x; lg[5] = b.y; lg[6] = b.z; lg[7] = b.w;
      lb[0] = c.x; lb[1] = c.y; lb[2] = c.z; lb[3] = c.w; lb[4] = d.x; lb[5] = d.y; lb[6] = d.z; lb[7] = d.w; }
    for (int unit = bid; unit < T / 128; unit += G) {
        const int tok0 = unit * 128;
        __syncthreads();
#pragma unroll 4
        for (int i = 0; i < 16; ++i) { const int t = 16 * wave + i;
            const v4u w = *(const GAS v4u*)(projp + (size_t)(tok0 + t) * LDP + C_VB + 8 * lane);
            float v[8] = {blo(w.x), bhi(w.x), blo(w.y), bhi(w.y), blo(w.z), bhi(w.z), blo(w.w), bhi(w.w)};
            float sm = 0.f;
#pragma unroll
            for (int e = 0; e < 8; ++e) sm += v[e];
            const float mu = wave_sum(sm) * (1.f / 512.f); float q = 0.f;
#pragma unroll
            for (int e = 0; e < 8; ++e) { v[e] -= mu; q += v[e] * v[e]; }
            const float rstd = 1.0f / sqrtf(wave_sum(q) * (1.f / 512.f) + EPS);
            v4u o; o.x = cvtpk(v[0] * rstd * lg[0] + lb[0], v[1] * rstd * lg[1] + lb[1]); o.y = cvtpk(v[2] * rstd * lg[2] + lb[2], v[3] * rstd * lg[3] + lb[3]);
            o.z = cvtpk(v[4] * rstd * lg[4] + lb[4], v[5] * rstd * lg[5] + lb[5]); o.w = cvtpk(v[6] * rstd * lg[6] + lb[6], v[7] * rstd * lg[7] + lb[7]);
            *(LAS v4u*)(L + t * GM_P + lane * 16) = o; }
        __syncthreads();
        const int g = wave >> 1, th = wave & 1;
        f32x16 acc[4][2];
#pragma unroll
        for (int ct = 0; ct < 4; ++ct)
#pragma unroll
            for (int tt = 0; tt < 2; ++tt)
#pragma unroll
                for (int r = 0; r < 16; ++r) acc[ct][tt][r] = 0.f;
#pragma unroll 1
        for (int ks = 0; ks < 4 * th + 4; ++ks) {
            bf16x8 af[4];
#pragma unroll
            for (int ct = 0; ct < 4; ++ct) { const LAS unsigned char* vp = L + (16 * ks + 8 * h + q4) * GM_P + (128 * g + 32 * ct + 16 * blk16 + 4 * p4) * 2;
                const s16x4 lo = vtr(vp), hi = vtr(vp + 4 * GM_P); af[ct] = __builtin_shufflevector(lo, hi, 0, 1, 2, 3, 4, 5, 6, 7); }
#pragma unroll
            for (int tt = 0; tt < 2; ++tt) if (ks < 4 * th + 2 * tt + 2) {
                const bf16x8 bfr = *(const GAS bf16x8*)(Wb + (size_t)(g * 128 + 64 * th + 32 * tt + r32) * 128 + 16 * ks + 8 * h);
#pragma unroll
                for (int ct = 0; ct < 4; ++ct) acc[ct][tt] = ATT_MFMA(af[ct], bfr, acc[ct][tt]);
            }
        }
#pragma unroll
        for (int tt = 0; tt < 2; ++tt) { const int t = 64 * th + 32 * tt + r32; const float bsv = bs[g * 128 + t];
            bf16* urow = projp + (size_t)(tok0 + t) * LDP + C_U + 128 * g + 4 * h;
#pragma unroll
            for (int ct = 0; ct < 4; ++ct)
#pragma unroll
                for (int g4 = 0; g4 < 4; ++g4) { bf16* up = urow + 32 * ct + 8 * g4; const v2u uw = *(const GAS v2u*)up;
                    v2u o; o.x = cvtpk(blo(uw.x) * (acc[ct][tt][4 * g4] + bsv), bhi(uw.x) * (acc[ct][tt][4 * g4 + 1] + bsv));
                    o.y = cvtpk(blo(uw.y) * (acc[ct][tt][4 * g4 + 2] + bsv), bhi(uw.y) * (acc[ct][tt][4 * g4 + 3] + bsv)); *(GAS v2u*)up = o; } }
    }
}

constexpr int XA_K_OFF = 0, XA_V_OFF = 65536;
__device__ __forceinline__ unsigned off_b(unsigned row, unsigned ch) { return 256u * row + 16u * (ch ^ (((row & 3u) << 2) | ((row >> 2) & 3u))); }
__device__ __forceinline__ void xattn_phase(LAS unsigned char* L, bf16* projp, const bf16* kvp, const float* cqg, const float* ckg, int bid, int G, int wave, int lane) {
    const int tid = wave * 64 + lane, r32 = lane & 31, h = lane >> 5, blk16 = (lane >> 4) & 1, q4 = (lane & 15) >> 2, p4 = lane & 3;
    const int fch = tid & 15;
    float gg[8];
#pragma unroll
    for (int i = 0; i < 8; ++i) gg[i] = cqg[8 * fch + i] * ckg[8 * fch + i] * (0.08838834764831845f * LOG2E);
    const float mq = wave_max(fmaxf(fabsf(cqg[lane]), fabsf(cqg[lane + 64]))), mk = wave_max(fmaxf(fabsf(ckg[lane]), fabsf(ckg[lane + 64])));
    const float m2 = 11.313708499f * mq * mk * LOG2E;
    for (int unit = bid; unit < 1024; unit += G) {
        const int qt = unit & 7, hd = (unit >> 3) & 3, b = unit >> 5;
        __syncthreads();
#pragma unroll 2
        for (int it = 0; it < 8; ++it) { const int row = (tid >> 4) + 32 * it;
            const bf16* src = kvp + (size_t)(b * MEM + row) * D + 128 * hd + 8 * fch;
            const v4u kx = *(const GAS v4u*)src, vx = *(const GAS v4u*)(src + 512);
            float k[8] = {blo(kx.x), bhi(kx.x), blo(kx.y), bhi(kx.y), blo(kx.z), bhi(kx.z), blo(kx.w), bhi(kx.w)};
            float ss = 0.f;
#pragma unroll
            for (int e = 0; e < 8; ++e) ss += k[e] * k[e];
            ss += __shfl_xor(ss, 1); ss += __shfl_xor(ss, 2); ss += __shfl_xor(ss, 4); ss += __shfl_xor(ss, 8);
            const float rstd = 1.0f / sqrtf(ss * (1.f / 128.f) + EPS);
            v4u ko; ko.x = cvtpk(k[0] * rstd * gg[0], k[1] * rstd * gg[1]); ko.y = cvtpk(k[2] * rstd * gg[2], k[3] * rstd * gg[3]);
            ko.z = cvtpk(k[4] * rstd * gg[4], k[5] * rstd * gg[5]); ko.w = cvtpk(k[6] * rstd * gg[6], k[7] * rstd * gg[7]);
            const unsigned o = off_b((unsigned)row, (unsigned)fch);
            *(LAS v4u*)(L + XA_K_OFF + o) = ko; *(LAS v4u*)(L + XA_V_OFF + o) = vx; }
        __syncthreads();
        bf16* qrow = projp + (size_t)(b * SEQ + 256 * qt + 32 * wave + r32) * LDP + C_QC + 128 * hd;
        bf16x8 qf[8]; float ss = 0.f;
#pragma unroll
        for (int ks = 0; ks < 8; ++ks) { const v4u w = *(const GAS v4u*)(qrow + 16 * ks + 8 * h); qf[ks] = __builtin_bit_cast(bf16x8, w);
            ss += (blo(w.x) * blo(w.x) + bhi(w.x) * bhi(w.x)) + (blo(w.y) * blo(w.y) + bhi(w.y) * bhi(w.y)) + (blo(w.z) * blo(w.z) + bhi(w.z) * bhi(w.z)) + (blo(w.w) * blo(w.w) + bhi(w.w) * bhi(w.w)); }
        ss += __shfl_xor(ss, 32);
        const float rq = 1.0f / sqrtf(ss * (1.f / 128.f) + EPS);
        f32x16 o[4];
#pragma unroll
        for (int dt = 0; dt < 4; ++dt)
#pragma unroll
            for (int r = 0; r < 16; ++r) o[dt][r] = 0.f;
        float lsum = 0.f;
#pragma unroll 1
        for (int kt = 0; kt < 8; ++kt) {
            f32x16 s;
#pragma unroll
            for (int r = 0; r < 16; ++r) s[r] = 0.f;
#pragma unroll
            for (int ks = 0; ks < 8; ++ks) { const bf16x8 kf = *(const LAS bf16x8*)(L + XA_K_OFF + off_b((unsigned)(32 * kt + r32), (unsigned)(2 * ks + h))); s = ATT_MFMA(kf, qf[ks], s); }
            float p[16];
#pragma unroll
            for (int r = 0; r < 16; ++r) { p[r] = __builtin_amdgcn_exp2f(s[r] * rq - m2); lsum += p[r]; }
#pragma unroll
            for (int s2 = 0; s2 < 2; ++s2) {
                const bf16x8 pb = pack8(p[8 * s2], p[8 * s2 + 1], p[8 * s2 + 2], p[8 * s2 + 3], p[8 * s2 + 4], p[8 * s2 + 5], p[8 * s2 + 6], p[8 * s2 + 7]);
                const unsigned r0 = (unsigned)(32 * kt + 16 * s2 + 4 * h + q4);
#pragma unroll
                for (int dt = 0; dt < 4; ++dt) {
                    const unsigned ch = (unsigned)(4 * dt + 2 * blk16 + (p4 >> 1));
                    const s16x4 lo = vtr(L + XA_V_OFF + off_b(r0, ch) + 8 * (p4 & 1)), hi = vtr(L + XA_V_OFF + off_b(r0 + 8u, ch) + 8 * (p4 & 1));
                    const bf16x8 vf = __builtin_shufflevector(lo, hi, 0, 1, 2, 3, 4, 5, 6, 7); o[dt] = ATT_MFMA(vf, pb, o[dt]); }
            }
        }
        const float inv = 1.0f / (lsum + __shfl_xor(lsum, 32));
#pragma unroll
        for (int dt = 0; dt < 4; ++dt)
#pragma unroll
            for (int g4 = 0; g4 < 4; ++g4) { v2u w; w.x = cvtpk(o[dt][4 * g4] * inv, o[dt][4 * g4 + 1] * inv); w.y = cvtpk(o[dt][4 * g4 + 2] * inv, o[dt][4 * g4 + 3] * inv);
                *(GAS v2u*)(qrow + 32 * dt + 8 * g4 + 4 * h) = w; }
    }
}
}

constexpr int NPHASE = 18;
__global__ void __launch_bounds__(NTHR, 2) fwd(Args args) {
    extern __shared__ __attribute__((aligned(16))) unsigned char lds[];
    LAS unsigned char* L = (LAS unsigned char*)lds;
    volatile LAS unsigned* MISC = (volatile LAS unsigned*)(L + MISC_OFF);
    const int wave_s = __builtin_amdgcn_readfirstlane((int)threadIdx.x >> 6);
    for (int u = threadIdx.x; u < (LDS_BYTES - LDSCTL_OFF) / 4; u += NTHR) ((LAS unsigned*)(L + LDSCTL_OFF))[u] = 0u;
    __syncthreads();
#define LANE_ID ((int)__builtin_amdgcn_mbcnt_hi(~0u, __builtin_amdgcn_mbcnt_lo(~0u, 0u)))
#if MK_FUSED
    XcdBarrier bar = xcd_barrier_post((unsigned*)(args.ws + WS_CTL) + CW_BAR, MISC + 8, wave_s == 0 && LANE_ID == 0);
#define GRID_BAR() xcd_barrier(bar, wave_s == 0 && LANE_ID == 0)
#else
    (void)MISC;
#define GRID_BAR() do {} while (0)
#endif
    const int lo = args.ph_lo, hi = args.ph_hi;
#define IN(k) (lo <= (k) && (k) < hi)
#define SEAM(k) do { if (IN(k) && IN((k) + 1)) GRID_BAR(); } while (0)
#define PV \
    int wave = wave_s; asm volatile("" : "+s"(wave)); int bid = blockIdx.x; asm volatile("" : "+s"(bid)); \
    const int lane = LANE_ID, tid = wave * 64 + lane; \
    const int G = gridDim.x, gw = bid * NWAVES + wave, NGW = G * NWAVES, gtid = bid * NTHR + tid, NT = G * NTHR; \
    unsigned char* ws = args.ws; asm volatile("" : "+s"(ws)); \
    gu32* ctl = (gu32*)(ws + WS_CTL); \
    LAS float* scr = (LAS float*)(L + RING_OFF + wave * 16384); \
    (void)lane; (void)tid; (void)bid; (void)gw; (void)NGW; (void)gtid; (void)NT; (void)ctl; (void)scr; (void)G;
#define Win_t ((bf16*)(ws + WS_WIN))
#define Wo_t ((bf16*)(ws + WS_WO))
#define Wmkv_t ((bf16*)(ws + WS_WMKV))
#define Wout_t ((bf16*)(ws + WS_WOUT))
#define Hb ((bf16*)(ws + WS_H))
#define proj ((bf16*)(ws + WS_PROJ))
#define memn ((bf16*)(ws + WS_MEMN))
#define kv ((bf16*)(ws + WS_KV))
#define rope ((float2*)(ws + WS_ROPE))
#define Wgu_t ((bf16*)(ws + WS_WGU))
#define Wd_t ((bf16*)(ws + WS_WD))
#define h2s ((bf16*)(ws + WS_H2S))
#define act ((bf16*)(ws + WS_ACT))
#define topk_idx ((int*)(ws + WS_META + MT_IDX))
#define topk_gate ((float*)(ws + WS_META + MT_GATE))
#define slot_of ((int*)(ws + WS_META + MT_SLOTOF))
#define slot_tok ((int*)(ws + WS_META + MT_STOK))
#define slot_gate ((float*)(ws + WS_META + MT_SGATE))
#define tile_e ((int*)(ws + WS_META + MT_TILEE))
#define Wsb ((bf16*)(ws + WS_META + MT_WSB))

    if (IN(0)) { PV
        const float* x = args.in[I_X]; (void)x;
        { const float* W = args.in[I_WIN]; constexpr int nrb = DIN / 32, nit = (D / 64) * nrb;
          for (int it = gw; it < nit; it += NGW) { const int kb = it / nrb, rb = it % nrb; tr_item(W, DIN, 64 * kb, win_srccol(32 * rb), Win_t, D, 32 * rb, 0, scr, lane); } }
        { const float* W = args.in[I_WOA]; constexpr int nrb = D / 32, nit = (1024 / 64) * nrb;
          for (int it = gw; it < nit; it += NGW) { const int kb = it / nrb, rb = it % nrb; tr_item(W, D, 64 * kb, 32 * rb, Wo_t, 2048, 32 * rb, 0, scr, lane); } }
        { const float* W = args.in[I_WOB]; constexpr int nrb = D / 32, nit = (512 / 64) * nrb;
          for (int it = gw; it < nit; it += NGW) { const int kb = it / nrb, rb = it % nrb; tr_item(W, D, 64 * kb, 32 * rb, Wo_t, 2048, 32 * rb, 1024, scr, lane); } }
        { const float* W = args.in[I_WOC]; constexpr int nrb = D / 32, nit = (512 / 64) * nrb;
          for (int it = gw; it < nit; it += NGW) { const int kb = it / nrb, rb = it % nrb; tr_item(W, D, 64 * kb, 32 * rb, Wo_t, 2048, 32 * rb, 1536, scr, lane); } }
        { const float* W = args.in[I_WMKV]; constexpr int nrb = D / 32, nit = (D / 64) * nrb;
          for (int it = gw; it < nit; it += NGW) { const int kb = it / nrb, rb = it % nrb; tr_item(W, D, 64 * kb, 32 * rb, Wmkv_t, D, 32 * rb, 0, scr, lane); } }
        { const float* W = args.in[I_WOUT]; constexpr int nrb = D / 32, nit = (D / 64) * nrb;
          for (int it = gw; it < nit; it += NGW) { const int kb = it / nrb, rb = it % nrb; tr_item(W, D, 64 * kb, 32 * rb, Wout_t, D, 32 * rb, 0, scr, lane); } }
        { const int* pos = (const int*)args.in[I_POS];
          for (int i = gtid; i < T * 32; i += NT) { const int t = i >> 5, f = i & 31;
              const float inv = powf(10000.0f, -(float)(2 * f) / 64.0f); const float ang = (float)pos[t] * inv;
              double sn, cs; sincos((double)ang, &sn, &cs); rope[i] = make_float2((float)cs, (float)sn); } }
        for (int i = gtid; i < 4 * 128 * 128; i += NT) { const int tt = (i >> 7) & 127, sp = i & 127; Wsb[i] = (bf16)(sp <= tt ? f2bf(args.in[I_WS][i]) : 0u); }
        for (int m = gw; m < T; m += NGW) rms_row_to_bf16(x + (size_t)m * D, args.in[I_ATTN_G], Hb + (size_t)m * D, lane);
        for (int m = gw; m < TM; m += NGW) rms_row_to_bf16(args.in[I_MEM] + (size_t)m * D, args.in[I_MEM_G], memn + (size_t)m * D, lane);
    }
    SEAM(0);
    if (IN(1)) { PV
        { pg8::Gemm g{Hb, Win_t, D, D, D}; pg8::StaticOrder S; S.init(T, DIN, G, bid); pg8::EpiBf16 E{proj, LDP};
          pg8::gemm_phase<pg8::EpiBf16, pg8::StaticOrder>(L + RING_OFF, g, S, E, wave); }
        { pg8::Gemm g{memn, Wmkv_t, D, D, D}; pg8::StaticOrder S; S.init(TM, D, G, bid); pg8::EpiBf16 E{kv, D};
          pg8::gemm_phase<pg8::EpiBf16, pg8::StaticOrder>(L + RING_OFF, g, S, E, wave); }
    }
    SEAM(1);
    if (IN(2)) { PV
        const int hw = lane >> 5, hl = lane & 31;
        for (int t = gw; t < T; t += NGW) {
            bf16* row = proj + (size_t)t * LDP;
            const float2 cs = rope[t * 32 + hl];
#pragma unroll 1
            for (int it = 0; it < 9; ++it) {
                const int hd = 2 * it + hw; const bool isk = hd >= 16;
                bf16* hp = row + (isk ? C_K + 64 * (hd - 16) : C_Q + 64 * hd);
                const float* gn = isk ? args.in[I_AKG] : args.in[I_AQG];
                const float x1 = bf2f(hp[hl]), x2 = bf2f(hp[hl + 32]);
                const float ss = half_sum(x1 * x1 + x2 * x2);
                const float rstd = 1.0f / sqrtf(ss * (1.f / 64.f) + EPS);
                const float y1 = x1 * rstd * gn[hl], y2 = x2 * rstd * gn[hl + 32];
                hp[hl] = (bf16)f2bf(y1 * cs.x - y2 * cs.y); hp[hl + 32] = (bf16)f2bf(y2 * cs.x + y1 * cs.y);
            }
            { bf16* up = row + C_U + 8 * lane; const v4u w = *(const v4u*)up;
              v4u o; o.x = pk2(gelu_erf(blo(w.x)), gelu_erf(bhi(w.x))); o.y = pk2(gelu_erf(blo(w.y)), gelu_erf(bhi(w.y)));
              o.z = pk2(gelu_erf(blo(w.z)), gelu_erf(bhi(w.z))); o.w = pk2(gelu_erf(blo(w.w)), gelu_erf(bhi(w.w))); *(v4u*)up = o; }
            { bf16* vp = row + C_VB + 8 * lane; const v4u w = *(const v4u*)vp;
              v4u o; o.x = pk2(gelu_erf(blo(w.x)), gelu_erf(bhi(w.x))); o.y = pk2(gelu_erf(blo(w.y)), gelu_erf(bhi(w.y)));
              o.z = pk2(gelu_erf(blo(w.z)), gelu_erf(bhi(w.z))); o.w = pk2(gelu_erf(blo(w.w)), gelu_erf(bhi(w.w))); *(v4u*)vp = o; }
        }
    }
    SEAM(2);
    if (IN(3)) { PV
        att::swa_phase(L + RING_OFF, proj, args.in[I_SINKS], args.in[I_AQG], args.in[I_AKG], bid, G, wave, lane);
        __syncthreads();
        att::gmlp_phase(L + RING_OFF, proj, Wsb, args.in[I_LNG], args.in[I_LNB], args.in[I_BS], bid, G, wave, lane);
        __syncthreads();
        att::xattn_phase(L + RING_OFF, proj, kv, args.in[I_CQG], args.in[I_CKG], bid, G, wave, lane);
        __syncthreads();
    }
    SEAM(3);
    if (IN(4)) { PV
        pg8::StaticOrder S; S.init(T, D, G, bid);
        { pg8::Gemm g{proj + C_Q, Wo_t, 1024, LDP, 2048}; pg8::EpiMerge<0> E{Hb, D, proj + C_G, LDP, args.in[I_BGATES]};
          pg8::gemm_phase<pg8::EpiMerge<0>, pg8::StaticOrder>(L + RING_OFF, g, S, E, wave); }
        { pg8::Gemm g{proj + C_U, Wo_t + 1024, 512, LDP, 2048}; pg8::EpiMerge<1> E{Hb, D, proj + C_G + 1024, LDP, args.in[I_BGATES] + 1024};
          pg8::gemm_phase<pg8::EpiMerge<1>, pg8::StaticOrder>(L + RING_OFF, g, S, E, wave); }
        { pg8::Gemm g{proj + C_QC, Wo_t + 1536, 512, LDP, 2048}; pg8::EpiMerge<1> E{Hb, D, proj + C_G + 2048, LDP, args.in[I_BGATES] + 2048};
          pg8::gemm_phase<pg8::EpiMerge<1>, pg8::StaticOrder>(L + RING_OFF, g, S, E, wave); }
    }
    SEAM(4);
    if (IN(5)) { PV
        const float* x = args.in[I_X];
        pg8::Gemm g{Hb, Wout_t, D, D, D}; pg8::StaticOrder S; S.init(T, D, G, bid); pg8::EpiResF32 E{args.out, x, D};
        pg8::gemm_phase<pg8::EpiResF32, pg8::StaticOrder>(L + RING_OFF, g, S, E, wave);
    }
    SEAM(5);
    if (IN(6)) { PV
        for (int i = gtid; i < NHALF * PH; i += NT) { slot_tok[i] = -1; slot_gate[i] = 0.f; }
        const float* rw = args.in[I_RW]; const float* rb = args.in[I_RB]; const float* fg = args.in[I_FFN_G];
        for (int t = gw; t < T; t += NGW) {
            const GAS f32x4* xr = (const GAS f32x4*)(args.out + (size_t)t * D) + lane;
            f32x4 v[4]; float s = 0.f;
#pragma unroll
            for (int j = 0; j < 4; ++j) { v[j] = xr[64 * j]; s += (v[j].x * v[j].x + v[j].y * v[j].y) + (v[j].z * v[j].z + v[j].w * v[j].w); }
            const float rstd = 1.0f / sqrtf(wave_sum(s) * (1.f / 1024.f) + EPS);
            GAS v2u* o8 = (GAS v2u*)(Hb + (size_t)t * D) + lane;
            float lg[32];
#pragma unroll
            for (int e = 0; e < 32; ++e) lg[e] = 0.f;
#pragma unroll
            for (int j = 0; j < 4; ++j) { const f32x4 gg = *((const GAS f32x4*)fg + lane + 64 * j);
                v[j].x *= rstd * gg.x; v[j].y *= rstd * gg.y; v[j].z *= rstd * gg.z; v[j].w *= rstd * gg.w;
                v2u o; o.x = pk2(v[j].x, v[j].y); o.y = pk2(v[j].z, v[j].w); o8[64 * j] = o;
                const float* rwp = rw + (size_t)(4 * lane + 256 * j) * 32;
#pragma unroll
                for (int e4 = 0; e4 < 8; ++e4) {
                    const f32x4 w0 = *(const f32x4*)(rwp + 4 * e4), w1 = *(const f32x4*)(rwp + 32 + 4 * e4), w2 = *(const f32x4*)(rwp + 64 + 4 * e4), w3 = *(const f32x4*)(rwp + 96 + 4 * e4);
                    lg[4 * e4 + 0] += v[j].x * w0.x + v[j].y * w1.x + v[j].z * w2.x + v[j].w * w3.x;
                    lg[4 * e4 + 1] += v[j].x * w0.y + v[j].y * w1.y + v[j].z * w2.y + v[j].w * w3.y;
                    lg[4 * e4 + 2] += v[j].x * w0.z + v[j].y * w1.z + v[j].z * w2.z + v[j].w * w3.z;
                    lg[4 * e4 + 3] += v[j].x * w0.w + v[j].y * w1.w + v[j].z * w2.w + v[j].w * w3.w;
                } }
#pragma unroll
            for (int e = 0; e < 32; ++e) lg[e] = wave_sum(lg[e]) + rb[e];
            int bi[4]; float bv[4];
#pragma unroll
            for (int k = 0; k < 4; ++k) { float best = -INFINITY; int b = 0;
#pragma unroll
                for (int e = 0; e < 32; ++e) if (lg[e] > best) { best = lg[e]; b = e; }
                bi[k] = b; bv[k] = best;
#pragma unroll
                for (int e = 0; e < 32; ++e) lg[e] = (e == b) ? -INFINITY : lg[e]; }
            const float p1 = expf(bv[1] - bv[0]), p2 = expf(bv[2] - bv[0]), p3 = expf(bv[3] - bv[0]); const float inv = 1.0f / (1.0f + p1 + p2 + p3);
            if (lane < 4) { const int e = lane == 0 ? bi[0] : lane == 1 ? bi[1] : lane == 2 ? bi[2] : bi[3];
                const float gt = (lane == 0 ? 1.0f : lane == 1 ? p1 : lane == 2 ? p2 : p3) * inv;
                topk_idx[t * 4 + lane] = e; topk_gate[t * 4 + lane] = gt;
                atomicAdd((unsigned*)(ctl + CW_CNT) + (t / TH) * 32 + e, 1u); }
        }
        { const float* W = args.in[I_WGU]; constexpr int nrb = 2048 / 32, per = (D / 64) * nrb, nit = NEXP * per;
          for (int it = gw; it < nit; it += NGW) { const int e = it / per, r0 = it % per, kb = r0 / nrb, rb = r0 % nrb; const int r = 32 * rb, j = r >> 8, rr = r & 255;
              const int sc = rr < 128 ? 128 * j + rr : 1024 + 128 * j + (rr - 128);
              tr_item(W + (size_t)e * D * 2048, 2048, 64 * kb, sc, Wgu_t + (size_t)e * 2048 * D, D, r, 0, scr, lane); } }
        { const float* W = args.in[I_WD]; constexpr int nrb = D / 32, per = (D / 64) * nrb, nit = NEXP * per;
          for (int it = gw; it < nit; it += NGW) { const int e = it / per, r0 = it % per, kb = r0 / nrb, rb = r0 % nrb;
              tr_item(W + (size_t)e * D * D, D, 64 * kb, 32 * rb, Wd_t + (size_t)e * D * D, D, 32 * rb, 0, scr, lane); } }
    }
    SEAM(6);
    if (IN(7)) { PV
        if (bid == 0 && tid == 0) {
            for (int h = 0; h < NHALF; ++h) { int row = 0, ntile = 0;
                for (int e = 0; e < NEXP; ++e) { const int c = (int)__hip_atomic_load((unsigned*)(ctl + CW_CNT) + h * 32 + e, RLX_AGENT);
                    ((unsigned*)(ctl + CW_START))[h * 32 + e] = (unsigned)row; const int nt = (c + 255) >> 8;
                    for (int i = 0; i < nt; ++i) tile_e[h * 1024 + ntile + i] = e;
                    ntile += nt; row += nt * 256; }
                ((unsigned*)(ctl + CW_NTILE))[h] = (unsigned)ntile; }
        }
    }
    SEAM(7);
    for (int h = 0; h < NHALF; ++h) {
        const int pb = 8 + 5 * h;
#define stok (slot_tok + h * PH)
#define sgate (slot_gate + h * PH)
#define NTILE_H ((int)__hip_atomic_load((unsigned*)(ctl + CW_NTILE) + h, RLX_AGENT))
        if (IN(pb)) { PV
            for (int i = gtid; i < TH * TOPK; i += NT) { const int a = h * TH * TOPK + i; const int e = topk_idx[a];
                const unsigned pos = atomicAdd((unsigned*)(ctl + CW_CUR) + h * 32 + e, 1u);
                const int slot = (int)(((unsigned*)(ctl + CW_START))[h * 32 + e] + pos);
                stok[slot] = a >> 2; sgate[slot] = topk_gate[a]; slot_of[a] = slot; }
        }
        SEAM(pb);
        if (IN(pb + 1)) { PV const int ntile = NTILE_H;
            for (int r = gw; r < ntile * 256; r += NGW) { const int tok = stok[r];
                v4u a = {0u, 0u, 0u, 0u}, b = {0u, 0u, 0u, 0u};
                if (tok >= 0) { const GAS v4u* sp = (const GAS v4u*)(Hb + (size_t)tok * D) + lane; a = sp[0]; b = sp[64]; }
                GAS v4u* dp = (GAS v4u*)(h2s + (size_t)r * D) + lane; dp[0] = a; dp[64] = b; }
        }
        SEAM(pb + 1);
        if (IN(pb + 2)) { PV const int ntile = NTILE_H;
            pg8::Gemm g{h2s, Wgu_t, D, D, D}; pg8::GroupedOrder S{tile_e + h * 1024, ntile, 8, G, bid}; pg8::EpiSwiglu E{act, args.in[I_BGU]};
            pg8::gemm_phase<pg8::EpiSwiglu, pg8::GroupedOrder>(L + RING_OFF, g, S, E, wave);
        }
        SEAM(pb + 2);
        if (IN(pb + 3)) { PV const int ntile = NTILE_H;
            pg8::Gemm g{act, Wd_t, D, D, D}; pg8::GroupedOrder S{tile_e + h * 1024, ntile, 4, G, bid}; pg8::EpiDown E{h2s, args.in[I_BD], sgate};
            pg8::gemm_phase<pg8::EpiDown, pg8::GroupedOrder>(L + RING_OFF, g, S, E, wave);
        }
        SEAM(pb + 3);
        if (IN(pb + 4)) { PV
            for (int t = h * TH + gw; t < (h + 1) * TH; t += NGW) {
                const int s0 = slot_of[t * 4], s1 = slot_of[t * 4 + 1], s2 = slot_of[t * 4 + 2], s3 = slot_of[t * 4 + 3];
                GAS f32x4* op = (GAS f32x4*)(args.out + (size_t)t * D) + lane;
#pragma unroll
                for (int j = 0; j < 4; ++j) { f32x4 o = op[64 * j];
                    const v2u a = *((const GAS v2u*)(h2s + (size_t)s0 * D) + lane + 64 * j), b = *((const GAS v2u*)(h2s + (size_t)s1 * D) + lane + 64 * j);
                    const v2u c = *((const GAS v2u*)(h2s + (size_t)s2 * D) + lane + 64 * j), d = *((const GAS v2u*)(h2s + (size_t)s3 * D) + lane + 64 * j);
                    o.x += ((blo(a.x) + blo(b.x)) + blo(c.x)) + blo(d.x); o.y += ((bhi(a.x) + bhi(b.x)) + bhi(c.x)) + bhi(d.x);
                    o.z += ((blo(a.y) + blo(b.y)) + blo(c.y)) + blo(d.y); o.w += ((bhi(a.y) + bhi(b.y)) + bhi(c.y)) + bhi(d.y);
                    op[64 * j] = o; }
            }
        }
        if (h + 1 < NHALF) SEAM(pb + 4);
    }
#undef IN
#undef SEAM
}

extern "C" void kernel_launch(void* const* d_in, const int* in_sizes, int n_in, void* d_out, int out_size, void* d_ws, size_t ws_size, hipStream_t stream) {
    static int grid = 0;
    if (grid == 0) {
        if (n_in != 28 || out_size != T * D || ws_size < WS_END) { fprintf(stderr, "kernel_launch: unexpected shapes: n_in %d out %d ws %zu (need %zu)\n", n_in, out_size, ws_size, (size_t)WS_END); grid = -1; return; }
        int dev = 0, cus = 0, per_cu = 0;
        if (hipGetDevice(&dev) != hipSuccess || hipDeviceGetAttribute(&cus, hipDeviceAttributeMultiprocessorCount, dev) != hipSuccess) { grid = -1; return; }
        if (hipFuncSetAttribute((const void*)fwd, hipFuncAttributeMaxDynamicSharedMemorySize, LDS_BYTES) != hipSuccess) { fprintf(stderr, "kernel_launch: hipFuncSetAttribute failed\n"); grid = -1; return; }
        if (hipOccupancyMaxActiveBlocksPerMultiprocessor(&per_cu, (const void*)fwd, NTHR, LDS_BYTES) != hipSuccess || per_cu < 1) { fprintf(stderr, "kernel_launch: occupancy query says %d\n", per_cu); }
        (void)hipGetLastError();
        grid = cus;
    }
    if (grid < 0) return;
    if (hipMemsetAsync((char*)d_ws + WS_CTL, 0, CTL_ZERO_BYTES, stream) != hipSuccess) { fprintf(stderr, "kernel_launch: memset failed\n"); return; }
    Args a{};
    for (int i = 0; i < 28; ++i) a.in[i] = (const float*)d_in[i];
    a.out = (float*)d_out; a.ws = (unsigned char*)d_ws;
#if MK_FUSED
    a.ph_lo = 0; a.ph_hi = NPHASE;
    hipLaunchKernelGGL(fwd, dim3(grid), dim3(NTHR), LDS_BYTES, stream, a);
#else
    for (int p = 0; p < NPHASE; ++p) { a.ph_lo = p; a.ph_hi = p + 1; hipLaunchKernelGGL(fwd, dim3(grid), dim3(NTHR), LDS_BYTES, stream, a); }
#endif
    const hipError_t le = hipPeekAtLastError();
    if (le != hipSuccess) fprintf(stderr, "kernel_launch: launch failed: %s\n", hipGetErrorName(le));
}
```

```cpp
#include <hip/hip_runtime.h>
#include <cstdio>
#include <cstdint>

#ifndef MK_FUSED
#define MK_FUSED 1
#endif

namespace pg8 {
#define PG8_LAS __attribute__((address_space(3)))
typedef unsigned short bf16_t;
typedef short bf16x8 __attribute__((ext_vector_type(8)));
typedef float f32x4 __attribute__((ext_vector_type(4)));
typedef unsigned u32x4 __attribute__((ext_vector_type(4)));
typedef float f32x2 __attribute__((ext_vector_type(2)));
constexpr int BM = 256, BK = 64, HALF = 128, HTB = HALF * BK * 2, STAGE_BYTES = 8 * HTB, NXCD = 8, WGM = 8;

__host__ __device__ __forceinline__ int lds_byte(int r, int c) { const int st = (r >> 4) * 2 + (c >> 5), rr = r & 15, cc = c & 31, ob = rr * 64 + cc * 2; return st * 1024 + (ob ^ (((ob >> 9) & 1) << 5)); }
__host__ __device__ __forceinline__ void stage_rc(int b, int& R, int& C) { const int st = b / 1024, sb = b % 1024, swz = sb ^ (((sb >> 9) & 1) << 5); R = (st >> 1) * 16 + swz / 64; C = (st & 1) * 32 + (swz % 64) / 2; }
__host__ __device__ __forceinline__ int perm32(int rho) { const int n = rho >> 4, i = rho & 15; return 8 * (i >> 2) + 4 * n + (i & 3); }

struct Unit { int pm, pn; };
struct Gemm { const bf16_t* A; const bf16_t* Bt; int K, lda, ldb; };

struct StaticOrder {
    int nM, nN, nwg, G, c;
    __host__ __device__ void init(int M, int N, int G_, int c_) { nM = M / BM; nN = N / BM; nwg = nM * nN; G = G_; c = c_; }
    __host__ __device__ bool next(int i, Unit& u) const {
        const long L = (long)i * G + c; if (L >= nwg) return false;
        int wgid = (int)L; { const int q = nwg / NXCD, r = nwg % NXCD, xcd = wgid % NXCD, off = wgid / NXCD; wgid = (xcd < r ? xcd * (q + 1) : r * (q + 1) + (xcd - r) * q) + off; }
        const int nig = WGM * nN, gid = wgid / nig, fm = gid * WGM, gsz = (nM - fm) < WGM ? (nM - fm) : WGM;
        u.pm = fm + ((wgid % nig) % gsz); u.pn = (wgid % nig) / gsz; return true;
    }
};
struct GroupedOrder {
    const int* tile_e; int ntile, nN, G, c;
    __device__ bool next(int i, Unit& u) const {
        const unsigned L = (unsigned)i * (unsigned)G + (unsigned)c; if (L >= (unsigned)(ntile * nN)) return false;
        const int tile = (int)(L / (unsigned)nN), j = (int)(L % (unsigned)nN);
        u.pm = tile; u.pn = tile_e[tile] * nN + j; return true;
    }
};

__device__ __forceinline__ unsigned cvt_pk_bf16(float lo, float hi) { unsigned r; asm volatile("v_cvt_pk_bf16_f32 %0, %1, %2" : "=v"(r) : "v"(lo), "v"(hi)); return r; }
__device__ __forceinline__ float bflo(unsigned w) { return __uint_as_float(w << 16); }
__device__ __forceinline__ float bfhi(unsigned w) { return __uint_as_float(w & 0xffff0000u); }


struct EpiBf16 {
    static constexpr bool PERM = true;
    bf16_t* O; int ldc;
    __device__ __forceinline__ void operator()(const f32x4 (&acc)[2][2][4][2], const Unit& u, int wr, int wc, int fr, int fq) const {
        const int row0 = u.pm * BM + wr * 64 + fr, col0 = u.pn * BM + wc * 32 + 8 * fq;
#pragma unroll
        for (int ai = 0; ai < 2; ++ai)
#pragma unroll
            for (int m = 0; m < 4; ++m) { bf16_t* rowp = O + (size_t)(row0 + ai * HALF + m * 16) * ldc + col0;
#pragma unroll
                for (int bj = 0; bj < 2; ++bj) { const f32x4 v0 = acc[ai][bj][m][0], v1 = acc[ai][bj][m][1];
                    u32x4 w; w.x = cvt_pk_bf16(v0[0], v0[1]); w.y = cvt_pk_bf16(v0[2], v0[3]); w.z = cvt_pk_bf16(v1[0], v1[1]); w.w = cvt_pk_bf16(v1[2], v1[3]);
                    *(u32x4*)(rowp + bj * HALF) = w; } }
    }
};
__device__ __forceinline__ f32x2 gelu_pk(f32x2 v) {
    const f32x2 av = __builtin_elementwise_abs(v), d = av * 0.2316418882f + 1.0f;
    f32x2 t; t.x = __builtin_amdgcn_rcpf(d.x); t.y = __builtin_amdgcn_rcpf(d.y);
    f32x2 q = t * 0.5307027145f + (-0.7265760135f); q = q * t + 0.7107068705f; q = q * t + (-0.142248368f); q = q * t + 0.127414796f; q = q * t;
    const f32x2 s = (v * v) * (-0.72134752044f);
    f32x2 e; e.x = __builtin_amdgcn_exp2f(s.x); e.y = __builtin_amdgcn_exp2f(s.y);
    const f32x2 m = v * (q * e), r = v - m;
    f32x2 o; o.x = v.x < 0.f ? m.x : r.x; o.y = v.y < 0.f ? m.y : r.y; return o;
}
struct EpiProj {
    static constexpr bool PERM = true;
    bf16_t* P; int ldp; const float* rope; const float* gq; const float* gk; const float* bgates; float eps;
    int c_q, c_k, c_v, c_g;
    __device__ __forceinline__ void operator()(const f32x4 (&acc)[2][2][4][2], const Unit& u, int wr, int wc, int fr, int fq) const {
        const int pn = u.pn, row0 = u.pm * BM + wr * 64 + fr;
        if (pn < 4 || pn == 8) {
            const bool isq = pn < 4, isv = (!isq) && (wc & 1);
            const int colbase = (isq ? c_q + 64 * (4 * pn + wc) : (isv ? c_v : c_k) + 64 * (wc >> 1)) + 8 * fq;
            if (isv) {
#pragma unroll
                for (int ai = 0; ai < 2; ++ai)
#pragma unroll
                    for (int m = 0; m < 4; ++m) { bf16_t* rowp = P + (size_t)(row0 + ai * HALF + m * 16) * ldp + colbase;
#pragma unroll
                        for (int bj = 0; bj < 2; ++bj) { const f32x4 v0 = acc[ai][bj][m][0], v1 = acc[ai][bj][m][1];
                            u32x4 w; w.x = cvt_pk_bf16(v0[0], v0[1]); w.y = cvt_pk_bf16(v0[2], v0[3]); w.z = cvt_pk_bf16(v1[0], v1[1]); w.w = cvt_pk_bf16(v1[2], v1[3]);
                            *(u32x4*)(rowp + 32 * bj) = w; } }
            } else {
                const float* gn = (isq ? gq : gk) + 8 * fq;
                const f32x4 ga0 = *(const f32x4*)gn, ga1 = *(const f32x4*)(gn + 4), gb0 = *(const f32x4*)(gn + 32), gb1 = *(const f32x4*)(gn + 36);
#pragma unroll
                for (int ai = 0; ai < 2; ++ai)
#pragma unroll
                    for (int m = 0; m < 4; ++m) {
                        const int r = row0 + ai * HALF + m * 16;
                        const f32x4 x10 = acc[ai][0][m][0], x11 = acc[ai][0][m][1], x20 = acc[ai][1][m][0], x21 = acc[ai][1][m][1];
                        float ss = ((x10[0] * x10[0] + x10[1] * x10[1]) + (x10[2] * x10[2] + x10[3] * x10[3])) + ((x11[0] * x11[0] + x11[1] * x11[1]) + (x11[2] * x11[2] + x11[3] * x11[3]))
                                 + ((x20[0] * x20[0] + x20[1] * x20[1]) + (x20[2] * x20[2] + x20[3] * x20[3])) + ((x21[0] * x21[0] + x21[1] * x21[1]) + (x21[2] * x21[2] + x21[3] * x21[3]));
                        ss += __shfl_xor(ss, 16); ss += __shfl_xor(ss, 32);
                        const float rstd = 1.0f / sqrtf(ss * (1.f / 64.f) + eps);
                        const float* rp = rope + ((size_t)r * 32 + 8 * fq) * 2;
                        const f32x4 cs0 = *(const f32x4*)rp, cs1 = *(const f32x4*)(rp + 4), cs2 = *(const f32x4*)(rp + 8), cs3 = *(const f32x4*)(rp + 12);
                        const f32x4 y10 = x10 * ga0 * rstd, y11 = x11 * ga1 * rstd, y20 = x20 * gb0 * rstd, y21 = x21 * gb1 * rstd;
                        float o1[8], o2[8];
                        o1[0] = y10[0] * cs0[0] - y20[0] * cs0[1]; o2[0] = y20[0] * cs0[0] + y10[0] * cs0[1];
                        o1[1] = y10[1] * cs0[2] - y20[1] * cs0[3]; o2[1] = y20[1] * cs0[2] + y10[1] * cs0[3];
                        o1[2] = y10[2] * cs1[0] - y20[2] * cs1[1]; o2[2] = y20[2] * cs1[0] + y10[2] * cs1[1];
                        o1[3] = y10[3] * cs1[2] - y20[3] * cs1[3]; o2[3] = y20[3] * cs1[2] + y10[3] * cs1[3];
                        o1[4] = y11[0] * cs2[0] - y21[0] * cs2[1]; o2[4] = y21[0] * cs2[0] + y11[0] * cs2[1];
                        o1[5] = y11[1] * cs2[2] - y21[1] * cs2[3]; o2[5] = y21[1] * cs2[2] + y11[1] * cs2[3];
                        o1[6] = y11[2] * cs3[0] - y21[2] * cs3[1]; o2[6] = y21[2] * cs3[0] + y11[2] * cs3[1];
                        o1[7] = y11[3] * cs3[2] - y21[3] * cs3[3]; o2[7] = y21[3] * cs3[2] + y11[3] * cs3[3];
                        bf16_t* rowp = P + (size_t)r * ldp + colbase;
                        u32x4 w; w.x = cvt_pk_bf16(o1[0], o1[1]); w.y = cvt_pk_bf16(o1[2], o1[3]); w.z = cvt_pk_bf16(o1[4], o1[5]); w.w = cvt_pk_bf16(o1[6], o1[7]);
                        *(u32x4*)rowp = w;
                        w.x = cvt_pk_bf16(o2[0], o2[1]); w.y = cvt_pk_bf16(o2[2], o2[3]); w.z = cvt_pk_bf16(o2[4], o2[5]); w.w = cvt_pk_bf16(o2[6], o2[7]);
                        *(u32x4*)(rowp + 32) = w;
                    }
            }
        } else {
            const int col0 = pn * BM + wc * 32 + 8 * fq;
            const int mode = (pn == 4 || pn == 5 || pn == 9 || pn == 10) ? 1 : (pn >= 11 ? 2 : 0);
#pragma unroll
            for (int bj = 0; bj < 2; ++bj) {
                f32x4 b0 = (f32x4){0.f, 0.f, 0.f, 0.f}, b1 = b0;
                if (mode == 2) { const float* bp = bgates + (col0 - c_g) + bj * HALF; b0 = *(const f32x4*)bp; b1 = *(const f32x4*)(bp + 4); }
#pragma unroll
                for (int ai = 0; ai < 2; ++ai)
#pragma unroll
                    for (int m = 0; m < 4; ++m) {
                        f32x4 v0 = acc[ai][bj][m][0], v1 = acc[ai][bj][m][1];
                        if (mode == 1) { const f32x2 a = gelu_pk((f32x2){v0[0], v0[1]}), b = gelu_pk((f32x2){v0[2], v0[3]}), c = gelu_pk((f32x2){v1[0], v1[1]}), d = gelu_pk((f32x2){v1[2], v1[3]});
                            v0 = (f32x4){a.x, a.y, b.x, b.y}; v1 = (f32x4){c.x, c.y, d.x, d.y}; }
                        else if (mode == 2) {
#pragma unroll
                            for (int i = 0; i < 4; ++i) { v0[i] = __builtin_amdgcn_rcpf(1.0f + __builtin_amdgcn_exp2f(-1.4426950408889634f * (v0[i] + b0[i])));
                                                          v1[i] = __builtin_amdgcn_rcpf(1.0f + __builtin_amdgcn_exp2f(-1.4426950408889634f * (v1[i] + b1[i]))); } }
                        u32x4 w; w.x = cvt_pk_bf16(v0[0], v0[1]); w.y = cvt_pk_bf16(v0[2], v0[3]); w.z = cvt_pk_bf16(v1[0], v1[1]); w.w = cvt_pk_bf16(v1[2], v1[3]);
                        *(u32x4*)(P + (size_t)(row0 + ai * HALF + m * 16) * ldp + col0 + bj * HALF) = w;
                    }
            }
        }
    }
};
template <int ACCUM> struct EpiMerge {
    static constexpr bool PERM = true;
    bf16_t* Mg; int ldm; const bf16_t* gate; int ldg;
    __device__ __forceinline__ void operator()(const f32x4 (&acc)[2][2][4][2], const Unit& u, int wr, int wc, int fr, int fq) const {
        const int row0 = u.pm * BM + wr * 64 + fr, col0 = u.pn * BM + wc * 32 + 8 * fq;
#pragma unroll
        for (int bj = 0; bj < 2; ++bj) {
#pragma unroll
            for (int ai = 0; ai < 2; ++ai)
#pragma unroll
                for (int m = 0; m < 4; ++m) {
                    const size_t r = (size_t)(row0 + ai * HALF + m * 16);
                    const u32x4 gw = *(const u32x4*)(gate + r * ldg + col0 + bj * HALF);
                    const f32x4 a0 = acc[ai][bj][m][0], a1 = acc[ai][bj][m][1];
                    float o[8] = {bflo(gw.x) * a0[0], bfhi(gw.x) * a0[1], bflo(gw.y) * a0[2], bfhi(gw.y) * a0[3], bflo(gw.z) * a1[0], bfhi(gw.z) * a1[1], bflo(gw.w) * a1[2], bfhi(gw.w) * a1[3]};
                    bf16_t* mp = Mg + r * ldm + col0 + bj * HALF;
                    if (ACCUM) { const u32x4 pw = *(const u32x4*)mp;
                        o[0] += bflo(pw.x); o[1] += bfhi(pw.x); o[2] += bflo(pw.y); o[3] += bfhi(pw.y); o[4] += bflo(pw.z); o[5] += bfhi(pw.z); o[6] += bflo(pw.w); o[7] += bfhi(pw.w); }
                    u32x4 w; w.x = cvt_pk_bf16(o[0], o[1]); w.y = cvt_pk_bf16(o[2], o[3]); w.z = cvt_pk_bf16(o[4], o[5]); w.w = cvt_pk_bf16(o[6], o[7]);
                    *(u32x4*)mp = w;
                }
        }
    }
};
struct EpiResF32 {
    static constexpr bool PERM = false;
    float* C; const float* R; int ldc;
    __device__ __forceinline__ void operator()(const f32x4 (&acc)[2][2][4][2], const Unit& u, int wr, int wc, int fr, int fq) const {
        const int row0 = u.pm * BM + wr * 64 + fr, col0 = u.pn * BM + wc * 32 + 4 * fq;
#pragma unroll
        for (int ai = 0; ai < 2; ++ai)
#pragma unroll
            for (int m = 0; m < 4; ++m) { const size_t ro = (size_t)(row0 + ai * HALF + m * 16) * ldc + col0;
#pragma unroll
                for (int bj = 0; bj < 2; ++bj)
#pragma unroll
                    for (int n = 0; n < 2; ++n) { const f32x4 rv = *(const f32x4*)(R + ro + bj * HALF + n * 16); *(f32x4*)(C + ro + bj * HALF + n * 16) = acc[ai][bj][m][n] + rv; } }
    }
};
struct EpiSwiglu {
    static constexpr bool PERM = true;
    bf16_t* act; const float* bgu;
    __device__ __forceinline__ void operator()(const f32x4 (&acc)[2][2][4][2], const Unit& u, int wr, int wc, int fr, int fq) const {
        const int e = u.pn >> 3, j = u.pn & 7;
        const int row0 = u.pm * BM + wr * 64 + fr, col0 = j * 128 + wc * 32 + 8 * fq;
        const float* bg = bgu + (size_t)e * 2048 + col0;
        const f32x4 g0 = *(const f32x4*)bg, g1 = *(const f32x4*)(bg + 4), u0 = *(const f32x4*)(bg + 1024), u1 = *(const f32x4*)(bg + 1028);
#pragma unroll
        for (int ai = 0; ai < 2; ++ai)
#pragma unroll
            for (int m = 0; m < 4; ++m) {
                float o[8];
#pragma unroll
                for (int i = 0; i < 8; ++i) {
                    float gt = (i < 4 ? acc[ai][0][m][0][i] + g0[i] : acc[ai][0][m][1][i - 4] + g1[i - 4]);
                    float up = (i < 4 ? acc[ai][1][m][0][i] + u0[i] : acc[ai][1][m][1][i - 4] + u1[i - 4]);
                    gt = fminf(gt, 7.0f); up = fminf(fmaxf(up, -7.0f), 7.0f);
                    const float sg = __builtin_amdgcn_rcpf(1.0f + __builtin_amdgcn_exp2f(-1.702f * 1.4426950408889634f * gt));
                    o[i] = (up + 1.0f) * (gt * sg);
                }
                u32x4 w; w.x = cvt_pk_bf16(o[0], o[1]); w.y = cvt_pk_bf16(o[2], o[3]); w.z = cvt_pk_bf16(o[4], o[5]); w.w = cvt_pk_bf16(o[6], o[7]);
                *(u32x4*)(act + (size_t)(row0 + ai * HALF + m * 16) * 1024 + col0) = w;
            }
    }
};
struct EpiDown {
    static constexpr bool PERM = true;
    bf16_t* Y; const float* bd; const float* sgate;
    __device__ __forceinline__ void operator()(const f32x4 (&acc)[2][2][4][2], const Unit& u, int wr, int wc, int fr, int fq) const {
        const int e = u.pn >> 2, j = u.pn & 3;
        const int row0 = u.pm * BM + wr * 64 + fr, col0 = j * 256 + wc * 32 + 8 * fq;
        const float* bp = bd + (size_t)e * 1024 + col0;
#pragma unroll
        for (int bj = 0; bj < 2; ++bj) {
            const f32x4 b0 = *(const f32x4*)(bp + bj * HALF), b1 = *(const f32x4*)(bp + bj * HALF + 4);
#pragma unroll
            for (int ai = 0; ai < 2; ++ai)
#pragma unroll
                for (int m = 0; m < 4; ++m) {
                    const int r = row0 + ai * HALF + m * 16; const float gs = sgate[r];
                    const f32x4 v0 = (acc[ai][bj][m][0] + b0) * gs, v1 = (acc[ai][bj][m][1] + b1) * gs;
                    u32x4 w; w.x = cvt_pk_bf16(v0[0], v0[1]); w.y = cvt_pk_bf16(v0[2], v0[3]); w.z = cvt_pk_bf16(v1[0], v1[1]); w.w = cvt_pk_bf16(v1[2], v1[3]);
                    *(u32x4*)(Y + (size_t)r * 1024 + col0 + bj * HALF) = w;
                }
        }
    }
};

template <class Epi, class Sched, bool ALIGN_EPI = true>
__device__ __forceinline__ void gemm_phase(PG8_LAS unsigned char* lds, const Gemm g, const Sched& S, const Epi& E, const int wid_in) {
    const int wid = __builtin_amdgcn_readfirstlane(wid_in), lane = (int)__builtin_amdgcn_mbcnt_hi(~0u, __builtin_amdgcn_mbcnt_lo(~0u, 0u)), tid = wid * 64 + lane, wr = wid >> 2, wc = wid & 3, fr = lane & 15, fq = lane >> 4;
    const int K = g.K, nt = K / BK;
    unsigned voffA[2], voffB[2];
#pragma unroll
    for (int i = 0; i < 2; ++i) { int R, C; stage_rc(tid * 16 + i * 8192, R, C); const int Rb = Epi::PERM ? ((R & ~31) + perm32(R & 31)) : R;
        voffA[i] = (unsigned)(R * g.lda + C) * 2u; voffB[i] = (unsigned)(Rb * g.ldb + C) * 2u; }
    const size_t kstep = (size_t)(BK * 2);
    const size_t hstepA = (size_t)HALF * g.lda * 2, hstepB = (size_t)HALF * g.ldb * 2;
    const size_t tstepA = 2 * hstepA, tstepB = 2 * hstepB;
    const unsigned ldsw = (unsigned)wid * 1024u;
    const int aoff = lds_byte(wr * 64 + fr, fq * 8), boff = lds_byte(wc * 32 + fr, fq * 8);
#define PG8_SA(b, h) (((b) * 2 + (h)) * HTB)
#define PG8_SB(b, h) ((4 + (b) * 2 + (h)) * HTB)
#define PG8_STAGE(bufoff, gbase, voff) do { _Pragma("unroll") for (int _i = 0; _i < 2; ++_i) \
        __builtin_amdgcn_global_load_lds((const unsigned*)((const char*)(gbase) + (voff)[_i]), (PG8_LAS unsigned*)(lds + (bufoff) + ldsw + _i * 8192), 16, 0, 0); } while (0)
#define PG8_LDA(dst, b, h) do { _Pragma("unroll") for (int m = 0; m < 4; ++m) _Pragma("unroll") for (int k = 0; k < 2; ++k) dst[m][k] = *(const PG8_LAS bf16x8*)(lds + PG8_SA(b, h) + aoff + m * 2048 + k * 1024); } while (0)
#define PG8_LDB(dst, b, h) do { _Pragma("unroll") for (int n = 0; n < 2; ++n) _Pragma("unroll") for (int k = 0; k < 2; ++k) dst[n][k] = *(const PG8_LAS bf16x8*)(lds + PG8_SB(b, h) + boff + n * 2048 + k * 1024); } while (0)
#define PG8_MMA(ai, bj, At, Bt) do { __builtin_amdgcn_s_setprio(1); _Pragma("unroll") for (int m = 0; m < 4; ++m) _Pragma("unroll") for (int n = 0; n < 2; ++n) _Pragma("unroll") for (int k = 0; k < 2; ++k) \
        acc[ai][bj][m][n] = __builtin_amdgcn_mfma_f32_16x16x32_bf16(Bt[n][k], At[m][k], acc[ai][bj][m][n], 0, 0, 0); __builtin_amdgcn_s_setprio(0); } while (0)
#define PG8_WAIT_V(n) asm volatile("s_waitcnt vmcnt(" #n ")" ::: "memory")
#define PG8_WAIT_L(n) asm volatile("s_waitcnt lgkmcnt(" #n ")" ::: "memory")
#define PG8_BAR __builtin_amdgcn_s_barrier()
#define PG8_SCHED __builtin_amdgcn_sched_barrier(0)
    Unit cur, nxt; int ui = 0;
    if (!S.next(0, cur)) return;
    f32x4 acc[2][2][4][2];
#pragma unroll
    for (int a = 0; a < 2; ++a)
#pragma unroll
        for (int b = 0; b < 2; ++b)
#pragma unroll
            for (int m = 0; m < 4; ++m)
#pragma unroll
                for (int n = 0; n < 2; ++n) acc[a][b][m][n] = (f32x4){0.f, 0.f, 0.f, 0.f};
    bf16x8 At[4][2], B0[2][2], B1[2][2];
    const char* cA = (const char*)g.A + (size_t)cur.pm * tstepA; const char* cB = (const char*)g.Bt + (size_t)cur.pn * tstepB;
    PG8_STAGE(PG8_SB(0, 0), cB, voffB); PG8_STAGE(PG8_SB(0, 1), cB + hstepB, voffB); PG8_STAGE(PG8_SA(0, 0), cA, voffA); PG8_STAGE(PG8_SA(0, 1), cA + hstepA, voffA);
    if (wr == 1) PG8_BAR;
    PG8_WAIT_V(2); PG8_BAR;
    PG8_STAGE(PG8_SB(1, 0), cB + kstep, voffB); PG8_STAGE(PG8_SA(1, 0), cA + kstep, voffA); PG8_STAGE(PG8_SB(1, 1), cB + hstepB + kstep, voffB);
    PG8_WAIT_V(6); PG8_BAR;
    for (;;) {
        const bool has_next = S.next(ui + 1, nxt);
        const char* nA = has_next ? (const char*)g.A + (size_t)nxt.pm * tstepA : cA; const char* nB = has_next ? (const char*)g.Bt + (size_t)nxt.pn * tstepB : cB;
        for (int t = 0; t < nt; t += 2) {
            const bool last = (t == nt - 2);
            const char* a1 = cA + (size_t)(t + 1) * kstep;
            const char* a2 = last ? nA : cA + (size_t)(t + 2) * kstep; const char* b2 = last ? nB : cB + (size_t)(t + 2) * kstep;
            const char* a3 = a2 + kstep; const char* b3 = b2 + kstep;
            PG8_LDB(B0, 0, 0); PG8_LDB(B1, 0, 1); PG8_SCHED; PG8_LDA(At, 0, 0); PG8_STAGE(PG8_SA(1, 1), a1 + hstepA, voffA);
            PG8_WAIT_V(8); PG8_WAIT_L(0); PG8_BAR; PG8_MMA(0, 0, At, B0); PG8_MMA(0, 1, At, B1); PG8_BAR; PG8_SCHED;
            PG8_LDA(At, 0, 1); PG8_STAGE(PG8_SB(0, 0), b2, voffB); PG8_STAGE(PG8_SB(0, 1), b2 + hstepB, voffB); PG8_STAGE(PG8_SA(0, 0), a2, voffA);
            PG8_WAIT_V(8); PG8_WAIT_L(0); PG8_BAR; PG8_MMA(1, 0, At, B0); PG8_MMA(1, 1, At, B1); PG8_BAR; PG8_SCHED;
            PG8_LDB(B0, 1, 0); PG8_LDB(B1, 1, 1); PG8_SCHED; PG8_LDA(At, 1, 0); PG8_STAGE(PG8_SA(0, 1), a2 + hstepA, voffA);
            PG8_WAIT_V(8); PG8_WAIT_L(0); PG8_BAR; PG8_MMA(0, 0, At, B0); PG8_MMA(0, 1, At, B1); PG8_BAR; PG8_SCHED;
            PG8_LDA(At, 1, 1); PG8_STAGE(PG8_SB(1, 0), b3, voffB); PG8_STAGE(PG8_SB(1, 1), b3 + hstepB, voffB); PG8_STAGE(PG8_SA(1, 0), a3, voffA);
            PG8_WAIT_V(8); PG8_WAIT_L(0); PG8_BAR; PG8_MMA(1, 0, At, B0); PG8_MMA(1, 1, At, B1); PG8_BAR; PG8_SCHED;
        }
        if constexpr (ALIGN_EPI) { if (wr == 0) PG8_BAR; }
        E(acc, cur, wr, wc, fr, fq);
        if (!has_next) break;
#pragma unroll
        for (int a = 0; a < 2; ++a)
#pragma unroll
            for (int b = 0; b < 2; ++b)
#pragma unroll
                for (int m = 0; m < 4; ++m)
#pragma unroll
                    for (int n = 0; n < 2; ++n) acc[a][b][m][n] = (f32x4){0.f, 0.f, 0.f, 0.f};
        cur = nxt; cA = nA; cB = nB; ++ui;
        if constexpr (ALIGN_EPI) { if (wr == 1) PG8_BAR; }
    }
    PG8_WAIT_V(0);
    if constexpr (!ALIGN_EPI) { if (wr == 0) PG8_BAR; }
    PG8_BAR;
#undef PG8_SA
#undef PG8_SB
#undef PG8_STAGE
#undef PG8_LDA
#undef PG8_LDB
#undef PG8_MMA
#undef PG8_WAIT_V
#undef PG8_WAIT_L
#undef PG8_BAR
#undef PG8_SCHED
}
template <class Epi, class Sched, bool ALIGN_EPI = true>
__device__ __forceinline__ void gemm_phase_gather(PG8_LAS unsigned char* lds, const Gemm g, const Sched& S, const Epi& E, const int wid_in, const int* rowmap) {
    const int wid = __builtin_amdgcn_readfirstlane(wid_in), lane = (int)__builtin_amdgcn_mbcnt_hi(~0u, __builtin_amdgcn_mbcnt_lo(~0u, 0u)), tid = wid * 64 + lane, wr = wid >> 2, wc = wid & 3, fr = lane & 15, fq = lane >> 4;
    const int K = g.K, nt = K / BK;
    unsigned voffB[2]; int RA[2]; unsigned CA2[2];
#pragma unroll
    for (int i = 0; i < 2; ++i) { int R, C; stage_rc(tid * 16 + i * 8192, R, C); const int Rb = Epi::PERM ? ((R & ~31) + perm32(R & 31)) : R;
        RA[i] = R; CA2[i] = (unsigned)C * 2u; voffB[i] = (unsigned)(Rb * g.ldb + C) * 2u; }
    const unsigned rowb = (unsigned)g.lda * 2u;
    unsigned ca0[2], ca1[2], na0[2], na1[2]; int raw0[2], raw1[2];
#define PG8_LOADIDX(d0, d1, pm_) do { _Pragma("unroll") for (int _i = 0; _i < 2; ++_i) { d0[_i] = rowmap[(pm_) * BM + RA[_i]]; d1[_i] = rowmap[(pm_) * BM + HALF + RA[_i]]; } } while (0)
#define PG8_CVTIDX(o0, o1, d0, d1) do { _Pragma("unroll") for (int _i = 0; _i < 2; ++_i) { o0[_i] = (unsigned)(d0[_i] < 0 ? 0 : d0[_i]) * rowb + CA2[_i]; o1[_i] = (unsigned)(d1[_i] < 0 ? 0 : d1[_i]) * rowb + CA2[_i]; } } while (0)
    const size_t kstep = (size_t)(BK * 2);
    const size_t hstepB = (size_t)HALF * g.ldb * 2;
    const size_t tstepB = 2 * hstepB;
    const unsigned ldsw = (unsigned)wid * 1024u;
    const int aoff = lds_byte(wr * 64 + fr, fq * 8), boff = lds_byte(wc * 32 + fr, fq * 8);
#define PG8_SA(b, h) (((b) * 2 + (h)) * HTB)
#define PG8_SB(b, h) ((4 + (b) * 2 + (h)) * HTB)
#define PG8_STAGE(bufoff, gbase, voff) do { _Pragma("unroll") for (int _i = 0; _i < 2; ++_i) \
        __builtin_amdgcn_global_load_lds((const unsigned*)((const char*)(gbase) + (voff)[_i]), (PG8_LAS unsigned*)(lds + (bufoff) + ldsw + _i * 8192), 16, 0, 0); } while (0)
#define PG8_LDA(dst, b, h) do { _Pragma("unroll") for (int m = 0; m < 4; ++m) _Pragma("unroll") for (int k = 0; k < 2; ++k) dst[m][k] = *(const PG8_LAS bf16x8*)(lds + PG8_SA(b, h) + aoff + m * 2048 + k * 1024); } while (0)
#define PG8_LDB(dst, b, h) do { _Pragma("unroll") for (int n = 0; n < 2; ++n) _Pragma("unroll") for (int k = 0; k < 2; ++k) dst[n][k] = *(const PG8_LAS bf16x8*)(lds + PG8_SB(b, h) + boff + n * 2048 + k * 1024); } while (0)
#define PG8_MMA(ai, bj, At, Bt) do { __builtin_amdgcn_s_setprio(1); _Pragma("unroll") for (int m = 0; m < 4; ++m) _Pragma("unroll") for (int n = 0; n < 2; ++n) _Pragma("unroll") for (int k = 0; k < 2; ++k) \
        acc[ai][bj][m][n] = __builtin_amdgcn_mfma_f32_16x16x32_bf16(Bt[n][k], At[m][k], acc[ai][bj][m][n], 0, 0, 0); __builtin_amdgcn_s_setprio(0); } while (0)
#define PG8_WAIT_V(n) asm volatile("s_waitcnt vmcnt(" #n ")" ::: "memory")
#define PG8_WAIT_L(n) asm volatile("s_waitcnt lgkmcnt(" #n ")" ::: "memory")
#define PG8_BAR __builtin_amdgcn_s_barrier()
#define PG8_SCHED __builtin_amdgcn_sched_barrier(0)
    Unit cur, nxt, nn; int ui = 0;
    if (!S.next(0, cur)) return;
    bool has_next = S.next(1, nxt);
    PG8_LOADIDX(raw0, raw1, cur.pm); PG8_CVTIDX(ca0, ca1, raw0, raw1);
    if (has_next) { PG8_LOADIDX(raw0, raw1, nxt.pm); PG8_CVTIDX(na0, na1, raw0, raw1); } else { na0[0] = ca0[0]; na0[1] = ca0[1]; na1[0] = ca1[0]; na1[1] = ca1[1]; }
    f32x4 acc[2][2][4][2];
#pragma unroll
    for (int a = 0; a < 2; ++a)
#pragma unroll
        for (int b = 0; b < 2; ++b)
#pragma unroll
            for (int m = 0; m < 4; ++m)
#pragma unroll
                for (int n = 0; n < 2; ++n) acc[a][b][m][n] = (f32x4){0.f, 0.f, 0.f, 0.f};
    bf16x8 At[4][2], B0[2][2], B1[2][2];
    const char* const cA = (const char*)g.A; const char* cB = (const char*)g.Bt + (size_t)cur.pn * tstepB;
    PG8_STAGE(PG8_SB(0, 0), cB, voffB); PG8_STAGE(PG8_SB(0, 1), cB + hstepB, voffB); PG8_STAGE(PG8_SA(0, 0), cA, ca0); PG8_STAGE(PG8_SA(0, 1), cA, ca1);
    if (wr == 1) PG8_BAR;
    PG8_WAIT_V(2); PG8_BAR;
    PG8_STAGE(PG8_SB(1, 0), cB + kstep, voffB); PG8_STAGE(PG8_SA(1, 0), cA + kstep, ca0); PG8_STAGE(PG8_SB(1, 1), cB + hstepB + kstep, voffB);
    PG8_WAIT_V(6); PG8_BAR;
    for (;;) {
        const bool has_next2 = has_next && S.next(ui + 2, nn);
        if (has_next2) PG8_LOADIDX(raw0, raw1, nn.pm);
        const char* nB = has_next ? (const char*)g.Bt + (size_t)nxt.pn * tstepB : cB;
        for (int t = 0; t < nt; t += 2) {
            const bool last = (t == nt - 2);
            const char* a1 = cA + (size_t)(t + 1) * kstep;
            const char* a2 = last ? cA : cA + (size_t)(t + 2) * kstep; const char* b2 = last ? nB : cB + (size_t)(t + 2) * kstep;
            const char* a3 = a2 + kstep; const char* b3 = b2 + kstep;
            unsigned s0[2], s1[2];
            s0[0] = last ? na0[0] : ca0[0]; s0[1] = last ? na0[1] : ca0[1]; s1[0] = last ? na1[0] : ca1[0]; s1[1] = last ? na1[1] : ca1[1];
            PG8_LDB(B0, 0, 0); PG8_LDB(B1, 0, 1); PG8_SCHED; PG8_LDA(At, 0, 0); PG8_STAGE(PG8_SA(1, 1), a1, ca1);
            PG8_WAIT_V(8); PG8_WAIT_L(0); PG8_BAR; PG8_MMA(0, 0, At, B0); PG8_MMA(0, 1, At, B1); PG8_BAR; PG8_SCHED;
            PG8_LDA(At, 0, 1); PG8_STAGE(PG8_SB(0, 0), b2, voffB); PG8_STAGE(PG8_SB(0, 1), b2 + hstepB, voffB); PG8_STAGE(PG8_SA(0, 0), a2, s0);
            PG8_WAIT_V(8); PG8_WAIT_L(0); PG8_BAR; PG8_MMA(1, 0, At, B0); PG8_MMA(1, 1, At, B1); PG8_BAR; PG8_SCHED;
            PG8_LDB(B0, 1, 0); PG8_LDB(B1, 1, 1); PG8_SCHED; PG8_LDA(At, 1, 0); PG8_STAGE(PG8_SA(0, 1), a2, s1);
            PG8_WAIT_V(8); PG8_WAIT_L(0); PG8_BAR; PG8_MMA(0, 0, At, B0); PG8_MMA(0, 1, At, B1); PG8_BAR; PG8_SCHED;
            PG8_LDA(At, 1, 1); PG8_STAGE(PG8_SB(1, 0), b3, voffB); PG8_STAGE(PG8_SB(1, 1), b3 + hstepB, voffB); PG8_STAGE(PG8_SA(1, 0), a3, s0);
            PG8_WAIT_V(8); PG8_WAIT_L(0); PG8_BAR; PG8_MMA(1, 0, At, B0); PG8_MMA(1, 1, At, B1); PG8_BAR; PG8_SCHED;
        }
        if constexpr (ALIGN_EPI) { if (wr == 0) PG8_BAR; }
        E(acc, cur, wr, wc, fr, fq);
        if (!has_next) break;
#pragma unroll
        for (int a = 0; a < 2; ++a)
#pragma unroll
            for (int b = 0; b < 2; ++b)
#pragma unroll
                for (int m = 0; m < 4; ++m)
#pragma unroll
                    for (int n = 0; n < 2; ++n) acc[a][b][m][n] = (f32x4){0.f, 0.f, 0.f, 0.f};
        cur = nxt; cB = nB; ++ui;
        ca0[0] = na0[0]; ca0[1] = na0[1]; ca1[0] = na1[0]; ca1[1] = na1[1];
        if (has_next2) { PG8_CVTIDX(na0, na1, raw0, raw1); nxt = nn; }
        has_next = has_next2;
        if constexpr (ALIGN_EPI) { if (wr == 1) PG8_BAR; }
    }
    PG8_WAIT_V(0);
    if constexpr (!ALIGN_EPI) { if (wr == 0) PG8_BAR; }
    PG8_BAR;
#undef PG8_LOADIDX
#undef PG8_CVTIDX
#undef PG8_SA
#undef PG8_SB
#undef PG8_STAGE
#undef PG8_LDA
#undef PG8_LDB
#undef PG8_MMA
#undef PG8_WAIT_V
#undef PG8_WAIT_L
#undef PG8_BAR
#undef PG8_SCHED
}
}

constexpr int NWAVES = 8, NTHR = 512;
constexpr int BATCH = 32, SEQ = 2048, D = 1024, T = BATCH * SEQ, MEM = 256, TM = BATCH * MEM;
constexpr int DIN = 5888;
constexpr float EPS = 1e-6f;
constexpr int LDP = DIN, C_Q = 0, C_U = 1024, C_QC = 1536, C_K = 2048, C_V = 2176, C_VB = 2304, C_G = 2816;
constexpr int NEXP = 32, TOPK = 4, NHALF = 2, TH = T / NHALF;
constexpr int PH = TH * TOPK + NEXP * 256;
constexpr int MAXTILE = PH / 256;

constexpr size_t MiB = 1u << 20;
constexpr size_t WS_CTL = 0, CTL_ZERO_BYTES = 1 * MiB;
constexpr size_t WS_ROPE = 1 * MiB;
constexpr size_t WS_WIN = 17 * MiB;
constexpr size_t WS_WO = 29 * MiB;
constexpr size_t WS_WMKV = 33 * MiB;
constexpr size_t WS_WOUT = 35 * MiB;
constexpr size_t WS_MEMN = 37 * MiB;
constexpr size_t WS_KV = 53 * MiB;
constexpr size_t WS_META = 69 * MiB;
constexpr size_t WS_H = 77 * MiB;
constexpr size_t WS_PROJ = 205 * MiB;
constexpr size_t WS_WGU = 205 * MiB;
constexpr size_t WS_WD = 333 * MiB;
constexpr size_t WS_H2S = 397 * MiB;
constexpr size_t WS_ACT = 669 * MiB;
constexpr size_t WS_END = 941 * MiB;
static_assert(WS_PROJ + (size_t)T * LDP * 2 <= WS_END && WS_H2S + (size_t)PH * 2048 <= WS_ACT && WS_ACT + (size_t)PH * 2048 <= WS_END, "ws map");
constexpr size_t MT_IDX = 0;
constexpr size_t MT_GATE = 1 * MiB;
constexpr size_t MT_SLOTOF = 2 * MiB;
constexpr size_t MT_STOK = 3 * MiB;
constexpr size_t MT_SGATE = 4 * MiB + 512 * 1024;
constexpr size_t MT_TILEE = 6 * MiB;
constexpr size_t MT_CMAT = 7 * MiB + 512 * 1024;
constexpr size_t MT_WSB = 7 * MiB;
constexpr int CW_BAR = 4096;
constexpr int CW_CNT = 1024;
constexpr int CW_CUR = 1024 + 64;
constexpr int CW_START = 1024 + 128;
constexpr int CW_NTILE = 1024 + 192;

constexpr int RING_OFF = 0, RING_BYTES = 131072;
constexpr int LDS_BYTES = 147456;
constexpr int LDSCTL_OFF = LDS_BYTES - 1024, MISC_OFF = LDSCTL_OFF + 320;

#define GAS __attribute__((address_space(1)))
#define LAS __attribute__((address_space(3)))
typedef unsigned short bf16;
typedef unsigned v4u __attribute__((ext_vector_type(4)));
typedef unsigned v2u __attribute__((ext_vector_type(2)));
typedef float f32x4 __attribute__((ext_vector_type(4)));
typedef GAS unsigned gu32;
#define RLX_AGENT __ATOMIC_RELAXED, __HIP_MEMORY_SCOPE_AGENT
#define LDS_WAIT() asm volatile("s_waitcnt lgkmcnt(0)" ::: "memory")
#define VM_WAIT() asm volatile("s_waitcnt vmcnt(0)" ::: "memory")
__device__ __forceinline__ unsigned f2bf(float f) { unsigned u = __builtin_bit_cast(unsigned, f); return (u + 0x7fffu + ((u >> 16) & 1u)) >> 16; }
__device__ __forceinline__ unsigned pk2(float lo, float hi) { return f2bf(lo) | (f2bf(hi) << 16); }
__device__ __forceinline__ float bf2f(bf16 b) { return __uint_as_float(((unsigned)b) << 16); }
__device__ __forceinline__ float blo(unsigned w) { return __uint_as_float(w << 16); }
__device__ __forceinline__ float bhi(unsigned w) { return __uint_as_float(w & 0xffff0000u); }

#define XB_TMO      128
#define XB_XCNT(j)  (256  + 64 * (j))
#define XB_XSUB(j)  (1280 + 64 * (j))
#define XB_XGEN(j)  (2304 + 64 * (j))
#define XB_TOP      3328
#define XB_TOPGEN   3392
#define XCD_BAR_WORDS 3456
#define XB_SPIN_CAP (1u << 22)
__device__ __forceinline__ unsigned xb_ld(unsigned* p)              { return __hip_atomic_load(p, __ATOMIC_RELAXED, __HIP_MEMORY_SCOPE_AGENT); }
__device__ __forceinline__ unsigned xb_add(unsigned* p, unsigned v) { return __hip_atomic_fetch_add(p, v, __ATOMIC_RELAXED, __HIP_MEMORY_SCOPE_AGENT); }
__device__ __forceinline__ unsigned xb_xcc_id() { return (unsigned)__builtin_amdgcn_s_getreg((3 << 11) | 20) & 0xFu; }
#define XB_SPIN(cond, bar) do { unsigned _sp = 0; while (cond) { __builtin_amdgcn_s_sleep(1); \
    if ((++_sp & 255u) == 0u) { if (xb_ld(&(bar)[XB_TMO])) break; if (_sp > XB_SPIN_CAP) { atomicAdd(&(bar)[XB_TMO], 1u); break; } } } } while (0)
struct XcdBarrier { unsigned* bar; unsigned x; volatile LAS unsigned* st; };
__device__ __forceinline__ XcdBarrier xcd_barrier_post(unsigned* bar, volatile LAS unsigned* st, bool leader) {
    XcdBarrier b; b.bar = bar; b.x = xb_xcc_id(); b.st = st;
    if (leader) (void)xb_add(&bar[XB_XCNT(b.x)], 1u);
    return b;
}
__device__ __forceinline__ void xcd_barrier_complete(unsigned* bar, unsigned x, unsigned& nloc, unsigned& nx) {
    const unsigned G = gridDim.x * gridDim.y * gridDim.z;
    unsigned sum, cnt, mine, sp = 0u;
    for (;;) {
        sum = 0u; cnt = 0u; mine = 0u;
#pragma unroll
        for (unsigned j = 0; j < 16; ++j) { const unsigned c = xb_ld(&bar[XB_XCNT(j)]); sum += c; cnt += (c > 0u) ? 1u : 0u; mine = (j == x) ? c : mine; }
        if (sum == G) break;
        __builtin_amdgcn_s_sleep(1);
        if ((++sp & 255u) == 0u) { if (xb_ld(&bar[XB_TMO])) break; if (sp > XB_SPIN_CAP) { atomicAdd(&bar[XB_TMO], 1u); break; } }
    }
    nloc = mine > 0u ? mine : 1u; nx = cnt > 0u ? cnt : 1u;
}
__device__ __forceinline__ void xcd_barrier(const XcdBarrier& b, bool leader) {
    asm volatile("s_waitcnt vmcnt(0)" ::: "memory");
    __syncthreads();
    if (leader) {
        unsigned* bar = b.bar;
        __builtin_amdgcn_s_waitcnt(0);
        unsigned nloc = b.st[0], nx = b.st[1];
        if (nloc == 0u) { xcd_barrier_complete(bar, b.x, nloc, nx); b.st[0] = nloc; b.st[1] = nx; }
        const unsigned old = xb_add(&bar[XB_XSUB(b.x)], 1u);
        const unsigned gen = old / nloc;
        if (old + 1u == (gen + 1u) * nloc) {
            __builtin_amdgcn_fence(__ATOMIC_RELEASE, "agent");
            asm volatile("s_waitcnt vmcnt(0)" ::: "memory");
            const unsigned og = xb_add(&bar[XB_TOP], 1u);
            const unsigned tg = og / nx;
            if (og + 1u == (tg + 1u) * nx) xb_add(&bar[XB_TOPGEN], 1u);
            else XB_SPIN(xb_ld(&bar[XB_TOPGEN]) == tg, bar);
            __builtin_amdgcn_fence(__ATOMIC_ACQUIRE, "agent");
            xb_add(&bar[XB_XGEN(b.x)], 1u);
            asm volatile("s_waitcnt vmcnt(0)" ::: "memory");
        } else {
            XB_SPIN(xb_ld(&bar[XB_XGEN(b.x)]) == gen, bar);
            __builtin_amdgcn_fence(__ATOMIC_ACQUIRE, "agent");
            asm volatile("s_waitcnt vmcnt(0)" ::: "memory");
        }
    }
    __syncthreads();
}

__device__ __forceinline__ float wave_sum(float v) {
#pragma unroll
    for (int o = 1; o < 64; o <<= 1) v += __shfl_xor(v, o);
    return v;
}
__device__ __forceinline__ float wave_max(float v) {
#pragma unroll
    for (int o = 1; o < 64; o <<= 1) v = fmaxf(v, __shfl_xor(v, o));
    return v;
}
__device__ __forceinline__ float half_sum(float v) {
#pragma unroll
    for (int o = 1; o < 32; o <<= 1) v += __shfl_xor(v, o);
    return v;
}
__device__ __forceinline__ float gelu_erf(float x) { return 0.5f * x * (1.0f + erff(x * 0.70710678118654752f)); }

struct Args {
    const float* in[28]; float* out; unsigned char* ws; int ph_lo, ph_hi;
};
enum { I_X = 0, I_MEM, I_POS, I_ATTN_G, I_MEM_G, I_WIN, I_BGATES, I_AQG, I_AKG, I_SINKS, I_WOA, I_LNG, I_LNB, I_WS, I_BS, I_WOB, I_WMKV, I_CQG, I_CKG, I_WOC, I_WOUT, I_FFN_G,
       I_RW, I_RB, I_WGU, I_BGU, I_WD, I_BD };

__device__ __forceinline__ void tr_item(const float* W, int ldw, int k0, int sc, bf16* WT, int ldt, int dr, int dk, LAS float* scr, int lane) {
#pragma unroll 8
    for (int i = 0; i < 32; ++i) { const int kk = 2 * i + (lane >> 5); scr[kk * 33 + (lane & 31)] = W[(size_t)(k0 + kk) * ldw + sc + (lane & 31)]; }
    LDS_WAIT(); asm volatile("" ::: "memory");
    const int c = lane & 7;
#pragma unroll
    for (int j = 0; j < 4; ++j) { const int n = (lane >> 3) + 8 * j; const LAS float* s = scr + (8 * c) * 33 + n;
        v4u o; o.x = pk2(s[0 * 33], s[1 * 33]); o.y = pk2(s[2 * 33], s[3 * 33]); o.z = pk2(s[4 * 33], s[5 * 33]); o.w = pk2(s[6 * 33], s[7 * 33]);
        *(GAS v4u*)(WT + (size_t)(dr + n) * ldt + dk + k0 + 8 * c) = o; }
    LDS_WAIT(); asm volatile("" ::: "memory");
}
__device__ __forceinline__ int win_srccol(int r) {
    if (r < 1024) { const int pn = r >> 8, blk = (r >> 5) & 7, bj = blk >> 2, wc = blk & 3; return 64 * (4 * pn + wc) + 32 * bj; }
    if (r < 1536) return 1280 + (r - 1024);
    if (r < 2048) return 2304 + (r - 1536);
    if (r < 2304) { const int blk = (r - 2048) >> 5, bj = blk >> 2, wc = blk & 3; return ((wc & 1) ? 1152 : 1024) + 64 * (wc >> 1) + 32 * bj; }
    if (r < 2816) return 1792 + (r - 2304);
    return r;
}
__device__ __forceinline__ void rms_row_to_bf16(const float* xrow, const float* g, bf16* orow, int lane) {
    const GAS f32x4* xr = (const GAS f32x4*)xrow + lane; const GAS f32x4* gr = (const GAS f32x4*)g + lane;
    f32x4 v[4]; float s = 0.f;
#pragma unroll
    for (int j = 0; j < 4; ++j) { v[j] = xr[64 * j]; s += (v[j].x * v[j].x + v[j].y * v[j].y) + (v[j].z * v[j].z + v[j].w * v[j].w); }
    const float rstd = 1.0f / sqrtf(wave_sum(s) * (1.f / 1024.f) + EPS);
    GAS v2u* o8 = (GAS v2u*)orow + lane;
#pragma unroll
    for (int j = 0; j < 4; ++j) { const f32x4 gg = gr[64 * j]; v2u o; o.x = pk2(v[j].x * rstd * gg.x, v[j].y * rstd * gg.y); o.y = pk2(v[j].z * rstd * gg.z, v[j].w * rstd * gg.w); o8[64 * j] = o; }
}

namespace att {
typedef short bf16x8 __attribute__((ext_vector_type(8)));
typedef short s16x4 __attribute__((ext_vector_type(4)));
typedef short v4i16_t __attribute__((ext_vector_type(4)));
typedef float f32x16 __attribute__((ext_vector_type(16)));
typedef float f32x2_t __attribute__((ext_vector_type(2)));
typedef __bf16 bf16x2_t __attribute__((ext_vector_type(2)));
#define ATT_MFMA(a, b, c) __builtin_amdgcn_mfma_f32_32x32x16_bf16((a), (b), (c), 0, 0, 0)
__device__ __forceinline__ unsigned cvtpk(float lo, float hi) { f32x2_t v = {lo, hi}; bf16x2_t b = __builtin_convertvector(v, bf16x2_t); return __builtin_bit_cast(unsigned, b); }
__device__ __forceinline__ s16x4 vtr(const LAS unsigned char* p) { return __builtin_bit_cast(s16x4, __builtin_amdgcn_ds_read_tr16_b64_v4i16((LAS v4i16_t*)p)); }
__device__ __forceinline__ int crow(int r, int h) { return (r & 3) + 8 * (r >> 2) + 4 * h; }
__device__ __forceinline__ bf16x8 pack8(float a0, float a1, float a2, float a3, float a4, float a5, float a6, float a7) {
    v4u w; w.x = cvtpk(a0, a1); w.y = cvtpk(a2, a3); w.z = cvtpk(a4, a5); w.w = cvtpk(a6, a7); return __builtin_bit_cast(bf16x8, w); }
constexpr float LOG2E = 1.4426950408889634f;
constexpr int SWA_KP = 144, SWA_VP = 192, SWA_K_OFF = 0, SWA_V_OFF = 256 * SWA_KP;

__device__ __forceinline__ void swa_phase(LAS unsigned char* L, bf16* projp, const float* sinks, const float* gq, const float* gk, int bid, int G, int wave, int lane) {
    const int tid = wave * 64 + lane, r32 = lane & 31, h = lane >> 5, blk16 = (lane >> 4) & 1, q4 = (lane & 15) >> 2, p4 = lane & 3;
    const float bnd = 8.0f * wave_max(fabsf(gq[lane])) * wave_max(fabsf(gk[lane]));
    for (int unit = bid; unit < 1024; unit += G) {
        const int blk = unit & 15, kvh = (unit >> 4) & 1, b = unit >> 5;
        const int tok0 = b * SEQ + blk * 128;
        __syncthreads();
        for (int it = (blk == 0 ? 2 : 0); it < 4; ++it) {
            const int row = (tid >> 3) + 64 * it, ch = tid & 7;
            const bf16* src = projp + (size_t)(tok0 - 128 + row) * LDP + 64 * kvh + 8 * ch;
            const v4u kx = *(const GAS v4u*)(src + C_K), vx = *(const GAS v4u*)(src + C_V);
            *(LAS v4u*)(L + SWA_K_OFF + row * SWA_KP + ch * 16) = kx;
            *(LAS v4u*)(L + SWA_V_OFF + row * SWA_VP + ch * 16) = vx;
        }
        __syncthreads();
        const int hd = kvh * 8 + wave;
        const float sink = sinks[hd];
        const float m2 = fmaxf(bnd, sink) * LOG2E;
        const float esink = __builtin_amdgcn_exp2f(sink * LOG2E - m2);
#pragma unroll 1
        for (int qi = 0; qi < 4; ++qi) {
            bf16* qrow = projp + (size_t)(tok0 + 32 * qi + r32) * LDP + C_Q + 64 * hd;
            bf16x8 qf[4];
#pragma unroll
            for (int ks = 0; ks < 4; ++ks) qf[ks] = *(const GAS bf16x8*)(qrow + 16 * ks + 8 * h);
            f32x16 o0, o1;
#pragma unroll
            for (int r = 0; r < 16; ++r) { o0[r] = 0.f; o1[r] = 0.f; }
            float lsum = 0.f;
            const int kt0 = (blk == 0) ? 4 : qi;
#pragma unroll 1
            for (int kt = kt0; kt <= qi + 4; ++kt) {
                f32x16 s;
#pragma unroll
                for (int r = 0; r < 16; ++r) s[r] = 0.f;
                const LAS unsigned char* kp = L + SWA_K_OFF + (32 * kt + r32) * SWA_KP + 16 * h;
#pragma unroll
                for (int ks = 0; ks < 4; ++ks) { const bf16x8 kf = *(const LAS bf16x8*)(kp + 32 * ks); s = ATT_MFMA(kf, qf[ks], s); }
                float p[16];
                const bool first = (kt == qi), lastt = (kt == qi + 4);
#pragma unroll
                for (int r = 0; r < 16; ++r) { const float e = __builtin_amdgcn_exp2f(s[r] * (0.125f * LOG2E) - m2); const int cr = crow(r, h);
                    const bool ok = (!first || cr > r32) && (!lastt || cr <= r32); p[r] = ok ? e : 0.f; lsum += p[r]; }
#pragma unroll
                for (int s2 = 0; s2 < 2; ++s2) {
                    const bf16x8 pb = pack8(p[8 * s2], p[8 * s2 + 1], p[8 * s2 + 2], p[8 * s2 + 3], p[8 * s2 + 4], p[8 * s2 + 5], p[8 * s2 + 6], p[8 * s2 + 7]);
                    const LAS unsigned char* vp = L + SWA_V_OFF + (32 * kt + 16 * s2 + 4 * h + q4) * SWA_VP + (16 * blk16 + 4 * p4) * 2;
                    { const s16x4 lo = vtr(vp), hi = vtr(vp + 8 * SWA_VP); const bf16x8 vf = __builtin_shufflevector(lo, hi, 0, 1, 2, 3, 4, 5, 6, 7); o0 = ATT_MFMA(vf, pb, o0); }
                    { const s16x4 lo = vtr(vp + 64), hi = vtr(vp + 64 + 8 * SWA_VP); const bf16x8 vf = __builtin_shufflevector(lo, hi, 0, 1, 2, 3, 4, 5, 6, 7); o1 = ATT_MFMA(vf, pb, o1); }
                }
            }
            const float tot = lsum + __shfl_xor(lsum, 32); const float inv = 1.0f / (tot + esink);
#pragma unroll
            for (int g4 = 0; g4 < 4; ++g4) {
                v2u w0; w0.x = cvtpk(o0[4 * g4] * inv, o0[4 * g4 + 1] * inv); w0.y = cvtpk(o0[4 * g4 + 2] * inv, o0[4 * g4 + 3] * inv);
                v2u w1; w1.x = cvtpk(o1[4 * g4] * inv, o1[4 * g4 + 1] * inv); w1.y = cvtpk(o1[4 * g4 + 2] * inv, o1[4 * g4 + 3] * inv);
                *(GAS v2u*)(qrow + 8 * g4 + 4 * h) = w0; *(GAS v2u*)(qrow + 32 + 8 * g4 + 4 * h) = w1;
            }
        }
    }
}

constexpr int GM_P = 1088;
__device__ __forceinline__ void gmlp_phase(LAS unsigned char* L, bf16* projp, const bf16* Wb, const float* lng, const float* lnb, const float* bs, int bid, int G, int wave, int lane) {
    const int r32 = lane & 31, h = lane >> 5, blk16 = (lane >> 4) & 1, q4 = (lane & 15) >> 2, p4 = lane & 3;
    float lg[8], lb[8];
    { const f32x4 a = *(const f32x4*)(lng + 8 * lane), b = *(const f32x4*)(lng + 8 * lane + 4), c = *(const f32x4*)(lnb + 8 * lane), d = *(const f32x4*)(lnb + 8 * lane + 4);
      lg[0] = a.x; lg[1] = a.y; lg[2] = a.z; lg[3] = a.w; lg[4] = b.x; lg[5] = b.y; lg[6] = b.z; lg[7] = b.w;
      lb[0] = c.x; lb[1] = c.y; lb[2] = c.z; lb[3] = c.w; lb[4] = d.x; lb[5] = d.y; lb[6] = d.z; lb[7] = d.w; }
    for (int unit = bid; unit < T / 128; unit += G) {
        const int tok0 = unit * 128;
        __syncthreads();
#pragma unroll 4
        for (int i = 0; i < 16; ++i) { const int t = 16 * wave + i;
            const v4u w = *(const GAS v4u*)(projp + (size_t)(tok0 + t) * LDP + C_VB + 8 * lane);
            float v[8] = {blo(w.x), bhi(w.x), blo(w.y), bhi(w.y), blo(w.z), bhi(w.z), blo(w.w), bhi(w.w)};
            float sm = 0.f;
#pragma unroll
            for (int e = 0; e < 8; ++e) sm += v[e];
            const float mu = wave_sum(sm) * (1.f / 512.f); float q = 0.f;
#pragma unroll
            for (int e = 0; e < 8; ++e) { v[e] -= mu; q += v[e] * v[e]; }
            const float rstd = 1.0f / sqrtf(wave_sum(q) * (1.f / 512.f) + EPS);
            v4u o; o.x = cvtpk(v[0] * rstd * lg[0] + lb[0], v[1] * rstd * lg[1] + lb[1]); o.y = cvtpk(v[2] * rstd * lg[2] + lb[2], v[3] * rstd * lg[3] + lb[3]);
            o.z = cvtpk(v[4] * rstd * lg[4] + lb[4], v[5] * rstd * lg[5] + lb[5]); o.w = cvtpk(v[6] * rstd * lg[6] + lb[6], v[7] * rstd * lg[7] + lb[7]);
            *(LAS v4u*)(L + t * GM_P + lane * 16) = o; }
        __syncthreads();
        const int g = wave >> 1, th = wave & 1;
        f32x16 acc[4][2];
#pragma unroll
        for (int ct = 0; ct < 4; ++ct)
#pragma unroll
            for (int tt = 0; tt < 2; ++tt)
#pragma unroll
                for (int r = 0; r < 16; ++r) acc[ct][tt][r] = 0.f;
#pragma unroll 1
        for (int ks = 0; ks < 4 * th + 4; ++ks) {
            bf16x8 af[4];
#pragma unroll
            for (int ct = 0; ct < 4; ++ct) { const LAS unsigned char* vp = L + (16 * ks + 8 * h + q4) * GM_P + (128 * g + 32 * ct + 16 * blk16 + 4 * p4) * 2;
                const s16x4 lo = vtr(vp), hi = vtr(vp + 4 * GM_P); af[ct] = __builtin_shufflevector(lo, hi, 0, 1, 2, 3, 4, 5, 6, 7); }
#pragma unroll
            for (int tt = 0; tt < 2; ++tt) if (ks < 4 * th + 2 * tt + 2) {
                const bf16x8 bfr = *(const GAS bf16x8*)(Wb + (size_t)(g * 128 + 64 * th + 32 * tt + r32) * 128 + 16 * ks + 8 * h);
#pragma unroll
                for (int ct = 0; ct < 4; ++ct) acc[ct][tt] = ATT_MFMA(af[ct], bfr, acc[ct][tt]);
            }
        }
#pragma unroll
        for (int tt = 0; tt < 2; ++tt) { const int t = 64 * th + 32 * tt + r32; const float bsv = bs[g * 128 + t];
            bf16* urow = projp + (size_t)(tok0 + t) * LDP + C_U + 128 * g + 4 * h;
#pragma unroll
            for (int ct = 0; ct < 4; ++ct)
#pragma unroll
                for (int g4 = 0; g4 < 4; ++g4) { bf16* up = urow + 32 * ct + 8 * g4; const v2u uw = *(const GAS v2u*)up;
                    v2u o; o.x = cvtpk(blo(uw.x) * (acc[ct][tt][4 * g4] + bsv), bhi(uw.x) * (acc[ct][tt][4 * g4 + 1] + bsv));
                    o.y = cvtpk(blo(uw.y) * (acc[ct][tt][4 * g4 + 2] + bsv), bhi(uw.y) * (acc[ct][tt][4 * g4 + 3] + bsv)); *(GAS v2u*)up = o; } }
    }
}

constexpr int XA_K_OFF = 0, XA_V_OFF = 65536;
__device__ __forceinline__ unsigned off_b(unsigned row, unsigned ch) { return 256u * row + 16u * (ch ^ (((row & 3u) << 2) | ((row >> 2) & 3u))); }
__device__ __forceinline__ void xattn_phase(LAS unsigned char* L, bf16* projp, const bf16* kvp, const float* cqg, const float* ckg, int bid, int G, int wave, int lane) {
    const int tid = wave * 64 + lane, r32 = lane & 31, h = lane >> 5, blk16 = (lane >> 4) & 1, q4 = (lane & 15) >> 2, p4 = lane & 3;
    const int fch = tid & 15;
    float gg[8];
#pragma unroll
    for (int i = 0; i < 8; ++i) gg[i] = cqg[8 * fch + i] * ckg[8 * fch + i] * (0.08838834764831845f * LOG2E);
    const float mq = wave_max(fmaxf(fabsf(cqg[lane]), fabsf(cqg[lane + 64]))), mk = wave_max(fmaxf(fabsf(ckg[lane]), fabsf(ckg[lane + 64])));
    const float m2 = 11.313708499f * mq * mk * LOG2E;
    for (int unit = bid; unit < 1024; unit += G) {
        const int qt = unit & 7, hd = (unit >> 3) & 3, b = unit >> 5;
        __syncthreads();
#pragma unroll 2
        for (int it = 0; it < 8; ++it) { const int row = (tid >> 4) + 32 * it;
            const bf16* src = kvp + (size_t)(b * MEM + row) * D + 128 * hd + 8 * fch;
            const v4u kx = *(const GAS v4u*)src, vx = *(const GAS v4u*)(src + 512);
            float k[8] = {blo(kx.x), bhi(kx.x), blo(kx.y), bhi(kx.y), blo(kx.z), bhi(kx.z), blo(kx.w), bhi(kx.w)};
            float ss = 0.f;
#pragma unroll
            for (int e = 0; e < 8; ++e) ss += k[e] * k[e];
            ss += __shfl_xor(ss, 1); ss += __shfl_xor(ss, 2); ss += __shfl_xor(ss, 4); ss += __shfl_xor(ss, 8);
            const float rstd = 1.0f / sqrtf(ss * (1.f / 128.f) + EPS);
            v4u ko; ko.x = cvtpk(k[0] * rstd * gg[0], k[1] * rstd * gg[1]); ko.y = cvtpk(k[2] * rstd * gg[2], k[3] * rstd * gg[3]);
            ko.z = cvtpk(k[4] * rstd * gg[4], k[5] * rstd * gg[5]); ko.w = cvtpk(k[6] * rstd * gg[6], k[7] * rstd * gg[7]);
            const unsigned o = off_b((unsigned)row, (unsigned)fch);
            *(LAS v4u*)(L + XA_K_OFF + o) = ko; *(LAS v4u*)(L + XA_V_OFF + o) = vx; }
        __syncthreads();
        bf16* qrow = projp + (size_t)(b * SEQ + 256 * qt + 32 * wave + r32) * LDP + C_QC + 128 * hd;
        bf16x8 qf[8]; float ss = 0.f;
#pragma unroll
        for (int ks = 0; ks < 8; ++ks) { const v4u w = *(const GAS v4u*)(qrow + 16 * ks + 8 * h); qf[ks] = __builtin_bit_cast(bf16x8, w);
            ss += (blo(w.x) * blo(w.x) + bhi(w.x) * bhi(w.x)) + (blo(w.y) * blo(w.y) + bhi(w.y) * bhi(w.y)) + (blo(w.z) * blo(w.z) + bhi(w.z) * bhi(w.z)) + (blo(w.w) * blo(w.w) + bhi(w.w) * bhi(w.w)); }
        ss += __shfl_xor(ss, 32);
        const float rq = 1.0f / sqrtf(ss * (1.f / 128.f) + EPS);
        f32x16 o[4];
#pragma unroll
        for (int dt = 0; dt < 4; ++dt)
#pragma unroll
            for (int r = 0; r < 16; ++r) o[dt][r] = 0.f;
        float lsum = 0.f;
#pragma unroll 1
        for (int kt = 0; kt < 8; ++kt) {
            f32x16 s;
#pragma unroll
            for (int r = 0; r < 16; ++r) s[r] = 0.f;
#pragma unroll
            for (int ks = 0; ks < 8; ++ks) { const bf16x8 kf = *(const LAS bf16x8*)(L + XA_K_OFF + off_b((unsigned)(32 * kt + r32), (unsigned)(2 * ks + h))); s = ATT_MFMA(kf, qf[ks], s); }
            float p[16];
#pragma unroll
            for (int r = 0; r < 16; ++r) { p[r] = __builtin_amdgcn_exp2f(s[r] * rq - m2); lsum += p[r]; }
#pragma unroll
            for (int s2 = 0; s2 < 2; ++s2) {
                const bf16x8 pb = pack8(p[8 * s2], p[8 * s2 + 1], p[8 * s2 + 2], p[8 * s2 + 3], p[8 * s2 + 4], p[8 * s2 + 5], p[8 * s2 + 6], p[8 * s2 + 7]);
                const unsigned r0 = (unsigned)(32 * kt + 16 * s2 + 4 * h + q4);
#pragma unroll
                for (int dt = 0; dt < 4; ++dt) {
                    const unsigned ch = (unsigned)(4 * dt + 2 * blk16 + (p4 >> 1));
                    const s16x4 lo = vtr(L + XA_V_OFF + off_b(r0, ch) + 8 * (p4 & 1)), hi = vtr(L + XA_V_OFF + off_b(r0 + 8u, ch) + 8 * (p4 & 1));
                    const bf16x8 vf = __builtin_shufflevector(lo, hi, 0, 1, 2, 3, 4, 5, 6, 7); o[dt] = ATT_MFMA(vf, pb, o[dt]); }
            }
        }
        const float inv = 1.0f / (lsum + __shfl_xor(lsum, 32));
#pragma unroll
        for (int dt = 0; dt < 4; ++dt)
#pragma unroll
            for (int g4 = 0; g4 < 4; ++g4) { v2u w; w.x = cvtpk(o[dt][4 * g4] * inv, o[dt][4 * g4 + 1] * inv); w.y = cvtpk(o[dt][4 * g4 + 2] * inv, o[dt][4 * g4 + 3] * inv);
                *(GAS v2u*)(qrow + 32 * dt + 8 * g4 + 4 * h) = w; }
    }
}
}

constexpr int NPHASE = 14;
__global__ void __launch_bounds__(NTHR, 2) fwd(Args args) {
    extern __shared__ __attribute__((aligned(16))) unsigned char lds[];
    LAS unsigned char* L = (LAS unsigned char*)lds;
    volatile LAS unsigned* MISC = (volatile LAS unsigned*)(L + MISC_OFF);
    const int wave_s = __builtin_amdgcn_readfirstlane((int)threadIdx.x >> 6);
    for (int u = threadIdx.x; u < (LDS_BYTES - LDSCTL_OFF) / 4; u += NTHR) ((LAS unsigned*)(L + LDSCTL_OFF))[u] = 0u;
    __syncthreads();
#define LANE_ID ((int)__builtin_amdgcn_mbcnt_hi(~0u, __builtin_amdgcn_mbcnt_lo(~0u, 0u)))
#if MK_FUSED
    XcdBarrier bar = xcd_barrier_post((unsigned*)(args.ws + WS_CTL) + CW_BAR, MISC + 8, wave_s == 0 && LANE_ID == 0);
#define GRID_BAR() xcd_barrier(bar, wave_s == 0 && LANE_ID == 0)
#else
    (void)MISC;
#define GRID_BAR() do {} while (0)
#endif
    const int lo = args.ph_lo, hi = args.ph_hi;
#define IN(k) (lo <= (k) && (k) < hi)
#define SEAM(k) do { if (IN(k) && IN((k) + 1)) GRID_BAR(); } while (0)
#define PV \
    int wave = wave_s; asm volatile("" : "+s"(wave)); int bid = blockIdx.x; asm volatile("" : "+s"(bid)); \
    const int lane = LANE_ID, tid = wave * 64 + lane; \
    const int G = gridDim.x, gw = bid * NWAVES + wave, NGW = G * NWAVES, gtid = bid * NTHR + tid, NT = G * NTHR; \
    unsigned char* ws = args.ws; asm volatile("" : "+s"(ws)); \
    gu32* ctl = (gu32*)(ws + WS_CTL); \
    LAS float* scr = (LAS float*)(L + RING_OFF + wave * 16384); \
    (void)lane; (void)tid; (void)bid; (void)gw; (void)NGW; (void)gtid; (void)NT; (void)ctl; (void)scr; (void)G;
#define Win_t ((bf16*)(ws + WS_WIN))
#define Wo_t ((bf16*)(ws + WS_WO))
#define Wmkv_t ((bf16*)(ws + WS_WMKV))
#define Wout_t ((bf16*)(ws + WS_WOUT))
#define Hb ((bf16*)(ws + WS_H))
#define proj ((bf16*)(ws + WS_PROJ))
#define memn ((bf16*)(ws + WS_MEMN))
#define kv ((bf16*)(ws + WS_KV))
#define rope ((float2*)(ws + WS_ROPE))
#define Wgu_t ((bf16*)(ws + WS_WGU))
#define Wd_t ((bf16*)(ws + WS_WD))
#define ybuf ((bf16*)(ws + WS_H2S))
#define act ((bf16*)(ws + WS_ACT))
#define topk_idx ((int*)(ws + WS_META + MT_IDX))
#define topk_gate ((float*)(ws + WS_META + MT_GATE))
#define slot_of ((int*)(ws + WS_META + MT_SLOTOF))
#define slot_tok ((int*)(ws + WS_META + MT_STOK))
#define slot_gate ((float*)(ws + WS_META + MT_SGATE))
#define tile_e ((int*)(ws + WS_META + MT_TILEE))
#define Wsb ((bf16*)(ws + WS_META + MT_WSB))
#define Cmat ((int*)(ws + WS_META + MT_CMAT))

    if (IN(0)) { PV
        const float* x = args.in[I_X]; (void)x;
        { const float* W = args.in[I_WIN]; constexpr int nrb = DIN / 32, nit = (D / 64) * nrb;
          for (int it = gw; it < nit; it += NGW) { const int kb = it / nrb, rb = it % nrb; tr_item(W, DIN, 64 * kb, win_srccol(32 * rb), Win_t, D, 32 * rb, 0, scr, lane); } }
        { const float* W = args.in[I_WOA]; constexpr int nrb = D / 32, nit = (1024 / 64) * nrb;
          for (int it = gw; it < nit; it += NGW) { const int kb = it / nrb, rb = it % nrb; tr_item(W, D, 64 * kb, 32 * rb, Wo_t, 2048, 32 * rb, 0, scr, lane); } }
        { const float* W = args.in[I_WOB]; constexpr int nrb = D / 32, nit = (512 / 64) * nrb;
          for (int it = gw; it < nit; it += NGW) { const int kb = it / nrb, rb = it % nrb; tr_item(W, D, 64 * kb, 32 * rb, Wo_t, 2048, 32 * rb, 1024, scr, lane); } }
        { const float* W = args.in[I_WOC]; constexpr int nrb = D / 32, nit = (512 / 64) * nrb;
          for (int it = gw; it < nit; it += NGW) { const int kb = it / nrb, rb = it % nrb; tr_item(W, D, 64 * kb, 32 * rb, Wo_t, 2048, 32 * rb, 1536, scr, lane); } }
        { const float* W = args.in[I_WMKV]; constexpr int nrb = D / 32, nit = (D / 64) * nrb;
          for (int it = gw; it < nit; it += NGW) { const int kb = it / nrb, rb = it % nrb; tr_item(W, D, 64 * kb, 32 * rb, Wmkv_t, D, 32 * rb, 0, scr, lane); } }
        { const float* W = args.in[I_WOUT]; constexpr int nrb = D / 32, nit = (D / 64) * nrb;
          for (int it = gw; it < nit; it += NGW) { const int kb = it / nrb, rb = it % nrb; tr_item(W, D, 64 * kb, 32 * rb, Wout_t, D, 32 * rb, 0, scr, lane); } }
        { const int* pos = (const int*)args.in[I_POS];
          for (int i = gtid; i < T * 32; i += NT) { const int t = i >> 5, f = i & 31;
              const float inv = powf(10000.0f, -(float)(2 * f) / 64.0f); const float ang = (float)pos[t] * inv;
              double sn, cs; sincos((double)ang, &sn, &cs); rope[i] = make_float2((float)cs, (float)sn); } }
        for (int i = gtid; i < 4 * 128 * 128; i += NT) { const int tt = (i >> 7) & 127, sp = i & 127; Wsb[i] = (bf16)(sp <= tt ? f2bf(args.in[I_WS][i]) : 0u); }
        for (int m = gw; m < T; m += NGW) rms_row_to_bf16(x + (size_t)m * D, args.in[I_ATTN_G], Hb + (size_t)m * D, lane);
        for (int m = gw; m < TM; m += NGW) rms_row_to_bf16(args.in[I_MEM] + (size_t)m * D, args.in[I_MEM_G], memn + (size_t)m * D, lane);
    }
    SEAM(0);
    if (IN(1)) { PV
        { pg8::Gemm g{Hb, Win_t, D, D, D}; pg8::StaticOrder S; S.init(T, DIN, G, bid);
          pg8::EpiProj E{proj, LDP, (const float*)rope, args.in[I_AQG], args.in[I_AKG], args.in[I_BGATES], EPS, C_Q, C_K, C_V, C_G};
          pg8::gemm_phase<pg8::EpiProj, pg8::StaticOrder>(L + RING_OFF, g, S, E, wave); }
        { pg8::Gemm g{memn, Wmkv_t, D, D, D}; pg8::StaticOrder S; S.init(TM, D, G, bid); pg8::EpiBf16 E{kv, D};
          pg8::gemm_phase<pg8::EpiBf16, pg8::StaticOrder>(L + RING_OFF, g, S, E, wave); }
    }
    if (IN(1) && IN(3)) GRID_BAR();
    if (IN(3)) { PV
        att::swa_phase(L + RING_OFF, proj, args.in[I_SINKS], args.in[I_AQG], args.in[I_AKG], bid, G, wave, lane);
        __syncthreads();
        att::gmlp_phase(L + RING_OFF, proj, Wsb, args.in[I_LNG], args.in[I_LNB], args.in[I_BS], bid, G, wave, lane);
        __syncthreads();
        att::xattn_phase(L + RING_OFF, proj, kv, args.in[I_CQG], args.in[I_CKG], bid, G, wave, lane);
        __syncthreads();
    }
    SEAM(3);
    if (IN(4)) { PV
        pg8::StaticOrder S; S.init(T, D, G, bid);
        { pg8::Gemm g{proj + C_Q, Wo_t, 1024, LDP, 2048}; pg8::EpiMerge<0> E{Hb, D, proj + C_G, LDP};
          pg8::gemm_phase<pg8::EpiMerge<0>, pg8::StaticOrder>(L + RING_OFF, g, S, E, wave); }
        { pg8::Gemm g{proj + C_U, Wo_t + 1024, 512, LDP, 2048}; pg8::EpiMerge<1> E{Hb, D, proj + C_G + 1024, LDP};
          pg8::gemm_phase<pg8::EpiMerge<1>, pg8::StaticOrder>(L + RING_OFF, g, S, E, wave); }
        { pg8::Gemm g{proj + C_QC, Wo_t + 1536, 512, LDP, 2048}; pg8::EpiMerge<1> E{Hb, D, proj + C_G + 2048, LDP};
          pg8::gemm_phase<pg8::EpiMerge<1>, pg8::StaticOrder>(L + RING_OFF, g, S, E, wave); }
    }
    SEAM(4);
    if (IN(5)) { PV
        const float* x = args.in[I_X];
        pg8::Gemm g{Hb, Wout_t, D, D, D}; pg8::StaticOrder S; S.init(T, D, G, bid); pg8::EpiResF32 E{args.out, x, D};
        pg8::gemm_phase<pg8::EpiResF32, pg8::StaticOrder>(L + RING_OFF, g, S, E, wave);
    }
    SEAM(5);
    if (IN(6)) { PV
        const float* rw = args.in[I_RW]; const float* rb = args.in[I_RB]; const float* fg = args.in[I_FFN_G];
        LAS unsigned* hist = (LAS unsigned*)(L + LDSCTL_OFF + 512);
        for (int vb = bid; vb < T / 256; vb += G) {
            __syncthreads();
            if (tid < 32) hist[tid] = 0u;
            __syncthreads();
#pragma unroll 1
            for (int ti = 0; ti < 32; ++ti) {
                const int t = vb * 256 + wave * 32 + ti;
                const GAS f32x4* xr = (const GAS f32x4*)(args.out + (size_t)t * D) + lane;
                f32x4 v[4]; float s = 0.f;
#pragma unroll
                for (int j = 0; j < 4; ++j) { v[j] = xr[64 * j]; s += (v[j].x * v[j].x + v[j].y * v[j].y) + (v[j].z * v[j].z + v[j].w * v[j].w); }
                const float rstd = 1.0f / sqrtf(wave_sum(s) * (1.f / 1024.f) + EPS);
                GAS v2u* o8 = (GAS v2u*)(Hb + (size_t)t * D) + lane;
                float lg[32];
#pragma unroll
                for (int e = 0; e < 32; ++e) lg[e] = 0.f;
#pragma unroll
                for (int j = 0; j < 4; ++j) { const f32x4 gg = *((const GAS f32x4*)fg + lane + 64 * j);
                    v[j].x *= rstd * gg.x; v[j].y *= rstd * gg.y; v[j].z *= rstd * gg.z; v[j].w *= rstd * gg.w;
                    v2u o; o.x = pk2(v[j].x, v[j].y); o.y = pk2(v[j].z, v[j].w); o8[64 * j] = o;
                    const float* rwp = rw + (size_t)(4 * lane + 256 * j) * 32;
#pragma unroll
                    for (int e4 = 0; e4 < 8; ++e4) {
                        const f32x4 w0 = *(const f32x4*)(rwp + 4 * e4), w1 = *(const f32x4*)(rwp + 32 + 4 * e4), w2 = *(const f32x4*)(rwp + 64 + 4 * e4), w3 = *(const f32x4*)(rwp + 96 + 4 * e4);
                        lg[4 * e4 + 0] += v[j].x * w0.x + v[j].y * w1.x + v[j].z * w2.x + v[j].w * w3.x;
                        lg[4 * e4 + 1] += v[j].x * w0.y + v[j].y * w1.y + v[j].z * w2.y + v[j].w * w3.y;
                        lg[4 * e4 + 2] += v[j].x * w0.z + v[j].y * w1.z + v[j].z * w2.z + v[j].w * w3.z;
                        lg[4 * e4 + 3] += v[j].x * w0.w + v[j].y * w1.w + v[j].z * w2.w + v[j].w * w3.w;
                    } }
#pragma unroll
                for (int e = 0; e < 32; ++e) lg[e] = wave_sum(lg[e]) + rb[e];
                int bi[4]; float bv[4];
#pragma unroll
                for (int k = 0; k < 4; ++k) { float best = -INFINITY; int b = 0;
#pragma unroll
                    for (int e = 0; e < 32; ++e) if (lg[e] > best) { best = lg[e]; b = e; }
                    bi[k] = b; bv[k] = best;
#pragma unroll
                    for (int e = 0; e < 32; ++e) lg[e] = (e == b) ? -INFINITY : lg[e]; }
                const float p1 = expf(bv[1] - bv[0]), p2 = expf(bv[2] - bv[0]), p3 = expf(bv[3] - bv[0]); const float inv = 1.0f / (1.0f + p1 + p2 + p3);
                if (lane < 4) { const int e = lane == 0 ? bi[0] : lane == 1 ? bi[1] : lane == 2 ? bi[2] : bi[3];
                    const float gt = (lane == 0 ? 1.0f : lane == 1 ? p1 : lane == 2 ? p2 : p3) * inv;
                    const unsigned rank = __hip_atomic_fetch_add(hist + e, 1u, __ATOMIC_RELAXED, __HIP_MEMORY_SCOPE_WORKGROUP);
                    topk_idx[t * 4 + lane] = e | (int)(rank << 8); topk_gate[t * 4 + lane] = gt; }
            }
            __syncthreads();
            if (tid < 32) Cmat[vb * 32 + tid] = (int)hist[tid];
        }
        { const float* W = args.in[I_WGU]; constexpr int nrb = 2048 / 32, per = (D / 64) * nrb, nit = NEXP * per;
          for (int it = gw; it < nit; it += NGW) { const int e = it / per, r0 = it % per, kb = r0 / nrb, rb = r0 % nrb; const int r = 32 * rb, j = r >> 8, rr = r & 255;
              const int sc = rr < 128 ? 128 * j + rr : 1024 + 128 * j + (rr - 128);
              tr_item(W + (size_t)e * D * 2048, 2048, 64 * kb, sc, Wgu_t + (size_t)e * 2048 * D, D, r, 0, scr, lane); } }
        { const float* W = args.in[I_WD]; constexpr int nrb = D / 32, per = (D / 64) * nrb, nit = NEXP * per;
          for (int it = gw; it < nit; it += NGW) { const int e = it / per, r0 = it % per, kb = r0 / nrb, rb = r0 % nrb;
              tr_item(W + (size_t)e * D * D, D, 64 * kb, 32 * rb, Wd_t + (size_t)e * D * D, D, 32 * rb, 0, scr, lane); } }
    }
    SEAM(6);
    if (IN(7)) { PV
        LAS int* psum = (LAS int*)(L + RING_OFF);
        LAS int* tot = psum + 512;
        LAS int* startv = tot + 64;
        LAS int* basev = startv + 64;
        LAS int* ntl = basev + 32;
        for (int vb = bid; vb < T / 256; vb += G) {
            __syncthreads();
            { const int e = tid & 31, part = tid >> 5; int ps = 0;
#pragma unroll 4
              for (int i = 0; i < 16; ++i) ps += Cmat[(part * 16 + i) * 32 + e];
              psum[part * 32 + e] = ps; }
            __syncthreads();
            if (tid < 64) { const int hh = tid >> 5, e = tid & 31; int tt = 0;
#pragma unroll
                for (int p = 0; p < 8; ++p) tt += psum[(hh * 8 + p) * 32 + e];
                tot[tid] = tt; }
            __syncthreads();
            if (tid < 2) { int row = 0; for (int e = 0; e < 32; ++e) { startv[tid * 32 + e] = row; row += (tot[tid * 32 + e] + 255) & ~255; } ntl[tid] = row >> 8; }
            __syncthreads();
            const int hh = vb >> 7, part = vb >> 4;
            if (tid < 32) { int bs = startv[hh * 32 + tid];
                for (int p = hh * 8; p < part; ++p) bs += psum[p * 32 + tid];
                for (int v2 = part * 16; v2 < vb; ++v2) bs += Cmat[v2 * 32 + tid];
                basev[tid] = bs; }
            __syncthreads();
            for (int i = tid; i < 1024; i += NTHR) { const int a = vb * 1024 + i; const int v = topk_idx[a]; const int e = v & 255, rank = v >> 8;
                const int slot = basev[e] + rank;
                slot_tok[hh * PH + slot] = a >> 2; slot_gate[hh * PH + slot] = topk_gate[a]; slot_of[a] = slot; }
            if (vb < 64) { const int h2 = vb >> 5, e = vb & 31; const int t0 = tot[h2 * 32 + e], st = startv[h2 * 32 + e], pd = ((t0 + 255) & ~255) - t0;
                if (tid < pd) { slot_tok[h2 * PH + st + t0 + tid] = -1; slot_gate[h2 * PH + st + t0 + tid] = 0.f; } }
            if (vb >= 64 && vb < 66) { const int h2 = vb - 64;
                if (tid < 32) { const int nt = (tot[h2 * 32 + tid] + 255) >> 8, first = startv[h2 * 32 + tid] >> 8; for (int i = 0; i < nt; ++i) tile_e[h2 * 1024 + first + i] = tid; }
                if (tid == 0) ((unsigned*)(ctl + CW_NTILE))[h2] = (unsigned)ntl[h2]; }
        }
    }
    SEAM(7);
#pragma unroll
    for (int h = 0; h < NHALF; ++h) {
        const int pb = 8 + 3 * h;
#define stok (slot_tok + h * PH)
#define sgate (slot_gate + h * PH)
#define NTILE_H ((int)__hip_atomic_load((unsigned*)(ctl + CW_NTILE) + h, RLX_AGENT))
        if (IN(pb)) { PV const int ntile = NTILE_H;
            pg8::Gemm g{Hb, Wgu_t, D, D, D}; pg8::GroupedOrder S{tile_e + h * 1024, ntile, 8, G, bid}; pg8::EpiSwiglu E{act, args.in[I_BGU]};
            pg8::gemm_phase_gather<pg8::EpiSwiglu, pg8::GroupedOrder>(L + RING_OFF, g, S, E, wave, stok);
        }
        SEAM(pb);
        if (IN(pb + 1)) { PV const int ntile = NTILE_H;
            pg8::Gemm g{act, Wd_t, D, D, D}; pg8::GroupedOrder S{tile_e + h * 1024, ntile, 4, G, bid}; pg8::EpiDown E{ybuf, args.in[I_BD], sgate};
            pg8::gemm_phase<pg8::EpiDown, pg8::GroupedOrder>(L + RING_OFF, g, S, E, wave);
        }
        SEAM(pb + 1);
        if (IN(pb + 2)) { PV
            for (int t = h * TH + gw; t < (h + 1) * TH; t += NGW) {
                const int s0 = slot_of[t * 4], s1 = slot_of[t * 4 + 1], s2 = slot_of[t * 4 + 2], s3 = slot_of[t * 4 + 3];
                GAS f32x4* op = (GAS f32x4*)(args.out + (size_t)t * D) + lane;
#pragma unroll
                for (int j = 0; j < 4; ++j) { f32x4 o = op[64 * j];
                    const v2u a = *((const GAS v2u*)(ybuf + (size_t)s0 * D) + lane + 64 * j), b = *((const GAS v2u*)(ybuf + (size_t)s1 * D) + lane + 64 * j);
                    const v2u c = *((const GAS v2u*)(ybuf + (size_t)s2 * D) + lane + 64 * j), d = *((const GAS v2u*)(ybuf + (size_t)s3 * D) + lane + 64 * j);
                    o.x += ((blo(a.x) + blo(b.x)) + blo(c.x)) + blo(d.x); o.y += ((bhi(a.x) + bhi(b.x)) + bhi(c.x)) + bhi(d.x);
                    o.z += ((blo(a.y) + blo(b.y)) + blo(c.y)) + blo(d.y); o.w += ((bhi(a.y) + bhi(b.y)) + bhi(c.y)) + bhi(d.y);
                    op[64 * j] = o; }
            }
        }
        if (h + 1 < NHALF) SEAM(pb + 2);
    }
#undef IN
#undef SEAM
}

extern "C" void kernel_launch(void* const* d_in, const int* in_sizes, int n_in, void* d_out, int out_size, void* d_ws, size_t ws_size, hipStream_t stream) {
    static int grid = 0;
    if (grid == 0) {
        if (n_in != 28 || out_size != T * D || ws_size < WS_END) { fprintf(stderr, "kernel_launch: unexpected shapes: n_in %d out %d ws %zu (need %zu)\n", n_in, out_size, ws_size, (size_t)WS_END); grid = -1; return; }
        int dev = 0, cus = 0, per_cu = 0;
        if (hipGetDevice(&dev) != hipSuccess || hipDeviceGetAttribute(&cus, hipDeviceAttributeMultiprocessorCount, dev) != hipSuccess) { grid = -1; return; }
        if (hipFuncSetAttribute((const void*)fwd, hipFuncAttributeMaxDynamicSharedMemorySize, LDS_BYTES) != hipSuccess) { fprintf(stderr, "kernel_launch: hipFuncSetAttribute failed\n"); grid = -1; return; }
        if (hipOccupancyMaxActiveBlocksPerMultiprocessor(&per_cu, (const void*)fwd, NTHR, LDS_BYTES) != hipSuccess || per_cu < 1) { fprintf(stderr, "kernel_launch: occupancy query says %d\n", per_cu); }
        (void)hipGetLastError();
        grid = cus;
    }
    if (grid < 0) return;
    if (hipMemsetAsync((char*)d_ws + WS_CTL, 0, CTL_ZERO_BYTES, stream) != hipSuccess) { fprintf(stderr, "kernel_launch: memset failed\n"); return; }
    Args a{};
    for (int i = 0; i < 28; ++i) a.in[i] = (const float*)d_in[i];
    a.out = (float*)d_out; a.ws = (unsigned char*)d_ws;
#if MK_FUSED
    a.ph_lo = 0; a.ph_hi = NPHASE;
    hipLaunchKernelGGL(fwd, dim3(grid), dim3(NTHR), LDS_BYTES, stream, a);
#else
    for (int p = 0; p < NPHASE; ++p) { a.ph_lo = p; a.ph_hi = p + 1; hipLaunchKernelGGL(fwd, dim3(grid), dim3(NTHR), LDS_BYTES, stream, a); }
#endif
    const hipError_t le = hipPeekAtLastError();
    if (le != hipSuccess) fprintf(stderr, "kernel_launch: launch failed: %s\n", hipGetErrorName(le));
}
```

```cpp
#include <hip/hip_runtime.h>
#include <cstdio>
#include <cstdint>

#ifndef MK_FUSED
#define MK_FUSED 1
#endif
#ifndef PROBE_MASK
#define PROBE_MASK 0
#endif
#ifndef PROBE_AMP
#define PROBE_AMP 4
#endif
#ifndef PROBE_SUBA
#define PROBE_SUBA -1
#endif
#ifndef PROBE_SUBB
#define PROBE_SUBB -1
#endif

__device__ __forceinline__ float xor16_sum(float v) { float a = v, b = v; asm("s_nop 1\n\tv_permlane16_swap_b32 %0, %1" : "+v"(a), "+v"(b)); return a + b; }
__device__ __forceinline__ float xor32_sum(float v) { float a = v, b = v; asm("s_nop 1\n\tv_permlane32_swap_b32 %0, %1" : "+v"(a), "+v"(b)); return a + b; }
__device__ __forceinline__ unsigned xor32_get(unsigned v, bool upper) { unsigned a = v, b = v; asm("s_nop 1\n\tv_permlane32_swap_b32 %0, %1" : "+v"(a), "+v"(b)); return upper ? a : b; }
namespace pg8 {
#define PG8_LAS __attribute__((address_space(3)))
typedef unsigned short bf16_t;
typedef short bf16x8 __attribute__((ext_vector_type(8)));
typedef float f32x4 __attribute__((ext_vector_type(4)));
typedef unsigned u32x4 __attribute__((ext_vector_type(4)));
typedef float f32x2 __attribute__((ext_vector_type(2)));
constexpr int BM = 256, BK = 64, HALF = 128, HTB = HALF * BK * 2, STAGE_BYTES = 8 * HTB, NXCD = 8, WGM = 8;

__host__ __device__ __forceinline__ int lds_byte(int r, int c) { const int st = (r >> 4) * 2 + (c >> 5), rr = r & 15, cc = c & 31, ob = rr * 64 + cc * 2; return st * 1024 + (ob ^ (((ob >> 9) & 1) << 5)); }
__host__ __device__ __forceinline__ void stage_rc(int b, int& R, int& C) { const int st = b / 1024, sb = b % 1024, swz = sb ^ (((sb >> 9) & 1) << 5); R = (st >> 1) * 16 + swz / 64; C = (st & 1) * 32 + (swz % 64) / 2; }
__host__ __device__ __forceinline__ int perm32(int rho) { const int n = rho >> 4, i = rho & 15; return 8 * (i >> 2) + 4 * n + (i & 3); }

struct Unit { int pm, pn; };
struct Gemm { const bf16_t* A; const bf16_t* Bt; int K, lda, ldb; };

struct StaticOrder {
    int nM, nN, nwg, G, c;
    __host__ __device__ void init(int M, int N, int G_, int c_) { nM = M / BM; nN = N / BM; nwg = nM * nN; G = G_; c = c_; }
    __host__ __device__ bool next(int i, Unit& u) const {
        const long L = (long)i * G + c; if (L >= nwg) return false;
        int wgid = (int)L; { const int q = nwg / NXCD, r = nwg % NXCD, xcd = wgid % NXCD, off = wgid / NXCD; wgid = (xcd < r ? xcd * (q + 1) : r * (q + 1) + (xcd - r) * q) + off; }
        const int nig = WGM * nN, gid = wgid / nig, fm = gid * WGM, gsz = (nM - fm) < WGM ? (nM - fm) : WGM;
        u.pm = fm + ((wgid % nig) % gsz); u.pn = (wgid % nig) / gsz; return true;
    }
};
struct GroupedOrder {
    const int* tile_e; int ntile, nN, G, c;
    __device__ bool next(int i, Unit& u) const {
        if ((G & 7) == 0) {
            const int x = c & 7, k = c >> 3, per = G >> 3;
            const unsigned q = (unsigned)i * (unsigned)per + (unsigned)k;
            const int tl = (int)(q / (unsigned)nN), j = (int)(q % (unsigned)nN), tile = tl * 8 + x;
            if (tile >= ntile) return false;
            u.pm = tile; u.pn = tile_e[tile] * nN + j; return true;
        }
        const unsigned L = (unsigned)i * (unsigned)G + (unsigned)c; if (L >= (unsigned)(ntile * nN)) return false;
        const int tile = (int)(L / (unsigned)nN), j = (int)(L % (unsigned)nN);
        u.pm = tile; u.pn = tile_e[tile] * nN + j; return true;
    }
};
typedef int v8i __attribute__((ext_vector_type(8)));
typedef int v4i __attribute__((ext_vector_type(4)));
__device__ __forceinline__ v8i cat8(bf16x8 lo, bf16x8 hi) { return __builtin_shufflevector(__builtin_bit_cast(v4i, lo), __builtin_bit_cast(v4i, hi), 0, 1, 2, 3, 4, 5, 6, 7); }
__device__ __forceinline__ bf16x8 lo8(v8i v) { return __builtin_bit_cast(bf16x8, (v4i)__builtin_shufflevector(v, v, 0, 1, 2, 3)); }
__device__ __forceinline__ bf16x8 hi8(v8i v) { return __builtin_bit_cast(bf16x8, (v4i)__builtin_shufflevector(v, v, 4, 5, 6, 7)); }
__device__ __forceinline__ unsigned cvt_pk_bf16(float lo, float hi) { unsigned r; asm volatile("v_cvt_pk_bf16_f32 %0, %1, %2" : "=v"(r) : "v"(lo), "v"(hi)); return r; }
__device__ __forceinline__ float bflo(unsigned w) { return __uint_as_float(w << 16); }
__device__ __forceinline__ float bfhi(unsigned w) { return __uint_as_float(w & 0xffff0000u); }


struct EpiBf16 {
    static constexpr bool PERM = true, HAS_MID = false;
    bf16_t* O; int ldc;
    __device__ __forceinline__ void operator()(const f32x4 (&acc)[2][2][4][2], const Unit& u, int wr, int wc, int fr, int fq) const {
        const int row0 = u.pm * BM + wr * 64 + fr, col0 = u.pn * BM + wc * 32 + 8 * fq;
#pragma unroll
        for (int ai = 0; ai < 2; ++ai)
#pragma unroll
            for (int m = 0; m < 4; ++m) { bf16_t* rowp = O + (size_t)(row0 + ai * HALF + m * 16) * ldc + col0;
#pragma unroll
                for (int bj = 0; bj < 2; ++bj) { const f32x4 v0 = acc[ai][bj][m][0], v1 = acc[ai][bj][m][1];
                    u32x4 w; w.x = cvt_pk_bf16(v0[0], v0[1]); w.y = cvt_pk_bf16(v0[2], v0[3]); w.z = cvt_pk_bf16(v1[0], v1[1]); w.w = cvt_pk_bf16(v1[2], v1[3]);
                    *(u32x4*)(rowp + bj * HALF) = w; } }
    }
};
__device__ __forceinline__ f32x2 gelu_pk(f32x2 v) {
    const f32x2 av = __builtin_elementwise_abs(v), d = av * 0.2316418882f + 1.0f;
    f32x2 t; t.x = __builtin_amdgcn_rcpf(d.x); t.y = __builtin_amdgcn_rcpf(d.y);
    f32x2 q = t * 0.5307027145f + (-0.7265760135f); q = q * t + 0.7107068705f; q = q * t + (-0.142248368f); q = q * t + 0.127414796f; q = q * t;
    const f32x2 s = (v * v) * (-0.72134752044f);
    f32x2 e; e.x = __builtin_amdgcn_exp2f(s.x); e.y = __builtin_amdgcn_exp2f(s.y);
    const f32x2 m = v * (q * e), r = v - m;
    f32x2 o; o.x = v.x < 0.f ? m.x : r.x; o.y = v.y < 0.f ? m.y : r.y; return o;
}
struct EpiProj {
    static constexpr bool PERM = true, HAS_MID = false;
    bf16_t* __restrict__ P; int ldp; const float* __restrict__ rope; const float* __restrict__ gq; const float* __restrict__ gk; const float* __restrict__ bgates; float eps;
    int c_q, c_k, c_v, c_g;
    __device__ __forceinline__ void operator()(const f32x4 (&acc)[2][2][4][2], const Unit& u, int wr, int wc, int fr, int fq) const {
        const int pn = u.pn, row0 = u.pm * BM + wr * 64 + fr;
        if (pn < 4 || pn == 8) {
            const bool isq = pn < 4, isv = (!isq) && (wc & 1);
            const int colbase = (isq ? c_q + 64 * (4 * pn + wc) : (isv ? c_v : c_k) + 64 * (wc >> 1)) + 8 * fq;
            if (isv) {
#pragma unroll
                for (int ai = 0; ai < 2; ++ai)
#pragma unroll
                    for (int m = 0; m < 4; ++m) { bf16_t* rowp = P + (size_t)(row0 + ai * HALF + m * 16) * ldp + colbase;
#pragma unroll
                        for (int bj = 0; bj < 2; ++bj) { const f32x4 v0 = acc[ai][bj][m][0], v1 = acc[ai][bj][m][1];
                            u32x4 w; w.x = cvt_pk_bf16(v0[0], v0[1]); w.y = cvt_pk_bf16(v0[2], v0[3]); w.z = cvt_pk_bf16(v1[0], v1[1]); w.w = cvt_pk_bf16(v1[2], v1[3]);
                            *(u32x4*)(rowp + 32 * bj) = w; } }
            } else {
                const float* gn = (isq ? gq : gk) + 8 * fq;
                const f32x4 ga0 = *(const f32x4*)gn, ga1 = *(const f32x4*)(gn + 4), gb0 = *(const f32x4*)(gn + 32), gb1 = *(const f32x4*)(gn + 36);
#pragma unroll
                for (int am = 0; am < 4; ++am) { const int ai = am >> 1;
                    f32x4 cs[4][4];
#pragma unroll
                    for (int m2 = 0; m2 < 2; ++m2) { const int m = (am & 1) * 2 + m2; const float* rp = rope + ((size_t)(row0 + ai * HALF + m * 16) * 32 + 8 * fq) * 2;
                        cs[m][0] = *(const f32x4*)rp; cs[m][1] = *(const f32x4*)(rp + 4); cs[m][2] = *(const f32x4*)(rp + 8); cs[m][3] = *(const f32x4*)(rp + 12); }
#pragma unroll
                    for (int m2 = 0; m2 < 2; ++m2) { const int m = (am & 1) * 2 + m2;
                        const int r = row0 + ai * HALF + m * 16;
                        const f32x4 x10 = acc[ai][0][m][0], x11 = acc[ai][0][m][1], x20 = acc[ai][1][m][0], x21 = acc[ai][1][m][1];
                        float ss = ((x10[0] * x10[0] + x10[1] * x10[1]) + (x10[2] * x10[2] + x10[3] * x10[3])) + ((x11[0] * x11[0] + x11[1] * x11[1]) + (x11[2] * x11[2] + x11[3] * x11[3]))
                                 + ((x20[0] * x20[0] + x20[1] * x20[1]) + (x20[2] * x20[2] + x20[3] * x20[3])) + ((x21[0] * x21[0] + x21[1] * x21[1]) + (x21[2] * x21[2] + x21[3] * x21[3]));
                        ss = xor32_sum(xor16_sum(ss));
                        const float rstd = 1.0f / sqrtf(ss * (1.f / 64.f) + eps);
                        const f32x4 cs0 = cs[m][0], cs1 = cs[m][1], cs2 = cs[m][2], cs3 = cs[m][3];
                        const f32x4 y10 = x10 * ga0 * rstd, y11 = x11 * ga1 * rstd, y20 = x20 * gb0 * rstd, y21 = x21 * gb1 * rstd;
                        float o1[8], o2[8];
                        o1[0] = y10[0] * cs0[0] - y20[0] * cs0[1]; o2[0] = y20[0] * cs0[0] + y10[0] * cs0[1];
                        o1[1] = y10[1] * cs0[2] - y20[1] * cs0[3]; o2[1] = y20[1] * cs0[2] + y10[1] * cs0[3];
                        o1[2] = y10[2] * cs1[0] - y20[2] * cs1[1]; o2[2] = y20[2] * cs1[0] + y10[2] * cs1[1];
                        o1[3] = y10[3] * cs1[2] - y20[3] * cs1[3]; o2[3] = y20[3] * cs1[2] + y10[3] * cs1[3];
                        o1[4] = y11[0] * cs2[0] - y21[0] * cs2[1]; o2[4] = y21[0] * cs2[0] + y11[0] * cs2[1];
                        o1[5] = y11[1] * cs2[2] - y21[1] * cs2[3]; o2[5] = y21[1] * cs2[2] + y11[1] * cs2[3];
                        o1[6] = y11[2] * cs3[0] - y21[2] * cs3[1]; o2[6] = y21[2] * cs3[0] + y11[2] * cs3[1];
                        o1[7] = y11[3] * cs3[2] - y21[3] * cs3[3]; o2[7] = y21[3] * cs3[2] + y11[3] * cs3[3];
                        bf16_t* rowp = P + (size_t)r * ldp + colbase;
                        u32x4 w; w.x = cvt_pk_bf16(o1[0], o1[1]); w.y = cvt_pk_bf16(o1[2], o1[3]); w.z = cvt_pk_bf16(o1[4], o1[5]); w.w = cvt_pk_bf16(o1[6], o1[7]);
                        *(u32x4*)rowp = w;
                        w.x = cvt_pk_bf16(o2[0], o2[1]); w.y = cvt_pk_bf16(o2[2], o2[3]); w.z = cvt_pk_bf16(o2[4], o2[5]); w.w = cvt_pk_bf16(o2[6], o2[7]);
                        *(u32x4*)(rowp + 32) = w;
                    }
                }
            }
        } else {
            const int col0 = pn * BM + wc * 32 + 8 * fq;
            const int mode = (pn == 4 || pn == 5 || pn == 9 || pn == 10) ? 1 : (pn >= 11 ? 2 : 0);
            f32x4 bb[2][2] = {{(f32x4){0.f, 0.f, 0.f, 0.f}, (f32x4){0.f, 0.f, 0.f, 0.f}}, {(f32x4){0.f, 0.f, 0.f, 0.f}, (f32x4){0.f, 0.f, 0.f, 0.f}}};
            if (mode == 2) { const float* bp = bgates + (col0 - c_g);
                bb[0][0] = *(const f32x4*)bp; bb[0][1] = *(const f32x4*)(bp + 4); bb[1][0] = *(const f32x4*)(bp + HALF); bb[1][1] = *(const f32x4*)(bp + HALF + 4); }
#pragma unroll
            for (int bj = 0; bj < 2; ++bj) {
                const f32x4 nb0 = bb[bj][0] * (-1.4426950408889634f), nb1 = bb[bj][1] * (-1.4426950408889634f);
#pragma unroll
                for (int ai = 0; ai < 2; ++ai)
#pragma unroll
                    for (int m = 0; m < 4; ++m) {
                        f32x4 v0 = acc[ai][bj][m][0], v1 = acc[ai][bj][m][1];
                        if (mode == 1) { const f32x2 a = gelu_pk((f32x2){v0[0], v0[1]}), b = gelu_pk((f32x2){v0[2], v0[3]}), c = gelu_pk((f32x2){v1[0], v1[1]}), d = gelu_pk((f32x2){v1[2], v1[3]});
                            v0 = (f32x4){a.x, a.y, b.x, b.y}; v1 = (f32x4){c.x, c.y, d.x, d.y}; }
                        if (mode == 2) {
                            typedef unsigned u32x2 __attribute__((ext_vector_type(2)));
                            u32x2 w8; unsigned wq[2] = {0u, 0u};
#pragma unroll
                            for (int p = 0; p < 4; ++p) {
                                const int n = p >> 1, i0 = (p & 1) * 2;
                                const f32x2 zv = n ? (f32x2){v1[i0], v1[i0 + 1]} : (f32x2){v0[i0], v0[i0 + 1]}, bv2 = n ? (f32x2){nb1[i0], nb1[i0 + 1]} : (f32x2){nb0[i0], nb0[i0 + 1]};
                                const f32x2 tv = zv * (-1.4426950408889634f) + bv2;
                                f32x2 ev; ev.x = __builtin_amdgcn_exp2f(tv.x); ev.y = __builtin_amdgcn_exp2f(tv.y);
                                const f32x2 dv = ev + 1.0f;
                                f32x2 gv; gv.x = __builtin_amdgcn_rcpf(dv.x); gv.y = __builtin_amdgcn_rcpf(dv.y);
                                const f32x2 cv = gv * 256.0f + (-0.5f);
                                wq[n] = __builtin_amdgcn_cvt_pk_u8_f32(cv.x, i0, wq[n]); wq[n] = __builtin_amdgcn_cvt_pk_u8_f32(cv.y, i0 + 1, wq[n]);
                            }
                            w8.x = wq[0]; w8.y = wq[1];
                            *(u32x2*)((unsigned char*)(P + (size_t)(row0 + ai * HALF + m * 16) * ldp + c_g) + (col0 - c_g) + bj * HALF) = w8;
                        } else {
                        u32x4 w; w.x = cvt_pk_bf16(v0[0], v0[1]); w.y = cvt_pk_bf16(v0[2], v0[3]); w.z = cvt_pk_bf16(v1[0], v1[1]); w.w = cvt_pk_bf16(v1[2], v1[3]);
                        *(u32x4*)(P + (size_t)(row0 + ai * HALF + m * 16) * ldp + col0 + bj * HALF) = w;
                        }
                    }
            }
        }
    }
};
template <int ACCUM> struct EpiMerge {
    static constexpr bool PERM = true, HAS_MID = false;
    bf16_t* Mg; int ldm; const bf16_t* gate; int ldg;
    __device__ __forceinline__ void operator()(const f32x4 (&acc)[2][2][4][2], const Unit& u, int wr, int wc, int fr, int fq) const {
        const int row0 = u.pm * BM + wr * 64 + fr, col0 = u.pn * BM + wc * 32 + 8 * fq;
#pragma unroll
        for (int bj = 0; bj < 2; ++bj) {
#pragma unroll
            for (int ai = 0; ai < 2; ++ai)
#pragma unroll
                for (int m = 0; m < 4; ++m) {
                    const size_t r = (size_t)(row0 + ai * HALF + m * 16);
                    const u32x4 gw = *(const u32x4*)(gate + r * ldg + col0 + bj * HALF);
                    const f32x4 a0 = acc[ai][bj][m][0], a1 = acc[ai][bj][m][1];
                    float o[8] = {bflo(gw.x) * a0[0], bfhi(gw.x) * a0[1], bflo(gw.y) * a0[2], bfhi(gw.y) * a0[3], bflo(gw.z) * a1[0], bfhi(gw.z) * a1[1], bflo(gw.w) * a1[2], bfhi(gw.w) * a1[3]};
                    bf16_t* mp = Mg + r * ldm + col0 + bj * HALF;
                    if (ACCUM) { const u32x4 pw = *(const u32x4*)mp;
                        o[0] += bflo(pw.x); o[1] += bfhi(pw.x); o[2] += bflo(pw.y); o[3] += bfhi(pw.y); o[4] += bflo(pw.z); o[5] += bfhi(pw.z); o[6] += bflo(pw.w); o[7] += bfhi(pw.w); }
                    u32x4 w; w.x = cvt_pk_bf16(o[0], o[1]); w.y = cvt_pk_bf16(o[2], o[3]); w.z = cvt_pk_bf16(o[4], o[5]); w.w = cvt_pk_bf16(o[6], o[7]);
                    *(u32x4*)mp = w;
                }
        }
    }
};
struct EpiMergeK {
    static constexpr bool PERM = true, HAS_MID = true; static constexpr int MID0 = 16, MID1 = 24;
    bf16_t* __restrict__ Mg; int ldm; const unsigned char* __restrict__ gates; int ldgb;
    typedef unsigned u32x2 __attribute__((ext_vector_type(2)));
    static __device__ __forceinline__ float gq(unsigned w, int i) { return ((float)((w >> (8 * i)) & 255u) + 0.5f) * (1.0f / 256.0f); }
    __device__ __forceinline__ void mid(f32x4 (&acc)[2][2][4][2], const Unit& u, int t, int wr, int wc, int fr, int fq) const {
        int row0 = u.pm * BM + wr * 64 + fr, col0 = u.pn * BM + wc * 32 + 8 * fq + (t == MID0 ? 0 : 1024);
        asm volatile("" : "+v"(row0), "+v"(col0));
#pragma unroll
        for (int bj = 0; bj < 2; ++bj)
#pragma unroll
            for (int ai = 0; ai < 2; ++ai)
#pragma unroll
                for (int m = 0; m < 4; ++m) {
                    const unsigned char* gp = gates + (size_t)(row0 + ai * HALF + m * 16) * ldgb + col0 + bj * HALF;
                    const u32x2 nw = *(const u32x2*)gp, dw = *(const u32x2*)(gp + 1024);
                    f32x4 r0, r1;
#pragma unroll
                    for (int i = 0; i < 4; ++i) { r0[i] = gq(nw.x, i) * __builtin_amdgcn_rcpf(gq(dw.x, i)); r1[i] = gq(nw.y, i) * __builtin_amdgcn_rcpf(gq(dw.y, i)); }
                    acc[ai][bj][m][0] *= r0; acc[ai][bj][m][1] *= r1;
                }
    }
    __device__ __forceinline__ void operator()(const f32x4 (&acc)[2][2][4][2], const Unit& u, int wr, int wc, int fr, int fq) const {
        const int row0 = u.pm * BM + wr * 64 + fr, col0 = u.pn * BM + wc * 32 + 8 * fq;
        u32x2 gw[2][2][4];
#pragma unroll
        for (int bj = 0; bj < 2; ++bj)
#pragma unroll
            for (int ai = 0; ai < 2; ++ai)
#pragma unroll
                for (int m = 0; m < 4; ++m) gw[bj][ai][m] = *(const u32x2*)(gates + (size_t)(row0 + ai * HALF + m * 16) * ldgb + 2048 + col0 + bj * HALF);
#pragma unroll
        for (int bj = 0; bj < 2; ++bj)
#pragma unroll
            for (int ai = 0; ai < 2; ++ai)
#pragma unroll
                for (int m = 0; m < 4; ++m) {
                    const size_t r = (size_t)(row0 + ai * HALF + m * 16);
                    const u32x2 g2 = gw[bj][ai][m];
                    const f32x4 a0 = acc[ai][bj][m][0], a1 = acc[ai][bj][m][1];
                    u32x4 w; w.x = cvt_pk_bf16(gq(g2.x, 0) * a0[0], gq(g2.x, 1) * a0[1]); w.y = cvt_pk_bf16(gq(g2.x, 2) * a0[2], gq(g2.x, 3) * a0[3]);
                    w.z = cvt_pk_bf16(gq(g2.y, 0) * a1[0], gq(g2.y, 1) * a1[1]); w.w = cvt_pk_bf16(gq(g2.y, 2) * a1[2], gq(g2.y, 3) * a1[3]);
                    *(u32x4*)(Mg + r * ldm + col0 + bj * HALF) = w;
                }
    }
};
__device__ __forceinline__ unsigned pk4_e4m3(float a, float b, float c, float d) { int w = 0; w = __builtin_amdgcn_cvt_pk_fp8_f32(a, b, w, false); w = __builtin_amdgcn_cvt_pk_fp8_f32(c, d, w, true); return (unsigned)w; }
struct EpiResF32 {
    static constexpr bool PERM = true, HAS_MID = false;
    bf16_t* __restrict__ X1; const float* __restrict__ R; unsigned char* __restrict__ X8p; int ldc;
    __device__ __forceinline__ void operator()(const f32x4 (&acc)[2][2][4][2], const Unit& u, int wr, int wc, int fr, int fq) const {
        const int row0 = u.pm * BM + wr * 64 + fr, col0 = u.pn * BM + wc * 32 + 8 * fq;
        typedef unsigned u32x2 __attribute__((ext_vector_type(2)));
#pragma unroll
        for (int ai = 0; ai < 2; ++ai) {
            f32x4 rv[4][2][2];
#pragma unroll
            for (int m = 0; m < 4; ++m) { const size_t ro = (size_t)(row0 + ai * HALF + m * 16) * ldc + col0;
#pragma unroll
                for (int bj = 0; bj < 2; ++bj) { rv[m][bj][0] = *(const f32x4*)(R + ro + bj * HALF); rv[m][bj][1] = *(const f32x4*)(R + ro + bj * HALF + 4); } }
#pragma unroll
            for (int m = 0; m < 4; ++m) { const size_t ro = (size_t)(row0 + ai * HALF + m * 16) * ldc + col0;
#pragma unroll
                for (int bj = 0; bj < 2; ++bj) { const f32x4 v0 = acc[ai][bj][m][0] + rv[m][bj][0], v1 = acc[ai][bj][m][1] + rv[m][bj][1];
                    u32x4 w; w.x = cvt_pk_bf16(v0[0], v0[1]); w.y = cvt_pk_bf16(v0[2], v0[3]); w.z = cvt_pk_bf16(v1[0], v1[1]); w.w = cvt_pk_bf16(v1[2], v1[3]);
                    *(u32x4*)(X1 + ro + bj * HALF) = w;
                    *(u32x2*)(X8p + ro + bj * HALF) = (u32x2){pk4_e4m3(v0[0], v0[1], v0[2], v0[3]), pk4_e4m3(v1[0], v1[1], v1[2], v1[3])}; } }
        }
    }
};
struct EpiSwiglu {
    static constexpr bool PERM = true, HAS_MID = false;
    bf16_t* act; const float* bgu;
    __device__ __forceinline__ void operator()(const f32x4 (&acc)[2][2][4][2], const Unit& u, int wr, int wc, int fr, int fq) const {
        const int e = u.pn >> 3, j = u.pn & 7;
        const int row0 = u.pm * BM + wr * 64 + fr, col0 = j * 128 + wc * 32 + 8 * fq;
        const float* bg = bgu + (size_t)e * 2048 + col0;
        const f32x4 g0 = *(const f32x4*)bg, g1 = *(const f32x4*)(bg + 4), u0 = *(const f32x4*)(bg + 1024), u1 = *(const f32x4*)(bg + 1028);
#pragma unroll
        for (int ai = 0; ai < 2; ++ai)
#pragma unroll
            for (int m = 0; m < 4; ++m) {
                float o[8];
#pragma unroll
                for (int i = 0; i < 8; ++i) {
                    float gt = (i < 4 ? acc[ai][0][m][0][i] + g0[i] : acc[ai][0][m][1][i - 4] + g1[i - 4]);
                    float up = (i < 4 ? acc[ai][1][m][0][i] + u0[i] : acc[ai][1][m][1][i - 4] + u1[i - 4]);
                    gt = fminf(gt, 7.0f); up = fminf(fmaxf(up, -7.0f), 7.0f);
                    const float sg = __builtin_amdgcn_rcpf(1.0f + __builtin_amdgcn_exp2f(-1.702f * 1.4426950408889634f * gt));
                    o[i] = (up + 1.0f) * (gt * sg);
                }
                u32x4 w; w.x = cvt_pk_bf16(o[0], o[1]); w.y = cvt_pk_bf16(o[2], o[3]); w.z = cvt_pk_bf16(o[4], o[5]); w.w = cvt_pk_bf16(o[6], o[7]);
                *(u32x4*)(act + (size_t)(row0 + ai * HALF + m * 16) * 1024 + col0) = w;
            }
    }
};
struct EpiSwiglu8 {
    static constexpr bool PERM = true, HAS_MID = false;
    unsigned char* __restrict__ act; const float* __restrict__ bgu; const float* __restrict__ srstd; float inv;
    __device__ __forceinline__ void operator()(const f32x4 (&acc)[2][2][4][2], const Unit& u, int wr, int wc, int fr, int fq) const {
        const int e = u.pn >> 3, j = u.pn & 7;
        const int row0 = u.pm * BM + wr * 64 + fr, col0 = j * 128 + wc * 32 + 8 * fq;
        const float* bg = bgu + (size_t)e * 2048 + col0;
        const f32x4 g0 = *(const f32x4*)bg, g1 = *(const f32x4*)(bg + 4), u0 = *(const f32x4*)(bg + 1024), u1 = *(const f32x4*)(bg + 1028);
        float rsv[8];
#pragma unroll
        for (int i = 0; i < 8; ++i) rsv[i] = srstd[row0 + (i >> 2) * HALF + (i & 3) * 16] * this->inv;
#pragma unroll
        for (int ai = 0; ai < 2; ++ai)
#pragma unroll
            for (int m = 0; m < 4; ++m) {
                float o[8]; const float inv = rsv[ai * 4 + m];
#pragma unroll
                for (int p = 0; p < 4; ++p) {
                    const int n = p >> 1, i0 = (p & 1) * 2;
                    const f32x2 ag = (f32x2){acc[ai][0][m][n][i0], acc[ai][0][m][n][i0 + 1]}, au = (f32x2){acc[ai][1][m][n][i0], acc[ai][1][m][n][i0 + 1]};
                    const f32x2 bgv = n ? (f32x2){g1[i0], g1[i0 + 1]} : (f32x2){g0[i0], g0[i0 + 1]}, buv = n ? (f32x2){u1[i0], u1[i0 + 1]} : (f32x2){u0[i0], u0[i0 + 1]};
                    f32x2 gt = ag * inv + bgv, up = au * inv + buv;
                    gt.x = fminf(gt.x, 7.0f); gt.y = fminf(gt.y, 7.0f);
                    up.x = __builtin_amdgcn_fmed3f(up.x, -7.0f, 7.0f); up.y = __builtin_amdgcn_fmed3f(up.y, -7.0f, 7.0f);
                    const f32x2 tt = gt * (-1.702f * 1.4426950408889634f);
                    f32x2 ev; ev.x = __builtin_amdgcn_exp2f(tt.x); ev.y = __builtin_amdgcn_exp2f(tt.y);
                    const f32x2 dv = ev + 1.0f;
                    f32x2 rv2; rv2.x = __builtin_amdgcn_rcpf(dv.x); rv2.y = __builtin_amdgcn_rcpf(dv.y);
                    const f32x2 ov = (up + 1.0f) * (gt * rv2);
                    o[2 * p] = ov.x; o[2 * p + 1] = ov.y;
                }
                f32x2 w; unsigned w0 = pk4_e4m3(o[0], o[1], o[2], o[3]), w1 = pk4_e4m3(o[4], o[5], o[6], o[7]);
                typedef unsigned u32x2 __attribute__((ext_vector_type(2)));
                *(u32x2*)(act + (size_t)(row0 + ai * HALF + m * 16) * 1024 + col0) = (u32x2){w0, w1}; (void)w;
            }
    }
};
struct EpiDown {
    static constexpr bool PERM = true, HAS_MID = false;
    unsigned char* __restrict__ Y; const float* __restrict__ bd; float inv;
    __device__ __forceinline__ void operator()(const f32x4 (&acc)[2][2][4][2], const Unit& u, int wr, int wc, int fr, int fq) const {
        const int e = u.pn >> 2, j = u.pn & 3;
        const int row0 = u.pm * BM + wr * 64 + fr, col0 = j * 256 + wc * 32 + 8 * fq;
        const float* bp = bd + (size_t)e * 1024 + col0;
        typedef unsigned u32x2 __attribute__((ext_vector_type(2)));
        const f32x4 b00 = *(const f32x4*)bp * 16.0f, b01 = *(const f32x4*)(bp + 4) * 16.0f, b10 = *(const f32x4*)(bp + HALF) * 16.0f, b11 = *(const f32x4*)(bp + HALF + 4) * 16.0f;
#pragma unroll
        for (int ai = 0; ai < 2; ++ai)
#pragma unroll
            for (int m = 0; m < 4; ++m) {
                unsigned char* yp = Y + (size_t)(row0 + ai * HALF + m * 16) * 1024 + col0;
                { const f32x4 v0 = acc[ai][0][m][0] * inv + b00, v1 = acc[ai][0][m][1] * inv + b01;
                  *(u32x2*)yp = (u32x2){pk4_e4m3(v0[0], v0[1], v0[2], v0[3]), pk4_e4m3(v1[0], v1[1], v1[2], v1[3])}; }
                { const f32x4 v0 = acc[ai][1][m][0] * inv + b10, v1 = acc[ai][1][m][1] * inv + b11;
                  *(u32x2*)(yp + HALF) = (u32x2){pk4_e4m3(v0[0], v0[1], v0[2], v0[3]), pk4_e4m3(v1[0], v1[1], v1[2], v1[3])}; }
            }
    }
};

template <class Epi, class Sched, bool F8 = false, bool ALIGN_EPI = true>
__device__ __forceinline__ void gemm_phase(PG8_LAS unsigned char* lds, const Gemm g, const Sched& S, const Epi& E, const int wid_in) {
    const int wid = __builtin_amdgcn_readfirstlane(wid_in), lane = (int)__builtin_amdgcn_mbcnt_hi(~0u, __builtin_amdgcn_mbcnt_lo(~0u, 0u)), tid = wid * 64 + lane, wr = wid >> 2, wc = wid & 3, fr = lane & 15, fq = lane >> 4;
    int K = g.K; asm volatile("" : "+s"(K));
    const int nt = K / BK;
    unsigned voffA[2], voffB[2];
#pragma unroll
    for (int i = 0; i < 2; ++i) { int R, C; stage_rc(tid * 16 + i * 8192, R, C); const int Rb = Epi::PERM ? ((R & ~31) + perm32(R & 31)) : R;
        voffA[i] = (unsigned)(R * g.lda + C) * 2u; voffB[i] = (unsigned)(Rb * g.ldb + C) * 2u; }
    const size_t kstep = (size_t)(BK * 2);
    const size_t hstepA = (size_t)HALF * g.lda * 2, hstepB = (size_t)HALF * g.ldb * 2;
    const size_t tstepA = 2 * hstepA, tstepB = 2 * hstepB;
    const unsigned ldsw = (unsigned)wid * 1024u;
    const int aoff = lds_byte(wr * 64 + fr, fq * 8), boff = lds_byte(wc * 32 + fr, fq * 8);
#define PG8_SA(b, h) (((b) * 2 + (h)) * HTB)
#define PG8_SB(b, h) ((4 + (b) * 2 + (h)) * HTB)
#define PG8_STAGE(bufoff, gbase, voff) do { _Pragma("unroll") for (int _i = 0; _i < 2; ++_i) \
        __builtin_amdgcn_global_load_lds((const unsigned*)((const char*)(gbase) + (voff)[_i]), (PG8_LAS unsigned*)(lds + (bufoff) + ldsw + _i * 8192), 16, 0, 0); } while (0)
#define PG8_LDA(dst, b, h) do { _Pragma("unroll") for (int m = 0; m < 4; ++m) dst[m] = cat8(*(const PG8_LAS bf16x8*)(lds + PG8_SA(b, h) + aoff + m * 2048), *(const PG8_LAS bf16x8*)(lds + PG8_SA(b, h) + aoff + m * 2048 + 1024)); } while (0)
#define PG8_LDB(dst, b, h) do { _Pragma("unroll") for (int n = 0; n < 2; ++n) dst[n] = cat8(*(const PG8_LAS bf16x8*)(lds + PG8_SB(b, h) + boff + n * 2048), *(const PG8_LAS bf16x8*)(lds + PG8_SB(b, h) + boff + n * 2048 + 1024)); } while (0)
#define PG8_MMA(ai, bj, At, Bt) do { __builtin_amdgcn_s_setprio(1); \
        if constexpr (F8) { asm volatile("s_nop 1"); _Pragma("unroll") for (int m = 0; m < 4; ++m) _Pragma("unroll") for (int n = 0; n < 2; ++n) \
            asm volatile("v_mfma_scale_f32_16x16x128_f8f6f4 %0, %1, %2, %0, %3, %3 op_sel_hi:[0,0,0]" : "+v"(acc[ai][bj][m][n]) : "v"(Bt[n]), "v"(At[m]), "v"(sc127)); } \
        else { _Pragma("unroll") for (int m = 0; m < 4; ++m) _Pragma("unroll") for (int n = 0; n < 2; ++n) { \
            acc[ai][bj][m][n] = __builtin_amdgcn_mfma_f32_16x16x32_bf16(lo8(Bt[n]), lo8(At[m]), acc[ai][bj][m][n], 0, 0, 0); \
            acc[ai][bj][m][n] = __builtin_amdgcn_mfma_f32_16x16x32_bf16(hi8(Bt[n]), hi8(At[m]), acc[ai][bj][m][n], 0, 0, 0); } } \
        __builtin_amdgcn_s_setprio(0); } while (0)
#define PG8_WAIT_V(n) asm volatile("s_waitcnt vmcnt(" #n ")" ::: "memory")
#define PG8_WAIT_L(n) asm volatile("s_waitcnt lgkmcnt(" #n ")" ::: "memory")
#define PG8_BAR __builtin_amdgcn_s_barrier()
#define PG8_SCHED __builtin_amdgcn_sched_barrier(0)
    const int sc127 = 0x7F7F7F7F; (void)sc127;
    Unit cur, nxt; int ui = 0;
    if (!S.next(0, cur)) return;
    f32x4 acc[2][2][4][2];
#pragma unroll
    for (int a = 0; a < 2; ++a)
#pragma unroll
        for (int b = 0; b < 2; ++b)
#pragma unroll
            for (int m = 0; m < 4; ++m)
#pragma unroll
                for (int n = 0; n < 2; ++n) acc[a][b][m][n] = (f32x4){0.f, 0.f, 0.f, 0.f};
    v8i At[4], B0[2], B1[2];
    const char* cA = (const char*)g.A + (size_t)cur.pm * tstepA; const char* cB = (const char*)g.Bt + (size_t)cur.pn * tstepB;
    PG8_STAGE(PG8_SB(0, 0), cB, voffB); PG8_STAGE(PG8_SB(0, 1), cB + hstepB, voffB); PG8_STAGE(PG8_SA(0, 0), cA, voffA); PG8_STAGE(PG8_SA(0, 1), cA + hstepA, voffA);
    if (wr == 1) PG8_BAR;
    PG8_WAIT_V(2); PG8_BAR;
    PG8_STAGE(PG8_SB(1, 0), cB + kstep, voffB); PG8_STAGE(PG8_SA(1, 0), cA + kstep, voffA); PG8_STAGE(PG8_SB(1, 1), cB + hstepB + kstep, voffB);
    PG8_WAIT_V(6); PG8_BAR;
    for (;;) {
        const bool has_next = S.next(ui + 1, nxt);
        const char* nA = has_next ? (const char*)g.A + (size_t)nxt.pm * tstepA : cA; const char* nB = has_next ? (const char*)g.Bt + (size_t)nxt.pn * tstepB : cB;
        for (int t = 0; t < nt; t += 2) {
            if constexpr (Epi::HAS_MID) { if (t == Epi::MID0 || t == Epi::MID1) E.mid(acc, cur, t, wr, wc, fr, fq); }
            const bool last = (t == nt - 2);
            const char* a1 = cA + (size_t)(t + 1) * kstep;
            const char* a2 = last ? nA : cA + (size_t)(t + 2) * kstep; const char* b2 = last ? nB : cB + (size_t)(t + 2) * kstep;
            const char* a3 = a2 + kstep; const char* b3 = b2 + kstep;
            PG8_LDB(B0, 0, 0); PG8_LDB(B1, 0, 1); PG8_SCHED; PG8_LDA(At, 0, 0); PG8_STAGE(PG8_SA(1, 1), a1 + hstepA, voffA);
            PG8_WAIT_V(8); PG8_WAIT_L(0); PG8_BAR; PG8_MMA(0, 0, At, B0); PG8_MMA(0, 1, At, B1); PG8_BAR; PG8_SCHED;
            PG8_LDA(At, 0, 1); PG8_STAGE(PG8_SB(0, 0), b2, voffB); PG8_STAGE(PG8_SB(0, 1), b2 + hstepB, voffB); PG8_STAGE(PG8_SA(0, 0), a2, voffA);
            PG8_WAIT_V(8); PG8_WAIT_L(0); PG8_BAR; PG8_MMA(1, 0, At, B0); PG8_MMA(1, 1, At, B1); PG8_BAR; PG8_SCHED;
            PG8_LDB(B0, 1, 0); PG8_LDB(B1, 1, 1); PG8_SCHED; PG8_LDA(At, 1, 0); PG8_STAGE(PG8_SA(0, 1), a2 + hstepA, voffA);
            PG8_WAIT_V(8); PG8_WAIT_L(0); PG8_BAR; PG8_MMA(0, 0, At, B0); PG8_MMA(0, 1, At, B1); PG8_BAR; PG8_SCHED;
            PG8_LDA(At, 1, 1); PG8_STAGE(PG8_SB(1, 0), b3, voffB); PG8_STAGE(PG8_SB(1, 1), b3 + hstepB, voffB); PG8_STAGE(PG8_SA(1, 0), a3, voffA);
            PG8_WAIT_V(8); PG8_WAIT_L(0); PG8_BAR; PG8_MMA(1, 0, At, B0); PG8_MMA(1, 1, At, B1); PG8_BAR; PG8_SCHED;
        }
        if constexpr (ALIGN_EPI) { if (wr == 0) PG8_BAR; }
        if constexpr (F8) asm volatile("s_nop 15\n\ts_nop 15" ::: "memory");
        E(acc, cur, wr, wc, fr, fq);
        if (!has_next) break;
#pragma unroll
        for (int a = 0; a < 2; ++a)
#pragma unroll
            for (int b = 0; b < 2; ++b)
#pragma unroll
                for (int m = 0; m < 4; ++m)
#pragma unroll
                    for (int n = 0; n < 2; ++n) acc[a][b][m][n] = (f32x4){0.f, 0.f, 0.f, 0.f};
        cur = nxt; cA = nA; cB = nB; ++ui;
        if constexpr (ALIGN_EPI) { if (wr == 1) PG8_BAR; }
    }
    PG8_WAIT_V(0);
    if constexpr (!ALIGN_EPI) { if (wr == 0) PG8_BAR; }
    PG8_BAR;
#undef PG8_SA
#undef PG8_SB
#undef PG8_STAGE
#undef PG8_LDA
#undef PG8_LDB
#undef PG8_MMA
#undef PG8_WAIT_V
#undef PG8_WAIT_L
#undef PG8_BAR
#undef PG8_SCHED
}
template <class Epi, class Sched, bool F8 = false, bool ALIGN_EPI = true>
__device__ __forceinline__ void gemm_phase_gather(PG8_LAS unsigned char* lds, const Gemm g, const Sched& S, const Epi& E, const int wid_in, const int* rowmap) {
    const int wid = __builtin_amdgcn_readfirstlane(wid_in), lane = (int)__builtin_amdgcn_mbcnt_hi(~0u, __builtin_amdgcn_mbcnt_lo(~0u, 0u)), tid = wid * 64 + lane, wr = wid >> 2, wc = wid & 3, fr = lane & 15, fq = lane >> 4;
    int K = g.K; asm volatile("" : "+s"(K));
    const int nt = K / BK;
    unsigned voffB[2]; int RA[2]; unsigned CA2[2];
#pragma unroll
    for (int i = 0; i < 2; ++i) { int R, C; stage_rc(tid * 16 + i * 8192, R, C); const int Rb = Epi::PERM ? ((R & ~31) + perm32(R & 31)) : R;
        RA[i] = R; CA2[i] = (unsigned)C * 2u; voffB[i] = (unsigned)(Rb * g.ldb + C) * 2u; }
    const unsigned rowb = (unsigned)g.lda * 2u;
    unsigned ca0[2], ca1[2], na0[2], na1[2]; int raw0[2], raw1[2];
#define PG8_LOADIDX(d0, d1, pm_) do { _Pragma("unroll") for (int _i = 0; _i < 2; ++_i) { d0[_i] = rowmap[(pm_) * BM + RA[_i]]; d1[_i] = rowmap[(pm_) * BM + HALF + RA[_i]]; } } while (0)
#define PG8_CVTIDX(o0, o1, d0, d1) do { _Pragma("unroll") for (int _i = 0; _i < 2; ++_i) { o0[_i] = (unsigned)(d0[_i] < 0 ? 0 : d0[_i]) * rowb + CA2[_i]; o1[_i] = (unsigned)(d1[_i] < 0 ? 0 : d1[_i]) * rowb + CA2[_i]; } } while (0)
    const size_t kstep = (size_t)(BK * 2);
    const size_t hstepB = (size_t)HALF * g.ldb * 2;
    const size_t tstepB = 2 * hstepB;
    const unsigned ldsw = (unsigned)wid * 1024u;
    const int aoff = lds_byte(wr * 64 + fr, fq * 8), boff = lds_byte(wc * 32 + fr, fq * 8);
#define PG8_SA(b, h) (((b) * 2 + (h)) * HTB)
#define PG8_SB(b, h) ((4 + (b) * 2 + (h)) * HTB)
#define PG8_STAGE(bufoff, gbase, voff) do { _Pragma("unroll") for (int _i = 0; _i < 2; ++_i) \
        __builtin_amdgcn_global_load_lds((const unsigned*)((const char*)(gbase) + (voff)[_i]), (PG8_LAS unsigned*)(lds + (bufoff) + ldsw + _i * 8192), 16, 0, 0); } while (0)
#define PG8_LDA(dst, b, h) do { _Pragma("unroll") for (int m = 0; m < 4; ++m) dst[m] = cat8(*(const PG8_LAS bf16x8*)(lds + PG8_SA(b, h) + aoff + m * 2048), *(const PG8_LAS bf16x8*)(lds + PG8_SA(b, h) + aoff + m * 2048 + 1024)); } while (0)
#define PG8_LDB(dst, b, h) do { _Pragma("unroll") for (int n = 0; n < 2; ++n) dst[n] = cat8(*(const PG8_LAS bf16x8*)(lds + PG8_SB(b, h) + boff + n * 2048), *(const PG8_LAS bf16x8*)(lds + PG8_SB(b, h) + boff + n * 2048 + 1024)); } while (0)
#define PG8_MMA(ai, bj, At, Bt) do { __builtin_amdgcn_s_setprio(1); \
        if constexpr (F8) { asm volatile("s_nop 1"); _Pragma("unroll") for (int m = 0; m < 4; ++m) _Pragma("unroll") for (int n = 0; n < 2; ++n) \
            asm volatile("v_mfma_scale_f32_16x16x128_f8f6f4 %0, %1, %2, %0, %3, %3 op_sel_hi:[0,0,0]" : "+v"(acc[ai][bj][m][n]) : "v"(Bt[n]), "v"(At[m]), "v"(sc127)); } \
        else { _Pragma("unroll") for (int m = 0; m < 4; ++m) _Pragma("unroll") for (int n = 0; n < 2; ++n) { \
            acc[ai][bj][m][n] = __builtin_amdgcn_mfma_f32_16x16x32_bf16(lo8(Bt[n]), lo8(At[m]), acc[ai][bj][m][n], 0, 0, 0); \
            acc[ai][bj][m][n] = __builtin_amdgcn_mfma_f32_16x16x32_bf16(hi8(Bt[n]), hi8(At[m]), acc[ai][bj][m][n], 0, 0, 0); } } \
        __builtin_amdgcn_s_setprio(0); } while (0)
#define PG8_WAIT_V(n) asm volatile("s_waitcnt vmcnt(" #n ")" ::: "memory")
#define PG8_WAIT_L(n) asm volatile("s_waitcnt lgkmcnt(" #n ")" ::: "memory")
#define PG8_BAR __builtin_amdgcn_s_barrier()
#define PG8_SCHED __builtin_amdgcn_sched_barrier(0)
    const int sc127 = 0x7F7F7F7F; (void)sc127;
    Unit cur, nxt, nn; int ui = 0;
    if (!S.next(0, cur)) return;
    bool has_next = S.next(1, nxt);
    PG8_LOADIDX(raw0, raw1, cur.pm); PG8_CVTIDX(ca0, ca1, raw0, raw1);
    if (has_next) { PG8_LOADIDX(raw0, raw1, nxt.pm); PG8_CVTIDX(na0, na1, raw0, raw1); } else { na0[0] = ca0[0]; na0[1] = ca0[1]; na1[0] = ca1[0]; na1[1] = ca1[1]; }
    f32x4 acc[2][2][4][2];
#pragma unroll
    for (int a = 0; a < 2; ++a)
#pragma unroll
        for (int b = 0; b < 2; ++b)
#pragma unroll
            for (int m = 0; m < 4; ++m)
#pragma unroll
                for (int n = 0; n < 2; ++n) acc[a][b][m][n] = (f32x4){0.f, 0.f, 0.f, 0.f};
    v8i At[4], B0[2], B1[2];
    const char* const cA = (const char*)g.A; const char* cB = (const char*)g.Bt + (size_t)cur.pn * tstepB;
    PG8_STAGE(PG8_SB(0, 0), cB, voffB); PG8_STAGE(PG8_SB(0, 1), cB + hstepB, voffB); PG8_STAGE(PG8_SA(0, 0), cA, ca0); PG8_STAGE(PG8_SA(0, 1), cA, ca1);
    if (wr == 1) PG8_BAR;
    PG8_WAIT_V(2); PG8_BAR;
    PG8_STAGE(PG8_SB(1, 0), cB + kstep, voffB); PG8_STAGE(PG8_SA(1, 0), cA + kstep, ca0); PG8_STAGE(PG8_SB(1, 1), cB + hstepB + kstep, voffB);
    PG8_WAIT_V(6); PG8_BAR;
    for (;;) {
        const bool has_next2 = has_next && S.next(ui + 2, nn);
        if (has_next2) PG8_LOADIDX(raw0, raw1, nn.pm);
        const char* nB = has_next ? (const char*)g.Bt + (size_t)nxt.pn * tstepB : cB;
        for (int t = 0; t < nt; t += 2) {
            const bool last = (t == nt - 2);
            const char* a1 = cA + (size_t)(t + 1) * kstep;
            const char* a2 = last ? cA : cA + (size_t)(t + 2) * kstep; const char* b2 = last ? nB : cB + (size_t)(t + 2) * kstep;
            const char* a3 = a2 + kstep; const char* b3 = b2 + kstep;
            unsigned s0[2], s1[2];
            s0[0] = last ? na0[0] : ca0[0]; s0[1] = last ? na0[1] : ca0[1]; s1[0] = last ? na1[0] : ca1[0]; s1[1] = last ? na1[1] : ca1[1];
            PG8_LDB(B0, 0, 0); PG8_LDB(B1, 0, 1); PG8_SCHED; PG8_LDA(At, 0, 0); PG8_STAGE(PG8_SA(1, 1), a1, ca1);
            PG8_WAIT_V(8); PG8_WAIT_L(0); PG8_BAR; PG8_MMA(0, 0, At, B0); PG8_MMA(0, 1, At, B1); PG8_BAR; PG8_SCHED;
            PG8_LDA(At, 0, 1); PG8_STAGE(PG8_SB(0, 0), b2, voffB); PG8_STAGE(PG8_SB(0, 1), b2 + hstepB, voffB); PG8_STAGE(PG8_SA(0, 0), a2, s0);
            PG8_WAIT_V(8); PG8_WAIT_L(0); PG8_BAR; PG8_MMA(1, 0, At, B0); PG8_MMA(1, 1, At, B1); PG8_BAR; PG8_SCHED;
            PG8_LDB(B0, 1, 0); PG8_LDB(B1, 1, 1); PG8_SCHED; PG8_LDA(At, 1, 0); PG8_STAGE(PG8_SA(0, 1), a2, s1);
            PG8_WAIT_V(8); PG8_WAIT_L(0); PG8_BAR; PG8_MMA(0, 0, At, B0); PG8_MMA(0, 1, At, B1); PG8_BAR; PG8_SCHED;
            PG8_LDA(At, 1, 1); PG8_STAGE(PG8_SB(1, 0), b3, voffB); PG8_STAGE(PG8_SB(1, 1), b3 + hstepB, voffB); PG8_STAGE(PG8_SA(1, 0), a3, s0);
            PG8_WAIT_V(8); PG8_WAIT_L(0); PG8_BAR; PG8_MMA(1, 0, At, B0); PG8_MMA(1, 1, At, B1); PG8_BAR; PG8_SCHED;
        }
        if constexpr (ALIGN_EPI) { if (wr == 0) PG8_BAR; }
        if constexpr (F8) asm volatile("s_nop 15\n\ts_nop 15" ::: "memory");
        E(acc, cur, wr, wc, fr, fq);
        if (!has_next) break;
#pragma unroll
        for (int a = 0; a < 2; ++a)
#pragma unroll
            for (int b = 0; b < 2; ++b)
#pragma unroll
                for (int m = 0; m < 4; ++m)
#pragma unroll
                    for (int n = 0; n < 2; ++n) acc[a][b][m][n] = (f32x4){0.f, 0.f, 0.f, 0.f};
        cur = nxt; cB = nB; ++ui;
        ca0[0] = na0[0]; ca0[1] = na0[1]; ca1[0] = na1[0]; ca1[1] = na1[1];
        if (has_next2) { PG8_CVTIDX(na0, na1, raw0, raw1); nxt = nn; }
        has_next = has_next2;
        if constexpr (ALIGN_EPI) { if (wr == 1) PG8_BAR; }
    }
    PG8_WAIT_V(0);
    if constexpr (!ALIGN_EPI) { if (wr == 0) PG8_BAR; }
    PG8_BAR;
#undef PG8_LOADIDX
#undef PG8_CVTIDX
#undef PG8_SA
#undef PG8_SB
#undef PG8_STAGE
#undef PG8_LDA
#undef PG8_LDB
#undef PG8_MMA
#undef PG8_WAIT_V
#undef PG8_WAIT_L
#undef PG8_BAR
#undef PG8_SCHED
}
}

constexpr int NWAVES = 8, NTHR = 512;
constexpr int BATCH = 32, SEQ = 2048, D = 1024, T = BATCH * SEQ, MEM = 256, TM = BATCH * MEM;
constexpr int DIN = 5888;
constexpr float EPS = 1e-6f;
constexpr int LDP = DIN, C_Q = 0, C_U = 1024, C_QC = 1536, C_K = 2048, C_V = 2176, C_VB = 2304, C_G = 2816;
constexpr float YSCALE = 16.0f;
constexpr float WSCALE = 64.0f;
constexpr int NEXP = 32, TOPK = 4;
constexpr int PS = T * TOPK + NEXP * 256;
constexpr int MAXTILE = PS / 256;

constexpr size_t MiB = 1u << 20;
constexpr size_t WS_CTL = 0, CTL_ZERO_BYTES = 1 * MiB;
constexpr size_t WS_WOUT = 1 * MiB;
constexpr size_t WS_ROPE = 3 * MiB;
constexpr size_t WS_WIN = 19 * MiB;
constexpr size_t WS_WO = 31 * MiB;
constexpr size_t WS_WMKV = 35 * MiB;
constexpr size_t WS_X8 = 3 * MiB;
constexpr size_t WS_SRSTD = 67 * MiB;
constexpr size_t WS_MEMN = 37 * MiB;
constexpr size_t WS_KV = 53 * MiB;
constexpr size_t WS_META = 69 * MiB;
constexpr size_t WS_H = 77 * MiB;
constexpr size_t WS_PROJ = 205 * MiB;
constexpr size_t WS_WGU = 141 * MiB;
constexpr size_t WS_WD = 205 * MiB;
constexpr size_t WS_ACT = 237 * MiB;
constexpr size_t WS_Y = 501 * MiB;
constexpr size_t WS_X1B = 765 * MiB;
constexpr size_t WS_END = 1013 * MiB;
static_assert(WS_PROJ + (size_t)T * LDP * 2 <= WS_END && WS_ACT + (size_t)PS * 1024 <= WS_Y && WS_Y + (size_t)T * TOPK * 2048 <= WS_END && WS_WGU + (size_t)NEXP * 2048 * 1024 <= WS_WD, "ws map");
constexpr size_t MT_IDX = 0;
constexpr size_t MT_GATE = 1 * MiB;
constexpr size_t MT_STOK = 2 * MiB;
constexpr size_t MT_SGATE = 3 * MiB + 512 * 1024;
constexpr size_t MT_SASG = 5 * MiB;
constexpr size_t MT_TILEE = 6 * MiB + 512 * 1024;
constexpr size_t MT_WSB = 7 * MiB;
constexpr size_t MT_RSTD = 7 * MiB + 128 * 1024;
constexpr size_t MT_CMAT = 7 * MiB + 512 * 1024;
constexpr size_t MT_RWP = 7 * MiB + 768 * 1024;
constexpr int CW_BAR = 4096;
constexpr int CW_NTILE = 1024;

constexpr int RING_OFF = 0, RING_BYTES = 131072;
constexpr int LDS_BYTES = 147456;
constexpr int LDSCTL_OFF = LDS_BYTES - 1024, MISC_OFF = LDSCTL_OFF + 320;

#define GAS __attribute__((address_space(1)))
#define LAS __attribute__((address_space(3)))
typedef unsigned short bf16;
typedef unsigned v4u __attribute__((ext_vector_type(4)));
typedef unsigned v2u __attribute__((ext_vector_type(2)));
typedef float f32x4 __attribute__((ext_vector_type(4)));
typedef GAS unsigned gu32;
#define RLX_AGENT __ATOMIC_RELAXED, __HIP_MEMORY_SCOPE_AGENT
#define LDS_WAIT() asm volatile("s_waitcnt lgkmcnt(0)" ::: "memory")
#define VM_WAIT() asm volatile("s_waitcnt vmcnt(0)" ::: "memory")
__device__ __forceinline__ unsigned f2bf(float f) { unsigned u = __builtin_bit_cast(unsigned, f); return (u + 0x7fffu + ((u >> 16) & 1u)) >> 16; }
__device__ __forceinline__ unsigned pk2(float lo, float hi) { return f2bf(lo) | (f2bf(hi) << 16); }
__device__ __forceinline__ unsigned pk4_fp8(float a, float b, float c, float d) { int w = 0; w = __builtin_amdgcn_cvt_pk_fp8_f32(a, b, w, false); w = __builtin_amdgcn_cvt_pk_fp8_f32(c, d, w, true); return (unsigned)w; }
__device__ __forceinline__ float bf2f(bf16 b) { return __uint_as_float(((unsigned)b) << 16); }
__device__ __forceinline__ float blo(unsigned w) { return __uint_as_float(w << 16); }
__device__ __forceinline__ float bhi(unsigned w) { return __uint_as_float(w & 0xffff0000u); }

#define XB_TMO      128
#define XB_XCNT(j)  (256  + 64 * (j))
#define XB_XSUB(j)  (1280 + 64 * (j))
#define XB_XGEN(j)  (2304 + 64 * (j))
#define XB_TOP      3328
#define XB_TOPGEN   3392
#define XCD_BAR_WORDS 3456
#define XB_SPIN_CAP (1u << 22)
__device__ __forceinline__ unsigned xb_ld(unsigned* p)              { return __hip_atomic_load(p, __ATOMIC_RELAXED, __HIP_MEMORY_SCOPE_AGENT); }
__device__ __forceinline__ unsigned xb_add(unsigned* p, unsigned v) { return __hip_atomic_fetch_add(p, v, __ATOMIC_RELAXED, __HIP_MEMORY_SCOPE_AGENT); }
__device__ __forceinline__ unsigned xb_xcc_id() { return (unsigned)__builtin_amdgcn_s_getreg((3 << 11) | 20) & 0xFu; }
#define XB_SPIN(cond, bar) do { unsigned _sp = 0; while (cond) { __builtin_amdgcn_s_sleep(1); \
    if ((++_sp & 255u) == 0u) { if (xb_ld(&(bar)[XB_TMO])) break; if (_sp > XB_SPIN_CAP) { atomicAdd(&(bar)[XB_TMO], 1u); break; } } } } while (0)
struct XcdBarrier { unsigned* bar; unsigned x; volatile LAS unsigned* st; };
__device__ __forceinline__ XcdBarrier xcd_barrier_post(unsigned* bar, volatile LAS unsigned* st, bool leader) {
    XcdBarrier b; b.bar = bar; b.x = xb_xcc_id(); b.st = st;
    if (leader) (void)xb_add(&bar[XB_XCNT(b.x)], 1u);
    return b;
}
__device__ __forceinline__ void xcd_barrier_complete(unsigned* bar, unsigned x, unsigned& nloc, unsigned& nx) {
    const unsigned G = gridDim.x * gridDim.y * gridDim.z;
    unsigned sum, cnt, mine, sp = 0u;
    for (;;) {
        sum = 0u; cnt = 0u; mine = 0u;
#pragma unroll
        for (unsigned j = 0; j < 16; ++j) { const unsigned c = xb_ld(&bar[XB_XCNT(j)]); sum += c; cnt += (c > 0u) ? 1u : 0u; mine = (j == x) ? c : mine; }
        if (sum == G) break;
        __builtin_amdgcn_s_sleep(1);
        if ((++sp & 255u) == 0u) { if (xb_ld(&bar[XB_TMO])) break; if (sp > XB_SPIN_CAP) { atomicAdd(&bar[XB_TMO], 1u); break; } }
    }
    nloc = mine > 0u ? mine : 1u; nx = cnt > 0u ? cnt : 1u;
}
__device__ __forceinline__ void xcd_barrier(const XcdBarrier& b, bool leader) {
    asm volatile("s_waitcnt vmcnt(0)" ::: "memory");
    __syncthreads();
    if (leader) {
        unsigned* bar = b.bar;
        __builtin_amdgcn_s_waitcnt(0);
        unsigned nloc = b.st[0], nx = b.st[1];
        if (nloc == 0u) { xcd_barrier_complete(bar, b.x, nloc, nx); b.st[0] = nloc; b.st[1] = nx; }
        const unsigned old = xb_add(&bar[XB_XSUB(b.x)], 1u);
        const unsigned gen = old / nloc;
        if (old + 1u == (gen + 1u) * nloc) {
            __builtin_amdgcn_fence(__ATOMIC_RELEASE, "agent");
            asm volatile("s_waitcnt vmcnt(0)" ::: "memory");
            const unsigned og = xb_add(&bar[XB_TOP], 1u);
            const unsigned tg = og / nx;
            if (og + 1u == (tg + 1u) * nx) xb_add(&bar[XB_TOPGEN], 1u);
            else XB_SPIN(xb_ld(&bar[XB_TOPGEN]) == tg, bar);
            __builtin_amdgcn_fence(__ATOMIC_ACQUIRE, "agent");
            xb_add(&bar[XB_XGEN(b.x)], 1u);
            asm volatile("s_waitcnt vmcnt(0)" ::: "memory");
        } else {
            XB_SPIN(xb_ld(&bar[XB_XGEN(b.x)]) == gen, bar);
            __builtin_amdgcn_fence(__ATOMIC_ACQUIRE, "agent");
            asm volatile("s_waitcnt vmcnt(0)" ::: "memory");
        }
    }
    __syncthreads();
}

__device__ __forceinline__ float dpp_add(float v, const int ctrl) { return v; }
#define DPP_ADD(v, ctrl) ((v) + __builtin_bit_cast(float, __builtin_amdgcn_update_dpp(0, __builtin_bit_cast(int, (v)), (ctrl), 0xf, 0xf, false)))
__device__ __forceinline__ float row16_sum(float v) { v = DPP_ADD(v, 0xB1); v = DPP_ADD(v, 0x4E); v = DPP_ADD(v, 0x141); v = DPP_ADD(v, 0x140); return v; }
__device__ __forceinline__ float wave_sum(float v) { return xor32_sum(xor16_sum(row16_sum(v))); }
__device__ __forceinline__ float wave_max(float v) {
#pragma unroll
    for (int o = 1; o < 64; o <<= 1) v = fmaxf(v, __shfl_xor(v, o));
    return v;
}
__device__ __forceinline__ float half_sum(float v) {
#pragma unroll
    for (int o = 1; o < 32; o <<= 1) v += __shfl_xor(v, o);
    return v;
}
__device__ __forceinline__ float gelu_erf(float x) { return 0.5f * x * (1.0f + erff(x * 0.70710678118654752f)); }

struct Args {
    const float* in[28]; float* out; unsigned char* ws; int ph_lo, ph_hi;
};
enum { I_X = 0, I_MEM, I_POS, I_ATTN_G, I_MEM_G, I_WIN, I_BGATES, I_AQG, I_AKG, I_SINKS, I_WOA, I_LNG, I_LNB, I_WS, I_BS, I_WOB, I_WMKV, I_CQG, I_CKG, I_WOC, I_WOUT, I_FFN_G,
       I_RW, I_RB, I_WGU, I_BGU, I_WD, I_BD };

__device__ __forceinline__ void tr_item(const float* W, int ldw, int k0, int sc, bf16* WT, int ldt, int dr, int dk, LAS float* scr, int lane) {
#pragma unroll 8
    for (int i = 0; i < 32; ++i) { const int kk = 2 * i + (lane >> 5); scr[kk * 33 + (lane & 31)] = W[(size_t)(k0 + kk) * ldw + sc + (lane & 31)]; }
    LDS_WAIT(); asm volatile("" ::: "memory");
    const int c = lane & 7;
#pragma unroll
    for (int j = 0; j < 4; ++j) { const int n = (lane >> 3) + 8 * j; const LAS float* s = scr + (8 * c) * 33 + n;
        v4u o; o.x = pk2(s[0 * 33], s[1 * 33]); o.y = pk2(s[2 * 33], s[3 * 33]); o.z = pk2(s[4 * 33], s[5 * 33]); o.w = pk2(s[6 * 33], s[7 * 33]);
        *(GAS v4u*)(WT + (size_t)(dr + n) * ldt + dk + k0 + 8 * c) = o; }
    LDS_WAIT(); asm volatile("" ::: "memory");
}
struct TrItem { const float* W; int ldw, k0, sc; bf16* WT; int ldt, dr, dk; const float* ks; };
__device__ __forceinline__ void tr_load(const TrItem& it, int lane, f32x4 (&v)[8]) {
    const float* p = it.W + (size_t)(it.k0 + (lane >> 3)) * it.ldw + it.sc + 4 * (lane & 7);
#pragma unroll
    for (int i = 0; i < 8; ++i) v[i] = *(const GAS f32x4*)(p + (size_t)(8 * i) * it.ldw);
}
__device__ __forceinline__ void tr_store(const TrItem& it, const f32x4 (&v)[8], LAS float* scr, int lane) {
#pragma unroll
    for (int i = 0; i < 8; ++i) { LAS float* p = scr + ((lane >> 3) + 8 * i) * 33 + 4 * (lane & 7); p[0] = v[i].x; p[1] = v[i].y; p[2] = v[i].z; p[3] = v[i].w; }
    LDS_WAIT(); asm volatile("" ::: "memory");
    const int c = lane & 7;
#pragma unroll
    for (int j = 0; j < 4; ++j) { const int n = (lane >> 3) + 8 * j; const LAS float* s = scr + (8 * c) * 33 + n;
        v4u o; o.x = pk2(s[0 * 33], s[1 * 33]); o.y = pk2(s[2 * 33], s[3 * 33]); o.z = pk2(s[4 * 33], s[5 * 33]); o.w = pk2(s[6 * 33], s[7 * 33]);
        *(GAS v4u*)(it.WT + (size_t)(it.dr + n) * it.ldt + it.dk + it.k0 + 8 * c) = o; }
    LDS_WAIT(); asm volatile("" ::: "memory");
}
__device__ __forceinline__ void tr_store8(const TrItem& it, const f32x4 (&v)[8], LAS float* scr, int lane, float sc) {
#pragma unroll
    for (int i = 0; i < 8; ++i) { LAS float* p = scr + ((lane >> 3) + 8 * i) * 33 + 4 * (lane & 7); p[0] = v[i].x; p[1] = v[i].y; p[2] = v[i].z; p[3] = v[i].w; }
    LDS_WAIT(); asm volatile("" ::: "memory");
    const int c = lane & 7; unsigned char* WT8 = (unsigned char*)it.WT;
    f32x4 k0v = (f32x4){sc, sc, sc, sc}, k1v = k0v;
    if (it.ks) { k0v = *(const GAS f32x4*)(it.ks + it.k0 + 8 * c) * sc; k1v = *(const GAS f32x4*)(it.ks + it.k0 + 8 * c + 4) * sc; }
#pragma unroll
    for (int j = 0; j < 4; ++j) { const int n = (lane >> 3) + 8 * j; const LAS float* s = scr + (8 * c) * 33 + n;
        v2u o; o.x = pk4_fp8(s[0 * 33] * k0v.x, s[1 * 33] * k0v.y, s[2 * 33] * k0v.z, s[3 * 33] * k0v.w); o.y = pk4_fp8(s[4 * 33] * k1v.x, s[5 * 33] * k1v.y, s[6 * 33] * k1v.z, s[7 * 33] * k1v.w);
        *(GAS v2u*)(WT8 + (size_t)(it.dr + n) * it.ldt + it.dk + it.k0 + 8 * c) = o; }
    LDS_WAIT(); asm volatile("" ::: "memory");
}
template <class F> __device__ __forceinline__ void tr_range8(int nit, F f, int gw, int NGW, LAS float* scr, int lane, float sc) {
    for (int it = gw; it < nit; it += 2 * NGW) {
        const TrItem a = f(it); f32x4 va[8], vb[8]; tr_load(a, lane, va);
        const bool two = it + NGW < nit; TrItem b = a; if (two) { b = f(it + NGW); tr_load(b, lane, vb); }
        tr_store8(a, va, scr, lane, sc);
        if (two) tr_store8(b, vb, scr, lane, sc);
    }
}
template <class F> __device__ __forceinline__ void tr_range(int nit, F f, int gw, int NGW, LAS float* scr, int lane) {
    for (int it = gw; it < nit; it += 2 * NGW) {
        const TrItem a = f(it); f32x4 va[8], vb[8]; tr_load(a, lane, va);
        const bool two = it + NGW < nit; TrItem b = a; if (two) { b = f(it + NGW); tr_load(b, lane, vb); }
        tr_store(a, va, scr, lane);
        if (two) tr_store(b, vb, scr, lane);
    }
}
__device__ __forceinline__ int win_srccol(int r) {
    if (r < 1024) { const int pn = r >> 8, blk = (r >> 5) & 7, bj = blk >> 2, wc = blk & 3; return 64 * (4 * pn + wc) + 32 * bj; }
    if (r < 1536) return 1280 + (r - 1024);
    if (r < 2048) return 2304 + (r - 1536);
    if (r < 2304) { const int blk = (r - 2048) >> 5, bj = blk >> 2, wc = blk & 3; return ((wc & 1) ? 1152 : 1024) + 64 * (wc >> 1) + 32 * bj; }
    if (r < 2816) return 1792 + (r - 2304);
    return r;
}
__device__ __forceinline__ void rms_row_to_bf16(const float* xrow, const float* g, bf16* orow, int lane) {
    const GAS f32x4* xr = (const GAS f32x4*)xrow + lane; const GAS f32x4* gr = (const GAS f32x4*)g + lane;
    f32x4 v[4]; float s = 0.f;
#pragma unroll
    for (int j = 0; j < 4; ++j) { v[j] = xr[64 * j]; s += (v[j].x * v[j].x + v[j].y * v[j].y) + (v[j].z * v[j].z + v[j].w * v[j].w); }
    const float rstd = 1.0f / sqrtf(wave_sum(s) * (1.f / 1024.f) + EPS);
    GAS v2u* o8 = (GAS v2u*)orow + lane;
#pragma unroll
    for (int j = 0; j < 4; ++j) { const f32x4 gg = gr[64 * j]; v2u o; o.x = pk2(v[j].x * rstd * gg.x, v[j].y * rstd * gg.y); o.y = pk2(v[j].z * rstd * gg.z, v[j].w * rstd * gg.w); o8[64 * j] = o; }
}

__device__ __forceinline__ void rms_rows4_to_bf16(const float* xrow, const float* g, bf16* orow, int lane) {
    const GAS f32x4* xr = (const GAS f32x4*)xrow + lane; const GAS f32x4* gr = (const GAS f32x4*)g + lane;
    f32x4 v[16]; float s[4];
#pragma unroll
    for (int j = 0; j < 16; ++j) v[j] = xr[64 * j];
#pragma unroll
    for (int r = 0; r < 4; ++r) { float a = 0.f;
#pragma unroll
        for (int j = 0; j < 4; ++j) a += (v[4 * r + j].x * v[4 * r + j].x + v[4 * r + j].y * v[4 * r + j].y) + (v[4 * r + j].z * v[4 * r + j].z + v[4 * r + j].w * v[4 * r + j].w);
        s[r] = a; }
#pragma unroll
    for (int r = 0; r < 4; ++r) s[r] = row16_sum(s[r]);
#pragma unroll
    for (int r = 0; r < 4; ++r) s[r] = xor32_sum(xor16_sum(s[r]));
    GAS v2u* o8 = (GAS v2u*)orow + lane;
#pragma unroll
    for (int r = 0; r < 4; ++r) { const float rs = 1.0f / sqrtf(s[r] * (1.f / 1024.f) + EPS);
#pragma unroll
        for (int j = 0; j < 4; ++j) { const f32x4 gg = gr[64 * j]; const f32x4 a = v[4 * r + j];
            v2u o; o.x = pk2(a.x * rs * gg.x, a.y * rs * gg.y); o.y = pk2(a.z * rs * gg.z, a.w * rs * gg.w); o8[256 * r + 64 * j] = o; } }
}
__device__ __forceinline__ void rms_rows2_to_bf16(const float* xrow, const float* g, bf16* orow, int lane) {
    const GAS f32x4* xr = (const GAS f32x4*)xrow + lane; const GAS f32x4* gr = (const GAS f32x4*)g + lane;
    f32x4 v[8]; float s0 = 0.f, s1 = 0.f;
#pragma unroll
    for (int j = 0; j < 8; ++j) v[j] = xr[64 * j];
#pragma unroll
    for (int j = 0; j < 4; ++j) { s0 += (v[j].x * v[j].x + v[j].y * v[j].y) + (v[j].z * v[j].z + v[j].w * v[j].w); s1 += (v[4 + j].x * v[4 + j].x + v[4 + j].y * v[4 + j].y) + (v[4 + j].z * v[4 + j].z + v[4 + j].w * v[4 + j].w); }
    const float r0 = 1.0f / sqrtf(wave_sum(s0) * (1.f / 1024.f) + EPS), r1 = 1.0f / sqrtf(wave_sum(s1) * (1.f / 1024.f) + EPS);
    GAS v2u* o8 = (GAS v2u*)orow + lane;
#pragma unroll
    for (int j = 0; j < 4; ++j) { const f32x4 gg = gr[64 * j];
        v2u o; o.x = pk2(v[j].x * r0 * gg.x, v[j].y * r0 * gg.y); o.y = pk2(v[j].z * r0 * gg.z, v[j].w * r0 * gg.w); o8[64 * j] = o;
        v2u p; p.x = pk2(v[4 + j].x * r1 * gg.x, v[4 + j].y * r1 * gg.y); p.y = pk2(v[4 + j].z * r1 * gg.z, v[4 + j].w * r1 * gg.w); o8[256 + 64 * j] = p; }
}
namespace att {
typedef short bf16x8 __attribute__((ext_vector_type(8)));
typedef short s16x4 __attribute__((ext_vector_type(4)));
typedef short v4i16_t __attribute__((ext_vector_type(4)));
typedef float f32x16 __attribute__((ext_vector_type(16)));
typedef float f32x2_t __attribute__((ext_vector_type(2)));
typedef __bf16 bf16x2_t __attribute__((ext_vector_type(2)));
#define ATT_MFMA(a, b, c) __builtin_amdgcn_mfma_f32_32x32x16_bf16((a), (b), (c), 0, 0, 0)
__device__ __forceinline__ unsigned cvtpk(float lo, float hi) { f32x2_t v = {lo, hi}; bf16x2_t b = __builtin_convertvector(v, bf16x2_t); return __builtin_bit_cast(unsigned, b); }
__device__ __forceinline__ s16x4 vtr(const LAS unsigned char* p) { return __builtin_bit_cast(s16x4, __builtin_amdgcn_ds_read_tr16_b64_v4i16((LAS v4i16_t*)p)); }
__device__ __forceinline__ int crow(int r, int h) { return (r & 3) + 8 * (r >> 2) + 4 * h; }
__device__ __forceinline__ bf16x8 pack8(float a0, float a1, float a2, float a3, float a4, float a5, float a6, float a7) {
    v4u w; w.x = cvtpk(a0, a1); w.y = cvtpk(a2, a3); w.z = cvtpk(a4, a5); w.w = cvtpk(a6, a7); return __builtin_bit_cast(bf16x8, w); }
constexpr float LOG2E = 1.4426950408889634f;
constexpr int SWA_KP = 144, SWA_VP = 192, SWA_K_OFF = 0, SWA_V_OFF = 256 * SWA_KP;

__device__ __forceinline__ void swa_phase(LAS unsigned char* L, bf16* projp, const float* sinks, const float* gq, const float* gk, int bid, int G, int wave, int lane) {
    const int tid = wave * 64 + lane, r32 = lane & 31, h = lane >> 5, blk16 = (lane >> 4) & 1, q4 = (lane & 15) >> 2, p4 = lane & 3;
    const float bnd = 8.0f * wave_max(fabsf(gq[lane])) * wave_max(fabsf(gk[lane]));
    v4u kx[4], vx[4];
#define SWA_LOADKV(u_) do { const int blk_ = (u_) & 15, kvh_ = ((u_) >> 4) & 1, b_ = (u_) >> 5; const int tok0_ = b_ * SEQ + blk_ * 128; \
        _Pragma("unroll") for (int it = 0; it < 4; ++it) if (it >= 2 || blk_ != 0) { \
            const bf16* src = projp + (size_t)(tok0_ - 128 + (tid >> 3) + 64 * it) * LDP + 64 * kvh_ + 8 * (tid & 7); \
            kx[it] = *(const GAS v4u*)(src + C_K); vx[it] = *(const GAS v4u*)(src + C_V); } } while (0)
    if (bid < 1024) SWA_LOADKV(bid);
    for (int unit = bid; unit < 1024; unit += G) {
        const int blk = unit & 15, kvh = (unit >> 4) & 1, b = unit >> 5;
        const int tok0 = b * SEQ + blk * 128;
        __syncthreads();
#pragma unroll
        for (int it = 0; it < 4; ++it) if (it >= 2 || blk != 0) {
            const int row = (tid >> 3) + 64 * it, ch = tid & 7;
            *(LAS v4u*)(L + SWA_K_OFF + row * SWA_KP + ch * 16) = kx[it];
            *(LAS v4u*)(L + SWA_V_OFF + row * SWA_VP + ch * 16) = vx[it];
        }
        __syncthreads();
        if (unit + G < 1024) SWA_LOADKV(unit + G);
        const int hd = kvh * 8 + wave;
        const float sink = sinks[hd];
        const float m2 = fmaxf(bnd, sink) * LOG2E;
        const float esink = __builtin_amdgcn_exp2f(sink * LOG2E - m2);
        bf16x8 qnx[4];
#pragma unroll
        for (int ks = 0; ks < 4; ++ks) qnx[ks] = *(const GAS bf16x8*)(projp + (size_t)(tok0 + r32) * LDP + C_Q + 64 * hd + 16 * ks + 8 * h);
#pragma unroll 1
        for (int qi = 0; qi < 4; ++qi) {
            bf16* qrow = projp + (size_t)(tok0 + 32 * qi + r32) * LDP + C_Q + 64 * hd;
            bf16x8 qf[4];
#pragma unroll
            for (int ks = 0; ks < 4; ++ks) qf[ks] = qnx[ks];
            if (qi < 3) {
#pragma unroll
                for (int ks = 0; ks < 4; ++ks) qnx[ks] = *(const GAS bf16x8*)(qrow + (size_t)32 * LDP + 16 * ks + 8 * h); }
            f32x16 o0, o1;
#pragma unroll
            for (int r = 0; r < 16; ++r) { o0[r] = 0.f; o1[r] = 0.f; }
            float lsum = 0.f;
            const int kt0 = (blk == 0) ? 4 : qi;
#pragma unroll 1
            for (int kt = kt0; kt <= qi + 4; ++kt) {
                f32x16 s;
#pragma unroll
                for (int r = 0; r < 16; ++r) s[r] = 0.f;
                const LAS unsigned char* kp = L + SWA_K_OFF + (32 * kt + r32) * SWA_KP + 16 * h;
#pragma unroll
                for (int ks = 0; ks < 4; ++ks) { const bf16x8 kf = *(const LAS bf16x8*)(kp + 32 * ks); s = ATT_MFMA(kf, qf[ks], s); }
                float p[16];
                const bool first = (kt == qi), lastt = (kt == qi + 4);
#pragma unroll
                for (int r = 0; r < 16; ++r) { const float e = __builtin_amdgcn_exp2f(s[r] * (0.125f * LOG2E) - m2); const int cr = crow(r, h);
                    const bool ok = (!first || cr > r32) && (!lastt || cr <= r32); p[r] = ok ? e : 0.f; lsum += p[r]; }
#pragma unroll
                for (int s2 = 0; s2 < 2; ++s2) {
                    const bf16x8 pb = pack8(p[8 * s2], p[8 * s2 + 1], p[8 * s2 + 2], p[8 * s2 + 3], p[8 * s2 + 4], p[8 * s2 + 5], p[8 * s2 + 6], p[8 * s2 + 7]);
                    const LAS unsigned char* vp = L + SWA_V_OFF + (32 * kt + 16 * s2 + 4 * h + q4) * SWA_VP + (16 * blk16 + 4 * p4) * 2;
                    { const s16x4 lo = vtr(vp), hi = vtr(vp + 8 * SWA_VP); const bf16x8 vf = __builtin_shufflevector(lo, hi, 0, 1, 2, 3, 4, 5, 6, 7); o0 = ATT_MFMA(vf, pb, o0); }
                    { const s16x4 lo = vtr(vp + 64), hi = vtr(vp + 64 + 8 * SWA_VP); const bf16x8 vf = __builtin_shufflevector(lo, hi, 0, 1, 2, 3, 4, 5, 6, 7); o1 = ATT_MFMA(vf, pb, o1); }
                }
            }
            const float tot = xor32_sum(lsum); const float inv = 1.0f / (tot + esink);
#pragma unroll
            for (int g4 = 0; g4 < 4; ++g4) {
                v2u w0; w0.x = cvtpk(o0[4 * g4] * inv, o0[4 * g4 + 1] * inv); w0.y = cvtpk(o0[4 * g4 + 2] * inv, o0[4 * g4 + 3] * inv);
                v2u w1; w1.x = cvtpk(o1[4 * g4] * inv, o1[4 * g4 + 1] * inv); w1.y = cvtpk(o1[4 * g4 + 2] * inv, o1[4 * g4 + 3] * inv);
                *(GAS v2u*)(qrow + 8 * g4 + 4 * h) = w0; *(GAS v2u*)(qrow + 32 + 8 * g4 + 4 * h) = w1;
            }
        }
    }
}

constexpr int GM_P = 1088;
__device__ __forceinline__ void gmlp_phase(LAS unsigned char* L, bf16* projp, const bf16* Wb, const float* lng, const float* lnb, const float* bs, int bid, int G, int wave, int lane) {
    const int r32 = lane & 31, h = lane >> 5, blk16 = (lane >> 4) & 1, q4 = (lane & 15) >> 2, p4 = lane & 3;
    float lg[8], lb[8];
    { const f32x4 a = *(const f32x4*)(lng + 8 * lane), b = *(const f32x4*)(lng + 8 * lane + 4), c = *(const f32x4*)(lnb + 8 * lane), d = *(const f32x4*)(lnb + 8 * lane + 4);
      lg[0] = a.x; lg[1] = a.y; lg[2] = a.z; lg[3] = a.w; lg[4] = b.x; lg[5] = b.y; lg[6] = b.z; lg[7] = b.w;
      lb[0] = c.x; lb[1] = c.y; lb[2] = c.z; lb[3] = c.w; lb[4] = d.x; lb[5] = d.y; lb[6] = d.z; lb[7] = d.w; }
    for (int unit = bid; unit < T / 128; unit += G) {
        const int tok0 = unit * 128;
        __syncthreads();
#pragma unroll 1
        for (int i0 = 0; i0 < 16; i0 += 8) {
            v4u w[8]; float sm[8], q[8];
#pragma unroll
            for (int i = 0; i < 8; ++i) w[i] = *(const GAS v4u*)(projp + (size_t)(tok0 + 16 * wave + i0 + i) * LDP + C_VB + 8 * lane);
#pragma unroll
            for (int i = 0; i < 8; ++i) sm[i] = row16_sum(((blo(w[i].x) + bhi(w[i].x)) + (blo(w[i].y) + bhi(w[i].y))) + ((blo(w[i].z) + bhi(w[i].z)) + (blo(w[i].w) + bhi(w[i].w))));
#pragma unroll
            for (int i = 0; i < 8; ++i) sm[i] = xor32_sum(xor16_sum(sm[i])) * (1.f / 512.f);
#pragma unroll
            for (int i = 0; i < 8; ++i) { const float mu = sm[i];
                const float d0 = blo(w[i].x) - mu, d1 = bhi(w[i].x) - mu, d2 = blo(w[i].y) - mu, d3 = bhi(w[i].y) - mu, d4 = blo(w[i].z) - mu, d5 = bhi(w[i].z) - mu, d6 = blo(w[i].w) - mu, d7 = bhi(w[i].w) - mu;
                q[i] = row16_sum(((d0 * d0 + d1 * d1) + (d2 * d2 + d3 * d3)) + ((d4 * d4 + d5 * d5) + (d6 * d6 + d7 * d7))); }
#pragma unroll
            for (int i = 0; i < 8; ++i) q[i] = xor32_sum(xor16_sum(q[i]));
#pragma unroll
            for (int i = 0; i < 8; ++i) { const float mu = sm[i], rstd = 1.0f / sqrtf(q[i] * (1.f / 512.f) + EPS);
                v4u o; o.x = cvtpk((blo(w[i].x) - mu) * rstd * lg[0] + lb[0], (bhi(w[i].x) - mu) * rstd * lg[1] + lb[1]); o.y = cvtpk((blo(w[i].y) - mu) * rstd * lg[2] + lb[2], (bhi(w[i].y) - mu) * rstd * lg[3] + lb[3]);
                o.z = cvtpk((blo(w[i].z) - mu) * rstd * lg[4] + lb[4], (bhi(w[i].z) - mu) * rstd * lg[5] + lb[5]); o.w = cvtpk((blo(w[i].w) - mu) * rstd * lg[6] + lb[6], (bhi(w[i].w) - mu) * rstd * lg[7] + lb[7]);
                *(LAS v4u*)(L + (16 * wave + i0 + i) * GM_P + lane * 16) = o; }
        }
        __syncthreads();
        const int g = wave >> 1, th = wave & 1;
        f32x16 acc[4][2];
#pragma unroll
        for (int ct = 0; ct < 4; ++ct)
#pragma unroll
            for (int tt = 0; tt < 2; ++tt)
#pragma unroll
                for (int r = 0; r < 16; ++r) acc[ct][tt][r] = 0.f;
#pragma unroll 1
        for (int ks = 0; ks < 4 * th + 4; ++ks) {
            bf16x8 af[4];
#pragma unroll
            for (int ct = 0; ct < 4; ++ct) { const LAS unsigned char* vp = L + (16 * ks + 8 * h + q4) * GM_P + (128 * g + 32 * ct + 16 * blk16 + 4 * p4) * 2;
                const s16x4 lo = vtr(vp), hi = vtr(vp + 4 * GM_P); af[ct] = __builtin_shufflevector(lo, hi, 0, 1, 2, 3, 4, 5, 6, 7); }
#pragma unroll
            for (int tt = 0; tt < 2; ++tt) if (ks < 4 * th + 2 * tt + 2) {
                const bf16x8 bfr = *(const GAS bf16x8*)(Wb + (size_t)(g * 128 + 64 * th + 32 * tt + r32) * 128 + 16 * ks + 8 * h);
#pragma unroll
                for (int ct = 0; ct < 4; ++ct) acc[ct][tt] = ATT_MFMA(af[ct], bfr, acc[ct][tt]);
            }
        }
#pragma unroll
        for (int tt = 0; tt < 2; ++tt) { const int t = 64 * th + 32 * tt + r32; const float bsv = bs[g * 128 + t];
            bf16* urow = projp + (size_t)(tok0 + t) * LDP + C_U + 128 * g + 4 * h;
#pragma unroll
            for (int ct = 0; ct < 4; ++ct)
#pragma unroll
                for (int g4 = 0; g4 < 4; ++g4) { bf16* up = urow + 32 * ct + 8 * g4; const v2u uw = *(const GAS v2u*)up;
                    v2u o; o.x = cvtpk(blo(uw.x) * (acc[ct][tt][4 * g4] + bsv), bhi(uw.x) * (acc[ct][tt][4 * g4 + 1] + bsv));
                    o.y = cvtpk(blo(uw.y) * (acc[ct][tt][4 * g4 + 2] + bsv), bhi(uw.y) * (acc[ct][tt][4 * g4 + 3] + bsv)); *(GAS v2u*)up = o; } }
    }
}

constexpr int XA_K_OFF = 0, XA_V_OFF = 65536;
__device__ __forceinline__ unsigned off_b(unsigned row, unsigned ch) { return 256u * row + 16u * (ch ^ (((row & 3u) << 2) | ((row >> 2) & 3u))); }
__device__ __forceinline__ void xattn_phase(LAS unsigned char* L, bf16* projp, const bf16* kvp, const float* cqg, const float* ckg, int bid, int G, int wave, int lane) {
    const int tid = wave * 64 + lane, r32 = lane & 31, h = lane >> 5, blk16 = (lane >> 4) & 1, q4 = (lane & 15) >> 2, p4 = lane & 3;
    const int fch = tid & 15;
    float gg[8];
#pragma unroll
    for (int i = 0; i < 8; ++i) gg[i] = cqg[8 * fch + i] * ckg[8 * fch + i] * (0.08838834764831845f * LOG2E);
    const float mq = wave_max(fmaxf(fabsf(cqg[lane]), fabsf(cqg[lane + 64]))), mk = wave_max(fmaxf(fabsf(ckg[lane]), fabsf(ckg[lane + 64])));
    const float m2 = 11.313708499f * mq * mk * LOG2E;
    for (int unit = bid; unit < 256; unit += G) {
        const int qh = unit & 1, hd = (unit >> 1) & 3, b = unit >> 3;
        __syncthreads();
        {   v4u kx[8], vx[8];
#pragma unroll
            for (int it = 0; it < 8; ++it) { const bf16* src = kvp + (size_t)(b * MEM + (tid >> 4) + 32 * it) * D + 128 * hd + 8 * fch; kx[it] = *(const GAS v4u*)src; vx[it] = *(const GAS v4u*)(src + 512); }
#pragma unroll
            for (int it = 0; it < 8; ++it) { const int row = (tid >> 4) + 32 * it;
                float k[8] = {blo(kx[it].x), bhi(kx[it].x), blo(kx[it].y), bhi(kx[it].y), blo(kx[it].z), bhi(kx[it].z), blo(kx[it].w), bhi(kx[it].w)};
                float ss = 0.f;
#pragma unroll
                for (int e = 0; e < 8; ++e) ss += k[e] * k[e];
                ss = row16_sum(ss);
                const float rstd = 1.0f / sqrtf(ss * (1.f / 128.f) + EPS);
                v4u ko; ko.x = cvtpk(k[0] * rstd * gg[0], k[1] * rstd * gg[1]); ko.y = cvtpk(k[2] * rstd * gg[2], k[3] * rstd * gg[3]);
                ko.z = cvtpk(k[4] * rstd * gg[4], k[5] * rstd * gg[5]); ko.w = cvtpk(k[6] * rstd * gg[6], k[7] * rstd * gg[7]);
                const unsigned o = off_b((unsigned)row, (unsigned)fch);
                *(LAS v4u*)(L + XA_K_OFF + o) = ko; *(LAS v4u*)(L + XA_V_OFF + o) = vx[it]; } }
        bf16* qrow0 = projp + (size_t)(b * SEQ + 1024 * qh + 32 * wave + r32) * LDP + C_QC + 128 * hd + 8 * h;
        v4u qn[8];
#pragma unroll
        for (int ks = 0; ks < 8; ++ks) qn[ks] = *(const GAS v4u*)(qrow0 + 16 * ks);
        __syncthreads();
#pragma unroll 1
        for (int qt = 0; qt < 4; ++qt) {
            bf16* qrow = qrow0 + (size_t)(256 * qt) * LDP;
            bf16x8 qf[8]; float ss = 0.f;
#pragma unroll
            for (int ks = 0; ks < 8; ++ks) { const v4u w = qn[ks]; qf[ks] = __builtin_bit_cast(bf16x8, w);
                ss += (blo(w.x) * blo(w.x) + bhi(w.x) * bhi(w.x)) + (blo(w.y) * blo(w.y) + bhi(w.y) * bhi(w.y)) + (blo(w.z) * blo(w.z) + bhi(w.z) * bhi(w.z)) + (blo(w.w) * blo(w.w) + bhi(w.w) * bhi(w.w)); }
            if (qt < 3) {
#pragma unroll
                for (int ks = 0; ks < 8; ++ks) qn[ks] = *(const GAS v4u*)(qrow + (size_t)256 * LDP + 16 * ks); }
            ss = xor32_sum(ss);
            const float rq = 1.0f / sqrtf(ss * (1.f / 128.f) + EPS);
            f32x16 o[4];
#pragma unroll
            for (int dt = 0; dt < 4; ++dt)
#pragma unroll
                for (int r = 0; r < 16; ++r) o[dt][r] = 0.f;
            float lsum = 0.f;
#pragma unroll 1
            for (int kt = 0; kt < 8; ++kt) {
                f32x16 s;
#pragma unroll
                for (int r = 0; r < 16; ++r) s[r] = 0.f;
#pragma unroll
                for (int ks = 0; ks < 8; ++ks) { const bf16x8 kf = *(const LAS bf16x8*)(L + XA_K_OFF + off_b((unsigned)(32 * kt + r32), (unsigned)(2 * ks + h))); s = ATT_MFMA(kf, qf[ks], s); }
                float p[16];
#pragma unroll
                for (int r = 0; r < 16; ++r) { p[r] = __builtin_amdgcn_exp2f(s[r] * rq - m2); lsum += p[r]; }
#pragma unroll
                for (int s2 = 0; s2 < 2; ++s2) {
                    const bf16x8 pb = pack8(p[8 * s2], p[8 * s2 + 1], p[8 * s2 + 2], p[8 * s2 + 3], p[8 * s2 + 4], p[8 * s2 + 5], p[8 * s2 + 6], p[8 * s2 + 7]);
                    const unsigned r0 = (unsigned)(32 * kt + 16 * s2 + 4 * h + q4);
#pragma unroll
                    for (int dt = 0; dt < 4; ++dt) {
                        const unsigned ch = (unsigned)(4 * dt + 2 * blk16 + (p4 >> 1));
                        const s16x4 lo = vtr(L + XA_V_OFF + off_b(r0, ch) + 8 * (p4 & 1)), hi = vtr(L + XA_V_OFF + off_b(r0 + 8u, ch) + 8 * (p4 & 1));
                        const bf16x8 vf = __builtin_shufflevector(lo, hi, 0, 1, 2, 3, 4, 5, 6, 7); o[dt] = ATT_MFMA(vf, pb, o[dt]); }
                }
            }
            const float inv = 1.0f / xor32_sum(lsum);
#pragma unroll
            for (int dt = 0; dt < 4; ++dt)
#pragma unroll
                for (int g4 = 0; g4 < 4; ++g4) { v2u w; w.x = cvtpk(o[dt][4 * g4] * inv, o[dt][4 * g4 + 1] * inv); w.y = cvtpk(o[dt][4 * g4 + 2] * inv, o[dt][4 * g4 + 3] * inv);
                    *(GAS v2u*)(qrow - 8 * h + 32 * dt + 8 * g4 + 4 * h) = w; }
        }
    }
}
}

constexpr int NPHASE = 11;
__global__ void __launch_bounds__(NTHR, 2) fwd(Args args) {
    extern __shared__ __attribute__((aligned(16))) unsigned char lds[];
    LAS unsigned char* L = (LAS unsigned char*)lds;
    volatile LAS unsigned* MISC = (volatile LAS unsigned*)(L + MISC_OFF);
    const int wave_s = __builtin_amdgcn_readfirstlane((int)threadIdx.x >> 6);
    for (int u = threadIdx.x; u < (LDS_BYTES - LDSCTL_OFF) / 4; u += NTHR) ((LAS unsigned*)(L + LDSCTL_OFF))[u] = 0u;
    __syncthreads();
#define LANE_ID ((int)__builtin_amdgcn_mbcnt_hi(~0u, __builtin_amdgcn_mbcnt_lo(~0u, 0u)))
#if MK_FUSED
    XcdBarrier bar = xcd_barrier_post((unsigned*)(args.ws + WS_CTL) + CW_BAR, MISC + 8, wave_s == 0 && LANE_ID == 0);
#define GRID_BAR() xcd_barrier(bar, wave_s == 0 && LANE_ID == 0)
#else
    (void)MISC;
#define GRID_BAR() do {} while (0)
#endif
    const int lo = args.ph_lo, hi = args.ph_hi;
#define IN(k) (lo <= (k) && (k) < hi)
#if PROBE_MASK
#define STAMP(k) do { if (blockIdx.x == 0 && wave_s == 0 && LANE_ID == 0) ((LAS unsigned*)(L + LDSCTL_OFF + 640))[(k) + 1] = (unsigned)__builtin_amdgcn_s_memrealtime(); } while (0)
#define STAMPX(i) do { if (blockIdx.x == 0 && wave_s == 0 && LANE_ID == 0) ((LAS unsigned*)(L + LDSCTL_OFF + 640))[16 + (i)] = (unsigned)__builtin_amdgcn_s_memrealtime(); } while (0)
#else
#define STAMP(k) do {} while (0)
#define STAMPX(i) do {} while (0)
#endif
#define SEAM(k) do { if (IN(k) && IN((k) + 1)) GRID_BAR(); STAMP(k); } while (0)
    STAMP(-1);
#define PV \
    int wave = wave_s; asm volatile("" : "+s"(wave)); int bid = blockIdx.x; asm volatile("" : "+s"(bid)); \
    const int lane = LANE_ID, tid = wave * 64 + lane; \
    const int G = gridDim.x, gw = bid * NWAVES + wave, NGW = G * NWAVES, gtid = bid * NTHR + tid, NT = G * NTHR; \
    GAS unsigned char* ws = (GAS unsigned char*)args.ws; asm volatile("" : "+s"(ws));     \
    gu32* ctl = (gu32*)(ws + WS_CTL); \
    LAS float* scr = (LAS float*)(L + RING_OFF + wave * 16384); \
    (void)lane; (void)tid; (void)bid; (void)gw; (void)NGW; (void)gtid; (void)NT; (void)ctl; (void)scr; (void)G;
#define Win_t ((bf16*)(ws + WS_WIN))
#define Wo_t ((bf16*)(ws + WS_WO))
#define Wmkv_t ((bf16*)(ws + WS_WMKV))
#define Wout_t ((bf16*)(ws + WS_WOUT))
#define Hb ((bf16*)(ws + WS_H))
#define proj ((bf16*)(ws + WS_PROJ))
#define memn ((bf16*)(ws + WS_MEMN))
#define kv ((bf16*)(ws + WS_KV))
#define rope ((float2*)(ws + WS_ROPE))
#define Wgu_t ((bf16*)(ws + WS_WGU))
#define Wd_t ((bf16*)(ws + WS_WD))
#define ybuf ((bf16*)(ws + WS_Y))
#define act ((bf16*)(ws + WS_ACT))
#define topk_idx ((int*)(ws + WS_META + MT_IDX))
#define topk_gate ((float*)(ws + WS_META + MT_GATE))
#define slot_of ((int*)(ws + WS_META + MT_SASG))
#define slot_tok ((int*)(ws + WS_META + MT_STOK))
#define slot_gate ((float*)(ws + WS_META + MT_SGATE))
#define tile_e ((int*)(ws + WS_META + MT_TILEE))
#define Wsb ((bf16*)(ws + WS_META + MT_WSB))
#define Cmat ((int*)(ws + WS_META + MT_CMAT))
#define Rwp ((float*)(ws + WS_META + MT_RWP))
#define rstd_tok ((float*)(ws + WS_META + MT_RSTD))
#define slot_rstd ((float*)(ws + WS_SRSTD))
#define X8 ((unsigned char*)(ws + WS_X8))
#define x1b ((bf16*)(ws + WS_X1B))

    if (IN(0)) { PV
        const float* x = args.in[I_X]; (void)x;
        {
            const float* Wi = args.in[I_WIN]; const float* Wa = args.in[I_WOA]; const float* Wb = args.in[I_WOB]; const float* Wc = args.in[I_WOC]; const float* Wm = args.in[I_WMKV]; const float* Wu = args.in[I_WOUT];
            bf16* Oi = Win_t; bf16* Oo = Wo_t; bf16* Om = Wmkv_t; bf16* Ou = Wout_t;
            constexpr int N0 = (D / 64) * (DIN / 32), N1 = N0 + 16 * 32, N2 = N1 + 8 * 32, N3 = N2 + 8 * 32, N4 = N3 + 16 * 32, N5 = N4 + 16 * 32;
            tr_range(N5, [=](int it) {
                if (it < N0) { const int kb = it / (DIN / 32), rb = it % (DIN / 32); return TrItem{Wi, DIN, 64 * kb, win_srccol(32 * rb), Oi, D, 32 * rb, 0, nullptr}; }
                if (it < N1) { const int r = it - N0; return TrItem{Wa, D, 64 * (r >> 5), 32 * (r & 31), Oo, 2048, 32 * (r & 31), 0, nullptr}; }
                if (it < N2) { const int r = it - N1; return TrItem{Wb, D, 64 * (r >> 5), 32 * (r & 31), Oo, 2048, 32 * (r & 31), 1024, nullptr}; }
                if (it < N3) { const int r = it - N2; return TrItem{Wc, D, 64 * (r >> 5), 32 * (r & 31), Oo, 2048, 32 * (r & 31), 1536, nullptr}; }
                if (it < N4) { const int r = it - N3; return TrItem{Wm, D, 64 * (r >> 5), 32 * (r & 31), Om, D, 32 * (r & 31), 0, nullptr}; }
                const int r = it - N4; return TrItem{Wu, D, 64 * (r >> 5), 32 * (r & 31), Ou, D, 32 * (r & 31), 0, nullptr}; }, gw, NGW, scr, lane);
        }
        STAMPX(8);
        for (int i = gtid; i < D * 32; i += NT) { const int k = i >> 5, e = i & 31; Rwp[(k >> 2) * 128 + e * 4 + (k & 3)] = args.in[I_FFN_G][k] * args.in[I_RW][i]; }
        { const int* pos = (const int*)args.in[I_POS];
          for (int i = gtid; i < T * 32; i += NT) { const int t = i >> 5, f = i & 31;
              const float inv = powf(10000.0f, -(float)(2 * f) / 64.0f); const float ang = (float)pos[t] * inv;
              float sn, cs; sincosf(ang, &sn, &cs); rope[i] = make_float2(cs, sn); } }
        for (int i = gtid; i < 4 * 128 * 128; i += NT) { const int tt = (i >> 7) & 127, sp = i & 127; Wsb[i] = (bf16)(sp <= tt ? f2bf(args.in[I_WS][i]) : 0u); }
        STAMPX(9);
        for (int m = gw; m < T / 4; m += NGW) rms_rows4_to_bf16(x + (size_t)m * 4 * D, args.in[I_ATTN_G], Hb + (size_t)m * 4 * D, lane);
        STAMPX(10);
        for (int m = gw; m < TM; m += NGW) rms_row_to_bf16(args.in[I_MEM] + (size_t)m * D, args.in[I_MEM_G], memn + (size_t)m * D, lane);
    }
    SEAM(0);
    if (IN(1)) { PV
        { pg8::Gemm g{Hb, Win_t, D, D, D}; pg8::StaticOrder S; S.init(T, DIN, G, bid);
          pg8::EpiProj E{proj, LDP, (const float*)rope, args.in[I_AQG], args.in[I_AKG], args.in[I_BGATES], EPS, C_Q, C_K, C_V, C_G};
          pg8::gemm_phase<pg8::EpiProj, pg8::StaticOrder>(L + RING_OFF, g, S, E, wave); }
        { pg8::Gemm g{memn, Wmkv_t, D, D, D}; pg8::StaticOrder S; S.init(TM, D, G, bid); pg8::EpiBf16 E{kv, D};
          pg8::gemm_phase<pg8::EpiBf16, pg8::StaticOrder>(L + RING_OFF, g, S, E, wave); }
    }
    if (IN(1) && IN(3)) GRID_BAR();
    STAMP(1); STAMP(2);
    if (IN(3)) { PV
        STAMPX(4);
        att::swa_phase(L + RING_OFF, proj, args.in[I_SINKS], args.in[I_AQG], args.in[I_AKG], bid, G, wave, lane);
        __syncthreads();
        STAMPX(5);
        att::gmlp_phase(L + RING_OFF, proj, Wsb, args.in[I_LNG], args.in[I_LNB], args.in[I_BS], bid, G, wave, lane);
        __syncthreads();
        STAMPX(6);
        att::xattn_phase(L + RING_OFF, proj, kv, args.in[I_CQG], args.in[I_CKG], bid, G, wave, lane);
        __syncthreads();
    }
    SEAM(3);
    if (IN(4)) { PV
        pg8::StaticOrder S; S.init(T, D, G, bid);
        pg8::Gemm g{proj + C_Q, Wo_t, 2048, LDP, 2048}; pg8::EpiMergeK E{Hb, D, (const unsigned char*)(proj + C_G), LDP * 2};
        pg8::gemm_phase<pg8::EpiMergeK, pg8::StaticOrder>(L + RING_OFF, g, S, E, wave);
    }
    SEAM(4);
    if (IN(5)) { PV
        const float* x = args.in[I_X];
        pg8::Gemm g{Hb, Wout_t, D, D, D}; pg8::StaticOrder S; S.init(T, D, G, bid); pg8::EpiResF32 E{x1b, x, X8, D};
        pg8::gemm_phase<pg8::EpiResF32, pg8::StaticOrder>(L + RING_OFF, g, S, E, wave);
    }
    SEAM(5);
    if (IN(6)) { PV
        const float* rb = args.in[I_RB]; const float* fg = args.in[I_FFN_G];
        LAS unsigned* hist = (LAS unsigned*)(L + LDSCTL_OFF + 512);
        const int r32 = lane & 31, hh = lane >> 5;
        STAMPX(0);
        for (int i = tid; i < 8192; i += NTHR) *(LAS f32x4*)(L + RING_OFF + i * 16) = *(const GAS f32x4*)(Rwp + 4 * i);
        for (int vb = bid; vb < T / 256; vb += G) {
            __syncthreads();
            if (tid < 32) hist[tid] = 0u;
            __syncthreads();
            const int tok0 = vb * 256 + wave * 32;
            att::f32x16 acc;
#pragma unroll
            for (int r = 0; r < 16; ++r) acc[r] = 0.f;
            float ss = 0.f;
            const bf16* xp = x1b + (size_t)(tok0 + r32) * D + 16 * hh;
            const LAS unsigned char* wl = L + RING_OFF + (4 * hh) * 512 + r32 * 16;
#define RT_LOAD(xs, it) do { _Pragma("unroll") for (int q = 0; q < 4; ++q) xs[q] = *(const GAS v2u*)(xp + 32 * (it) + 4 * q); } while (0)
#define RT_COMP(xs, it) do { _Pragma("unroll") for (int q = 0; q < 4; ++q) { const f32x4 wa = *(const LAS f32x4*)(wl + (8 * (it) + q) * 512); \
                    const f32x4 xv = (f32x4){blo(xs[q].x), bhi(xs[q].x), blo(xs[q].y), bhi(xs[q].y)}; \
                    ss += (xv.x * xv.x + xv.y * xv.y) + (xv.z * xv.z + xv.w * xv.w); \
                    acc = __builtin_amdgcn_mfma_f32_32x32x2f32(wa.x, xv.x, acc, 0, 0, 0); acc = __builtin_amdgcn_mfma_f32_32x32x2f32(wa.y, xv.y, acc, 0, 0, 0); \
                    acc = __builtin_amdgcn_mfma_f32_32x32x2f32(wa.z, xv.z, acc, 0, 0, 0); acc = __builtin_amdgcn_mfma_f32_32x32x2f32(wa.w, xv.w, acc, 0, 0, 0); } } while (0)
            v2u x0[4], x1[4], x2[4];
            RT_LOAD(x0, 0); RT_LOAD(x1, 1);
#pragma unroll 1
            for (int it = 0; it < 30; it += 3) {
                RT_LOAD(x2, it + 2); RT_COMP(x0, it);
                RT_LOAD(x0, it + 3); RT_COMP(x1, it + 1);
                RT_LOAD(x1, it + 4); RT_COMP(x2, it + 2);
            }
            RT_COMP(x0, 30); RT_COMP(x1, 31);
#undef RT_LOAD
#undef RT_COMP
            ss = xor32_sum(ss);
            const float rstd = 1.0f / sqrtf(ss * (1.f / 1024.f) + EPS);
            float v[16];
#pragma unroll
            for (int r = 0; r < 16; ++r) v[r] = acc[r] * rstd + rb[att::crow(r, hh)];
            float cv[8]; int ci[8];
#pragma unroll
            for (int k = 0; k < 4; ++k) { float best = -INFINITY; int bi = 99;
#pragma unroll
                for (int r = 0; r < 16; ++r) if (v[r] > best) { best = v[r]; bi = att::crow(r, hh); }
                cv[k] = best; ci[k] = bi;
#pragma unroll
                for (int r = 0; r < 16; ++r) v[r] = (att::crow(r, hh) == bi) ? -INFINITY : v[r]; }
#pragma unroll
            for (int k = 0; k < 4; ++k) { cv[4 + k] = __builtin_bit_cast(float, xor32_get(__builtin_bit_cast(unsigned, cv[k]), hh != 0)); ci[4 + k] = (int)xor32_get((unsigned)ci[k], hh != 0); }
            float bv[4]; int be[4];
#pragma unroll
            for (int k = 0; k < 4; ++k) { float best = -INFINITY; int bi = 99;
#pragma unroll
                for (int c = 0; c < 8; ++c) if (cv[c] > best || (cv[c] == best && ci[c] < bi)) { best = cv[c]; bi = ci[c]; }
                bv[k] = best; be[k] = bi;
#pragma unroll
                for (int c = 0; c < 8; ++c) cv[c] = (ci[c] == bi) ? -INFINITY : cv[c]; }
            const float p1 = expf(bv[1] - bv[0]), p2 = expf(bv[2] - bv[0]), p3 = expf(bv[3] - bv[0]); const float inv = 1.0f / (1.0f + p1 + p2 + p3);
            if (hh == 0) {
                int4 iw; float4 gw4;
                iw.x = be[0] | (int)(__hip_atomic_fetch_add(hist + be[0], 1u, __ATOMIC_RELAXED, __HIP_MEMORY_SCOPE_WORKGROUP) << 8);
                iw.y = be[1] | (int)(__hip_atomic_fetch_add(hist + be[1], 1u, __ATOMIC_RELAXED, __HIP_MEMORY_SCOPE_WORKGROUP) << 8);
                iw.z = be[2] | (int)(__hip_atomic_fetch_add(hist + be[2], 1u, __ATOMIC_RELAXED, __HIP_MEMORY_SCOPE_WORKGROUP) << 8);
                iw.w = be[3] | (int)(__hip_atomic_fetch_add(hist + be[3], 1u, __ATOMIC_RELAXED, __HIP_MEMORY_SCOPE_WORKGROUP) << 8);
                gw4.x = inv; gw4.y = p1 * inv; gw4.z = p2 * inv; gw4.w = p3 * inv;
                *(int4*)(topk_idx + (size_t)(tok0 + r32) * 4) = iw; *(float4*)(topk_gate + (size_t)(tok0 + r32) * 4) = gw4; }
            if (hh == 0) rstd_tok[tok0 + r32] = rstd;
            if (vb == 0) STAMPX(3);
            __syncthreads();
            if (tid < 32) Cmat[vb * 32 + tid] = (int)hist[tid];
        }
        STAMPX(1);
        { const float* W = args.in[I_WGU]; unsigned char* O = (unsigned char*)Wgu_t; constexpr int nrb = 2048 / 32, per = (D / 64) * nrb;
          tr_range8(NEXP * per, [=](int it) { const int e = it / per, r0 = it % per, kb = r0 / nrb, rb2 = r0 % nrb; const int r = 32 * rb2, j = r >> 8, rr = r & 255;
              const int sc = rr < 128 ? 128 * j + rr : 1024 + 128 * j + (rr - 128);
              return TrItem{W + (size_t)e * D * 2048, 2048, 64 * kb, sc, (bf16*)(O + (size_t)e * 2048 * D), D, r, 0, fg}; }, gw, NGW, scr, lane, WSCALE); }
        STAMPX(2);
        { const float* W = args.in[I_WD]; unsigned char* O = (unsigned char*)Wd_t; constexpr int nrb = D / 32, per = (D / 64) * nrb;
          tr_range8(NEXP * per, [=](int it) { const int e = it / per, r0 = it % per, kb = r0 / nrb, rb2 = r0 % nrb;
              return TrItem{W + (size_t)e * D * D, D, 64 * kb, 32 * rb2, (bf16*)(O + (size_t)e * D * D), D, 32 * rb2, 0, nullptr}; }, gw, NGW, scr, lane, WSCALE); }
    }
    SEAM(6);
    if (IN(7)) { PV
        LAS int* psum = (LAS int*)(L + RING_OFF);
        LAS int* tot = psum + 512;
        LAS int* startv = tot + 32;
        LAS int* basev = startv + 32;
        LAS int* ntl = basev + 32;
        for (int vb = bid; vb < T / 256; vb += G) {
            __syncthreads();
            { const int e = tid & 31, part = tid >> 5; int ps = 0;
#pragma unroll 4
              for (int i = 0; i < 16; ++i) ps += Cmat[(part * 16 + i) * 32 + e];
              psum[part * 32 + e] = ps; }
            __syncthreads();
            if (tid < 32) { int tt = 0;
#pragma unroll
                for (int p = 0; p < 16; ++p) tt += psum[p * 32 + tid];
                tot[tid] = tt; }
            __syncthreads();
            if (tid == 0) { int row = 0; for (int e = 0; e < 32; ++e) { startv[e] = row; row += (tot[e] + 255) & ~255; } ntl[0] = row >> 8; }
            __syncthreads();
            const int part = vb >> 4;
            if (tid < 32) { int bs = startv[tid];
                for (int p = 0; p < part; ++p) bs += psum[p * 32 + tid];
                for (int v2 = part * 16; v2 < vb; ++v2) bs += Cmat[v2 * 32 + tid];
                basev[tid] = bs; }
            __syncthreads();
            for (int i = tid; i < 1024; i += NTHR) { const int a = vb * 1024 + i; const int v = topk_idx[a]; const int e = v & 255, rank = v >> 8;
                const int slot = basev[e] + rank;
                slot_tok[slot] = a >> 2; slot_of[a] = slot; slot_rstd[slot] = rstd_tok[a >> 2]; }
            if (vb < 32) { const int e = vb; const int t0 = tot[e], st = startv[e], pd = ((t0 + 255) & ~255) - t0;
                if (tid < pd) { slot_tok[st + t0 + tid] = -1; slot_rstd[st + t0 + tid] = 0.f; } }
            if (vb == 32) {
                if (tid < 32) { const int nt = (tot[tid] + 255) >> 8, first = startv[tid] >> 8; for (int i = 0; i < nt; ++i) tile_e[first + i] = tid; }
                if (tid == 0) ((unsigned*)(ctl + CW_NTILE))[0] = (unsigned)ntl[0]; }
        }
    }
    SEAM(7);
#define NTILE_ALL ((int)__hip_atomic_load((unsigned*)(ctl + CW_NTILE), RLX_AGENT))
    if (IN(8)) { PV const int ntile = NTILE_ALL;
        pg8::Gemm g{(const bf16*)X8, Wgu_t, D / 2, D / 2, D / 2};
        pg8::GroupedOrder S{tile_e, ntile, 8, G, bid}; pg8::EpiSwiglu8 E{(unsigned char*)act, args.in[I_BGU], slot_rstd, 1.0f / WSCALE};
        pg8::gemm_phase_gather<pg8::EpiSwiglu8, pg8::GroupedOrder, true>(L + RING_OFF, g, S, E, wave, slot_tok);
    }
    SEAM(8);
    if (IN(9)) { PV const int ntile = NTILE_ALL;
        pg8::Gemm g{act, Wd_t, D / 2, D / 2, D / 2}; pg8::GroupedOrder S{tile_e, ntile, 4, G, bid}; static_assert(YSCALE == 16.0f, "EpiDown scales the bias by 16"); pg8::EpiDown E{(unsigned char*)ybuf, args.in[I_BD], YSCALE / WSCALE};
        pg8::gemm_phase<pg8::EpiDown, pg8::GroupedOrder, true>(L + RING_OFF, g, S, E, wave);
    }
    SEAM(9);
    if (IN(10)) { PV
        typedef float f2t __attribute__((ext_vector_type(2)));
        int4 sl = *(const int4*)(slot_of + (size_t)gw * 4); float4 gt = *(const float4*)(topk_gate + (size_t)gw * 4);
        for (int t = gw; t < T; t += NGW) {
            GAS f32x4* op = (GAS f32x4*)(args.out + (size_t)t * D) + lane;
            const GAS v2u* xq = (const GAS v2u*)(x1b + (size_t)t * D) + lane;
            const unsigned char* yb = (const unsigned char*)ybuf + 4 * lane;
            f32x4 o[4]; unsigned ya[4][4];
#pragma unroll
            for (int j = 0; j < 4; ++j) { const v2u xw = xq[64 * j]; o[j] = (f32x4){blo(xw.x), bhi(xw.x), blo(xw.y), bhi(xw.y)};
                ya[0][j] = *(const GAS unsigned*)(yb + (size_t)sl.x * D + 256 * j); ya[1][j] = *(const GAS unsigned*)(yb + (size_t)sl.y * D + 256 * j);
                ya[2][j] = *(const GAS unsigned*)(yb + (size_t)sl.z * D + 256 * j); ya[3][j] = *(const GAS unsigned*)(yb + (size_t)sl.w * D + 256 * j); }
            const float g0 = gt.x * (1.0f / YSCALE), g1 = gt.y * (1.0f / YSCALE), g2 = gt.z * (1.0f / YSCALE), g3 = gt.w * (1.0f / YSCALE);
            if (t + NGW < T) { sl = *(const int4*)(slot_of + (size_t)(t + NGW) * 4); gt = *(const float4*)(topk_gate + (size_t)(t + NGW) * 4); }
#pragma unroll
            for (int j = 0; j < 4; ++j) {
                const f2t l0 = __builtin_amdgcn_cvt_pk_f32_fp8((int)ya[0][j], false), h0 = __builtin_amdgcn_cvt_pk_f32_fp8((int)ya[0][j], true);
                const f2t l1 = __builtin_amdgcn_cvt_pk_f32_fp8((int)ya[1][j], false), h1 = __builtin_amdgcn_cvt_pk_f32_fp8((int)ya[1][j], true);
                const f2t l2 = __builtin_amdgcn_cvt_pk_f32_fp8((int)ya[2][j], false), h2 = __builtin_amdgcn_cvt_pk_f32_fp8((int)ya[2][j], true);
                const f2t l3 = __builtin_amdgcn_cvt_pk_f32_fp8((int)ya[3][j], false), h3 = __builtin_amdgcn_cvt_pk_f32_fp8((int)ya[3][j], true);
                const f2t lo = ((l0 * g0 + l1 * g1) + l2 * g2) + l3 * g3, hi = ((h0 * g0 + h1 * g1) + h2 * g2) + h3 * g3;
                o[j].x += lo.x; o[j].y += lo.y; o[j].z += hi.x; o[j].w += hi.y;
                op[64 * j] = o[j]; }
        }
    }
#if PROBE_MASK
    __syncthreads(); STAMP(10);
    if (blockIdx.x == 0 && wave_s == 0 && LANE_ID == 0) { const LAS unsigned* st = (const LAS unsigned*)(L + LDSCTL_OFF + 640); unsigned d = 0;
        for (int k = 0; k < NPHASE; ++k) if ((PROBE_MASK >> k) & 1) d += st[k + 1] - st[k];
        if (PROBE_SUBA >= 0) d = st[16 + PROBE_SUBB] - st[16 + PROBE_SUBA];
        const unsigned long long t0 = __builtin_amdgcn_s_memrealtime(); while (__builtin_amdgcn_s_memrealtime() - t0 < (unsigned long long)d * PROBE_AMP) __builtin_amdgcn_s_sleep(16); }
#endif
#undef IN
#undef SEAM
}

extern "C" void kernel_launch(void* const* d_in, const int* in_sizes, int n_in, void* d_out, int out_size, void* d_ws, size_t ws_size, hipStream_t stream) {
    static int grid = 0;
    if (grid == 0) {
        if (n_in != 28 || out_size != T * D || ws_size < WS_END) { fprintf(stderr, "kernel_launch: unexpected shapes: n_in %d out %d ws %zu (need %zu)\n", n_in, out_size, ws_size, (size_t)WS_END); grid = -1; return; }
        int dev = 0, cus = 0, per_cu = 0;
        if (hipGetDevice(&dev) != hipSuccess || hipDeviceGetAttribute(&cus, hipDeviceAttributeMultiprocessorCount, dev) != hipSuccess) { grid = -1; return; }
        if (hipFuncSetAttribute((const void*)fwd, hipFuncAttributeMaxDynamicSharedMemorySize, LDS_BYTES) != hipSuccess) { fprintf(stderr, "kernel_launch: hipFuncSetAttribute failed\n"); grid = -1; return; }
        if (hipOccupancyMaxActiveBlocksPerMultiprocessor(&per_cu, (const void*)fwd, NTHR, LDS_BYTES) != hipSuccess || per_cu < 1) { fprintf(stderr, "kernel_launch: occupancy query says %d\n", per_cu); }
        (void)hipGetLastError();
        grid = cus;
    }
    if (grid < 0) return;
    if (hipMemsetAsync((char*)d_ws + WS_CTL, 0, CTL_ZERO_BYTES, stream) != hipSuccess) { fprintf(stderr, "kernel_launch: memset failed\n"); return; }
    Args a{};
    for (int i = 0; i < 28; ++i) a.in[i] = (const float*)d_in[i];
    a.out = (float*)d_out; a.ws = (unsigned char*)d_ws;
#if MK_FUSED
    a.ph_lo = 0; a.ph_hi = NPHASE;
    hipLaunchKernelGGL(fwd, dim3(grid), dim3(NTHR), LDS_BYTES, stream, a);
#else
    for (int p = 0; p < NPHASE; ++p) { a.ph_lo = p; a.ph_hi = p + 1; hipLaunchKernelGGL(fwd, dim3(grid), dim3(NTHR), LDS_BYTES, stream, a); }
#endif
    const hipError_t le = hipPeekAtLastError();
    if (le != hipSuccess) fprintf(stderr, "kernel_launch: launch failed: %s\n", hipGetErrorName(le));
}
```

```cpp
#include <hip/hip_runtime.h>
#include <cstdio>
#include <cstdint>

#ifndef MK_FUSED
#define MK_FUSED 1
#endif
#ifndef PROBE_MASK
#define PROBE_MASK 0
#endif
#ifndef PROBE_AMP
#define PROBE_AMP 4
#endif
#ifndef PROBE_SUBA
#define PROBE_SUBA -1
#endif
#ifndef PROBE_SUBB
#define PROBE_SUBB -1
#endif

__device__ __forceinline__ float xor16_sum(float v) { float a = v, b = v; asm("s_nop 1\n\tv_permlane16_swap_b32 %0, %1" : "+v"(a), "+v"(b)); return a + b; }
__device__ __forceinline__ float xor32_sum(float v) { float a = v, b = v; asm("s_nop 1\n\tv_permlane32_swap_b32 %0, %1" : "+v"(a), "+v"(b)); return a + b; }
__device__ __forceinline__ unsigned xor32_get(unsigned v, bool upper) { unsigned a = v, b = v; asm("s_nop 1\n\tv_permlane32_swap_b32 %0, %1" : "+v"(a), "+v"(b)); return upper ? a : b; }
namespace pg8 {
#define PG8_LAS __attribute__((address_space(3)))
typedef unsigned short bf16_t;
typedef short bf16x8 __attribute__((ext_vector_type(8)));
typedef float f32x4 __attribute__((ext_vector_type(4)));
typedef unsigned u32x4 __attribute__((ext_vector_type(4)));
typedef float f32x2 __attribute__((ext_vector_type(2)));
constexpr int BM = 256, BK = 64, HALF = 128, HTB = HALF * BK * 2, STAGE_BYTES = 8 * HTB, NXCD = 8, WGM = 8;

__host__ __device__ __forceinline__ int lds_byte(int r, int c) { const int st = (r >> 4) * 2 + (c >> 5), rr = r & 15, cc = c & 31, ob = rr * 64 + cc * 2; return st * 1024 + (ob ^ (((ob >> 9) & 1) << 5)); }
__host__ __device__ __forceinline__ void stage_rc(int b, int& R, int& C) { const int st = b / 1024, sb = b % 1024, swz = sb ^ (((sb >> 9) & 1) << 5); R = (st >> 1) * 16 + swz / 64; C = (st & 1) * 32 + (swz % 64) / 2; }
__host__ __device__ __forceinline__ int perm32(int rho) { const int n = rho >> 4, i = rho & 15; return 8 * (i >> 2) + 4 * n + (i & 3); }

struct Unit { int pm, pn; };
struct Gemm { const bf16_t* A; const bf16_t* Bt; int K, lda, ldb; };

struct StaticOrder {
    int nM, nN, nwg, G, c;
    __host__ __device__ void init(int M, int N, int G_, int c_) { nM = M / BM; nN = N / BM; nwg = nM * nN; G = G_; c = c_; }
    __host__ __device__ bool next(int i, Unit& u) const {
        const long L = (long)i * G + c; if (L >= nwg) return false;
        int wgid = (int)L; { const int q = nwg / NXCD, r = nwg % NXCD, xcd = wgid % NXCD, off = wgid / NXCD; wgid = (xcd < r ? xcd * (q + 1) : r * (q + 1) + (xcd - r) * q) + off; }
        const int nig = WGM * nN, gid = wgid / nig, fm = gid * WGM, gsz = (nM - fm) < WGM ? (nM - fm) : WGM;
        u.pm = fm + ((wgid % nig) % gsz); u.pn = (wgid % nig) / gsz; return true;
    }
};
struct GroupedOrder {
    const int* tile_e; int ntile, nN, G, c;
    __device__ bool next(int i, Unit& u) const {
        if ((G & 7) == 0) {
            const int x = c & 7, k = c >> 3, per = G >> 3;
            const unsigned q = (unsigned)i * (unsigned)per + (unsigned)k;
            const int tl = (int)(q / (unsigned)nN), j = (int)(q % (unsigned)nN), tile = tl * 8 + x;
            if (tile >= ntile) return false;
            u.pm = tile; u.pn = tile_e[tile] * nN + j; return true;
        }
        const unsigned L = (unsigned)i * (unsigned)G + (unsigned)c; if (L >= (unsigned)(ntile * nN)) return false;
        const int tile = (int)(L / (unsigned)nN), j = (int)(L % (unsigned)nN);
        u.pm = tile; u.pn = tile_e[tile] * nN + j; return true;
    }
};
typedef int v8i __attribute__((ext_vector_type(8)));
typedef int v4i __attribute__((ext_vector_type(4)));
__device__ __forceinline__ v8i cat8(bf16x8 lo, bf16x8 hi) { return __builtin_shufflevector(__builtin_bit_cast(v4i, lo), __builtin_bit_cast(v4i, hi), 0, 1, 2, 3, 4, 5, 6, 7); }
__device__ __forceinline__ bf16x8 lo8(v8i v) { return __builtin_bit_cast(bf16x8, (v4i)__builtin_shufflevector(v, v, 0, 1, 2, 3)); }
__device__ __forceinline__ bf16x8 hi8(v8i v) { return __builtin_bit_cast(bf16x8, (v4i)__builtin_shufflevector(v, v, 4, 5, 6, 7)); }
__device__ __forceinline__ unsigned cvt_pk_bf16(float lo, float hi) { unsigned r; asm volatile("v_cvt_pk_bf16_f32 %0, %1, %2" : "=v"(r) : "v"(lo), "v"(hi)); return r; }
__device__ __forceinline__ float bflo(unsigned w) { return __uint_as_float(w << 16); }
__device__ __forceinline__ float bfhi(unsigned w) { return __uint_as_float(w & 0xffff0000u); }


struct EpiBf16 {
    static constexpr bool PERM = true, HAS_MID = false;
    bf16_t* O; int ldc;
    __device__ __forceinline__ void operator()(const f32x4 (&acc)[2][2][4][2], const Unit& u, int wr, int wc, int fr, int fq) const {
        const int row0 = u.pm * BM + wr * 64 + fr, col0 = u.pn * BM + wc * 32 + 8 * fq;
#pragma unroll
        for (int ai = 0; ai < 2; ++ai)
#pragma unroll
            for (int m = 0; m < 4; ++m) { bf16_t* rowp = O + (size_t)(row0 + ai * HALF + m * 16) * ldc + col0;
#pragma unroll
                for (int bj = 0; bj < 2; ++bj) { const f32x4 v0 = acc[ai][bj][m][0], v1 = acc[ai][bj][m][1];
                    u32x4 w; w.x = cvt_pk_bf16(v0[0], v0[1]); w.y = cvt_pk_bf16(v0[2], v0[3]); w.z = cvt_pk_bf16(v1[0], v1[1]); w.w = cvt_pk_bf16(v1[2], v1[3]);
                    *(u32x4*)(rowp + bj * HALF) = w; } }
    }
};
__device__ __forceinline__ f32x2 gelu_pk(f32x2 v) {
    const f32x2 av = __builtin_elementwise_abs(v), d = av * 0.2316418882f + 1.0f;
    f32x2 t; t.x = __builtin_amdgcn_rcpf(d.x); t.y = __builtin_amdgcn_rcpf(d.y);
    f32x2 q = t * 0.5307027145f + (-0.7265760135f); q = q * t + 0.7107068705f; q = q * t + (-0.142248368f); q = q * t + 0.127414796f; q = q * t;
    const f32x2 s = (v * v) * (-0.72134752044f);
    f32x2 e; e.x = __builtin_amdgcn_exp2f(s.x); e.y = __builtin_amdgcn_exp2f(s.y);
    const f32x2 m = v * (q * e), r = v - m;
    f32x2 o; o.x = v.x < 0.f ? m.x : r.x; o.y = v.y < 0.f ? m.y : r.y; return o;
}
struct EpiProj {
    static constexpr bool PERM = true, HAS_MID = false;
    bf16_t* __restrict__ P; int ldp; const float* __restrict__ rope; const float* __restrict__ gq; const float* __restrict__ gk; const float* __restrict__ bgates; float eps;
    int c_q, c_k, c_v, c_g;
    __device__ __forceinline__ void operator()(const f32x4 (&acc)[2][2][4][2], const Unit& u, int wr, int wc, int fr, int fq) const {
        const int pn = u.pn, row0 = u.pm * BM + wr * 64 + fr;
        if (pn < 4 || pn == 8) {
            const bool isq = pn < 4, isv = (!isq) && (wc & 1);
            const int colbase = (isq ? c_q + 64 * (4 * pn + wc) : (isv ? c_v : c_k) + 64 * (wc >> 1)) + 8 * fq;
            if (isv) {
#pragma unroll
                for (int ai = 0; ai < 2; ++ai)
#pragma unroll
                    for (int m = 0; m < 4; ++m) { bf16_t* rowp = P + (size_t)(row0 + ai * HALF + m * 16) * ldp + colbase;
#pragma unroll
                        for (int bj = 0; bj < 2; ++bj) { const f32x4 v0 = acc[ai][bj][m][0], v1 = acc[ai][bj][m][1];
                            u32x4 w; w.x = cvt_pk_bf16(v0[0], v0[1]); w.y = cvt_pk_bf16(v0[2], v0[3]); w.z = cvt_pk_bf16(v1[0], v1[1]); w.w = cvt_pk_bf16(v1[2], v1[3]);
                            *(u32x4*)(rowp + 32 * bj) = w; } }
            } else {
                const float* gn = (isq ? gq : gk) + 8 * fq;
                const f32x4 ga0 = *(const f32x4*)gn, ga1 = *(const f32x4*)(gn + 4), gb0 = *(const f32x4*)(gn + 32), gb1 = *(const f32x4*)(gn + 36);
#pragma unroll
                for (int am = 0; am < 4; ++am) { const int ai = am >> 1;
                    f32x4 cs[4][4];
#pragma unroll
                    for (int m2 = 0; m2 < 2; ++m2) { const int m = (am & 1) * 2 + m2; const float* rp = rope + ((size_t)(row0 + ai * HALF + m * 16) * 32 + 8 * fq) * 2;
                        cs[m][0] = *(const f32x4*)rp; cs[m][1] = *(const f32x4*)(rp + 4); cs[m][2] = *(const f32x4*)(rp + 8); cs[m][3] = *(const f32x4*)(rp + 12); }
#pragma unroll
                    for (int m2 = 0; m2 < 2; ++m2) { const int m = (am & 1) * 2 + m2;
                        const int r = row0 + ai * HALF + m * 16;
                        const f32x4 x10 = acc[ai][0][m][0], x11 = acc[ai][0][m][1], x20 = acc[ai][1][m][0], x21 = acc[ai][1][m][1];
                        float ss = ((x10[0] * x10[0] + x10[1] * x10[1]) + (x10[2] * x10[2] + x10[3] * x10[3])) + ((x11[0] * x11[0] + x11[1] * x11[1]) + (x11[2] * x11[2] + x11[3] * x11[3]))
                                 + ((x20[0] * x20[0] + x20[1] * x20[1]) + (x20[2] * x20[2] + x20[3] * x20[3])) + ((x21[0] * x21[0] + x21[1] * x21[1]) + (x21[2] * x21[2] + x21[3] * x21[3]));
                        ss = xor32_sum(xor16_sum(ss));
                        const float rstd = 1.0f / sqrtf(ss * (1.f / 64.f) + eps);
                        const f32x4 cs0 = cs[m][0], cs1 = cs[m][1], cs2 = cs[m][2], cs3 = cs[m][3];
                        const f32x4 y10 = x10 * ga0 * rstd, y11 = x11 * ga1 * rstd, y20 = x20 * gb0 * rstd, y21 = x21 * gb1 * rstd;
                        float o1[8], o2[8];
                        o1[0] = y10[0] * cs0[0] - y20[0] * cs0[1]; o2[0] = y20[0] * cs0[0] + y10[0] * cs0[1];
                        o1[1] = y10[1] * cs0[2] - y20[1] * cs0[3]; o2[1] = y20[1] * cs0[2] + y10[1] * cs0[3];
                        o1[2] = y10[2] * cs1[0] - y20[2] * cs1[1]; o2[2] = y20[2] * cs1[0] + y10[2] * cs1[1];
                        o1[3] = y10[3] * cs1[2] - y20[3] * cs1[3]; o2[3] = y20[3] * cs1[2] + y10[3] * cs1[3];
                        o1[4] = y11[0] * cs2[0] - y21[0] * cs2[1]; o2[4] = y21[0] * cs2[0] + y11[0] * cs2[1];
                        o1[5] = y11[1] * cs2[2] - y21[1] * cs2[3]; o2[5] = y21[1] * cs2[2] + y11[1] * cs2[3];
                        o1[6] = y11[2] * cs3[0] - y21[2] * cs3[1]; o2[6] = y21[2] * cs3[0] + y11[2] * cs3[1];
                        o1[7] = y11[3] * cs3[2] - y21[3] * cs3[3]; o2[7] = y21[3] * cs3[2] + y11[3] * cs3[3];
                        bf16_t* rowp = P + (size_t)r * ldp + colbase;
                        u32x4 w; w.x = cvt_pk_bf16(o1[0], o1[1]); w.y = cvt_pk_bf16(o1[2], o1[3]); w.z = cvt_pk_bf16(o1[4], o1[5]); w.w = cvt_pk_bf16(o1[6], o1[7]);
                        *(u32x4*)rowp = w;
                        w.x = cvt_pk_bf16(o2[0], o2[1]); w.y = cvt_pk_bf16(o2[2], o2[3]); w.z = cvt_pk_bf16(o2[4], o2[5]); w.w = cvt_pk_bf16(o2[6], o2[7]);
                        *(u32x4*)(rowp + 32) = w;
                    }
                }
            }
        } else {
            const int col0 = pn * BM + wc * 32 + 8 * fq;
            const int mode = (pn == 4 || pn == 5 || pn == 9 || pn == 10) ? 1 : (pn >= 11 ? 2 : 0);
            f32x4 bb[2][2] = {{(f32x4){0.f, 0.f, 0.f, 0.f}, (f32x4){0.f, 0.f, 0.f, 0.f}}, {(f32x4){0.f, 0.f, 0.f, 0.f}, (f32x4){0.f, 0.f, 0.f, 0.f}}};
            if (mode == 2) { const float* bp = bgates + (col0 - c_g);
                bb[0][0] = *(const f32x4*)bp; bb[0][1] = *(const f32x4*)(bp + 4); bb[1][0] = *(const f32x4*)(bp + HALF); bb[1][1] = *(const f32x4*)(bp + HALF + 4); }
#pragma unroll
            for (int bj = 0; bj < 2; ++bj) {
                const f32x4 nb0 = bb[bj][0] * (-1.4426950408889634f), nb1 = bb[bj][1] * (-1.4426950408889634f);
#pragma unroll
                for (int ai = 0; ai < 2; ++ai)
#pragma unroll
                    for (int m = 0; m < 4; ++m) {
                        f32x4 v0 = acc[ai][bj][m][0], v1 = acc[ai][bj][m][1];
                        if (mode == 1) { const f32x2 a = gelu_pk((f32x2){v0[0], v0[1]}), b = gelu_pk((f32x2){v0[2], v0[3]}), c = gelu_pk((f32x2){v1[0], v1[1]}), d = gelu_pk((f32x2){v1[2], v1[3]});
                            v0 = (f32x4){a.x, a.y, b.x, b.y}; v1 = (f32x4){c.x, c.y, d.x, d.y}; }
                        if (mode == 2) {
                            typedef unsigned u32x2 __attribute__((ext_vector_type(2)));
                            u32x2 w8; unsigned wq[2] = {0u, 0u};
#pragma unroll
                            for (int p = 0; p < 4; ++p) {
                                const int n = p >> 1, i0 = (p & 1) * 2;
                                const f32x2 zv = n ? (f32x2){v1[i0], v1[i0 + 1]} : (f32x2){v0[i0], v0[i0 + 1]}, bv2 = n ? (f32x2){nb1[i0], nb1[i0 + 1]} : (f32x2){nb0[i0], nb0[i0 + 1]};
                                const f32x2 tv = zv * (-1.4426950408889634f) + bv2;
                                f32x2 ev; ev.x = __builtin_amdgcn_exp2f(tv.x); ev.y = __builtin_amdgcn_exp2f(tv.y);
                                const f32x2 dv = ev + 1.0f;
                                f32x2 gv; gv.x = __builtin_amdgcn_rcpf(dv.x); gv.y = __builtin_amdgcn_rcpf(dv.y);
                                const f32x2 cv = gv * 256.0f + (-0.5f);
                                wq[n] = __builtin_amdgcn_cvt_pk_u8_f32(cv.x, i0, wq[n]); wq[n] = __builtin_amdgcn_cvt_pk_u8_f32(cv.y, i0 + 1, wq[n]);
                            }
                            w8.x = wq[0]; w8.y = wq[1];
                            *(u32x2*)((unsigned char*)(P + (size_t)(row0 + ai * HALF + m * 16) * ldp + c_g) + (col0 - c_g) + bj * HALF) = w8;
                        } else {
                        u32x4 w; w.x = cvt_pk_bf16(v0[0], v0[1]); w.y = cvt_pk_bf16(v0[2], v0[3]); w.z = cvt_pk_bf16(v1[0], v1[1]); w.w = cvt_pk_bf16(v1[2], v1[3]);
                        *(u32x4*)(P + (size_t)(row0 + ai * HALF + m * 16) * ldp + col0 + bj * HALF) = w;
                        }
                    }
            }
        }
    }
};
template <int ACCUM> struct EpiMerge {
    static constexpr bool PERM = true, HAS_MID = false;
    bf16_t* Mg; int ldm; const bf16_t* gate; int ldg;
    __device__ __forceinline__ void operator()(const f32x4 (&acc)[2][2][4][2], const Unit& u, int wr, int wc, int fr, int fq) const {
        const int row0 = u.pm * BM + wr * 64 + fr, col0 = u.pn * BM + wc * 32 + 8 * fq;
#pragma unroll
        for (int bj = 0; bj < 2; ++bj) {
#pragma unroll
            for (int ai = 0; ai < 2; ++ai)
#pragma unroll
                for (int m = 0; m < 4; ++m) {
                    const size_t r = (size_t)(row0 + ai * HALF + m * 16);
                    const u32x4 gw = *(const u32x4*)(gate + r * ldg + col0 + bj * HALF);
                    const f32x4 a0 = acc[ai][bj][m][0], a1 = acc[ai][bj][m][1];
                    float o[8] = {bflo(gw.x) * a0[0], bfhi(gw.x) * a0[1], bflo(gw.y) * a0[2], bfhi(gw.y) * a0[3], bflo(gw.z) * a1[0], bfhi(gw.z) * a1[1], bflo(gw.w) * a1[2], bfhi(gw.w) * a1[3]};
                    bf16_t* mp = Mg + r * ldm + col0 + bj * HALF;
                    if (ACCUM) { const u32x4 pw = *(const u32x4*)mp;
                        o[0] += bflo(pw.x); o[1] += bfhi(pw.x); o[2] += bflo(pw.y); o[3] += bfhi(pw.y); o[4] += bflo(pw.z); o[5] += bfhi(pw.z); o[6] += bflo(pw.w); o[7] += bfhi(pw.w); }
                    u32x4 w; w.x = cvt_pk_bf16(o[0], o[1]); w.y = cvt_pk_bf16(o[2], o[3]); w.z = cvt_pk_bf16(o[4], o[5]); w.w = cvt_pk_bf16(o[6], o[7]);
                    *(u32x4*)mp = w;
                }
        }
    }
};
struct EpiMergeK {
    static constexpr bool PERM = true, HAS_MID = true; static constexpr int MID0 = 16, MID1 = 24;
    bf16_t* __restrict__ Mg; int ldm; const unsigned char* __restrict__ gates; int ldgb;
    typedef unsigned u32x2 __attribute__((ext_vector_type(2)));
    static __device__ __forceinline__ float gq(unsigned w, int i) { return ((float)((w >> (8 * i)) & 255u) + 0.5f) * (1.0f / 256.0f); }
    __device__ __forceinline__ void mid(f32x4 (&acc)[2][2][4][2], const Unit& u, int t, int wr, int wc, int fr, int fq) const {
        int row0 = u.pm * BM + wr * 64 + fr, col0 = u.pn * BM + wc * 32 + 8 * fq + (t == MID0 ? 0 : 1024);
        asm volatile("" : "+v"(row0), "+v"(col0));
#pragma unroll
        for (int bj = 0; bj < 2; ++bj)
#pragma unroll
            for (int ai = 0; ai < 2; ++ai)
#pragma unroll
                for (int m = 0; m < 4; ++m) {
                    const unsigned char* gp = gates + (size_t)(row0 + ai * HALF + m * 16) * ldgb + col0 + bj * HALF;
                    const u32x2 nw = *(const u32x2*)gp, dw = *(const u32x2*)(gp + 1024);
                    f32x4 r0, r1;
#pragma unroll
                    for (int i = 0; i < 4; ++i) { r0[i] = gq(nw.x, i) * __builtin_amdgcn_rcpf(gq(dw.x, i)); r1[i] = gq(nw.y, i) * __builtin_amdgcn_rcpf(gq(dw.y, i)); }
                    acc[ai][bj][m][0] *= r0; acc[ai][bj][m][1] *= r1;
                }
    }
    __device__ __forceinline__ void operator()(const f32x4 (&acc)[2][2][4][2], const Unit& u, int wr, int wc, int fr, int fq) const {
        const int row0 = u.pm * BM + wr * 64 + fr, col0 = u.pn * BM + wc * 32 + 8 * fq;
        u32x2 gw[2][2][4];
#pragma unroll
        for (int bj = 0; bj < 2; ++bj)
#pragma unroll
            for (int ai = 0; ai < 2; ++ai)
#pragma unroll
                for (int m = 0; m < 4; ++m) gw[bj][ai][m] = *(const u32x2*)(gates + (size_t)(row0 + ai * HALF + m * 16) * ldgb + 2048 + col0 + bj * HALF);
#pragma unroll
        for (int bj = 0; bj < 2; ++bj)
#pragma unroll
            for (int ai = 0; ai < 2; ++ai)
#pragma unroll
                for (int m = 0; m < 4; ++m) {
                    const size_t r = (size_t)(row0 + ai * HALF + m * 16);
                    const u32x2 g2 = gw[bj][ai][m];
                    const f32x4 a0 = acc[ai][bj][m][0], a1 = acc[ai][bj][m][1];
                    u32x4 w; w.x = cvt_pk_bf16(gq(g2.x, 0) * a0[0], gq(g2.x, 1) * a0[1]); w.y = cvt_pk_bf16(gq(g2.x, 2) * a0[2], gq(g2.x, 3) * a0[3]);
                    w.z = cvt_pk_bf16(gq(g2.y, 0) * a1[0], gq(g2.y, 1) * a1[1]); w.w = cvt_pk_bf16(gq(g2.y, 2) * a1[2], gq(g2.y, 3) * a1[3]);
                    *(u32x4*)(Mg + r * ldm + col0 + bj * HALF) = w;
                }
    }
};
__device__ __forceinline__ unsigned pk4_e4m3(float a, float b, float c, float d) { int w = 0; w = __builtin_amdgcn_cvt_pk_fp8_f32(a, b, w, false); w = __builtin_amdgcn_cvt_pk_fp8_f32(c, d, w, true); return (unsigned)w; }
struct EpiResF32 {
    static constexpr bool PERM = true, HAS_MID = false;
    bf16_t* __restrict__ X1; const float* __restrict__ R; unsigned char* __restrict__ X8p; int ldc;
    __device__ __forceinline__ void operator()(const f32x4 (&acc)[2][2][4][2], const Unit& u, int wr, int wc, int fr, int fq) const {
        const int row0 = u.pm * BM + wr * 64 + fr, col0 = u.pn * BM + wc * 32 + 8 * fq;
        typedef unsigned u32x2 __attribute__((ext_vector_type(2)));
#pragma unroll
        for (int ai = 0; ai < 2; ++ai) {
            f32x4 rv[4][2][2];
#pragma unroll
            for (int m = 0; m < 4; ++m) { const size_t ro = (size_t)(row0 + ai * HALF + m * 16) * ldc + col0;
#pragma unroll
                for (int bj = 0; bj < 2; ++bj) { rv[m][bj][0] = *(const f32x4*)(R + ro + bj * HALF); rv[m][bj][1] = *(const f32x4*)(R + ro + bj * HALF + 4); } }
#pragma unroll
            for (int m = 0; m < 4; ++m) { const size_t ro = (size_t)(row0 + ai * HALF + m * 16) * ldc + col0;
#pragma unroll
                for (int bj = 0; bj < 2; ++bj) { const f32x4 v0 = acc[ai][bj][m][0] + rv[m][bj][0], v1 = acc[ai][bj][m][1] + rv[m][bj][1];
                    u32x4 w; w.x = cvt_pk_bf16(v0[0], v0[1]); w.y = cvt_pk_bf16(v0[2], v0[3]); w.z = cvt_pk_bf16(v1[0], v1[1]); w.w = cvt_pk_bf16(v1[2], v1[3]);
                    *(u32x4*)(X1 + ro + bj * HALF) = w;
                    *(u32x2*)(X8p + ro + bj * HALF) = (u32x2){pk4_e4m3(v0[0], v0[1], v0[2], v0[3]), pk4_e4m3(v1[0], v1[1], v1[2], v1[3])}; } }
        }
    }
};
struct EpiSwiglu {
    static constexpr bool PERM = true, HAS_MID = false;
    bf16_t* act; const float* bgu;
    __device__ __forceinline__ void operator()(const f32x4 (&acc)[2][2][4][2], const Unit& u, int wr, int wc, int fr, int fq) const {
        const int e = u.pn >> 3, j = u.pn & 7;
        const int row0 = u.pm * BM + wr * 64 + fr, col0 = j * 128 + wc * 32 + 8 * fq;
        const float* bg = bgu + (size_t)e * 2048 + col0;
        const f32x4 g0 = *(const f32x4*)bg, g1 = *(const f32x4*)(bg + 4), u0 = *(const f32x4*)(bg + 1024), u1 = *(const f32x4*)(bg + 1028);
#pragma unroll
        for (int ai = 0; ai < 2; ++ai)
#pragma unroll
            for (int m = 0; m < 4; ++m) {
                float o[8];
#pragma unroll
                for (int i = 0; i < 8; ++i) {
                    float gt = (i < 4 ? acc[ai][0][m][0][i] + g0[i] : acc[ai][0][m][1][i - 4] + g1[i - 4]);
                    float up = (i < 4 ? acc[ai][1][m][0][i] + u0[i] : acc[ai][1][m][1][i - 4] + u1[i - 4]);
                    gt = fminf(gt, 7.0f); up = fminf(fmaxf(up, -7.0f), 7.0f);
                    const float sg = __builtin_amdgcn_rcpf(1.0f + __builtin_amdgcn_exp2f(-1.702f * 1.4426950408889634f * gt));
                    o[i] = (up + 1.0f) * (gt * sg);
                }
                u32x4 w; w.x = cvt_pk_bf16(o[0], o[1]); w.y = cvt_pk_bf16(o[2], o[3]); w.z = cvt_pk_bf16(o[4], o[5]); w.w = cvt_pk_bf16(o[6], o[7]);
                *(u32x4*)(act + (size_t)(row0 + ai * HALF + m * 16) * 1024 + col0) = w;
            }
    }
};
struct EpiSwiglu8 {
    static constexpr bool PERM = true, HAS_MID = false;
    unsigned char* __restrict__ act; const float* __restrict__ bgu; const float* __restrict__ srstd; float inv;
    __device__ __forceinline__ void operator()(const f32x4 (&acc)[2][2][4][2], const Unit& u, int wr, int wc, int fr, int fq) const {
        const int e = u.pn >> 3, j = u.pn & 7;
        const int row0 = u.pm * BM + wr * 64 + fr, col0 = j * 128 + wc * 32 + 8 * fq;
        const float* bg = bgu + (size_t)e * 2048 + col0;
        const f32x4 g0 = *(const f32x4*)bg, g1 = *(const f32x4*)(bg + 4), u0 = *(const f32x4*)(bg + 1024), u1 = *(const f32x4*)(bg + 1028);
        float rsv[8];
#pragma unroll
        for (int i = 0; i < 8; ++i) rsv[i] = srstd[row0 + (i >> 2) * HALF + (i & 3) * 16] * this->inv;
#pragma unroll
        for (int ai = 0; ai < 2; ++ai)
#pragma unroll
            for (int m = 0; m < 4; ++m) {
                float o[8]; const float inv = rsv[ai * 4 + m];
#pragma unroll
                for (int p = 0; p < 4; ++p) {
                    const int n = p >> 1, i0 = (p & 1) * 2;
                    const f32x2 ag = (f32x2){acc[ai][0][m][n][i0], acc[ai][0][m][n][i0 + 1]}, au = (f32x2){acc[ai][1][m][n][i0], acc[ai][1][m][n][i0 + 1]};
                    const f32x2 bgv = n ? (f32x2){g1[i0], g1[i0 + 1]} : (f32x2){g0[i0], g0[i0 + 1]}, buv = n ? (f32x2){u1[i0], u1[i0 + 1]} : (f32x2){u0[i0], u0[i0 + 1]};
                    f32x2 gt = ag * inv + bgv, up = au * inv + buv;
                    gt.x = fminf(gt.x, 7.0f); gt.y = fminf(gt.y, 7.0f);
                    up.x = __builtin_amdgcn_fmed3f(up.x, -7.0f, 7.0f); up.y = __builtin_amdgcn_fmed3f(up.y, -7.0f, 7.0f);
                    const f32x2 tt = gt * (-1.702f * 1.4426950408889634f);
                    f32x2 ev; ev.x = __builtin_amdgcn_exp2f(tt.x); ev.y = __builtin_amdgcn_exp2f(tt.y);
                    const f32x2 dv = ev + 1.0f;
                    f32x2 rv2; rv2.x = __builtin_amdgcn_rcpf(dv.x); rv2.y = __builtin_amdgcn_rcpf(dv.y);
                    const f32x2 ov = (up + 1.0f) * (gt * rv2);
                    o[2 * p] = ov.x; o[2 * p + 1] = ov.y;
                }
                f32x2 w; unsigned w0 = pk4_e4m3(o[0], o[1], o[2], o[3]), w1 = pk4_e4m3(o[4], o[5], o[6], o[7]);
                typedef unsigned u32x2 __attribute__((ext_vector_type(2)));
                *(u32x2*)(act + (size_t)(row0 + ai * HALF + m * 16) * 1024 + col0) = (u32x2){w0, w1}; (void)w;
            }
    }
};
struct EpiDown {
    static constexpr bool PERM = true, HAS_MID = false;
    unsigned char* __restrict__ Y; const float* __restrict__ bd; float inv;
    __device__ __forceinline__ void operator()(const f32x4 (&acc)[2][2][4][2], const Unit& u, int wr, int wc, int fr, int fq) const {
        const int e = u.pn >> 2, j = u.pn & 3;
        const int row0 = u.pm * BM + wr * 64 + fr, col0 = j * 256 + wc * 32 + 8 * fq;
        const float* bp = bd + (size_t)e * 1024 + col0;
        typedef unsigned u32x2 __attribute__((ext_vector_type(2)));
        const f32x4 b00 = *(const f32x4*)bp * 16.0f, b01 = *(const f32x4*)(bp + 4) * 16.0f, b10 = *(const f32x4*)(bp + HALF) * 16.0f, b11 = *(const f32x4*)(bp + HALF + 4) * 16.0f;
#pragma unroll
        for (int ai = 0; ai < 2; ++ai)
#pragma unroll
            for (int m = 0; m < 4; ++m) {
                unsigned char* yp = Y + (size_t)(row0 + ai * HALF + m * 16) * 1024 + col0;
                { const f32x4 v0 = acc[ai][0][m][0] * inv + b00, v1 = acc[ai][0][m][1] * inv + b01;
                  *(u32x2*)yp = (u32x2){pk4_e4m3(v0[0], v0[1], v0[2], v0[3]), pk4_e4m3(v1[0], v1[1], v1[2], v1[3])}; }
                { const f32x4 v0 = acc[ai][1][m][0] * inv + b10, v1 = acc[ai][1][m][1] * inv + b11;
                  *(u32x2*)(yp + HALF) = (u32x2){pk4_e4m3(v0[0], v0[1], v0[2], v0[3]), pk4_e4m3(v1[0], v1[1], v1[2], v1[3])}; }
            }
    }
};

template <class Epi, class Sched, bool F8 = false, bool ALIGN_EPI = true>
__device__ __forceinline__ void gemm_phase(PG8_LAS unsigned char* lds, const Gemm g, const Sched& S, const Epi& E, const int wid_in) {
    const int wid = __builtin_amdgcn_readfirstlane(wid_in), lane = (int)__builtin_amdgcn_mbcnt_hi(~0u, __builtin_amdgcn_mbcnt_lo(~0u, 0u)), tid = wid * 64 + lane, wr = wid >> 2, wc = wid & 3, fr = lane & 15, fq = lane >> 4;
    int K = g.K; asm volatile("" : "+s"(K));
    const int nt = K / BK;
    unsigned voffA[2], voffB[2];
#pragma unroll
    for (int i = 0; i < 2; ++i) { int R, C; stage_rc(tid * 16 + i * 8192, R, C); const int Rb = Epi::PERM ? ((R & ~31) + perm32(R & 31)) : R;
        voffA[i] = (unsigned)(R * g.lda + C) * 2u; voffB[i] = (unsigned)(Rb * g.ldb + C) * 2u; }
    const size_t kstep = (size_t)(BK * 2);
    const size_t hstepA = (size_t)HALF * g.lda * 2, hstepB = (size_t)HALF * g.ldb * 2;
    const size_t tstepA = 2 * hstepA, tstepB = 2 * hstepB;
    const unsigned ldsw = (unsigned)wid * 1024u;
    const int aoff = lds_byte(wr * 64 + fr, fq * 8), boff = lds_byte(wc * 32 + fr, fq * 8);
#define PG8_SA(b, h) (((b) * 2 + (h)) * HTB)
#define PG8_SB(b, h) ((4 + (b) * 2 + (h)) * HTB)
#define PG8_STAGE(bufoff, gbase, voff) do { _Pragma("unroll") for (int _i = 0; _i < 2; ++_i) \
        __builtin_amdgcn_global_load_lds((const unsigned*)((const char*)(gbase) + (voff)[_i]), (PG8_LAS unsigned*)(lds + (bufoff) + ldsw + _i * 8192), 16, 0, 0); } while (0)
#define PG8_LDA(dst, b, h) do { _Pragma("unroll") for (int m = 0; m < 4; ++m) dst[m] = cat8(*(const PG8_LAS bf16x8*)(lds + PG8_SA(b, h) + aoff + m * 2048), *(const PG8_LAS bf16x8*)(lds + PG8_SA(b, h) + aoff + m * 2048 + 1024)); } while (0)
#define PG8_LDB(dst, b, h) do { _Pragma("unroll") for (int n = 0; n < 2; ++n) dst[n] = cat8(*(const PG8_LAS bf16x8*)(lds + PG8_SB(b, h) + boff + n * 2048), *(const PG8_LAS bf16x8*)(lds + PG8_SB(b, h) + boff + n * 2048 + 1024)); } while (0)
#define PG8_MMA(ai, bj, At, Bt) do { __builtin_amdgcn_s_setprio(1); \
        if constexpr (F8) { asm volatile("s_nop 1"); _Pragma("unroll") for (int m = 0; m < 4; ++m) _Pragma("unroll") for (int n = 0; n < 2; ++n) \
            asm volatile("v_mfma_scale_f32_16x16x128_f8f6f4 %0, %1, %2, %0, %3, %3 op_sel_hi:[0,0,0]" : "+v"(acc[ai][bj][m][n]) : "v"(Bt[n]), "v"(At[m]), "v"(sc127)); } \
        else { _Pragma("unroll") for (int m = 0; m < 4; ++m) _Pragma("unroll") for (int n = 0; n < 2; ++n) { \
            acc[ai][bj][m][n] = __builtin_amdgcn_mfma_f32_16x16x32_bf16(lo8(Bt[n]), lo8(At[m]), acc[ai][bj][m][n], 0, 0, 0); \
            acc[ai][bj][m][n] = __builtin_amdgcn_mfma_f32_16x16x32_bf16(hi8(Bt[n]), hi8(At[m]), acc[ai][bj][m][n], 0, 0, 0); } } \
        __builtin_amdgcn_s_setprio(0); } while (0)
#define PG8_WAIT_V(n) asm volatile("s_waitcnt vmcnt(" #n ")" ::: "memory")
#define PG8_WAIT_L(n) asm volatile("s_waitcnt lgkmcnt(" #n ")" ::: "memory")
#define PG8_BAR __builtin_amdgcn_s_barrier()
#define PG8_SCHED __builtin_amdgcn_sched_barrier(0)
    const int sc127 = 0x7F7F7F7F; (void)sc127;
    Unit cur, nxt; int ui = 0;
    if (!S.next(0, cur)) return;
    f32x4 acc[2][2][4][2];
#pragma unroll
    for (int a = 0; a < 2; ++a)
#pragma unroll
        for (int b = 0; b < 2; ++b)
#pragma unroll
            for (int m = 0; m < 4; ++m)
#pragma unroll
                for (int n = 0; n < 2; ++n) acc[a][b][m][n] = (f32x4){0.f, 0.f, 0.f, 0.f};
    v8i At[4], B0[2], B1[2];
    const char* cA = (const char*)g.A + (size_t)cur.pm * tstepA; const char* cB = (const char*)g.Bt + (size_t)cur.pn * tstepB;
    PG8_STAGE(PG8_SB(0, 0), cB, voffB); PG8_STAGE(PG8_SB(0, 1), cB + hstepB, voffB); PG8_STAGE(PG8_SA(0, 0), cA, voffA); PG8_STAGE(PG8_SA(0, 1), cA + hstepA, voffA);
    if (wr == 1) PG8_BAR;
    PG8_WAIT_V(2); PG8_BAR;
    PG8_STAGE(PG8_SB(1, 0), cB + kstep, voffB); PG8_STAGE(PG8_SA(1, 0), cA + kstep, voffA); PG8_STAGE(PG8_SB(1, 1), cB + hstepB + kstep, voffB);
    PG8_WAIT_V(6); PG8_BAR;
    for (;;) {
        const bool has_next = S.next(ui + 1, nxt);
        const char* nA = has_next ? (const char*)g.A + (size_t)nxt.pm * tstepA : cA; const char* nB = has_next ? (const char*)g.Bt + (size_t)nxt.pn * tstepB : cB;
        for (int t = 0; t < nt; t += 2) {
            if constexpr (Epi::HAS_MID) { if (t == Epi::MID0 || t == Epi::MID1) E.mid(acc, cur, t, wr, wc, fr, fq); }
            const bool last = (t == nt - 2);
            const char* a1 = cA + (size_t)(t + 1) * kstep;
            const char* a2 = last ? nA : cA + (size_t)(t + 2) * kstep; const char* b2 = last ? nB : cB + (size_t)(t + 2) * kstep;
            const char* a3 = a2 + kstep; const char* b3 = b2 + kstep;
            PG8_LDB(B0, 0, 0); PG8_LDB(B1, 0, 1); PG8_SCHED; PG8_LDA(At, 0, 0); PG8_STAGE(PG8_SA(1, 1), a1 + hstepA, voffA);
            PG8_WAIT_V(8); PG8_WAIT_L(0); PG8_BAR; PG8_MMA(0, 0, At, B0); PG8_MMA(0, 1, At, B1); PG8_BAR; PG8_SCHED;
            PG8_LDA(At, 0, 1); PG8_STAGE(PG8_SB(0, 0), b2, voffB); PG8_STAGE(PG8_SB(0, 1), b2 + hstepB, voffB); PG8_STAGE(PG8_SA(0, 0), a2, voffA);
            PG8_WAIT_V(8); PG8_WAIT_L(0); PG8_BAR; PG8_MMA(1, 0, At, B0); PG8_MMA(1, 1, At, B1); PG8_BAR; PG8_SCHED;
            PG8_LDB(B0, 1, 0); PG8_LDB(B1, 1, 1); PG8_SCHED; PG8_LDA(At, 1, 0); PG8_STAGE(PG8_SA(0, 1), a2 + hstepA, voffA);
            PG8_WAIT_V(8); PG8_WAIT_L(0); PG8_BAR; PG8_MMA(0, 0, At, B0); PG8_MMA(0, 1, At, B1); PG8_BAR; PG8_SCHED;
            PG8_LDA(At, 1, 1); PG8_STAGE(PG8_SB(1, 0), b3, voffB); PG8_STAGE(PG8_SB(1, 1), b3 + hstepB, voffB); PG8_STAGE(PG8_SA(1, 0), a3, voffA);
            PG8_WAIT_V(8); PG8_WAIT_L(0); PG8_BAR; PG8_MMA(1, 0, At, B0); PG8_MMA(1, 1, At, B1); PG8_BAR; PG8_SCHED;
        }
        if constexpr (ALIGN_EPI) { if (wr == 0) PG8_BAR; }
        if constexpr (F8) asm volatile("s_nop 15\n\ts_nop 15" ::: "memory");
        E(acc, cur, wr, wc, fr, fq);
        if (!has_next) break;
#pragma unroll
        for (int a = 0; a < 2; ++a)
#pragma unroll
            for (int b = 0; b < 2; ++b)
#pragma unroll
                for (int m = 0; m < 4; ++m)
#pragma unroll
                    for (int n = 0; n < 2; ++n) acc[a][b][m][n] = (f32x4){0.f, 0.f, 0.f, 0.f};
        cur = nxt; cA = nA; cB = nB; ++ui;
        if constexpr (ALIGN_EPI) { if (wr == 1) PG8_BAR; }
    }
    PG8_WAIT_V(0);
    if constexpr (!ALIGN_EPI) { if (wr == 0) PG8_BAR; }
    PG8_BAR;
#undef PG8_SA
#undef PG8_SB
#undef PG8_STAGE
#undef PG8_LDA
#undef PG8_LDB
#undef PG8_MMA
#undef PG8_WAIT_V
#undef PG8_WAIT_L
#undef PG8_BAR
#undef PG8_SCHED
}
template <class Epi, class Sched, bool F8 = false, bool ALIGN_EPI = true>
__device__ __forceinline__ void gemm_phase_gather(PG8_LAS unsigned char* lds, const Gemm g, const Sched& S, const Epi& E, const int wid_in, const int* rowmap) {
    const int wid = __builtin_amdgcn_readfirstlane(wid_in), lane = (int)__builtin_amdgcn_mbcnt_hi(~0u, __builtin_amdgcn_mbcnt_lo(~0u, 0u)), tid = wid * 64 + lane, wr = wid >> 2, wc = wid & 3, fr = lane & 15, fq = lane >> 4;
    int K = g.K; asm volatile("" : "+s"(K));
    const int nt = K / BK;
    unsigned voffB[2]; int RA[2]; unsigned CA2[2];
#pragma unroll
    for (int i = 0; i < 2; ++i) { int R, C; stage_rc(tid * 16 + i * 8192, R, C); const int Rb = Epi::PERM ? ((R & ~31) + perm32(R & 31)) : R;
        RA[i] = R; CA2[i] = (unsigned)C * 2u; voffB[i] = (unsigned)(Rb * g.ldb + C) * 2u; }
    const unsigned rowb = (unsigned)g.lda * 2u;
    unsigned ca0[2], ca1[2], na0[2], na1[2]; int raw0[2], raw1[2];
#define PG8_LOADIDX(d0, d1, pm_) do { _Pragma("unroll") for (int _i = 0; _i < 2; ++_i) { d0[_i] = rowmap[(pm_) * BM + RA[_i]]; d1[_i] = rowmap[(pm_) * BM + HALF + RA[_i]]; } } while (0)
#define PG8_CVTIDX(o0, o1, d0, d1) do { _Pragma("unroll") for (int _i = 0; _i < 2; ++_i) { o0[_i] = (unsigned)(d0[_i] < 0 ? 0 : d0[_i]) * rowb + CA2[_i]; o1[_i] = (unsigned)(d1[_i] < 0 ? 0 : d1[_i]) * rowb + CA2[_i]; } } while (0)
    const size_t kstep = (size_t)(BK * 2);
    const size_t hstepB = (size_t)HALF * g.ldb * 2;
    const size_t tstepB = 2 * hstepB;
    const unsigned ldsw = (unsigned)wid * 1024u;
    const int aoff = lds_byte(wr * 64 + fr, fq * 8), boff = lds_byte(wc * 32 + fr, fq * 8);
#define PG8_SA(b, h) (((b) * 2 + (h)) * HTB)
#define PG8_SB(b, h) ((4 + (b) * 2 + (h)) * HTB)
#define PG8_STAGE(bufoff, gbase, voff) do { _Pragma("unroll") for (int _i = 0; _i < 2; ++_i) \
        __builtin_amdgcn_global_load_lds((const unsigned*)((const char*)(gbase) + (voff)[_i]), (PG8_LAS unsigned*)(lds + (bufoff) + ldsw + _i * 8192), 16, 0, 0); } while (0)
#define PG8_LDA(dst, b, h) do { _Pragma("unroll") for (int m = 0; m < 4; ++m) dst[m] = cat8(*(const PG8_LAS bf16x8*)(lds + PG8_SA(b, h) + aoff + m * 2048), *(const PG8_LAS bf16x8*)(lds + PG8_SA(b, h) + aoff + m * 2048 + 1024)); } while (0)
#define PG8_LDB(dst, b, h) do { _Pragma("unroll") for (int n = 0; n < 2; ++n) dst[n] = cat8(*(const PG8_LAS bf16x8*)(lds + PG8_SB(b, h) + boff + n * 2048), *(const PG8_LAS bf16x8*)(lds + PG8_SB(b, h) + boff + n * 2048 + 1024)); } while (0)
#define PG8_MMA(ai, bj, At, Bt) do { __builtin_amdgcn_s_setprio(1); \
        if constexpr (F8) { asm volatile("s_nop 1"); _Pragma("unroll") for (int m = 0; m < 4; ++m) _Pragma("unroll") for (int n = 0; n < 2; ++n) \
            asm volatile("v_mfma_scale_f32_16x16x128_f8f6f4 %0, %1, %2, %0, %3, %3 op_sel_hi:[0,0,0]" : "+v"(acc[ai][bj][m][n]) : "v"(Bt[n]), "v"(At[m]), "v"(sc127)); } \
        else { _Pragma("unroll") for (int m = 0; m < 4; ++m) _Pragma("unroll") for (int n = 0; n < 2; ++n) { \
            acc[ai][bj][m][n] = __builtin_amdgcn_mfma_f32_16x16x32_bf16(lo8(Bt[n]), lo8(At[m]), acc[ai][bj][m][n], 0, 0, 0); \
            acc[ai][bj][m][n] = __builtin_amdgcn_mfma_f32_16x16x32_bf16(hi8(Bt[n]), hi8(At[m]), acc[ai][bj][m][n], 0, 0, 0); } } \
        __builtin_amdgcn_s_setprio(0); } while (0)
#define PG8_WAIT_V(n) asm volatile("s_waitcnt vmcnt(" #n ")" ::: "memory")
#define PG8_WAIT_L(n) asm volatile("s_waitcnt lgkmcnt(" #n ")" ::: "memory")
#define PG8_BAR __builtin_amdgcn_s_barrier()
#define PG8_SCHED __builtin_amdgcn_sched_barrier(0)
    const int sc127 = 0x7F7F7F7F; (void)sc127;
    Unit cur, nxt, nn; int ui = 0;
    if (!S.next(0, cur)) return;
    bool has_next = S.next(1, nxt);
    PG8_LOADIDX(raw0, raw1, cur.pm); PG8_CVTIDX(ca0, ca1, raw0, raw1);
    if (has_next) { PG8_LOADIDX(raw0, raw1, nxt.pm); PG8_CVTIDX(na0, na1, raw0, raw1); } else { na0[0] = ca0[0]; na0[1] = ca0[1]; na1[0] = ca1[0]; na1[1] = ca1[1]; }
    f32x4 acc[2][2][4][2];
#pragma unroll
    for (int a = 0; a < 2; ++a)
#pragma unroll
        for (int b = 0; b < 2; ++b)
#pragma unroll
            for (int m = 0; m < 4; ++m)
#pragma unroll
                for (int n = 0; n < 2; ++n) acc[a][b][m][n] = (f32x4){0.f, 0.f, 0.f, 0.f};
    v8i At[4], B0[2], B1[2];
    const char* const cA = (const char*)g.A; const char* cB = (const char*)g.Bt + (size_t)cur.pn * tstepB;
    PG8_STAGE(PG8_SB(0, 0), cB, voffB); PG8_STAGE(PG8_SB(0, 1), cB + hstepB, voffB); PG8_STAGE(PG8_SA(0, 0), cA, ca0); PG8_STAGE(PG8_SA(0, 1), cA, ca1);
    if (wr == 1) PG8_BAR;
    PG8_WAIT_V(2); PG8_BAR;
    PG8_STAGE(PG8_SB(1, 0), cB + kstep, voffB); PG8_STAGE(PG8_SA(1, 0), cA + kstep, ca0); PG8_STAGE(PG8_SB(1, 1), cB + hstepB + kstep, voffB);
    PG8_WAIT_V(6); PG8_BAR;
    for (;;) {
        const bool has_next2 = has_next && S.next(ui + 2, nn);
        if (has_next2) PG8_LOADIDX(raw0, raw1, nn.pm);
        const char* nB = has_next ? (const char*)g.Bt + (size_t)nxt.pn * tstepB : cB;
        for (int t = 0; t < nt; t += 2) {
            const bool last = (t == nt - 2);
            const char* a1 = cA + (size_t)(t + 1) * kstep;
            const char* a2 = last ? cA : cA + (size_t)(t + 2) * kstep; const char* b2 = last ? nB : cB + (size_t)(t + 2) * kstep;
            const char* a3 = a2 + kstep; const char* b3 = b2 + kstep;
            unsigned s0[2], s1[2];
            s0[0] = last ? na0[0] : ca0[0]; s0[1] = last ? na0[1] : ca0[1]; s1[0] = last ? na1[0] : ca1[0]; s1[1] = last ? na1[1] : ca1[1];
            PG8_LDB(B0, 0, 0); PG8_LDB(B1, 0, 1); PG8_SCHED; PG8_LDA(At, 0, 0); PG8_STAGE(PG8_SA(1, 1), a1, ca1);
            PG8_WAIT_V(8); PG8_WAIT_L(0); PG8_BAR; PG8_MMA(0, 0, At, B0); PG8_MMA(0, 1, At, B1); PG8_BAR; PG8_SCHED;
            PG8_LDA(At, 0, 1); PG8_STAGE(PG8_SB(0, 0), b2, voffB); PG8_STAGE(PG8_SB(0, 1), b2 + hstepB, voffB); PG8_STAGE(PG8_SA(0, 0), a2, s0);
            PG8_WAIT_V(8); PG8_WAIT_L(0); PG8_BAR; PG8_MMA(1, 0, At, B0); PG8_MMA(1, 1, At, B1); PG8_BAR; PG8_SCHED;
            PG8_LDB(B0, 1, 0); PG8_LDB(B1, 1, 1); PG8_SCHED; PG8_LDA(At, 1, 0); PG8_STAGE(PG8_SA(0, 1), a2, s1);
            PG8_WAIT_V(8); PG8_WAIT_L(0); PG8_BAR; PG8_MMA(0, 0, At, B0); PG8_MMA(0, 1, At, B1); PG8_BAR; PG8_SCHED;
            PG8_LDA(At, 1, 1); PG8_STAGE(PG8_SB(1, 0), b3, voffB); PG8_STAGE(PG8_SB(1, 1), b3 + hstepB, voffB); PG8_STAGE(PG8_SA(1, 0), a3, s0);
            PG8_WAIT_V(8); PG8_WAIT_L(0); PG8_BAR; PG8_MMA(1, 0, At, B0); PG8_MMA(1, 1, At, B1); PG8_BAR; PG8_SCHED;
        }
        if constexpr (ALIGN_EPI) { if (wr == 0) PG8_BAR; }
        if constexpr (F8) asm volatile("s_nop 15\n\ts_nop 15" ::: "memory");
        E(acc, cur, wr, wc, fr, fq);
        if (!has_next) break;
#pragma unroll
        for (int a = 0; a < 2; ++a)
#pragma unroll
            for (int b = 0; b < 2; ++b)
#pragma unroll
                for (int m = 0; m < 4; ++m)
#pragma unroll
                    for (int n = 0; n < 2; ++n) acc[a][b][m][n] = (f32x4){0.f, 0.f, 0.f, 0.f};
        cur = nxt; cB = nB; ++ui;
        ca0[0] = na0[0]; ca0[1] = na0[1]; ca1[0] = na1[0]; ca1[1] = na1[1];
        if (has_next2) { PG8_CVTIDX(na0, na1, raw0, raw1); nxt = nn; }
        has_next = has_next2;
        if constexpr (ALIGN_EPI) { if (wr == 1) PG8_BAR; }
    }
    PG8_WAIT_V(0);
    if constexpr (!ALIGN_EPI) { if (wr == 0) PG8_BAR; }
    PG8_BAR;
#undef PG8_LOADIDX
#undef PG8_CVTIDX
#undef PG8_SA
#undef PG8_SB
#undef PG8_STAGE
#undef PG8_LDA
#undef PG8_LDB
#undef PG8_MMA
#undef PG8_WAIT_V
#undef PG8_WAIT_L
#undef PG8_BAR
#undef PG8_SCHED
}
}

constexpr int NWAVES = 8, NTHR = 512;
constexpr int BATCH = 32, SEQ = 2048, D = 1024, T = BATCH * SEQ, MEM = 256, TM = BATCH * MEM;
constexpr int DIN = 5888;
constexpr float EPS = 1e-6f;
constexpr int LDP = DIN, C_Q = 0, C_U = 1024, C_QC = 1536, C_K = 2048, C_V = 2176, C_VB = 2304, C_G = 2816;
constexpr float YSCALE = 16.0f;
constexpr float WSCALE = 64.0f;
constexpr int NEXP = 32, TOPK = 4;
constexpr int PS = T * TOPK + NEXP * 256;
constexpr int MAXTILE = PS / 256;

constexpr size_t MiB = 1u << 20;
constexpr size_t WS_CTL = 0, CTL_ZERO_BYTES = 1 * MiB;
constexpr size_t WS_WOUT = 1 * MiB;
constexpr size_t WS_ROPE = 3 * MiB;
constexpr size_t WS_WIN = 19 * MiB;
constexpr size_t WS_WO = 31 * MiB;
constexpr size_t WS_WMKV = 35 * MiB;
constexpr size_t WS_X8 = 3 * MiB;
constexpr size_t WS_SRSTD = 67 * MiB;
constexpr size_t WS_MEMN = 37 * MiB;
constexpr size_t WS_KV = 53 * MiB;
constexpr size_t WS_META = 69 * MiB;
constexpr size_t WS_H = 77 * MiB;
constexpr size_t WS_PROJ = 205 * MiB;
constexpr size_t WS_WGU = 141 * MiB;
constexpr size_t WS_WD = 205 * MiB;
constexpr size_t WS_ACT = 237 * MiB;
constexpr size_t WS_Y = 501 * MiB;
constexpr size_t WS_X1B = 765 * MiB;
constexpr size_t WS_END = 1013 * MiB;
static_assert(WS_PROJ + (size_t)T * LDP * 2 <= WS_END && WS_ACT + (size_t)PS * 1024 <= WS_Y && WS_Y + (size_t)T * TOPK * 2048 <= WS_END && WS_WGU + (size_t)NEXP * 2048 * 1024 <= WS_WD, "ws map");
constexpr size_t MT_IDX = 0;
constexpr size_t MT_GATE = 1 * MiB;
constexpr size_t MT_STOK = 2 * MiB;
constexpr size_t MT_SGATE = 3 * MiB + 512 * 1024;
constexpr size_t MT_SASG = 5 * MiB;
constexpr size_t MT_TILEE = 6 * MiB + 512 * 1024;
constexpr size_t MT_WSB = 7 * MiB;
constexpr size_t MT_RSTD = 7 * MiB + 128 * 1024;
constexpr size_t MT_CMAT = 7 * MiB + 512 * 1024;
constexpr size_t MT_RWP = 7 * MiB + 768 * 1024;
constexpr int CW_BAR = 4096;
constexpr int CW_NTILE = 1024;

constexpr int RING_OFF = 0, RING_BYTES = 131072;
constexpr int LDS_BYTES = 147456;
constexpr int LDSCTL_OFF = LDS_BYTES - 1024, MISC_OFF = LDSCTL_OFF + 320;

#define GAS __attribute__((address_space(1)))
#define LAS __attribute__((address_space(3)))
typedef unsigned short bf16;
typedef unsigned v4u __attribute__((ext_vector_type(4)));
typedef unsigned v2u __attribute__((ext_vector_type(2)));
typedef float f32x4 __attribute__((ext_vector_type(4)));
typedef GAS unsigned gu32;
#define RLX_AGENT __ATOMIC_RELAXED, __HIP_MEMORY_SCOPE_AGENT
#define LDS_WAIT() asm volatile("s_waitcnt lgkmcnt(0)" ::: "memory")
#define VM_WAIT() asm volatile("s_waitcnt vmcnt(0)" ::: "memory")
__device__ __forceinline__ unsigned f2bf(float f) { unsigned u = __builtin_bit_cast(unsigned, f); return (u + 0x7fffu + ((u >> 16) & 1u)) >> 16; }
__device__ __forceinline__ unsigned pk2(float lo, float hi) { return f2bf(lo) | (f2bf(hi) << 16); }
__device__ __forceinline__ unsigned pk4_fp8(float a, float b, float c, float d) { int w = 0; w = __builtin_amdgcn_cvt_pk_fp8_f32(a, b, w, false); w = __builtin_amdgcn_cvt_pk_fp8_f32(c, d, w, true); return (unsigned)w; }
__device__ __forceinline__ float bf2f(bf16 b) { return __uint_as_float(((unsigned)b) << 16); }
__device__ __forceinline__ float blo(unsigned w) { return __uint_as_float(w << 16); }
__device__ __forceinline__ float bhi(unsigned w) { return __uint_as_float(w & 0xffff0000u); }

#define XB_TMO      128
#define XB_XCNT(j)  (256  + 64 * (j))
#define XB_XSUB(j)  (1280 + 64 * (j))
#define XB_XGEN(j)  (2304 + 64 * (j))
#define XB_TOP      3328
#define XB_TOPGEN   3392
#define XCD_BAR_WORDS 3456
#define XB_SPIN_CAP (1u << 22)
__device__ __forceinline__ unsigned xb_ld(unsigned* p)              { return __hip_atomic_load(p, __ATOMIC_RELAXED, __HIP_MEMORY_SCOPE_AGENT); }
__device__ __forceinline__ unsigned xb_add(unsigned* p, unsigned v) { return __hip_atomic_fetch_add(p, v, __ATOMIC_RELAXED, __HIP_MEMORY_SCOPE_AGENT); }
__device__ __forceinline__ unsigned xb_xcc_id() { return (unsigned)__builtin_amdgcn_s_getreg((3 << 11) | 20) & 0xFu; }
#define XB_SPIN(cond, bar) do { unsigned _sp = 0; while (cond) { __builtin_amdgcn_s_sleep(1); \
    if ((++_sp & 255u) == 0u) { if (xb_ld(&(bar)[XB_TMO])) break; if (_sp > XB_SPIN_CAP) { atomicAdd(&(bar)[XB_TMO], 1u); break; } } } } while (0)
struct XcdBarrier { unsigned* bar; unsigned x; volatile LAS unsigned* st; };
__device__ __forceinline__ XcdBarrier xcd_barrier_post(unsigned* bar, volatile LAS unsigned* st, bool leader) {
    XcdBarrier b; b.bar = bar; b.x = xb_xcc_id(); b.st = st;
    if (leader) (void)xb_add(&bar[XB_XCNT(b.x)], 1u);
    return b;
}
__device__ __forceinline__ void xcd_barrier_complete(unsigned* bar, unsigned x, unsigned& nloc, unsigned& nx) {
    const unsigned G = gridDim.x * gridDim.y * gridDim.z;
    unsigned sum, cnt, mine, sp = 0u;
    for (;;) {
        sum = 0u; cnt = 0u; mine = 0u;
#pragma unroll
        for (unsigned j = 0; j < 16; ++j) { const unsigned c = xb_ld(&bar[XB_XCNT(j)]); sum += c; cnt += (c > 0u) ? 1u : 0u; mine = (j == x) ? c : mine; }
        if (sum == G) break;
        __builtin_amdgcn_s_sleep(1);
        if ((++sp & 255u) == 0u) { if (xb_ld(&bar[XB_TMO])) break; if (sp > XB_SPIN_CAP) { atomicAdd(&bar[XB_TMO], 1u); break; } }
    }
    nloc = mine > 0u ? mine : 1u; nx = cnt > 0u ? cnt : 1u;
}
__device__ __forceinline__ void xcd_barrier(const XcdBarrier& b, bool leader) {
    asm volatile("s_waitcnt vmcnt(0)" ::: "memory");
    __syncthreads();
    if (leader) {
        unsigned* bar = b.bar;
        __builtin_amdgcn_s_waitcnt(0);
        unsigned nloc = b.st[0], nx = b.st[1];
        if (nloc == 0u) { xcd_barrier_complete(bar, b.x, nloc, nx); b.st[0] = nloc; b.st[1] = nx; }
        const unsigned old = xb_add(&bar[XB_XSUB(b.x)], 1u);
        const unsigned gen = old / nloc;
        if (old + 1u == (gen + 1u) * nloc) {
            __builtin_amdgcn_fence(__ATOMIC_RELEASE, "agent");
            asm volatile("s_waitcnt vmcnt(0)" ::: "memory");
            const unsigned og = xb_add(&bar[XB_TOP], 1u);
            const unsigned tg = og / nx;
            if (og + 1u == (tg + 1u) * nx) xb_add(&bar[XB_TOPGEN], 1u);
            else XB_SPIN(xb_ld(&bar[XB_TOPGEN]) == tg, bar);
            __builtin_amdgcn_fence(__ATOMIC_ACQUIRE, "agent");
            xb_add(&bar[XB_XGEN(b.x)], 1u);
            asm volatile("s_waitcnt vmcnt(0)" ::: "memory");
        } else {
            XB_SPIN(xb_ld(&bar[XB_XGEN(b.x)]) == gen, bar);
            __builtin_amdgcn_fence(__ATOMIC_ACQUIRE, "agent");
            asm volatile("s_waitcnt vmcnt(0)" ::: "memory");
        }
    }
    __syncthreads();
}

__device__ __forceinline__ float dpp_add(float v, const int ctrl) { return v; }
#define DPP_ADD(v, ctrl) ((v) + __builtin_bit_cast(float, __builtin_amdgcn_update_dpp(0, __builtin_bit_cast(int, (v)), (ctrl), 0xf, 0xf, false)))
__device__ __forceinline__ float row16_sum(float v) { v = DPP_ADD(v, 0xB1); v = DPP_ADD(v, 0x4E); v = DPP_ADD(v, 0x141); v = DPP_ADD(v, 0x140); return v; }
__device__ __forceinline__ float wave_sum(float v) { return xor32_sum(xor16_sum(row16_sum(v))); }
__device__ __forceinline__ float wave_max(float v) {
#pragma unroll
    for (int o = 1; o < 64; o <<= 1) v = fmaxf(v, __shfl_xor(v, o));
    return v;
}
__device__ __forceinline__ float half_sum(float v) {
#pragma unroll
    for (int o = 1; o < 32; o <<= 1) v += __shfl_xor(v, o);
    return v;
}
__device__ __forceinline__ float gelu_erf(float x) { return 0.5f * x * (1.0f + erff(x * 0.70710678118654752f)); }

struct Args {
    const float* in[28]; float* out; unsigned char* ws; int ph_lo, ph_hi;
};
enum { I_X = 0, I_MEM, I_POS, I_ATTN_G, I_MEM_G, I_WIN, I_BGATES, I_AQG, I_AKG, I_SINKS, I_WOA, I_LNG, I_LNB, I_WS, I_BS, I_WOB, I_WMKV, I_CQG, I_CKG, I_WOC, I_WOUT, I_FFN_G,
       I_RW, I_RB, I_WGU, I_BGU, I_WD, I_BD };

__device__ __forceinline__ void tr_item(const float* W, int ldw, int k0, int sc, bf16* WT, int ldt, int dr, int dk, LAS float* scr, int lane) {
#pragma unroll 8
    for (int i = 0; i < 32; ++i) { const int kk = 2 * i + (lane >> 5); scr[kk * 33 + (lane & 31)] = W[(size_t)(k0 + kk) * ldw + sc + (lane & 31)]; }
    LDS_WAIT(); asm volatile("" ::: "memory");
    const int c = lane & 7;
#pragma unroll
    for (int j = 0; j < 4; ++j) { const int n = (lane >> 3) + 8 * j; const LAS float* s = scr + (8 * c) * 33 + n;
        v4u o; o.x = pk2(s[0 * 33], s[1 * 33]); o.y = pk2(s[2 * 33], s[3 * 33]); o.z = pk2(s[4 * 33], s[5 * 33]); o.w = pk2(s[6 * 33], s[7 * 33]);
        *(GAS v4u*)(WT + (size_t)(dr + n) * ldt + dk + k0 + 8 * c) = o; }
    LDS_WAIT(); asm volatile("" ::: "memory");
}
struct TrItem { const float* W; int ldw, k0, sc; bf16* WT; int ldt, dr, dk; const float* ks; };
__device__ __forceinline__ void tr_load(const TrItem& it, int lane, f32x4 (&v)[8]) {
    const float* p = it.W + (size_t)(it.k0 + (lane >> 3)) * it.ldw + it.sc + 4 * (lane & 7);
#pragma unroll
    for (int i = 0; i < 8; ++i) v[i] = *(const GAS f32x4*)(p + (size_t)(8 * i) * it.ldw);
}
__device__ __forceinline__ void tr_store(const TrItem& it, const f32x4 (&v)[8], LAS float* scr, int lane) {
#pragma unroll
    for (int i = 0; i < 8; ++i) { LAS float* p = scr + ((lane >> 3) + 8 * i) * 33 + 4 * (lane & 7); p[0] = v[i].x; p[1] = v[i].y; p[2] = v[i].z; p[3] = v[i].w; }
    LDS_WAIT(); asm volatile("" ::: "memory");
    const int c = lane & 7;
#pragma unroll
    for (int j = 0; j < 4; ++j) { const int n = (lane >> 3) + 8 * j; const LAS float* s = scr + (8 * c) * 33 + n;
        v4u o; o.x = pk2(s[0 * 33], s[1 * 33]); o.y = pk2(s[2 * 33], s[3 * 33]); o.z = pk2(s[4 * 33], s[5 * 33]); o.w = pk2(s[6 * 33], s[7 * 33]);
        *(GAS v4u*)(it.WT + (size_t)(it.dr + n) * it.ldt + it.dk + it.k0 + 8 * c) = o; }
    LDS_WAIT(); asm volatile("" ::: "memory");
}
__device__ __forceinline__ void tr_store8(const TrItem& it, const f32x4 (&v)[8], LAS float* scr, int lane, float sc) {
#pragma unroll
    for (int i = 0; i < 8; ++i) { LAS float* p = scr + ((lane >> 3) + 8 * i) * 33 + 4 * (lane & 7); p[0] = v[i].x; p[1] = v[i].y; p[2] = v[i].z; p[3] = v[i].w; }
    LDS_WAIT(); asm volatile("" ::: "memory");
    const int c = lane & 7; unsigned char* WT8 = (unsigned char*)it.WT;
    f32x4 k0v = (f32x4){sc, sc, sc, sc}, k1v = k0v;
    if (it.ks) { k0v = *(const GAS f32x4*)(it.ks + it.k0 + 8 * c) * sc; k1v = *(const GAS f32x4*)(it.ks + it.k0 + 8 * c + 4) * sc; }
#pragma unroll
    for (int j = 0; j < 4; ++j) { const int n = (lane >> 3) + 8 * j; const LAS float* s = scr + (8 * c) * 33 + n;
        v2u o; o.x = pk4_fp8(s[0 * 33] * k0v.x, s[1 * 33] * k0v.y, s[2 * 33] * k0v.z, s[3 * 33] * k0v.w); o.y = pk4_fp8(s[4 * 33] * k1v.x, s[5 * 33] * k1v.y, s[6 * 33] * k1v.z, s[7 * 33] * k1v.w);
        *(GAS v2u*)(WT8 + (size_t)(it.dr + n) * it.ldt + it.dk + it.k0 + 8 * c) = o; }
    LDS_WAIT(); asm volatile("" ::: "memory");
}
template <class F> __device__ __forceinline__ void tr_range8(int nit, F f, int gw, int NGW, LAS float* scr, int lane, float sc) {
    for (int it = gw; it < nit; it += 2 * NGW) {
        const TrItem a = f(it); f32x4 va[8], vb[8]; tr_load(a, lane, va);
        const bool two = it + NGW < nit; TrItem b = a; if (two) { b = f(it + NGW); tr_load(b, lane, vb); }
        tr_store8(a, va, scr, lane, sc);
        if (two) tr_store8(b, vb, scr, lane, sc);
    }
}
template <class F> __device__ __forceinline__ void tr_range(int nit, F f, int gw, int NGW, LAS float* scr, int lane) {
    for (int it = gw; it < nit; it += 2 * NGW) {
        const TrItem a = f(it); f32x4 va[8], vb[8]; tr_load(a, lane, va);
        const bool two = it + NGW < nit; TrItem b = a; if (two) { b = f(it + NGW); tr_load(b, lane, vb); }
        tr_store(a, va, scr, lane);
        if (two) tr_store(b, vb, scr, lane);
    }
}
__device__ __forceinline__ int win_srccol(int r) {
    if (r < 1024) { const int pn = r >> 8, blk = (r >> 5) & 7, bj = blk >> 2, wc = blk & 3; return 64 * (4 * pn + wc) + 32 * bj; }
    if (r < 1536) return 1280 + (r - 1024);
    if (r < 2048) return 2304 + (r - 1536);
    if (r < 2304) { const int blk = (r - 2048) >> 5, bj = blk >> 2, wc = blk & 3; return ((wc & 1) ? 1152 : 1024) + 64 * (wc >> 1) + 32 * bj; }
    if (r < 2816) return 1792 + (r - 2304);
    return r;
}
__device__ __forceinline__ void rms_row_to_bf16(const float* xrow, const float* g, bf16* orow, int lane) {
    const GAS f32x4* xr = (const GAS f32x4*)xrow + lane; const GAS f32x4* gr = (const GAS f32x4*)g + lane;
    f32x4 v[4]; float s = 0.f;
#pragma unroll
    for (int j = 0; j < 4; ++j) { v[j] = xr[64 * j]; s += (v[j].x * v[j].x + v[j].y * v[j].y) + (v[j].z * v[j].z + v[j].w * v[j].w); }
    const float rstd = 1.0f / sqrtf(wave_sum(s) * (1.f / 1024.f) + EPS);
    GAS v2u* o8 = (GAS v2u*)orow + lane;
#pragma unroll
    for (int j = 0; j < 4; ++j) { const f32x4 gg = gr[64 * j]; v2u o; o.x = pk2(v[j].x * rstd * gg.x, v[j].y * rstd * gg.y); o.y = pk2(v[j].z * rstd * gg.z, v[j].w * rstd * gg.w); o8[64 * j] = o; }
}

__device__ __forceinline__ void rms_rows4_to_bf16(const float* xrow, const float* g, bf16* orow, int lane) {
    const GAS f32x4* xr = (const GAS f32x4*)xrow + lane; const GAS f32x4* gr = (const GAS f32x4*)g + lane;
    f32x4 v[16]; float s[4];
#pragma unroll
    for (int j = 0; j < 16; ++j) v[j] = xr[64 * j];
#pragma unroll
    for (int r = 0; r < 4; ++r) { float a = 0.f;
#pragma unroll
        for (int j = 0; j < 4; ++j) a += (v[4 * r + j].x * v[4 * r + j].x + v[4 * r + j].y * v[4 * r + j].y) + (v[4 * r + j].z * v[4 * r + j].z + v[4 * r + j].w * v[4 * r + j].w);
        s[r] = a; }
#pragma unroll
    for (int r = 0; r < 4; ++r) s[r] = row16_sum(s[r]);
#pragma unroll
    for (int r = 0; r < 4; ++r) s[r] = xor32_sum(xor16_sum(s[r]));
    GAS v2u* o8 = (GAS v2u*)orow + lane;
#pragma unroll
    for (int r = 0; r < 4; ++r) { const float rs = 1.0f / sqrtf(s[r] * (1.f / 1024.f) + EPS);
#pragma unroll
        for (int j = 0; j < 4; ++j) { const f32x4 gg = gr[64 * j]; const f32x4 a = v[4 * r + j];
            v2u o; o.x = pk2(a.x * rs * gg.x, a.y * rs * gg.y); o.y = pk2(a.z * rs * gg.z, a.w * rs * gg.w); o8[256 * r + 64 * j] = o; } }
}
__device__ __forceinline__ void rms_rows2_to_bf16(const float* xrow, const float* g, bf16* orow, int lane) {
    const GAS f32x4* xr = (const GAS f32x4*)xrow + lane; const GAS f32x4* gr = (const GAS f32x4*)g + lane;
    f32x4 v[8]; float s0 = 0.f, s1 = 0.f;
#pragma unroll
    for (int j = 0; j < 8; ++j) v[j] = xr[64 * j];
#pragma unroll
    for (int j = 0; j < 4; ++j) { s0 += (v[j].x * v[j].x + v[j].y * v[j].y) + (v[j].z * v[j].z + v[j].w * v[j].w); s1 += (v[4 + j].x * v[4 + j].x + v[4 + j].y * v[4 + j].y) + (v[4 + j].z * v[4 + j].z + v[4 + j].w * v[4 + j].w); }
    const float r0 = 1.0f / sqrtf(wave_sum(s0) * (1.f / 1024.f) + EPS), r1 = 1.0f / sqrtf(wave_sum(s1) * (1.f / 1024.f) + EPS);
    GAS v2u* o8 = (GAS v2u*)orow + lane;
#pragma unroll
    for (int j = 0; j < 4; ++j) { const f32x4 gg = gr[64 * j];
        v2u o; o.x = pk2(v[j].x * r0 * gg.x, v[j].y * r0 * gg.y); o.y = pk2(v[j].z * r0 * gg.z, v[j].w * r0 * gg.w); o8[64 * j] = o;
        v2u p; p.x = pk2(v[4 + j].x * r1 * gg.x, v[4 + j].y * r1 * gg.y); p.y = pk2(v[4 + j].z * r1 * gg.z, v[4 + j].w * r1 * gg.w); o8[256 + 64 * j] = p; }
}
namespace att {
typedef short bf16x8 __attribute__((ext_vector_type(8)));
typedef short s16x4 __attribute__((ext_vector_type(4)));
typedef short v4i16_t __attribute__((ext_vector_type(4)));
typedef float f32x16 __attribute__((ext_vector_type(16)));
typedef float f32x2_t __attribute__((ext_vector_type(2)));
typedef __bf16 bf16x2_t __attribute__((ext_vector_type(2)));
#define ATT_MFMA(a, b, c) __builtin_amdgcn_mfma_f32_32x32x16_bf16((a), (b), (c), 0, 0, 0)
__device__ __forceinline__ unsigned cvtpk(float lo, float hi) { f32x2_t v = {lo, hi}; bf16x2_t b = __builtin_convertvector(v, bf16x2_t); return __builtin_bit_cast(unsigned, b); }
__device__ __forceinline__ s16x4 vtr(const LAS unsigned char* p) { return __builtin_bit_cast(s16x4, __builtin_amdgcn_ds_read_tr16_b64_v4i16((LAS v4i16_t*)p)); }
__device__ __forceinline__ int crow(int r, int h) { return (r & 3) + 8 * (r >> 2) + 4 * h; }
__device__ __forceinline__ bf16x8 pack8(float a0, float a1, float a2, float a3, float a4, float a5, float a6, float a7) {
    v4u w; w.x = cvtpk(a0, a1); w.y = cvtpk(a2, a3); w.z = cvtpk(a4, a5); w.w = cvtpk(a6, a7); return __builtin_bit_cast(bf16x8, w); }
constexpr float LOG2E = 1.4426950408889634f;
constexpr int SWA_KP = 144, SWA_VP = 192, SWA_K_OFF = 0, SWA_V_OFF = 256 * SWA_KP;

__device__ __forceinline__ void swa_phase(LAS unsigned char* L, bf16* projp, const float* sinks, const float* gq, const float* gk, int bid, int G, int wave, int lane) {
    const int tid = wave * 64 + lane, r32 = lane & 31, h = lane >> 5, blk16 = (lane >> 4) & 1, q4 = (lane & 15) >> 2, p4 = lane & 3;
    const float bnd = 8.0f * wave_max(fabsf(gq[lane])) * wave_max(fabsf(gk[lane]));
    v4u kx[4], vx[4];
#define SWA_LOADKV(u_) do { const int blk_ = (u_) & 15, kvh_ = ((u_) >> 4) & 1, b_ = (u_) >> 5; const int tok0_ = b_ * SEQ + blk_ * 128; \
        _Pragma("unroll") for (int it = 0; it < 4; ++it) if (it >= 2 || blk_ != 0) { \
            const bf16* src = projp + (size_t)(tok0_ - 128 + (tid >> 3) + 64 * it) * LDP + 64 * kvh_ + 8 * (tid & 7); \
            kx[it] = *(const GAS v4u*)(src + C_K); vx[it] = *(const GAS v4u*)(src + C_V); } } while (0)
    if (bid < 1024) SWA_LOADKV(bid);
    for (int unit = bid; unit < 1024; unit += G) {
        const int blk = unit & 15, kvh = (unit >> 4) & 1, b = unit >> 5;
        const int tok0 = b * SEQ + blk * 128;
        __syncthreads();
#pragma unroll
        for (int it = 0; it < 4; ++it) if (it >= 2 || blk != 0) {
            const int row = (tid >> 3) + 64 * it, ch = tid & 7;
            *(LAS v4u*)(L + SWA_K_OFF + row * SWA_KP + ch * 16) = kx[it];
            *(LAS v4u*)(L + SWA_V_OFF + row * SWA_VP + ch * 16) = vx[it];
        }
        __syncthreads();
        if (unit + G < 1024) SWA_LOADKV(unit + G);
        const int hd = kvh * 8 + wave;
        const float sink = sinks[hd];
        const float m2 = fmaxf(bnd, sink) * LOG2E;
        const float esink = __builtin_amdgcn_exp2f(sink * LOG2E - m2);
        bf16x8 qnx[4];
#pragma unroll
        for (int ks = 0; ks < 4; ++ks) qnx[ks] = *(const GAS bf16x8*)(projp + (size_t)(tok0 + r32) * LDP + C_Q + 64 * hd + 16 * ks + 8 * h);
#pragma unroll 1
        for (int qi = 0; qi < 4; ++qi) {
            bf16* qrow = projp + (size_t)(tok0 + 32 * qi + r32) * LDP + C_Q + 64 * hd;
            bf16x8 qf[4];
#pragma unroll
            for (int ks = 0; ks < 4; ++ks) qf[ks] = qnx[ks];
            if (qi < 3) {
#pragma unroll
                for (int ks = 0; ks < 4; ++ks) qnx[ks] = *(const GAS bf16x8*)(qrow + (size_t)32 * LDP + 16 * ks + 8 * h); }
            f32x16 o0, o1;
#pragma unroll
            for (int r = 0; r < 16; ++r) { o0[r] = 0.f; o1[r] = 0.f; }
            float lsum = 0.f;
            const int kt0 = (blk == 0) ? 4 : qi;
#pragma unroll 1
            for (int kt = kt0; kt <= qi + 4; ++kt) {
                f32x16 s;
#pragma unroll
                for (int r = 0; r < 16; ++r) s[r] = 0.f;
                const LAS unsigned char* kp = L + SWA_K_OFF + (32 * kt + r32) * SWA_KP + 16 * h;
#pragma unroll
                for (int ks = 0; ks < 4; ++ks) { const bf16x8 kf = *(const LAS bf16x8*)(kp + 32 * ks); s = ATT_MFMA(kf, qf[ks], s); }
                float p[16];
                const bool first = (kt == qi), lastt = (kt == qi + 4);
#pragma unroll
                for (int r = 0; r < 16; ++r) { const float e = __builtin_amdgcn_exp2f(s[r] * (0.125f * LOG2E) - m2); const int cr = crow(r, h);
                    const bool ok = (!first || cr > r32) && (!lastt || cr <= r32); p[r] = ok ? e : 0.f; lsum += p[r]; }
#pragma unroll
                for (int s2 = 0; s2 < 2; ++s2) {
                    const bf16x8 pb = pack8(p[8 * s2], p[8 * s2 + 1], p[8 * s2 + 2], p[8 * s2 + 3], p[8 * s2 + 4], p[8 * s2 + 5], p[8 * s2 + 6], p[8 * s2 + 7]);
                    const LAS unsigned char* vp = L + SWA_V_OFF + (32 * kt + 16 * s2 + 4 * h + q4) * SWA_VP + (16 * blk16 + 4 * p4) * 2;
                    { const s16x4 lo = vtr(vp), hi = vtr(vp + 8 * SWA_VP); const bf16x8 vf = __builtin_shufflevector(lo, hi, 0, 1, 2, 3, 4, 5, 6, 7); o0 = ATT_MFMA(vf, pb, o0); }
                    { const s16x4 lo = vtr(vp + 64), hi = vtr(vp + 64 + 8 * SWA_VP); const bf16x8 vf = __builtin_shufflevector(lo, hi, 0, 1, 2, 3, 4, 5, 6, 7); o1 = ATT_MFMA(vf, pb, o1); }
                }
            }
            const float tot = xor32_sum(lsum); const float inv = 1.0f / (tot + esink);
#pragma unroll
            for (int g4 = 0; g4 < 4; ++g4) {
                v2u w0; w0.x = cvtpk(o0[4 * g4] * inv, o0[4 * g4 + 1] * inv); w0.y = cvtpk(o0[4 * g4 + 2] * inv, o0[4 * g4 + 3] * inv);
                v2u w1; w1.x = cvtpk(o1[4 * g4] * inv, o1[4 * g4 + 1] * inv); w1.y = cvtpk(o1[4 * g4 + 2] * inv, o1[4 * g4 + 3] * inv);
                *(GAS v2u*)(qrow + 8 * g4 + 4 * h) = w0; *(GAS v2u*)(qrow + 32 + 8 * g4 + 4 * h) = w1;
            }
        }
    }
}

constexpr int GM_P = 1088;
__device__ __forceinline__ void gmlp_phase(LAS unsigned char* L, bf16* projp, const bf16* Wb, const float* lng, const float* lnb, const float* bs, int bid, int G, int wave, int lane) {
    const int r32 = lane & 31, h = lane >> 5, blk16 = (lane >> 4) & 1, q4 = (lane & 15) >> 2, p4 = lane & 3;
    float lg[8], lb[8];
    { const f32x4 a = *(const f32x4*)(lng + 8 * lane), b = *(const f32x4*)(lng + 8 * lane + 4), c = *(const f32x4*)(lnb + 8 * lane), d = *(const f32x4*)(lnb + 8 * lane + 4);
      lg[0] = a.x; lg[1] = a.y; lg[2] = a.z; lg[3] = a.w; lg[4] = b.x; lg[5] = b.y; lg[6] = b.z; lg[7] = b.w;
      lb[0] = c.x; lb[1] = c.y; lb[2] = c.z; lb[3] = c.w; lb[4] = d.x; lb[5] = d.y; lb[6] = d.z; lb[7] = d.w; }
    for (int unit = bid; unit < T / 128; unit += G) {
        const int tok0 = unit * 128;
        __syncthreads();
#pragma unroll 1
        for (int i0 = 0; i0 < 16; i0 += 8) {
            v4u w[8]; float sm[8], q[8];
#pragma unroll
            for (int i = 0; i < 8; ++i) w[i] = *(const GAS v4u*)(projp + (size_t)(tok0 + 16 * wave + i0 + i) * LDP + C_VB + 8 * lane);
#pragma unroll
            for (int i = 0; i < 8; ++i) sm[i] = row16_sum(((blo(w[i].x) + bhi(w[i].x)) + (blo(w[i].y) + bhi(w[i].y))) + ((blo(w[i].z) + bhi(w[i].z)) + (blo(w[i].w) + bhi(w[i].w))));
#pragma unroll
            for (int i = 0; i < 8; ++i) sm[i] = xor32_sum(xor16_sum(sm[i])) * (1.f / 512.f);
#pragma unroll
            for (int i = 0; i < 8; ++i) { const float mu = sm[i];
                const float d0 = blo(w[i].x) - mu, d1 = bhi(w[i].x) - mu, d2 = blo(w[i].y) - mu, d3 = bhi(w[i].y) - mu, d4 = blo(w[i].z) - mu, d5 = bhi(w[i].z) - mu, d6 = blo(w[i].w) - mu, d7 = bhi(w[i].w) - mu;
                q[i] = row16_sum(((d0 * d0 + d1 * d1) + (d2 * d2 + d3 * d3)) + ((d4 * d4 + d5 * d5) + (d6 * d6 + d7 * d7))); }
#pragma unroll
            for (int i = 0; i < 8; ++i) q[i] = xor32_sum(xor16_sum(q[i]));
#pragma unroll
            for (int i = 0; i < 8; ++i) { const float mu = sm[i], rstd = 1.0f / sqrtf(q[i] * (1.f / 512.f) + EPS);
                v4u o; o.x = cvtpk((blo(w[i].x) - mu) * rstd * lg[0] + lb[0], (bhi(w[i].x) - mu) * rstd * lg[1] + lb[1]); o.y = cvtpk((blo(w[i].y) - mu) * rstd * lg[2] + lb[2], (bhi(w[i].y) - mu) * rstd * lg[3] + lb[3]);
                o.z = cvtpk((blo(w[i].z) - mu) * rstd * lg[4] + lb[4], (bhi(w[i].z) - mu) * rstd * lg[5] + lb[5]); o.w = cvtpk((blo(w[i].w) - mu) * rstd * lg[6] + lb[6], (bhi(w[i].w) - mu) * rstd * lg[7] + lb[7]);
                *(LAS v4u*)(L + (16 * wave + i0 + i) * GM_P + lane * 16) = o; }
        }
        __syncthreads();
        const int g = wave >> 1, th = wave & 1;
        f32x16 acc[4][2];
#pragma unroll
        for (int ct = 0; ct < 4; ++ct)
#pragma unroll
            for (int tt = 0; tt < 2; ++tt)
#pragma unroll
                for (int r = 0; r < 16; ++r) acc[ct][tt][r] = 0.f;
#pragma unroll 1
        for (int ks = 0; ks < 4 * th + 4; ++ks) {
            bf16x8 af[4];
#pragma unroll
            for (int ct = 0; ct < 4; ++ct) { const LAS unsigned char* vp = L + (16 * ks + 8 * h + q4) * GM_P + (128 * g + 32 * ct + 16 * blk16 + 4 * p4) * 2;
                const s16x4 lo = vtr(vp), hi = vtr(vp + 4 * GM_P); af[ct] = __builtin_shufflevector(lo, hi, 0, 1, 2, 3, 4, 5, 6, 7); }
#pragma unroll
            for (int tt = 0; tt < 2; ++tt) if (ks < 4 * th + 2 * tt + 2) {
                const bf16x8 bfr = *(const GAS bf16x8*)(Wb + (size_t)(g * 128 + 64 * th + 32 * tt + r32) * 128 + 16 * ks + 8 * h);
#pragma unroll
                for (int ct = 0; ct < 4; ++ct) acc[ct][tt] = ATT_MFMA(af[ct], bfr, acc[ct][tt]);
            }
        }
#pragma unroll
        for (int tt = 0; tt < 2; ++tt) { const int t = 64 * th + 32 * tt + r32; const float bsv = bs[g * 128 + t];
            bf16* urow = projp + (size_t)(tok0 + t) * LDP + C_U + 128 * g + 4 * h;
#pragma unroll
            for (int ct = 0; ct < 4; ++ct)
#pragma unroll
                for (int g4 = 0; g4 < 4; ++g4) { bf16* up = urow + 32 * ct + 8 * g4; const v2u uw = *(const GAS v2u*)up;
                    v2u o; o.x = cvtpk(blo(uw.x) * (acc[ct][tt][4 * g4] + bsv), bhi(uw.x) * (acc[ct][tt][4 * g4 + 1] + bsv));
                    o.y = cvtpk(blo(uw.y) * (acc[ct][tt][4 * g4 + 2] + bsv), bhi(uw.y) * (acc[ct][tt][4 * g4 + 3] + bsv)); *(GAS v2u*)up = o; } }
    }
}

constexpr int XA_K_OFF = 0, XA_V_OFF = 65536;
__device__ __forceinline__ unsigned off_b(unsigned row, unsigned ch) { return 256u * row + 16u * (ch ^ (((row & 3u) << 2) | ((row >> 2) & 3u))); }
__device__ __forceinline__ void xattn_phase(LAS unsigned char* L, bf16* projp, const bf16* kvp, const float* cqg, const float* ckg, int bid, int G, int wave, int lane) {
    const int tid = wave * 64 + lane, r32 = lane & 31, h = lane >> 5, blk16 = (lane >> 4) & 1, q4 = (lane & 15) >> 2, p4 = lane & 3;
    const int fch = tid & 15;
    float gg[8];
#pragma unroll
    for (int i = 0; i < 8; ++i) gg[i] = cqg[8 * fch + i] * ckg[8 * fch + i] * (0.08838834764831845f * LOG2E);
    const float mq = wave_max(fmaxf(fabsf(cqg[lane]), fabsf(cqg[lane + 64]))), mk = wave_max(fmaxf(fabsf(ckg[lane]), fabsf(ckg[lane + 64])));
    const float m2 = 11.313708499f * mq * mk * LOG2E;
    for (int unit = bid; unit < 256; unit += G) {
        const int qh = unit & 1, hd = (unit >> 1) & 3, b = unit >> 3;
        __syncthreads();
        {   v4u kx[8], vx[8];
#pragma unroll
            for (int it = 0; it < 8; ++it) { const bf16* src = kvp + (size_t)(b * MEM + (tid >> 4) + 32 * it) * D + 128 * hd + 8 * fch; kx[it] = *(const GAS v4u*)src; vx[it] = *(const GAS v4u*)(src + 512); }
#pragma unroll
            for (int it = 0; it < 8; ++it) { const int row = (tid >> 4) + 32 * it;
                float k[8] = {blo(kx[it].x), bhi(kx[it].x), blo(kx[it].y), bhi(kx[it].y), blo(kx[it].z), bhi(kx[it].z), blo(kx[it].w), bhi(kx[it].w)};
                float ss = 0.f;
#pragma unroll
                for (int e = 0; e < 8; ++e) ss += k[e] * k[e];
                ss = row16_sum(ss);
                const float rstd = 1.0f / sqrtf(ss * (1.f / 128.f) + EPS);
                v4u ko; ko.x = cvtpk(k[0] * rstd * gg[0], k[1] * rstd * gg[1]); ko.y = cvtpk(k[2] * rstd * gg[2], k[3] * rstd * gg[3]);
                ko.z = cvtpk(k[4] * rstd * gg[4], k[5] * rstd * gg[5]); ko.w = cvtpk(k[6] * rstd * gg[6], k[7] * rstd * gg[7]);
                const unsigned o = off_b((unsigned)row, (unsigned)fch);
                *(LAS v4u*)(L + XA_K_OFF + o) = ko; *(LAS v4u*)(L + XA_V_OFF + o) = vx[it]; } }
        bf16* qrow0 = projp + (size_t)(b * SEQ + 1024 * qh + 32 * wave + r32) * LDP + C_QC + 128 * hd + 8 * h;
        v4u qn[8];
#pragma unroll
        for (int ks = 0; ks < 8; ++ks) qn[ks] = *(const GAS v4u*)(qrow0 + 16 * ks);
        __syncthreads();
#pragma unroll 1
        for (int qt = 0; qt < 4; ++qt) {
            bf16* qrow = qrow0 + (size_t)(256 * qt) * LDP;
            bf16x8 qf[8]; float ss = 0.f;
#pragma unroll
            for (int ks = 0; ks < 8; ++ks) { const v4u w = qn[ks]; qf[ks] = __builtin_bit_cast(bf16x8, w);
                ss += (blo(w.x) * blo(w.x) + bhi(w.x) * bhi(w.x)) + (blo(w.y) * blo(w.y) + bhi(w.y) * bhi(w.y)) + (blo(w.z) * blo(w.z) + bhi(w.z) * bhi(w.z)) + (blo(w.w) * blo(w.w) + bhi(w.w) * bhi(w.w)); }
            if (qt < 3) {
#pragma unroll
                for (int ks = 0; ks < 8; ++ks) qn[ks] = *(const GAS v4u*)(qrow + (size_t)256 * LDP + 16 * ks); }
            ss = xor32_sum(ss);
            const float rq = 1.0f / sqrtf(ss * (1.f / 128.f) + EPS);
            f32x16 o[4];
#pragma unroll
            for (int dt = 0; dt < 4; ++dt)
#pragma unroll
                for (int r = 0; r < 16; ++r) o[dt][r] = 0.f;
            float lsum = 0.f;
#pragma unroll 1
            for (int kt = 0; kt < 8; ++kt) {
                f32x16 s;
#pragma unroll
                for (int r = 0; r < 16; ++r) s[r] = 0.f;
#pragma unroll
                for (int ks = 0; ks < 8; ++ks) { const bf16x8 kf = *(const LAS bf16x8*)(L + XA_K_OFF + off_b((unsigned)(32 * kt + r32), (unsigned)(2 * ks + h))); s = ATT_MFMA(kf, qf[ks], s); }
                float p[16];
#pragma unroll
                for (int r = 0; r < 16; ++r) { p[r] = __builtin_amdgcn_exp2f(s[r] * rq - m2); lsum += p[r]; }
#pragma unroll
                for (int s2 = 0; s2 < 2; ++s2) {
                    const bf16x8 pb = pack8(p[8 * s2], p[8 * s2 + 1], p[8 * s2 + 2], p[8 * s2 + 3], p[8 * s2 + 4], p[8 * s2 + 5], p[8 * s2 + 6], p[8 * s2 + 7]);
                    const unsigned r0 = (unsigned)(32 * kt + 16 * s2 + 4 * h + q4);
#pragma unroll
                    for (int dt = 0; dt < 4; ++dt) {
                        const unsigned ch = (unsigned)(4 * dt + 2 * blk16 + (p4 >> 1));
                        const s16x4 lo = vtr(L + XA_V_OFF + off_b(r0, ch) + 8 * (p4 & 1)), hi = vtr(L + XA_V_OFF + off_b(r0 + 8u, ch) + 8 * (p4 & 1));
                        const bf16x8 vf = __builtin_shufflevector(lo, hi, 0, 1, 2, 3, 4, 5, 6, 7); o[dt] = ATT_MFMA(vf, pb, o[dt]); }
                }
            }
            const float inv = 1.0f / xor32_sum(lsum);
#pragma unroll
            for (int dt = 0; dt < 4; ++dt)
#pragma unroll
                for (int g4 = 0; g4 < 4; ++g4) { v2u w; w.x = cvtpk(o[dt][4 * g4] * inv, o[dt][4 * g4 + 1] * inv); w.y = cvtpk(o[dt][4 * g4 + 2] * inv, o[dt][4 * g4 + 3] * inv);
                    *(GAS v2u*)(qrow - 8 * h + 32 * dt + 8 * g4 + 4 * h) = w; }
        }
    }
}
}

constexpr int NPHASE = 11;
__global__ void __launch_bounds__(NTHR, 2) fwd(Args args) {
    extern __shared__ __attribute__((aligned(16))) unsigned char lds[];
    LAS unsigned char* L = (LAS unsigned char*)lds;
    volatile LAS unsigned* MISC = (volatile LAS unsigned*)(L + MISC_OFF);
    const int wave_s = __builtin_amdgcn_readfirstlane((int)threadIdx.x >> 6);
    for (int u = threadIdx.x; u < (LDS_BYTES - LDSCTL_OFF) / 4; u += NTHR) ((LAS unsigned*)(L + LDSCTL_OFF))[u] = 0u;
    __syncthreads();
#define LANE_ID ((int)__builtin_amdgcn_mbcnt_hi(~0u, __builtin_amdgcn_mbcnt_lo(~0u, 0u)))
#if MK_FUSED
    XcdBarrier bar = xcd_barrier_post((unsigned*)(args.ws + WS_CTL) + CW_BAR, MISC + 8, wave_s == 0 && LANE_ID == 0);
#define GRID_BAR() xcd_barrier(bar, wave_s == 0 && LANE_ID == 0)
#else
    (void)MISC;
#define GRID_BAR() do {} while (0)
#endif
    const int lo = args.ph_lo, hi = args.ph_hi;
#define IN(k) (lo <= (k) && (k) < hi)
#if PROBE_MASK
#define STAMP(k) do { if (blockIdx.x == 0 && wave_s == 0 && LANE_ID == 0) ((LAS unsigned*)(L + LDSCTL_OFF + 640))[(k) + 1] = (unsigned)__builtin_amdgcn_s_memrealtime(); } while (0)
#define STAMPX(i) do { if (blockIdx.x == 0 && wave_s == 0 && LANE_ID == 0) ((LAS unsigned*)(L + LDSCTL_OFF + 640))[16 + (i)] = (unsigned)__builtin_amdgcn_s_memrealtime(); } while (0)
#else
#define STAMP(k) do {} while (0)
#define STAMPX(i) do {} while (0)
#endif
#define SEAM(k) do { if (IN(k) && IN((k) + 1)) GRID_BAR(); STAMP(k); } while (0)
    STAMP(-1);
#define PV \
    int wave = wave_s; asm volatile("" : "+s"(wave)); int bid = blockIdx.x; asm volatile("" : "+s"(bid)); \
    const int lane = LANE_ID, tid = wave * 64 + lane; \
    const int G = gridDim.x, gw = bid * NWAVES + wave, NGW = G * NWAVES, gtid = bid * NTHR + tid, NT = G * NTHR; \
    GAS unsigned char* ws = (GAS unsigned char*)args.ws; asm volatile("" : "+s"(ws));     \
    gu32* ctl = (gu32*)(ws + WS_CTL); \
    LAS float* scr = (LAS float*)(L + RING_OFF + wave * 16384); \
    (void)lane; (void)tid; (void)bid; (void)gw; (void)NGW; (void)gtid; (void)NT; (void)ctl; (void)scr; (void)G;
#define Win_t ((bf16*)(ws + WS_WIN))
#define Wo_t ((bf16*)(ws + WS_WO))
#define Wmkv_t ((bf16*)(ws + WS_WMKV))
#define Wout_t ((bf16*)(ws + WS_WOUT))
#define Hb ((bf16*)(ws + WS_H))
#define proj ((bf16*)(ws + WS_PROJ))
#define memn ((bf16*)(ws + WS_MEMN))
#define kv ((bf16*)(ws + WS_KV))
#define rope ((float2*)(ws + WS_ROPE))
#define Wgu_t ((bf16*)(ws + WS_WGU))
#define Wd_t ((bf16*)(ws + WS_WD))
#define ybuf ((bf16*)(ws + WS_Y))
#define act ((bf16*)(ws + WS_ACT))
#define topk_idx ((int*)(ws + WS_META + MT_IDX))
#define topk_gate ((float*)(ws + WS_META + MT_GATE))
#define slot_of ((int*)(ws + WS_META + MT_SASG))
#define slot_tok ((int*)(ws + WS_META + MT_STOK))
#define slot_gate ((float*)(ws + WS_META + MT_SGATE))
#define tile_e ((int*)(ws + WS_META + MT_TILEE))
#define Wsb ((bf16*)(ws + WS_META + MT_WSB))
#define Cmat ((int*)(ws + WS_META + MT_CMAT))
#define Rwp ((float*)(ws + WS_META + MT_RWP))
#define rstd_tok ((float*)(ws + WS_META + MT_RSTD))
#define slot_rstd ((float*)(ws + WS_SRSTD))
#define X8 ((unsigned char*)(ws + WS_X8))
#define x1b ((bf16*)(ws + WS_X1B))

    if (IN(0)) { PV
        const float* x = args.in[I_X]; (void)x;
        {
            const float* Wi = args.in[I_WIN]; const float* Wa = args.in[I_WOA]; const float* Wb = args.in[I_WOB]; const float* Wc = args.in[I_WOC]; const float* Wm = args.in[I_WMKV]; const float* Wu = args.in[I_WOUT];
            bf16* Oi = Win_t; bf16* Oo = Wo_t; bf16* Om = Wmkv_t; bf16* Ou = Wout_t;
            constexpr int N0 = (D / 64) * (DIN / 32), N1 = N0 + 16 * 32, N2 = N1 + 8 * 32, N3 = N2 + 8 * 32, N4 = N3 + 16 * 32, N5 = N4 + 16 * 32;
            tr_range(N5, [=](int it) {
                if (it < N0) { const int kb = it / (DIN / 32), rb = it % (DIN / 32); return TrItem{Wi, DIN, 64 * kb, win_srccol(32 * rb), Oi, D, 32 * rb, 0, nullptr}; }
                if (it < N1) { const int r = it - N0; return TrItem{Wa, D, 64 * (r >> 5), 32 * (r & 31), Oo, 2048, 32 * (r & 31), 0, nullptr}; }
                if (it < N2) { const int r = it - N1; return TrItem{Wb, D, 64 * (r >> 5), 32 * (r & 31), Oo, 2048, 32 * (r & 31), 1024, nullptr}; }
                if (it < N3) { const int r = it - N2; return TrItem{Wc, D, 64 * (r >> 5), 32 * (r & 31), Oo, 2048, 32 * (r & 31), 1536, nullptr}; }
                if (it < N4) { const int r = it - N3; return TrItem{Wm, D, 64 * (r >> 5), 32 * (r & 31), Om, D, 32 * (r & 31), 0, nullptr}; }
                const int r = it - N4; return TrItem{Wu, D, 64 * (r >> 5), 32 * (r & 31), Ou, D, 32 * (r & 31), 0, nullptr}; }, gw, NGW, scr, lane);
        }
        STAMPX(8);
        for (int i = gtid; i < D * 32; i += NT) { const int k = i >> 5, e = i & 31; Rwp[(k >> 2) * 128 + e * 4 + (k & 3)] = args.in[I_FFN_G][k] * args.in[I_RW][i]; }
        { const int* pos = (const int*)args.in[I_POS];
          for (int i = gtid; i < T * 32; i += NT) { const int t = i >> 5, f = i & 31;
              const float inv = powf(10000.0f, -(float)(2 * f) / 64.0f); const float ang = (float)pos[t] * inv;
              float sn, cs; sincosf(ang, &sn, &cs); rope[i] = make_float2(cs, sn); } }
        for (int i = gtid; i < 4 * 128 * 128; i += NT) { const int tt = (i >> 7) & 127, sp = i & 127; Wsb[i] = (bf16)(sp <= tt ? f2bf(args.in[I_WS][i]) : 0u); }
        STAMPX(9);
        {
            f32x4 gg[4];
#pragma unroll
            for (int j = 0; j < 4; ++j) gg[j] = *((const GAS f32x4*)args.in[I_ATTN_G] + lane + 64 * j);
            f32x4 va[16], vb[16];
            int m = gw;
            if (m < T / 4) { const GAS f32x4* xr = (const GAS f32x4*)(x + (size_t)m * 4 * D) + lane;
#pragma unroll
                for (int j = 0; j < 16; ++j) va[j] = xr[64 * j]; }
#define ROWS4_FINISH(v, mm) do { float s_[4]; \
                _Pragma("unroll") for (int r = 0; r < 4; ++r) { float a_ = 0.f; \
                    _Pragma("unroll") for (int j = 0; j < 4; ++j) a_ += (v[4 * r + j].x * v[4 * r + j].x + v[4 * r + j].y * v[4 * r + j].y) + (v[4 * r + j].z * v[4 * r + j].z + v[4 * r + j].w * v[4 * r + j].w); \
                    s_[r] = row16_sum(a_); } \
                _Pragma("unroll") for (int r = 0; r < 4; ++r) s_[r] = xor32_sum(xor16_sum(s_[r])); \
                GAS v2u* o8_ = (GAS v2u*)(Hb + (size_t)(mm) * 4 * D) + lane; \
                _Pragma("unroll") for (int r = 0; r < 4; ++r) { const float rs_ = 1.0f / sqrtf(s_[r] * (1.f / 1024.f) + EPS); \
                    _Pragma("unroll") for (int j = 0; j < 4; ++j) { const f32x4 a_ = v[4 * r + j]; \
                        v2u o_; o_.x = pk2(a_.x * rs_ * gg[j].x, a_.y * rs_ * gg[j].y); o_.y = pk2(a_.z * rs_ * gg[j].z, a_.w * rs_ * gg[j].w); o8_[256 * r + 64 * j] = o_; } } } while (0)
            for (; m < T / 4; m += 2 * NGW) {
                const int m2 = m + NGW; const bool two = m2 < T / 4;
                if (two) { const GAS f32x4* xr = (const GAS f32x4*)(x + (size_t)m2 * 4 * D) + lane;
#pragma unroll
                    for (int j = 0; j < 16; ++j) vb[j] = xr[64 * j]; }
                ROWS4_FINISH(va, m);
                const int m3 = m + 2 * NGW;
                if (m3 < T / 4) { const GAS f32x4* xr = (const GAS f32x4*)(x + (size_t)m3 * 4 * D) + lane;
#pragma unroll
                    for (int j = 0; j < 16; ++j) va[j] = xr[64 * j]; }
                if (two) ROWS4_FINISH(vb, m2);
            }
#undef ROWS4_FINISH
        }
        STAMPX(10);
        for (int m = gw; m < TM; m += NGW) rms_row_to_bf16(args.in[I_MEM] + (size_t)m * D, args.in[I_MEM_G], memn + (size_t)m * D, lane);
    }
    SEAM(0);
    if (IN(1)) { PV
        { pg8::Gemm g{Hb, Win_t, D, D, D}; pg8::StaticOrder S; S.init(T, DIN, G, bid);
          pg8::EpiProj E{proj, LDP, (const float*)rope, args.in[I_AQG], args.in[I_AKG], args.in[I_BGATES], EPS, C_Q, C_K, C_V, C_G};
          pg8::gemm_phase<pg8::EpiProj, pg8::StaticOrder>(L + RING_OFF, g, S, E, wave); }
        { pg8::Gemm g{memn, Wmkv_t, D, D, D}; pg8::StaticOrder S; S.init(TM, D, G, bid); pg8::EpiBf16 E{kv, D};
          pg8::gemm_phase<pg8::EpiBf16, pg8::StaticOrder>(L + RING_OFF, g, S, E, wave); }
    }
    if (IN(1) && IN(3)) GRID_BAR();
    STAMP(1); STAMP(2);
    if (IN(3)) { PV
        STAMPX(4);
        att::swa_phase(L + RING_OFF, proj, args.in[I_SINKS], args.in[I_AQG], args.in[I_AKG], bid, G, wave, lane);
        __syncthreads();
        STAMPX(5);
        att::gmlp_phase(L + RING_OFF, proj, Wsb, args.in[I_LNG], args.in[I_LNB], args.in[I_BS], bid, G, wave, lane);
        __syncthreads();
        STAMPX(6);
        att::xattn_phase(L + RING_OFF, proj, kv, args.in[I_CQG], args.in[I_CKG], bid, G, wave, lane);
        __syncthreads();
    }
    SEAM(3);
    if (IN(4)) { PV
        pg8::StaticOrder S; S.init(T, D, G, bid);
        pg8::Gemm g{proj + C_Q, Wo_t, 2048, LDP, 2048}; pg8::EpiMergeK E{Hb, D, (const unsigned char*)(proj + C_G), LDP * 2};
        pg8::gemm_phase<pg8::EpiMergeK, pg8::StaticOrder>(L + RING_OFF, g, S, E, wave);
    }
    SEAM(4);
    if (IN(5)) { PV
        const float* x = args.in[I_X];
        pg8::Gemm g{Hb, Wout_t, D, D, D}; pg8::StaticOrder S; S.init(T, D, G, bid); pg8::EpiResF32 E{x1b, x, X8, D};
        pg8::gemm_phase<pg8::EpiResF32, pg8::StaticOrder>(L + RING_OFF, g, S, E, wave);
    }
    SEAM(5);
    if (IN(6)) { PV
        const float* rb = args.in[I_RB]; const float* fg = args.in[I_FFN_G];
        LAS unsigned* hist = (LAS unsigned*)(L + LDSCTL_OFF + 512);
        const int r32 = lane & 31, hh = lane >> 5;
        STAMPX(0);
        for (int i = tid; i < 8192; i += NTHR) *(LAS f32x4*)(L + RING_OFF + i * 16) = *(const GAS f32x4*)(Rwp + 4 * i);
        for (int vb = bid; vb < T / 256; vb += G) {
            __syncthreads();
            if (tid < 32) hist[tid] = 0u;
            __syncthreads();
            const int tok0 = vb * 256 + wave * 32;
            att::f32x16 acc;
#pragma unroll
            for (int r = 0; r < 16; ++r) acc[r] = 0.f;
            float ss = 0.f;
            const bf16* xp = x1b + (size_t)(tok0 + r32) * D + 16 * hh;
            const LAS unsigned char* wl = L + RING_OFF + (4 * hh) * 512 + r32 * 16;
#define RT_LOAD(xs, it) do { _Pragma("unroll") for (int q = 0; q < 4; ++q) xs[q] = *(const GAS v2u*)(xp + 32 * (it) + 4 * q); } while (0)
#define RT_COMP(xs, it) do { _Pragma("unroll") for (int q = 0; q < 4; ++q) { const f32x4 wa = *(const LAS f32x4*)(wl + (8 * (it) + q) * 512); \
                    const f32x4 xv = (f32x4){blo(xs[q].x), bhi(xs[q].x), blo(xs[q].y), bhi(xs[q].y)}; \
                    ss += (xv.x * xv.x + xv.y * xv.y) + (xv.z * xv.z + xv.w * xv.w); \
                    acc = __builtin_amdgcn_mfma_f32_32x32x2f32(wa.x, xv.x, acc, 0, 0, 0); acc = __builtin_amdgcn_mfma_f32_32x32x2f32(wa.y, xv.y, acc, 0, 0, 0); \
                    acc = __builtin_amdgcn_mfma_f32_32x32x2f32(wa.z, xv.z, acc, 0, 0, 0); acc = __builtin_amdgcn_mfma_f32_32x32x2f32(wa.w, xv.w, acc, 0, 0, 0); } } while (0)
            v2u x0[4], x1[4], x2[4];
            RT_LOAD(x0, 0); RT_LOAD(x1, 1);
#pragma unroll 1
            for (int it = 0; it < 30; it += 3) {
                RT_LOAD(x2, it + 2); RT_COMP(x0, it);
                RT_LOAD(x0, it + 3); RT_COMP(x1, it + 1);
                RT_LOAD(x1, it + 4); RT_COMP(x2, it + 2);
            }
            RT_COMP(x0, 30); RT_COMP(x1, 31);
#undef RT_LOAD
#undef RT_COMP
            ss = xor32_sum(ss);
            const float rstd = 1.0f / sqrtf(ss * (1.f / 1024.f) + EPS);
            float v[16];
#pragma unroll
            for (int r = 0; r < 16; ++r) v[r] = acc[r] * rstd + rb[att::crow(r, hh)];
            float cv[8]; int ci[8];
#pragma unroll
            for (int k = 0; k < 4; ++k) { float best = -INFINITY; int bi = 99;
#pragma unroll
                for (int r = 0; r < 16; ++r) if (v[r] > best) { best = v[r]; bi = att::crow(r, hh); }
                cv[k] = best; ci[k] = bi;
#pragma unroll
                for (int r = 0; r < 16; ++r) v[r] = (att::crow(r, hh) == bi) ? -INFINITY : v[r]; }
#pragma unroll
            for (int k = 0; k < 4; ++k) { cv[4 + k] = __builtin_bit_cast(float, xor32_get(__builtin_bit_cast(unsigned, cv[k]), hh != 0)); ci[4 + k] = (int)xor32_get((unsigned)ci[k], hh != 0); }
            float bv[4]; int be[4];
#pragma unroll
            for (int k = 0; k < 4; ++k) { float best = -INFINITY; int bi = 99;
#pragma unroll
                for (int c = 0; c < 8; ++c) if (cv[c] > best || (cv[c] == best && ci[c] < bi)) { best = cv[c]; bi = ci[c]; }
                bv[k] = best; be[k] = bi;
#pragma unroll
                for (int c = 0; c < 8; ++c) cv[c] = (ci[c] == bi) ? -INFINITY : cv[c]; }
            const float p1 = expf(bv[1] - bv[0]), p2 = expf(bv[2] - bv[0]), p3 = expf(bv[3] - bv[0]); const float inv = 1.0f / (1.0f + p1 + p2 + p3);
            if (hh == 0) {
                int4 iw; float4 gw4;
                iw.x = be[0] | (int)(__hip_atomic_fetch_add(hist + be[0], 1u, __ATOMIC_RELAXED, __HIP_MEMORY_SCOPE_WORKGROUP) << 8);
                iw.y = be[1] | (int)(__hip_atomic_fetch_add(hist + be[1], 1u, __ATOMIC_RELAXED, __HIP_MEMORY_SCOPE_WORKGROUP) << 8);
                iw.z = be[2] | (int)(__hip_atomic_fetch_add(hist + be[2], 1u, __ATOMIC_RELAXED, __HIP_MEMORY_SCOPE_WORKGROUP) << 8);
                iw.w = be[3] | (int)(__hip_atomic_fetch_add(hist + be[3], 1u, __ATOMIC_RELAXED, __HIP_MEMORY_SCOPE_WORKGROUP) << 8);
                gw4.x = inv; gw4.y = p1 * inv; gw4.z = p2 * inv; gw4.w = p3 * inv;
                *(int4*)(topk_idx + (size_t)(tok0 + r32) * 4) = iw; *(float4*)(topk_gate + (size_t)(tok0 + r32) * 4) = gw4; }
            if (hh == 0) rstd_tok[tok0 + r32] = rstd;
            if (vb == 0) STAMPX(3);
            __syncthreads();
            if (tid < 32) Cmat[vb * 32 + tid] = (int)hist[tid];
        }
        STAMPX(1);
        { const float* W = args.in[I_WGU]; unsigned char* O = (unsigned char*)Wgu_t; constexpr int nrb = 2048 / 32, per = (D / 64) * nrb;
          tr_range8(NEXP * per, [=](int it) { const int e = it / per, r0 = it % per, kb = r0 / nrb, rb2 = r0 % nrb; const int r = 32 * rb2, j = r >> 8, rr = r & 255;
              const int sc = rr < 128 ? 128 * j + rr : 1024 + 128 * j + (rr - 128);
              return TrItem{W + (size_t)e * D * 2048, 2048, 64 * kb, sc, (bf16*)(O + (size_t)e * 2048 * D), D, r, 0, fg}; }, gw, NGW, scr, lane, WSCALE); }
        STAMPX(2);
        { const float* W = args.in[I_WD]; unsigned char* O = (unsigned char*)Wd_t; constexpr int nrb = D / 32, per = (D / 64) * nrb;
          tr_range8(NEXP * per, [=](int it) { const int e = it / per, r0 = it % per, kb = r0 / nrb, rb2 = r0 % nrb;
              return TrItem{W + (size_t)e * D * D, D, 64 * kb, 32 * rb2, (bf16*)(O + (size_t)e * D * D), D, 32 * rb2, 0, nullptr}; }, gw, NGW, scr, lane, WSCALE); }
    }
    SEAM(6);
    if (IN(7)) { PV
        LAS int* psum = (LAS int*)(L + RING_OFF);
        LAS int* tot = psum + 512;
        LAS int* startv = tot + 32;
        LAS int* basev = startv + 32;
        LAS int* ntl = basev + 32;
        for (int vb = bid; vb < T / 256; vb += G) {
            __syncthreads();
            { const int e = tid & 31, part = tid >> 5; int ps = 0;
#pragma unroll 4
              for (int i = 0; i < 16; ++i) ps += Cmat[(part * 16 + i) * 32 + e];
              psum[part * 32 + e] = ps; }
            __syncthreads();
            if (tid < 32) { int tt = 0;
#pragma unroll
                for (int p = 0; p < 16; ++p) tt += psum[p * 32 + tid];
                tot[tid] = tt; }
            __syncthreads();
            if (tid == 0) { int row = 0; for (int e = 0; e < 32; ++e) { startv[e] = row; row += (tot[e] + 255) & ~255; } ntl[0] = row >> 8; }
            __syncthreads();
            const int part = vb >> 4;
            if (tid < 32) { int bs = startv[tid];
                for (int p = 0; p < part; ++p) bs += psum[p * 32 + tid];
                for (int v2 = part * 16; v2 < vb; ++v2) bs += Cmat[v2 * 32 + tid];
                basev[tid] = bs; }
            __syncthreads();
            for (int i = tid; i < 1024; i += NTHR) { const int a = vb * 1024 + i; const int v = topk_idx[a]; const int e = v & 255, rank = v >> 8;
                const int slot = basev[e] + rank;
                slot_tok[slot] = a >> 2; slot_of[a] = slot; slot_rstd[slot] = rstd_tok[a >> 2]; }
            if (vb < 32) { const int e = vb; const int t0 = tot[e], st = startv[e], pd = ((t0 + 255) & ~255) - t0;
                if (tid < pd) { slot_tok[st + t0 + tid] = -1; slot_rstd[st + t0 + tid] = 0.f; } }
            if (vb == 32) {
                if (tid < 32) { const int nt = (tot[tid] + 255) >> 8, first = startv[tid] >> 8; for (int i = 0; i < nt; ++i) tile_e[first + i] = tid; }
                if (tid == 0) ((unsigned*)(ctl + CW_NTILE))[0] = (unsigned)ntl[0]; }
        }
    }
    SEAM(7);
#define NTILE_ALL ((int)__hip_atomic_load((unsigned*)(ctl + CW_NTILE), RLX_AGENT))
    if (IN(8)) { PV const int ntile = NTILE_ALL;
        pg8::Gemm g{(const bf16*)X8, Wgu_t, D / 2, D / 2, D / 2};
        pg8::GroupedOrder S{tile_e, ntile, 8, G, bid}; pg8::EpiSwiglu8 E{(unsigned char*)act, args.in[I_BGU], slot_rstd, 1.0f / WSCALE};
        pg8::gemm_phase_gather<pg8::EpiSwiglu8, pg8::GroupedOrder, true>(L + RING_OFF, g, S, E, wave, slot_tok);
    }
    SEAM(8);
    if (IN(9)) { PV const int ntile = NTILE_ALL;
        pg8::Gemm g{act, Wd_t, D / 2, D / 2, D / 2}; pg8::GroupedOrder S{tile_e, ntile, 4, G, bid}; static_assert(YSCALE == 16.0f, "EpiDown scales the bias by 16"); pg8::EpiDown E{(unsigned char*)ybuf, args.in[I_BD], YSCALE / WSCALE};
        pg8::gemm_phase<pg8::EpiDown, pg8::GroupedOrder, true>(L + RING_OFF, g, S, E, wave);
    }
    SEAM(9);
    if (IN(10)) { PV
        typedef float f2t __attribute__((ext_vector_type(2)));
        int4 sl = *(const int4*)(slot_of + (size_t)gw * 4); float4 gt = *(const float4*)(topk_gate + (size_t)gw * 4);
        for (int t = gw; t < T; t += NGW) {
            GAS f32x4* op = (GAS f32x4*)(args.out + (size_t)t * D) + lane;
            const GAS v2u* xq = (const GAS v2u*)(x1b + (size_t)t * D) + lane;
            const unsigned char* yb = (const unsigned char*)ybuf + 4 * lane;
            f32x4 o[4]; unsigned ya[4][4];
#pragma unroll
            for (int j = 0; j < 4; ++j) { const v2u xw = xq[64 * j]; o[j] = (f32x4){blo(xw.x), bhi(xw.x), blo(xw.y), bhi(xw.y)};
                ya[0][j] = *(const GAS unsigned*)(yb + (size_t)sl.x * D + 256 * j); ya[1][j] = *(const GAS unsigned*)(yb + (size_t)sl.y * D + 256 * j);
                ya[2][j] = *(const GAS unsigned*)(yb + (size_t)sl.z * D + 256 * j); ya[3][j] = *(const GAS unsigned*)(yb + (size_t)sl.w * D + 256 * j); }
            const float g0 = gt.x * (1.0f / YSCALE), g1 = gt.y * (1.0f / YSCALE), g2 = gt.z * (1.0f / YSCALE), g3 = gt.w * (1.0f / YSCALE);
            if (t + NGW < T) { sl = *(const int4*)(slot_of + (size_t)(t + NGW) * 4); gt = *(const float4*)(topk_gate + (size_t)(t + NGW) * 4); }
#pragma unroll
            for (int j = 0; j < 4; ++j) {
                const f2t l0 = __builtin_amdgcn_cvt_pk_f32_fp8((int)ya[0][j], false), h0 = __builtin_amdgcn_cvt_pk_f32_fp8((int)ya[0][j], true);
                const f2t l1 = __builtin_amdgcn_cvt_pk_f32_fp8((int)ya[1][j], false), h1 = __builtin_amdgcn_cvt_pk_f32_fp8((int)ya[1][j], true);
                const f2t l2 = __builtin_amdgcn_cvt_pk_f32_fp8((int)ya[2][j], false), h2 = __builtin_amdgcn_cvt_pk_f32_fp8((int)ya[2][j], true);
                const f2t l3 = __builtin_amdgcn_cvt_pk_f32_fp8((int)ya[3][j], false), h3 = __builtin_amdgcn_cvt_pk_f32_fp8((int)ya[3][j], true);
                const f2t lo = ((l0 * g0 + l1 * g1) + l2 * g2) + l3 * g3, hi = ((h0 * g0 + h1 * g1) + h2 * g2) + h3 * g3;
                o[j].x += lo.x; o[j].y += lo.y; o[j].z += hi.x; o[j].w += hi.y;
                op[64 * j] = o[j]; }
        }
    }
#if PROBE_MASK
    __syncthreads(); STAMP(10);
    if (blockIdx.x == 0 && wave_s == 0 && LANE_ID == 0) { const LAS unsigned* st = (const LAS unsigned*)(L + LDSCTL_OFF + 640); unsigned d = 0;
        for (int k = 0; k < NPHASE; ++k) if ((PROBE_MASK >> k) & 1) d += st[k + 1] - st[k];
        if (PROBE_SUBA >= 0) d = st[16 + PROBE_SUBB] - st[16 + PROBE_SUBA];
        const unsigned long long t0 = __builtin_amdgcn_s_memrealtime(); while (__builtin_amdgcn_s_memrealtime() - t0 < (unsigned long long)d * PROBE_AMP) __builtin_amdgcn_s_sleep(16); }
#endif
#undef IN
#undef SEAM
}

extern "C" void kernel_launch(void* const* d_in, const int* in_sizes, int n_in, void* d_out, int out_size, void* d_ws, size_t ws_size, hipStream_t stream) {
    static int grid = 0;
    if (grid == 0) {
        if (n_in != 28 || out_size != T * D || ws_size < WS_END) { fprintf(stderr, "kernel_launch: unexpected shapes: n_in %d out %d ws %zu (need %zu)\n", n_in, out_size, ws_size, (size_t)WS_END); grid = -1; return; }
        int dev = 0, cus = 0, per_cu = 0;
        if (hipGetDevice(&dev) != hipSuccess || hipDeviceGetAttribute(&cus, hipDeviceAttributeMultiprocessorCount, dev) != hipSuccess) { grid = -1; return; }
        if (hipFuncSetAttribute((const void*)fwd, hipFuncAttributeMaxDynamicSharedMemorySize, LDS_BYTES) != hipSuccess) { fprintf(stderr, "kernel_launch: hipFuncSetAttribute failed\n"); grid = -1; return; }
        if (hipOccupancyMaxActiveBlocksPerMultiprocessor(&per_cu, (const void*)fwd, NTHR, LDS_BYTES) != hipSuccess || per_cu < 1) { fprintf(stderr, "kernel_launch: occupancy query says %d\n", per_cu); }
        (void)hipGetLastError();
        grid = cus;
    }
    if (grid < 0) return;
    if (hipMemsetAsync((char*)d_ws + WS_CTL, 0, CTL_ZERO_BYTES, stream) != hipSuccess) { fprintf(stderr, "kernel_launch: memset failed\n"); return; }
    Args a{};
    for (int i = 0; i < 28; ++i) a.in[i] = (const float*)d_in[i];
    a.out = (float*)d_out; a.ws = (unsigned char*)d_ws;
#if MK_FUSED
    a.ph_lo = 0; a.ph_hi = NPHASE;
    hipLaunchKernelGGL(fwd, dim3(grid), dim3(NTHR), LDS_BYTES, stream, a);
#else
    for (int p = 0; p < NPHASE; ++p) { a.ph_lo = p; a.ph_hi = p + 1; hipLaunchKernelGGL(fwd, dim3(grid), dim3(NTHR), LDS_BYTES, stream, a); }
#endif
    const hipError_t le = hipPeekAtLastError();
    if (le != hipSuccess) fprintf(stderr, "kernel_launch: launch failed: %s\n", hipGetErrorName(le));
}
```

```cpp
#include <hip/hip_runtime.h>
#include <cstdio>
#include <cstdint>

#ifndef MK_FUSED
#define MK_FUSED 1
#endif
#ifndef PROBE_MASK
#define PROBE_MASK 0
#endif
#ifndef PROBE_AMP
#define PROBE_AMP 4
#endif
#ifndef PROBE_SUBA
#define PROBE_SUBA -1
#endif
#ifndef PROBE_SUBB
#define PROBE_SUBB -1
#endif

__device__ __forceinline__ float xor16_sum(float v) { float a = v, b = v; asm("s_nop 1\n\tv_permlane16_swap_b32 %0, %1" : "+v"(a), "+v"(b)); return a + b; }
__device__ __forceinline__ float xor32_sum(float v) { float a = v, b = v; asm("s_nop 1\n\tv_permlane32_swap_b32 %0, %1" : "+v"(a), "+v"(b)); return a + b; }
__device__ __forceinline__ unsigned xor32_get(unsigned v, bool upper) { unsigned a = v, b = v; asm("s_nop 1\n\tv_permlane32_swap_b32 %0, %1" : "+v"(a), "+v"(b)); return upper ? a : b; }
namespace pg8 {
#define PG8_LAS __attribute__((address_space(3)))
typedef unsigned short bf16_t;
typedef short bf16x8 __attribute__((ext_vector_type(8)));
typedef float f32x4 __attribute__((ext_vector_type(4)));
typedef unsigned u32x4 __attribute__((ext_vector_type(4)));
typedef float f32x2 __attribute__((ext_vector_type(2)));
constexpr int BM = 256, BK = 64, HALF = 128, HTB = HALF * BK * 2, STAGE_BYTES = 8 * HTB, NXCD = 8, WGM = 8;

__host__ __device__ __forceinline__ int lds_byte(int r, int c) { const int st = (r >> 4) * 2 + (c >> 5), rr = r & 15, cc = c & 31, ob = rr * 64 + cc * 2; return st * 1024 + (ob ^ (((ob >> 9) & 1) << 5)); }
__host__ __device__ __forceinline__ void stage_rc(int b, int& R, int& C) { const int st = b / 1024, sb = b % 1024, swz = sb ^ (((sb >> 9) & 1) << 5); R = (st >> 1) * 16 + swz / 64; C = (st & 1) * 32 + (swz % 64) / 2; }
__host__ __device__ __forceinline__ int perm32(int rho) { const int n = rho >> 4, i = rho & 15; return 8 * (i >> 2) + 4 * n + (i & 3); }

struct Unit { int pm, pn; };
struct Gemm { const bf16_t* A; const bf16_t* Bt; int K, lda, ldb; };

struct StaticOrder {
    int nM, nN, nwg, G, c;
    __host__ __device__ void init(int M, int N, int G_, int c_) { nM = M / BM; nN = N / BM; nwg = nM * nN; G = G_; c = c_; }
    __host__ __device__ bool next(int i, Unit& u) const {
        const long L = (long)i * G + c; if (L >= nwg) return false;
        int wgid = (int)L; { const int q = nwg / NXCD, r = nwg % NXCD, xcd = wgid % NXCD, off = wgid / NXCD; wgid = (xcd < r ? xcd * (q + 1) : r * (q + 1) + (xcd - r) * q) + off; }
        const int nig = WGM * nN, gid = wgid / nig, fm = gid * WGM, gsz = (nM - fm) < WGM ? (nM - fm) : WGM;
        u.pm = fm + ((wgid % nig) % gsz); u.pn = (wgid % nig) / gsz; return true;
    }
};
struct GroupedOrder {
    const int* tile_e; int ntile, nN, G, c;
    __device__ bool next(int i, Unit& u) const {
        if ((G & 7) == 0) {
            const int x = c & 7, k = c >> 3, per = G >> 3;
            const unsigned q = (unsigned)i * (unsigned)per + (unsigned)k;
            const int tl = (int)(q / (unsigned)nN), j = (int)(q % (unsigned)nN), tile = tl * 8 + x;
            if (tile >= ntile) return false;
            u.pm = tile; u.pn = tile_e[tile] * nN + j; return true;
        }
        const unsigned L = (unsigned)i * (unsigned)G + (unsigned)c; if (L >= (unsigned)(ntile * nN)) return false;
        const int tile = (int)(L / (unsigned)nN), j = (int)(L % (unsigned)nN);
        u.pm = tile; u.pn = tile_e[tile] * nN + j; return true;
    }
};
typedef int v8i __attribute__((ext_vector_type(8)));
typedef int v4i __attribute__((ext_vector_type(4)));
__device__ __forceinline__ v8i cat8(bf16x8 lo, bf16x8 hi) { return __builtin_shufflevector(__builtin_bit_cast(v4i, lo), __builtin_bit_cast(v4i, hi), 0, 1, 2, 3, 4, 5, 6, 7); }
__device__ __forceinline__ bf16x8 lo8(v8i v) { return __builtin_bit_cast(bf16x8, (v4i)__builtin_shufflevector(v, v, 0, 1, 2, 3)); }
__device__ __forceinline__ bf16x8 hi8(v8i v) { return __builtin_bit_cast(bf16x8, (v4i)__builtin_shufflevector(v, v, 4, 5, 6, 7)); }
__device__ __forceinline__ unsigned cvt_pk_bf16(float lo, float hi) { unsigned r; asm volatile("v_cvt_pk_bf16_f32 %0, %1, %2" : "=v"(r) : "v"(lo), "v"(hi)); return r; }
__device__ __forceinline__ float bflo(unsigned w) { return __uint_as_float(w << 16); }
__device__ __forceinline__ float bfhi(unsigned w) { return __uint_as_float(w & 0xffff0000u); }


struct EpiBf16 {
    static constexpr bool PERM = true, HAS_MID = false;
    bf16_t* O; int ldc;
    __device__ __forceinline__ void operator()(const f32x4 (&acc)[2][2][4][2], const Unit& u, int wr, int wc, int fr, int fq) const {
        const int row0 = u.pm * BM + wr * 64 + fr, col0 = u.pn * BM + wc * 32 + 8 * fq;
#pragma unroll
        for (int ai = 0; ai < 2; ++ai)
#pragma unroll
            for (int m = 0; m < 4; ++m) { bf16_t* rowp = O + (size_t)(row0 + ai * HALF + m * 16) * ldc + col0;
#pragma unroll
                for (int bj = 0; bj < 2; ++bj) { const f32x4 v0 = acc[ai][bj][m][0], v1 = acc[ai][bj][m][1];
                    u32x4 w; w.x = cvt_pk_bf16(v0[0], v0[1]); w.y = cvt_pk_bf16(v0[2], v0[3]); w.z = cvt_pk_bf16(v1[0], v1[1]); w.w = cvt_pk_bf16(v1[2], v1[3]);
                    *(u32x4*)(rowp + bj * HALF) = w; } }
    }
};
__device__ __forceinline__ f32x2 gelu_pk(f32x2 v) {
    const f32x2 av = __builtin_elementwise_abs(v), d = av * 0.2316418882f + 1.0f;
    f32x2 t; t.x = __builtin_amdgcn_rcpf(d.x); t.y = __builtin_amdgcn_rcpf(d.y);
    f32x2 q = t * 0.5307027145f + (-0.7265760135f); q = q * t + 0.7107068705f; q = q * t + (-0.142248368f); q = q * t + 0.127414796f; q = q * t;
    const f32x2 s = (v * v) * (-0.72134752044f);
    f32x2 e; e.x = __builtin_amdgcn_exp2f(s.x); e.y = __builtin_amdgcn_exp2f(s.y);
    const f32x2 m = v * (q * e), r = v - m;
    f32x2 o; o.x = v.x < 0.f ? m.x : r.x; o.y = v.y < 0.f ? m.y : r.y; return o;
}
struct EpiProj {
    static constexpr bool PERM = true, HAS_MID = false;
    bf16_t* __restrict__ P; int ldp; const float* __restrict__ rope; const float* __restrict__ gq; const float* __restrict__ gk; const float* __restrict__ bgates; float eps;
    int c_q, c_k, c_v, c_g;
    __device__ __forceinline__ void operator()(const f32x4 (&acc)[2][2][4][2], const Unit& u, int wr, int wc, int fr, int fq) const {
        const int pn = u.pn, row0 = u.pm * BM + wr * 64 + fr;
        if (pn < 4 || pn == 8) {
            const bool isq = pn < 4, isv = (!isq) && (wc & 1);
            const int colbase = (isq ? c_q + 64 * (4 * pn + wc) : (isv ? c_v : c_k) + 64 * (wc >> 1)) + 8 * fq;
            if (isv) {
#pragma unroll
                for (int ai = 0; ai < 2; ++ai)
#pragma unroll
                    for (int m = 0; m < 4; ++m) { bf16_t* rowp = P + (size_t)(row0 + ai * HALF + m * 16) * ldp + colbase;
#pragma unroll
                        for (int bj = 0; bj < 2; ++bj) { const f32x4 v0 = acc[ai][bj][m][0], v1 = acc[ai][bj][m][1];
                            u32x4 w; w.x = cvt_pk_bf16(v0[0], v0[1]); w.y = cvt_pk_bf16(v0[2], v0[3]); w.z = cvt_pk_bf16(v1[0], v1[1]); w.w = cvt_pk_bf16(v1[2], v1[3]);
                            *(u32x4*)(rowp + 32 * bj) = w; } }
            } else {
                const float* gn = (isq ? gq : gk) + 8 * fq;
                const f32x4 ga0 = *(const f32x4*)gn, ga1 = *(const f32x4*)(gn + 4), gb0 = *(const f32x4*)(gn + 32), gb1 = *(const f32x4*)(gn + 36);
#pragma unroll
                for (int am = 0; am < 4; ++am) { const int ai = am >> 1;
                    f32x4 cs[4][4];
#pragma unroll
                    for (int m2 = 0; m2 < 2; ++m2) { const int m = (am & 1) * 2 + m2; const float* rp = rope + ((size_t)(row0 + ai * HALF + m * 16) * 32 + 8 * fq) * 2;
                        cs[m][0] = *(const f32x4*)rp; cs[m][1] = *(const f32x4*)(rp + 4); cs[m][2] = *(const f32x4*)(rp + 8); cs[m][3] = *(const f32x4*)(rp + 12); }
#pragma unroll
                    for (int m2 = 0; m2 < 2; ++m2) { const int m = (am & 1) * 2 + m2;
                        const int r = row0 + ai * HALF + m * 16;
                        const f32x4 x10 = acc[ai][0][m][0], x11 = acc[ai][0][m][1], x20 = acc[ai][1][m][0], x21 = acc[ai][1][m][1];
                        float ss = ((x10[0] * x10[0] + x10[1] * x10[1]) + (x10[2] * x10[2] + x10[3] * x10[3])) + ((x11[0] * x11[0] + x11[1] * x11[1]) + (x11[2] * x11[2] + x11[3] * x11[3]))
                                 + ((x20[0] * x20[0] + x20[1] * x20[1]) + (x20[2] * x20[2] + x20[3] * x20[3])) + ((x21[0] * x21[0] + x21[1] * x21[1]) + (x21[2] * x21[2] + x21[3] * x21[3]));
                        ss = xor32_sum(xor16_sum(ss));
                        const float rstd = 1.0f / sqrtf(ss * (1.f / 64.f) + eps);
                        const f32x4 cs0 = cs[m][0], cs1 = cs[m][1], cs2 = cs[m][2], cs3 = cs[m][3];
                        const f32x4 y10 = x10 * ga0 * rstd, y11 = x11 * ga1 * rstd, y20 = x20 * gb0 * rstd, y21 = x21 * gb1 * rstd;
                        float o1[8], o2[8];
                        o1[0] = y10[0] * cs0[0] - y20[0] * cs0[1]; o2[0] = y20[0] * cs0[0] + y10[0] * cs0[1];
                        o1[1] = y10[1] * cs0[2] - y20[1] * cs0[3]; o2[1] = y20[1] * cs0[2] + y10[1] * cs0[3];
                        o1[2] = y10[2] * cs1[0] - y20[2] * cs1[1]; o2[2] = y20[2] * cs1[0] + y10[2] * cs1[1];
                        o1[3] = y10[3] * cs1[2] - y20[3] * cs1[3]; o2[3] = y20[3] * cs1[2] + y10[3] * cs1[3];
                        o1[4] = y11[0] * cs2[0] - y21[0] * cs2[1]; o2[4] = y21[0] * cs2[0] + y11[0] * cs2[1];
                        o1[5] = y11[1] * cs2[2] - y21[1] * cs2[3]; o2[5] = y21[1] * cs2[2] + y11[1] * cs2[3];
                        o1[6] = y11[2] * cs3[0] - y21[2] * cs3[1]; o2[6] = y21[2] * cs3[0] + y11[2] * cs3[1];
                        o1[7] = y11[3] * cs3[2] - y21[3] * cs3[3]; o2[7] = y21[3] * cs3[2] + y11[3] * cs3[3];
                        bf16_t* rowp = P + (size_t)r * ldp + colbase;
                        u32x4 w; w.x = cvt_pk_bf16(o1[0], o1[1]); w.y = cvt_pk_bf16(o1[2], o1[3]); w.z = cvt_pk_bf16(o1[4], o1[5]); w.w = cvt_pk_bf16(o1[6], o1[7]);
                        *(u32x4*)rowp = w;
                        w.x = cvt_pk_bf16(o2[0], o2[1]); w.y = cvt_pk_bf16(o2[2], o2[3]); w.z = cvt_pk_bf16(o2[4], o2[5]); w.w = cvt_pk_bf16(o2[6], o2[7]);
                        *(u32x4*)(rowp + 32) = w;
                    }
                }
            }
        } else {
            const int col0 = pn * BM + wc * 32 + 8 * fq;
            const int mode = (pn == 4 || pn == 5 || pn == 9 || pn == 10) ? 1 : (pn >= 11 ? 2 : 0);
            f32x4 bb[2][2] = {{(f32x4){0.f, 0.f, 0.f, 0.f}, (f32x4){0.f, 0.f, 0.f, 0.f}}, {(f32x4){0.f, 0.f, 0.f, 0.f}, (f32x4){0.f, 0.f, 0.f, 0.f}}};
            if (mode == 2) { const float* bp = bgates + (col0 - c_g);
                bb[0][0] = *(const f32x4*)bp; bb[0][1] = *(const f32x4*)(bp + 4); bb[1][0] = *(const f32x4*)(bp + HALF); bb[1][1] = *(const f32x4*)(bp + HALF + 4); }
#pragma unroll
            for (int bj = 0; bj < 2; ++bj) {
                const f32x4 nb0 = bb[bj][0] * (-1.4426950408889634f), nb1 = bb[bj][1] * (-1.4426950408889634f);
#pragma unroll
                for (int ai = 0; ai < 2; ++ai)
#pragma unroll
                    for (int m = 0; m < 4; ++m) {
                        f32x4 v0 = acc[ai][bj][m][0], v1 = acc[ai][bj][m][1];
                        if (mode == 1) { const f32x2 a = gelu_pk((f32x2){v0[0], v0[1]}), b = gelu_pk((f32x2){v0[2], v0[3]}), c = gelu_pk((f32x2){v1[0], v1[1]}), d = gelu_pk((f32x2){v1[2], v1[3]});
                            v0 = (f32x4){a.x, a.y, b.x, b.y}; v1 = (f32x4){c.x, c.y, d.x, d.y}; }
                        if (mode == 2) {
                            typedef unsigned u32x2 __attribute__((ext_vector_type(2)));
                            u32x2 w8; unsigned wq[2] = {0u, 0u};
#pragma unroll
                            for (int p = 0; p < 4; ++p) {
                                const int n = p >> 1, i0 = (p & 1) * 2;
                                const f32x2 zv = n ? (f32x2){v1[i0], v1[i0 + 1]} : (f32x2){v0[i0], v0[i0 + 1]}, bv2 = n ? (f32x2){nb1[i0], nb1[i0 + 1]} : (f32x2){nb0[i0], nb0[i0 + 1]};
                                const f32x2 tv = zv * (-1.4426950408889634f) + bv2;
                                f32x2 ev; ev.x = __builtin_amdgcn_exp2f(tv.x); ev.y = __builtin_amdgcn_exp2f(tv.y);
                                const f32x2 dv = ev + 1.0f;
                                f32x2 gv; gv.x = __builtin_amdgcn_rcpf(dv.x); gv.y = __builtin_amdgcn_rcpf(dv.y);
                                const f32x2 cv = gv * 256.0f + (-0.5f);
                                wq[n] = __builtin_amdgcn_cvt_pk_u8_f32(cv.x, i0, wq[n]); wq[n] = __builtin_amdgcn_cvt_pk_u8_f32(cv.y, i0 + 1, wq[n]);
                            }
                            w8.x = wq[0]; w8.y = wq[1];
                            *(u32x2*)((unsigned char*)(P + (size_t)(row0 + ai * HALF + m * 16) * ldp + c_g) + (col0 - c_g) + bj * HALF) = w8;
                        } else {
                        u32x4 w; w.x = cvt_pk_bf16(v0[0], v0[1]); w.y = cvt_pk_bf16(v0[2], v0[3]); w.z = cvt_pk_bf16(v1[0], v1[1]); w.w = cvt_pk_bf16(v1[2], v1[3]);
                        *(u32x4*)(P + (size_t)(row0 + ai * HALF + m * 16) * ldp + col0 + bj * HALF) = w;
                        }
                    }
            }
        }
    }
};
template <int ACCUM> struct EpiMerge {
    static constexpr bool PERM = true, HAS_MID = false;
    bf16_t* Mg; int ldm; const bf16_t* gate; int ldg;
    __device__ __forceinline__ void operator()(const f32x4 (&acc)[2][2][4][2], const Unit& u, int wr, int wc, int fr, int fq) const {
        const int row0 = u.pm * BM + wr * 64 + fr, col0 = u.pn * BM + wc * 32 + 8 * fq;
#pragma unroll
        for (int bj = 0; bj < 2; ++bj) {
#pragma unroll
            for (int ai = 0; ai < 2; ++ai)
#pragma unroll
                for (int m = 0; m < 4; ++m) {
                    const size_t r = (size_t)(row0 + ai * HALF + m * 16);
                    const u32x4 gw = *(const u32x4*)(gate + r * ldg + col0 + bj * HALF);
                    const f32x4 a0 = acc[ai][bj][m][0], a1 = acc[ai][bj][m][1];
                    float o[8] = {bflo(gw.x) * a0[0], bfhi(gw.x) * a0[1], bflo(gw.y) * a0[2], bfhi(gw.y) * a0[3], bflo(gw.z) * a1[0], bfhi(gw.z) * a1[1], bflo(gw.w) * a1[2], bfhi(gw.w) * a1[3]};
                    bf16_t* mp = Mg + r * ldm + col0 + bj * HALF;
                    if (ACCUM) { const u32x4 pw = *(const u32x4*)mp;
                        o[0] += bflo(pw.x); o[1] += bfhi(pw.x); o[2] += bflo(pw.y); o[3] += bfhi(pw.y); o[4] += bflo(pw.z); o[5] += bfhi(pw.z); o[6] += bflo(pw.w); o[7] += bfhi(pw.w); }
                    u32x4 w; w.x = cvt_pk_bf16(o[0], o[1]); w.y = cvt_pk_bf16(o[2], o[3]); w.z = cvt_pk_bf16(o[4], o[5]); w.w = cvt_pk_bf16(o[6], o[7]);
                    *(u32x4*)mp = w;
                }
        }
    }
};
struct EpiMergeK {
    static constexpr bool PERM = true, HAS_MID = true; static constexpr int MID0 = 16, MID1 = 24;
    bf16_t* __restrict__ Mg; int ldm; const unsigned char* __restrict__ gates; int ldgb;
    typedef unsigned u32x2 __attribute__((ext_vector_type(2)));
    static __device__ __forceinline__ float gq(unsigned w, int i) { return ((float)((w >> (8 * i)) & 255u) + 0.5f) * (1.0f / 256.0f); }
    __device__ __forceinline__ void mid(f32x4 (&acc)[2][2][4][2], const Unit& u, int t, int wr, int wc, int fr, int fq) const {
        int row0 = u.pm * BM + wr * 64 + fr, col0 = u.pn * BM + wc * 32 + 8 * fq + (t == MID0 ? 0 : 1024);
        asm volatile("" : "+v"(row0), "+v"(col0));
#pragma unroll
        for (int bj = 0; bj < 2; ++bj)
#pragma unroll
            for (int ai = 0; ai < 2; ++ai)
#pragma unroll
                for (int m = 0; m < 4; ++m) {
                    const unsigned char* gp = gates + (size_t)(row0 + ai * HALF + m * 16) * ldgb + col0 + bj * HALF;
                    const u32x2 nw = *(const u32x2*)gp, dw = *(const u32x2*)(gp + 1024);
                    f32x4 r0, r1;
#pragma unroll
                    for (int i = 0; i < 4; ++i) { r0[i] = gq(nw.x, i) * __builtin_amdgcn_rcpf(gq(dw.x, i)); r1[i] = gq(nw.y, i) * __builtin_amdgcn_rcpf(gq(dw.y, i)); }
                    acc[ai][bj][m][0] *= r0; acc[ai][bj][m][1] *= r1;
                }
    }
    __device__ __forceinline__ void operator()(const f32x4 (&acc)[2][2][4][2], const Unit& u, int wr, int wc, int fr, int fq) const {
        const int row0 = u.pm * BM + wr * 64 + fr, col0 = u.pn * BM + wc * 32 + 8 * fq;
        u32x2 gw[2][2][4];
#pragma unroll
        for (int bj = 0; bj < 2; ++bj)
#pragma unroll
            for (int ai = 0; ai < 2; ++ai)
#pragma unroll
                for (int m = 0; m < 4; ++m) gw[bj][ai][m] = *(const u32x2*)(gates + (size_t)(row0 + ai * HALF + m * 16) * ldgb + 2048 + col0 + bj * HALF);
#pragma unroll
        for (int bj = 0; bj < 2; ++bj)
#pragma unroll
            for (int ai = 0; ai < 2; ++ai)
#pragma unroll
                for (int m = 0; m < 4; ++m) {
                    const size_t r = (size_t)(row0 + ai * HALF + m * 16);
                    const u32x2 g2 = gw[bj][ai][m];
                    const f32x4 a0 = acc[ai][bj][m][0], a1 = acc[ai][bj][m][1];
                    u32x4 w; w.x = cvt_pk_bf16(gq(g2.x, 0) * a0[0], gq(g2.x, 1) * a0[1]); w.y = cvt_pk_bf16(gq(g2.x, 2) * a0[2], gq(g2.x, 3) * a0[3]);
                    w.z = cvt_pk_bf16(gq(g2.y, 0) * a1[0], gq(g2.y, 1) * a1[1]); w.w = cvt_pk_bf16(gq(g2.y, 2) * a1[2], gq(g2.y, 3) * a1[3]);
                    *(u32x4*)(Mg + r * ldm + col0 + bj * HALF) = w;
                }
    }
};
__device__ __forceinline__ unsigned pk4_e4m3(float a, float b, float c, float d) { int w = 0; w = __builtin_amdgcn_cvt_pk_fp8_f32(a, b, w, false); w = __builtin_amdgcn_cvt_pk_fp8_f32(c, d, w, true); return (unsigned)w; }
struct EpiResF32 {
    static constexpr bool PERM = true, HAS_MID = false;
    bf16_t* __restrict__ X1; const float* __restrict__ R; unsigned char* __restrict__ X8p; int ldc;
    __device__ __forceinline__ void operator()(const f32x4 (&acc)[2][2][4][2], const Unit& u, int wr, int wc, int fr, int fq) const {
        const int row0 = u.pm * BM + wr * 64 + fr, col0 = u.pn * BM + wc * 32 + 8 * fq;
        typedef unsigned u32x2 __attribute__((ext_vector_type(2)));
#pragma unroll
        for (int ai = 0; ai < 2; ++ai) {
            f32x4 rv[4][2][2];
#pragma unroll
            for (int m = 0; m < 4; ++m) { const size_t ro = (size_t)(row0 + ai * HALF + m * 16) * ldc + col0;
#pragma unroll
                for (int bj = 0; bj < 2; ++bj) { rv[m][bj][0] = *(const f32x4*)(R + ro + bj * HALF); rv[m][bj][1] = *(const f32x4*)(R + ro + bj * HALF + 4); } }
#pragma unroll
            for (int m = 0; m < 4; ++m) { const size_t ro = (size_t)(row0 + ai * HALF + m * 16) * ldc + col0;
#pragma unroll
                for (int bj = 0; bj < 2; ++bj) { const f32x4 v0 = acc[ai][bj][m][0] + rv[m][bj][0], v1 = acc[ai][bj][m][1] + rv[m][bj][1];
                    u32x4 w; w.x = cvt_pk_bf16(v0[0], v0[1]); w.y = cvt_pk_bf16(v0[2], v0[3]); w.z = cvt_pk_bf16(v1[0], v1[1]); w.w = cvt_pk_bf16(v1[2], v1[3]);
                    *(u32x4*)(X1 + ro + bj * HALF) = w;
                    *(u32x2*)(X8p + ro + bj * HALF) = (u32x2){pk4_e4m3(v0[0], v0[1], v0[2], v0[3]), pk4_e4m3(v1[0], v1[1], v1[2], v1[3])}; } }
        }
    }
};
struct EpiSwiglu {
    static constexpr bool PERM = true, HAS_MID = false;
    bf16_t* act; const float* bgu;
    __device__ __forceinline__ void operator()(const f32x4 (&acc)[2][2][4][2], const Unit& u, int wr, int wc, int fr, int fq) const {
        const int e = u.pn >> 3, j = u.pn & 7;
        const int row0 = u.pm * BM + wr * 64 + fr, col0 = j * 128 + wc * 32 + 8 * fq;
        const float* bg = bgu + (size_t)e * 2048 + col0;
        const f32x4 g0 = *(const f32x4*)bg, g1 = *(const f32x4*)(bg + 4), u0 = *(const f32x4*)(bg + 1024), u1 = *(const f32x4*)(bg + 1028);
#pragma unroll
        for (int ai = 0; ai < 2; ++ai)
#pragma unroll
            for (int m = 0; m < 4; ++m) {
                float o[8];
#pragma unroll
                for (int i = 0; i < 8; ++i) {
                    float gt = (i < 4 ? acc[ai][0][m][0][i] + g0[i] : acc[ai][0][m][1][i - 4] + g1[i - 4]);
                    float up = (i < 4 ? acc[ai][1][m][0][i] + u0[i] : acc[ai][1][m][1][i - 4] + u1[i - 4]);
                    gt = fminf(gt, 7.0f); up = fminf(fmaxf(up, -7.0f), 7.0f);
                    const float sg = __builtin_amdgcn_rcpf(1.0f + __builtin_amdgcn_exp2f(-1.702f * 1.4426950408889634f * gt));
                    o[i] = (up + 1.0f) * (gt * sg);
                }
                u32x4 w; w.x = cvt_pk_bf16(o[0], o[1]); w.y = cvt_pk_bf16(o[2], o[3]); w.z = cvt_pk_bf16(o[4], o[5]); w.w = cvt_pk_bf16(o[6], o[7]);
                *(u32x4*)(act + (size_t)(row0 + ai * HALF + m * 16) * 1024 + col0) = w;
            }
    }
};
struct EpiSwiglu8 {
    static constexpr bool PERM = true, HAS_MID = false;
    unsigned char* __restrict__ act; const float* __restrict__ bgu; const float* __restrict__ srstd; float inv;
    __device__ __forceinline__ void operator()(const f32x4 (&acc)[2][2][4][2], const Unit& u, int wr, int wc, int fr, int fq) const {
        const int e = u.pn >> 3, j = u.pn & 7;
        const int row0 = u.pm * BM + wr * 64 + fr, col0 = j * 128 + wc * 32 + 8 * fq;
        const float* bg = bgu + (size_t)e * 2048 + col0;
        const f32x4 g0 = *(const f32x4*)bg, g1 = *(const f32x4*)(bg + 4), u0 = *(const f32x4*)(bg + 1024), u1 = *(const f32x4*)(bg + 1028);
        float rsv[8];
#pragma unroll
        for (int i = 0; i < 8; ++i) rsv[i] = srstd[row0 + (i >> 2) * HALF + (i & 3) * 16] * this->inv;
#pragma unroll
        for (int ai = 0; ai < 2; ++ai)
#pragma unroll
            for (int m = 0; m < 4; ++m) {
                float o[8]; const float inv = rsv[ai * 4 + m];
#pragma unroll
                for (int p = 0; p < 4; ++p) {
                    const int n = p >> 1, i0 = (p & 1) * 2;
                    const f32x2 ag = (f32x2){acc[ai][0][m][n][i0], acc[ai][0][m][n][i0 + 1]}, au = (f32x2){acc[ai][1][m][n][i0], acc[ai][1][m][n][i0 + 1]};
                    const f32x2 bgv = n ? (f32x2){g1[i0], g1[i0 + 1]} : (f32x2){g0[i0], g0[i0 + 1]}, buv = n ? (f32x2){u1[i0], u1[i0 + 1]} : (f32x2){u0[i0], u0[i0 + 1]};
                    f32x2 gt = ag * inv + bgv, up = au * inv + buv;
                    gt.x = fminf(gt.x, 7.0f); gt.y = fminf(gt.y, 7.0f);
                    up.x = __builtin_amdgcn_fmed3f(up.x, -7.0f, 7.0f); up.y = __builtin_amdgcn_fmed3f(up.y, -7.0f, 7.0f);
                    const f32x2 tt = gt * (-1.702f * 1.4426950408889634f);
                    f32x2 ev; ev.x = __builtin_amdgcn_exp2f(tt.x); ev.y = __builtin_amdgcn_exp2f(tt.y);
                    const f32x2 dv = ev + 1.0f;
                    f32x2 rv2; rv2.x = __builtin_amdgcn_rcpf(dv.x); rv2.y = __builtin_amdgcn_rcpf(dv.y);
                    const f32x2 ov = (up + 1.0f) * (gt * rv2);
                    o[2 * p] = ov.x; o[2 * p + 1] = ov.y;
                }
                f32x2 w; unsigned w0 = pk4_e4m3(o[0], o[1], o[2], o[3]), w1 = pk4_e4m3(o[4], o[5], o[6], o[7]);
                typedef unsigned u32x2 __attribute__((ext_vector_type(2)));
                *(u32x2*)(act + (size_t)(row0 + ai * HALF + m * 16) * 1024 + col0) = (u32x2){w0, w1}; (void)w;
            }
    }
};
struct EpiDown {
    static constexpr bool PERM = true, HAS_MID = false;
    unsigned char* __restrict__ Y; const float* __restrict__ bd; float inv;
    __device__ __forceinline__ void operator()(const f32x4 (&acc)[2][2][4][2], const Unit& u, int wr, int wc, int fr, int fq) const {
        const int e = u.pn >> 2, j = u.pn & 3;
        const int row0 = u.pm * BM + wr * 64 + fr, col0 = j * 256 + wc * 32 + 8 * fq;
        const float* bp = bd + (size_t)e * 1024 + col0;
        typedef unsigned u32x2 __attribute__((ext_vector_type(2)));
        const f32x4 b00 = *(const f32x4*)bp * 16.0f, b01 = *(const f32x4*)(bp + 4) * 16.0f, b10 = *(const f32x4*)(bp + HALF) * 16.0f, b11 = *(const f32x4*)(bp + HALF + 4) * 16.0f;
#pragma unroll
        for (int ai = 0; ai < 2; ++ai)
#pragma unroll
            for (int m = 0; m < 4; ++m) {
                unsigned char* yp = Y + (size_t)(row0 + ai * HALF + m * 16) * 1024 + col0;
                { const f32x4 v0 = acc[ai][0][m][0] * inv + b00, v1 = acc[ai][0][m][1] * inv + b01;
                  *(u32x2*)yp = (u32x2){pk4_e4m3(v0[0], v0[1], v0[2], v0[3]), pk4_e4m3(v1[0], v1[1], v1[2], v1[3])}; }
                { const f32x4 v0 = acc[ai][1][m][0] * inv + b10, v1 = acc[ai][1][m][1] * inv + b11;
                  *(u32x2*)(yp + HALF) = (u32x2){pk4_e4m3(v0[0], v0[1], v0[2], v0[3]), pk4_e4m3(v1[0], v1[1], v1[2], v1[3])}; }
            }
    }
};

template <class Epi, class Sched, bool F8 = false, bool ALIGN_EPI = true>
__device__ __forceinline__ void gemm_phase(PG8_LAS unsigned char* lds, const Gemm g, const Sched& S, const Epi& E, const int wid_in) {
    const int wid = __builtin_amdgcn_readfirstlane(wid_in), lane = (int)__builtin_amdgcn_mbcnt_hi(~0u, __builtin_amdgcn_mbcnt_lo(~0u, 0u)), tid = wid * 64 + lane, wr = wid >> 2, wc = wid & 3, fr = lane & 15, fq = lane >> 4;
    int K = g.K; asm volatile("" : "+s"(K));
    const int nt = K / BK;
    unsigned voffA[2], voffB[2];
#pragma unroll
    for (int i = 0; i < 2; ++i) { int R, C; stage_rc(tid * 16 + i * 8192, R, C); const int Rb = Epi::PERM ? ((R & ~31) + perm32(R & 31)) : R;
        voffA[i] = (unsigned)(R * g.lda + C) * 2u; voffB[i] = (unsigned)(Rb * g.ldb + C) * 2u; }
    const size_t kstep = (size_t)(BK * 2);
    const size_t hstepA = (size_t)HALF * g.lda * 2, hstepB = (size_t)HALF * g.ldb * 2;
    const size_t tstepA = 2 * hstepA, tstepB = 2 * hstepB;
    const unsigned ldsw = (unsigned)wid * 1024u;
    const int aoff = lds_byte(wr * 64 + fr, fq * 8), boff = lds_byte(wc * 32 + fr, fq * 8);
#define PG8_SA(b, h) (((b) * 2 + (h)) * HTB)
#define PG8_SB(b, h) ((4 + (b) * 2 + (h)) * HTB)
#define PG8_STAGE(bufoff, gbase, voff) do { _Pragma("unroll") for (int _i = 0; _i < 2; ++_i) \
        __builtin_amdgcn_global_load_lds((const unsigned*)((const char*)(gbase) + (voff)[_i]), (PG8_LAS unsigned*)(lds + (bufoff) + ldsw + _i * 8192), 16, 0, 0); } while (0)
#define PG8_LDA(dst, b, h) do { _Pragma("unroll") for (int m = 0; m < 4; ++m) dst[m] = cat8(*(const PG8_LAS bf16x8*)(lds + PG8_SA(b, h) + aoff + m * 2048), *(const PG8_LAS bf16x8*)(lds + PG8_SA(b, h) + aoff + m * 2048 + 1024)); } while (0)
#define PG8_LDB(dst, b, h) do { _Pragma("unroll") for (int n = 0; n < 2; ++n) dst[n] = cat8(*(const PG8_LAS bf16x8*)(lds + PG8_SB(b, h) + boff + n * 2048), *(const PG8_LAS bf16x8*)(lds + PG8_SB(b, h) + boff + n * 2048 + 1024)); } while (0)
#define PG8_MMA(ai, bj, At, Bt) do { __builtin_amdgcn_s_setprio(1); \
        if constexpr (F8) { asm volatile("s_nop 1"); _Pragma("unroll") for (int m = 0; m < 4; ++m) _Pragma("unroll") for (int n = 0; n < 2; ++n) \
            asm volatile("v_mfma_scale_f32_16x16x128_f8f6f4 %0, %1, %2, %0, %3, %3 op_sel_hi:[0,0,0]" : "+v"(acc[ai][bj][m][n]) : "v"(Bt[n]), "v"(At[m]), "v"(sc127)); } \
        else { _Pragma("unroll") for (int m = 0; m < 4; ++m) _Pragma("unroll") for (int n = 0; n < 2; ++n) { \
            acc[ai][bj][m][n] = __builtin_amdgcn_mfma_f32_16x16x32_bf16(lo8(Bt[n]), lo8(At[m]), acc[ai][bj][m][n], 0, 0, 0); \
            acc[ai][bj][m][n] = __builtin_amdgcn_mfma_f32_16x16x32_bf16(hi8(Bt[n]), hi8(At[m]), acc[ai][bj][m][n], 0, 0, 0); } } \
        __builtin_amdgcn_s_setprio(0); } while (0)
#define PG8_WAIT_V(n) asm volatile("s_waitcnt vmcnt(" #n ")" ::: "memory")
#define PG8_WAIT_L(n) asm volatile("s_waitcnt lgkmcnt(" #n ")" ::: "memory")
#define PG8_BAR __builtin_amdgcn_s_barrier()
#define PG8_SCHED __builtin_amdgcn_sched_barrier(0)
    const int sc127 = 0x7F7F7F7F; (void)sc127;
    Unit cur, nxt; int ui = 0;
    if (!S.next(0, cur)) return;
    f32x4 acc[2][2][4][2];
#pragma unroll
    for (int a = 0; a < 2; ++a)
#pragma unroll
        for (int b = 0; b < 2; ++b)
#pragma unroll
            for (int m = 0; m < 4; ++m)
#pragma unroll
                for (int n = 0; n < 2; ++n) acc[a][b][m][n] = (f32x4){0.f, 0.f, 0.f, 0.f};
    v8i At[4], B0[2], B1[2];
    const char* cA = (const char*)g.A + (size_t)cur.pm * tstepA; const char* cB = (const char*)g.Bt + (size_t)cur.pn * tstepB;
    PG8_STAGE(PG8_SB(0, 0), cB, voffB); PG8_STAGE(PG8_SB(0, 1), cB + hstepB, voffB); PG8_STAGE(PG8_SA(0, 0), cA, voffA); PG8_STAGE(PG8_SA(0, 1), cA + hstepA, voffA);
    if (wr == 1) PG8_BAR;
    PG8_WAIT_V(2); PG8_BAR;
    PG8_STAGE(PG8_SB(1, 0), cB + kstep, voffB); PG8_STAGE(PG8_SA(1, 0), cA + kstep, voffA); PG8_STAGE(PG8_SB(1, 1), cB + hstepB + kstep, voffB);
    PG8_WAIT_V(6); PG8_BAR;
    for (;;) {
        const bool has_next = S.next(ui + 1, nxt);
        const char* nA = has_next ? (const char*)g.A + (size_t)nxt.pm * tstepA : cA; const char* nB = has_next ? (const char*)g.Bt + (size_t)nxt.pn * tstepB : cB;
        for (int t = 0; t < nt; t += 2) {
            if constexpr (Epi::HAS_MID) { if (t == Epi::MID0 || t == Epi::MID1) E.mid(acc, cur, t, wr, wc, fr, fq); }
            const bool last = (t == nt - 2);
            const char* a1 = cA + (size_t)(t + 1) * kstep;
            const char* a2 = last ? nA : cA + (size_t)(t + 2) * kstep; const char* b2 = last ? nB : cB + (size_t)(t + 2) * kstep;
            const char* a3 = a2 + kstep; const char* b3 = b2 + kstep;
            PG8_LDB(B0, 0, 0); PG8_LDB(B1, 0, 1); PG8_SCHED; PG8_LDA(At, 0, 0); PG8_STAGE(PG8_SA(1, 1), a1 + hstepA, voffA);
            PG8_WAIT_V(8); PG8_WAIT_L(0); PG8_BAR; PG8_MMA(0, 0, At, B0); PG8_MMA(0, 1, At, B1); PG8_BAR; PG8_SCHED;
            PG8_LDA(At, 0, 1); PG8_STAGE(PG8_SB(0, 0), b2, voffB); PG8_STAGE(PG8_SB(0, 1), b2 + hstepB, voffB); PG8_STAGE(PG8_SA(0, 0), a2, voffA);
            PG8_WAIT_V(8); PG8_WAIT_L(0); PG8_BAR; PG8_MMA(1, 0, At, B0); PG8_MMA(1, 1, At, B1); PG8_BAR; PG8_SCHED;
            PG8_LDB(B0, 1, 0); PG8_LDB(B1, 1, 1); PG8_SCHED; PG8_LDA(At, 1, 0); PG8_STAGE(PG8_SA(0, 1), a2 + hstepA, voffA);
            PG8_WAIT_V(8); PG8_WAIT_L(0); PG8_BAR; PG8_MMA(0, 0, At, B0); PG8_MMA(0, 1, At, B1); PG8_BAR; PG8_SCHED;
            PG8_LDA(At, 1, 1); PG8_STAGE(PG8_SB(1, 0), b3, voffB); PG8_STAGE(PG8_SB(1, 1), b3 + hstepB, voffB); PG8_STAGE(PG8_SA(1, 0), a3, voffA);
            PG8_WAIT_V(8); PG8_WAIT_L(0); PG8_BAR; PG8_MMA(1, 0, At, B0); PG8_MMA(1, 1, At, B1); PG8_BAR; PG8_SCHED;
        }
        if constexpr (ALIGN_EPI) { if (wr == 0) PG8_BAR; }
        if constexpr (F8) asm volatile("s_nop 15\n\ts_nop 15" ::: "memory");
        E(acc, cur, wr, wc, fr, fq);
        if (!has_next) break;
#pragma unroll
        for (int a = 0; a < 2; ++a)
#pragma unroll
            for (int b = 0; b < 2; ++b)
#pragma unroll
                for (int m = 0; m < 4; ++m)
#pragma unroll
                    for (int n = 0; n < 2; ++n) acc[a][b][m][n] = (f32x4){0.f, 0.f, 0.f, 0.f};
        cur = nxt; cA = nA; cB = nB; ++ui;
        if constexpr (ALIGN_EPI) { if (wr == 1) PG8_BAR; }
    }
    PG8_WAIT_V(0);
    if constexpr (!ALIGN_EPI) { if (wr == 0) PG8_BAR; }
    PG8_BAR;
#undef PG8_SA
#undef PG8_SB
#undef PG8_STAGE
#undef PG8_LDA
#undef PG8_LDB
#undef PG8_MMA
#undef PG8_WAIT_V
#undef PG8_WAIT_L
#undef PG8_BAR
#undef PG8_SCHED
}
template <class Epi, class Sched, bool F8 = false, bool ALIGN_EPI = true>
__device__ __forceinline__ void gemm_phase_gather(PG8_LAS unsigned char* lds, const Gemm g, const Sched& S, const Epi& E, const int wid_in, const int* rowmap) {
    const int wid = __builtin_amdgcn_readfirstlane(wid_in), lane = (int)__builtin_amdgcn_mbcnt_hi(~0u, __builtin_amdgcn_mbcnt_lo(~0u, 0u)), tid = wid * 64 + lane, wr = wid >> 2, wc = wid & 3, fr = lane & 15, fq = lane >> 4;
    int K = g.K; asm volatile("" : "+s"(K));
    const int nt = K / BK;
    unsigned voffB[2]; int RA[2]; unsigned CA2[2];
#pragma unroll
    for (int i = 0; i < 2; ++i) { int R, C; stage_rc(tid * 16 + i * 8192, R, C); const int Rb = Epi::PERM ? ((R & ~31) + perm32(R & 31)) : R;
        RA[i] = R; CA2[i] = (unsigned)C * 2u; voffB[i] = (unsigned)(Rb * g.ldb + C) * 2u; }
    const unsigned rowb = (unsigned)g.lda * 2u;
    unsigned ca0[2], ca1[2], na0[2], na1[2]; int raw0[2], raw1[2];
#define PG8_LOADIDX(d0, d1, pm_) do { _Pragma("unroll") for (int _i = 0; _i < 2; ++_i) { d0[_i] = rowmap[(pm_) * BM + RA[_i]]; d1[_i] = rowmap[(pm_) * BM + HALF + RA[_i]]; } } while (0)
#define PG8_CVTIDX(o0, o1, d0, d1) do { _Pragma("unroll") for (int _i = 0; _i < 2; ++_i) { o0[_i] = (unsigned)(d0[_i] < 0 ? 0 : d0[_i]) * rowb + CA2[_i]; o1[_i] = (unsigned)(d1[_i] < 0 ? 0 : d1[_i]) * rowb + CA2[_i]; } } while (0)
    const size_t kstep = (size_t)(BK * 2);
    const size_t hstepB = (size_t)HALF * g.ldb * 2;
    const size_t tstepB = 2 * hstepB;
    const unsigned ldsw = (unsigned)wid * 1024u;
    const int aoff = lds_byte(wr * 64 + fr, fq * 8), boff = lds_byte(wc * 32 + fr, fq * 8);
#define PG8_SA(b, h) (((b) * 2 + (h)) * HTB)
#define PG8_SB(b, h) ((4 + (b) * 2 + (h)) * HTB)
#define PG8_STAGE(bufoff, gbase, voff) do { _Pragma("unroll") for (int _i = 0; _i < 2; ++_i) \
        __builtin_amdgcn_global_load_lds((const unsigned*)((const char*)(gbase) + (voff)[_i]), (PG8_LAS unsigned*)(lds + (bufoff) + ldsw + _i * 8192), 16, 0, 0); } while (0)
#define PG8_LDA(dst, b, h) do { _Pragma("unroll") for (int m = 0; m < 4; ++m) dst[m] = cat8(*(const PG8_LAS bf16x8*)(lds + PG8_SA(b, h) + aoff + m * 2048), *(const PG8_LAS bf16x8*)(lds + PG8_SA(b, h) + aoff + m * 2048 + 1024)); } while (0)
#define PG8_LDB(dst, b, h) do { _Pragma("unroll") for (int n = 0; n < 2; ++n) dst[n] = cat8(*(const PG8_LAS bf16x8*)(lds + PG8_SB(b, h) + boff + n * 2048), *(const PG8_LAS bf16x8*)(lds + PG8_SB(b, h) + boff + n * 2048 + 1024)); } while (0)
#define PG8_MMA(ai, bj, At, Bt) do { __builtin_amdgcn_s_setprio(1); \
        if constexpr (F8) { asm volatile("s_nop 1"); _Pragma("unroll") for (int m = 0; m < 4; ++m) _Pragma("unroll") for (int n = 0; n < 2; ++n) \
            asm volatile("v_mfma_scale_f32_16x16x128_f8f6f4 %0, %1, %2, %0, %3, %3 op_sel_hi:[0,0,0]" : "+v"(acc[ai][bj][m][n]) : "v"(Bt[n]), "v"(At[m]), "v"(sc127)); } \
        else { _Pragma("unroll") for (int m = 0; m < 4; ++m) _Pragma("unroll") for (int n = 0; n < 2; ++n) { \
            acc[ai][bj][m][n] = __builtin_amdgcn_mfma_f32_16x16x32_bf16(lo8(Bt[n]), lo8(At[m]), acc[ai][bj][m][n], 0, 0, 0); \
            acc[ai][bj][m][n] = __builtin_amdgcn_mfma_f32_16x16x32_bf16(hi8(Bt[n]), hi8(At[m]), acc[ai][bj][m][n], 0, 0, 0); } } \
        __builtin_amdgcn_s_setprio(0); } while (0)
#define PG8_WAIT_V(n) asm volatile("s_waitcnt vmcnt(" #n ")" ::: "memory")
#define PG8_WAIT_L(n) asm volatile("s_waitcnt lgkmcnt(" #n ")" ::: "memory")
#define PG8_BAR __builtin_amdgcn_s_barrier()
#define PG8_SCHED __builtin_amdgcn_sched_barrier(0)
    const int sc127 = 0x7F7F7F7F; (void)sc127;
    Unit cur, nxt, nn; int ui = 0;
    if (!S.next(0, cur)) return;
    bool has_next = S.next(1, nxt);
    PG8_LOADIDX(raw0, raw1, cur.pm); PG8_CVTIDX(ca0, ca1, raw0, raw1);
    if (has_next) { PG8_LOADIDX(raw0, raw1, nxt.pm); PG8_CVTIDX(na0, na1, raw0, raw1); } else { na0[0] = ca0[0]; na0[1] = ca0[1]; na1[0] = ca1[0]; na1[1] = ca1[1]; }
    f32x4 acc[2][2][4][2];
#pragma unroll
    for (int a = 0; a < 2; ++a)
#pragma unroll
        for (int b = 0; b < 2; ++b)
#pragma unroll
            for (int m = 0; m < 4; ++m)
#pragma unroll
                for (int n = 0; n < 2; ++n) acc[a][b][m][n] = (f32x4){0.f, 0.f, 0.f, 0.f};
    v8i At[4], B0[2], B1[2];
    const char* const cA = (const char*)g.A; const char* cB = (const char*)g.Bt + (size_t)cur.pn * tstepB;
    PG8_STAGE(PG8_SB(0, 0), cB, voffB); PG8_STAGE(PG8_SB(0, 1), cB + hstepB, voffB); PG8_STAGE(PG8_SA(0, 0), cA, ca0); PG8_STAGE(PG8_SA(0, 1), cA, ca1);
    if (wr == 1) PG8_BAR;
    PG8_WAIT_V(2); PG8_BAR;
    PG8_STAGE(PG8_SB(1, 0), cB + kstep, voffB); PG8_STAGE(PG8_SA(1, 0), cA + kstep, ca0); PG8_STAGE(PG8_SB(1, 1), cB + hstepB + kstep, voffB);
    PG8_WAIT_V(6); PG8_BAR;
    for (;;) {
        const bool has_next2 = has_next && S.next(ui + 2, nn);
        if (has_next2) PG8_LOADIDX(raw0, raw1, nn.pm);
        const char* nB = has_next ? (const char*)g.Bt + (size_t)nxt.pn * tstepB : cB;
        for (int t = 0; t < nt; t += 2) {
            const bool last = (t == nt - 2);
            const char* a1 = cA + (size_t)(t + 1) * kstep;
            const char* a2 = last ? cA : cA + (size_t)(t + 2) * kstep; const char* b2 = last ? nB : cB + (size_t)(t + 2) * kstep;
            const char* a3 = a2 + kstep; const char* b3 = b2 + kstep;
            unsigned s0[2], s1[2];
            s0[0] = last ? na0[0] : ca0[0]; s0[1] = last ? na0[1] : ca0[1]; s1[0] = last ? na1[0] : ca1[0]; s1[1] = last ? na1[1] : ca1[1];
            PG8_LDB(B0, 0, 0); PG8_LDB(B1, 0, 1); PG8_SCHED; PG8_LDA(At, 0, 0); PG8_STAGE(PG8_SA(1, 1), a1, ca1);
            PG8_WAIT_V(8); PG8_WAIT_L(0); PG8_BAR; PG8_MMA(0, 0, At, B0); PG8_MMA(0, 1, At, B1); PG8_BAR; PG8_SCHED;
            PG8_LDA(At, 0, 1); PG8_STAGE(PG8_SB(0, 0), b2, voffB); PG8_STAGE(PG8_SB(0, 1), b2 + hstepB, voffB); PG8_STAGE(PG8_SA(0, 0), a2, s0);
            PG8_WAIT_V(8); PG8_WAIT_L(0); PG8_BAR; PG8_MMA(1, 0, At, B0); PG8_MMA(1, 1, At, B1); PG8_BAR; PG8_SCHED;
            PG8_LDB(B0, 1, 0); PG8_LDB(B1, 1, 1); PG8_SCHED; PG8_LDA(At, 1, 0); PG8_STAGE(PG8_SA(0, 1), a2, s1);
            PG8_WAIT_V(8); PG8_WAIT_L(0); PG8_BAR; PG8_MMA(0, 0, At, B0); PG8_MMA(0, 1, At, B1); PG8_BAR; PG8_SCHED;
            PG8_LDA(At, 1, 1); PG8_STAGE(PG8_SB(1, 0), b3, voffB); PG8_STAGE(PG8_SB(1, 1), b3 + hstepB, voffB); PG8_STAGE(PG8_SA(1, 0), a3, s0);
            PG8_WAIT_V(8); PG8_WAIT_L(0); PG8_BAR; PG8_MMA(1, 0, At, B0); PG8_MMA(1, 1, At, B1); PG8_BAR; PG8_SCHED;
        }
        if constexpr (ALIGN_EPI) { if (wr == 0) PG8_BAR; }
        if constexpr (F8) asm volatile("s_nop 15\n\ts_nop 15" ::: "memory");
        E(acc, cur, wr, wc, fr, fq);
        if (!has_next) break;
#pragma unroll
        for (int a = 0; a < 2; ++a)
#pragma unroll
            for (int b = 0; b < 2; ++b)
#pragma unroll
                for (int m = 0; m < 4; ++m)
#pragma unroll
                    for (int n = 0; n < 2; ++n) acc[a][b][m][n] = (f32x4){0.f, 0.f, 0.f, 0.f};
        cur = nxt; cB = nB; ++ui;
        ca0[0] = na0[0]; ca0[1] = na0[1]; ca1[0] = na1[0]; ca1[1] = na1[1];
        if (has_next2) { PG8_CVTIDX(na0, na1, raw0, raw1); nxt = nn; }
        has_next = has_next2;
        if constexpr (ALIGN_EPI) { if (wr == 1) PG8_BAR; }
    }
    PG8_WAIT_V(0);
    if constexpr (!ALIGN_EPI) { if (wr == 0) PG8_BAR; }
    PG8_BAR;
#undef PG8_LOADIDX
#undef PG8_CVTIDX
#undef PG8_SA
#undef PG8_SB
#undef PG8_STAGE
#undef PG8_LDA
#undef PG8_LDB
#undef PG8_MMA
#undef PG8_WAIT_V
#undef PG8_WAIT_L
#undef PG8_BAR
#undef PG8_SCHED
}
}

constexpr int NWAVES = 8, NTHR = 512;
constexpr int BATCH = 32, SEQ = 2048, D = 1024, T = BATCH * SEQ, MEM = 256, TM = BATCH * MEM;
constexpr int DIN = 5888;
constexpr float EPS = 1e-6f;
constexpr int LDP = DIN, C_Q = 0, C_U = 1024, C_QC = 1536, C_K = 2048, C_V = 2176, C_VB = 2304, C_G = 2816;
constexpr int WD_P1_ITEMS = 8192;
constexpr float YSCALE = 16.0f;
constexpr float WSCALE = 64.0f;
constexpr int NEXP = 32, TOPK = 4;
constexpr int PS = T * TOPK + NEXP * 256;
constexpr int MAXTILE = PS / 256;

constexpr size_t MiB = 1u << 20;
constexpr size_t WS_CTL = 0, CTL_ZERO_BYTES = 1 * MiB;
constexpr size_t WS_WOUT = 1 * MiB;
constexpr size_t WS_ROPE = 3 * MiB;
constexpr size_t WS_WIN = 19 * MiB;
constexpr size_t WS_WO = 31 * MiB;
constexpr size_t WS_WMKV = 35 * MiB;
constexpr size_t WS_X8 = 3 * MiB;
constexpr size_t WS_SRSTD = 67 * MiB;
constexpr size_t WS_MEMN = 37 * MiB;
constexpr size_t WS_KV = 53 * MiB;
constexpr size_t WS_META = 69 * MiB;
constexpr size_t WS_H = 77 * MiB;
constexpr size_t WS_PROJ = 205 * MiB;
constexpr size_t WS_WGU = 141 * MiB;
constexpr size_t WS_WD = 941 * MiB;
constexpr size_t WS_ACT = 237 * MiB;
constexpr size_t WS_Y = 501 * MiB;
constexpr size_t WS_X1B = 765 * MiB;
constexpr size_t WS_END = 1013 * MiB;
static_assert(WS_PROJ + (size_t)T * LDP * 2 <= WS_END && WS_ACT + (size_t)PS * 1024 <= WS_Y && WS_Y + (size_t)T * TOPK * 2048 <= WS_END && WS_WGU + (size_t)NEXP * 2048 * 1024 <= WS_PROJ && WS_WD + (size_t)NEXP * 1024 * 1024 <= WS_END, "ws map");
constexpr size_t MT_IDX = 0;
constexpr size_t MT_GATE = 1 * MiB;
constexpr size_t MT_STOK = 2 * MiB;
constexpr size_t MT_SGATE = 3 * MiB + 512 * 1024;
constexpr size_t MT_SASG = 5 * MiB;
constexpr size_t MT_TILEE = 6 * MiB + 512 * 1024;
constexpr size_t MT_WSB = 7 * MiB;
constexpr size_t MT_RSTD = 7 * MiB + 128 * 1024;
constexpr size_t MT_CMAT = 7 * MiB + 512 * 1024;
constexpr size_t MT_RWP = 7 * MiB + 768 * 1024;
constexpr int CW_BAR = 4096;
constexpr int CW_NTILE = 1024;

constexpr int RING_OFF = 0, RING_BYTES = 131072;
constexpr int LDS_BYTES = 147456;
constexpr int LDSCTL_OFF = LDS_BYTES - 1024, MISC_OFF = LDSCTL_OFF + 320;

#define GAS __attribute__((address_space(1)))
#define LAS __attribute__((address_space(3)))
typedef unsigned short bf16;
typedef unsigned v4u __attribute__((ext_vector_type(4)));
typedef unsigned v2u __attribute__((ext_vector_type(2)));
typedef float f32x4 __attribute__((ext_vector_type(4)));
typedef GAS unsigned gu32;
#define RLX_AGENT __ATOMIC_RELAXED, __HIP_MEMORY_SCOPE_AGENT
#define LDS_WAIT() asm volatile("s_waitcnt lgkmcnt(0)" ::: "memory")
#define VM_WAIT() asm volatile("s_waitcnt vmcnt(0)" ::: "memory")
__device__ __forceinline__ unsigned f2bf(float f) { unsigned u = __builtin_bit_cast(unsigned, f); return (u + 0x7fffu + ((u >> 16) & 1u)) >> 16; }
__device__ __forceinline__ unsigned pk2(float lo, float hi) { return f2bf(lo) | (f2bf(hi) << 16); }
__device__ __forceinline__ unsigned pk4_fp8(float a, float b, float c, float d) { int w = 0; w = __builtin_amdgcn_cvt_pk_fp8_f32(a, b, w, false); w = __builtin_amdgcn_cvt_pk_fp8_f32(c, d, w, true); return (unsigned)w; }
__device__ __forceinline__ float bf2f(bf16 b) { return __uint_as_float(((unsigned)b) << 16); }
__device__ __forceinline__ float blo(unsigned w) { return __uint_as_float(w << 16); }
__device__ __forceinline__ float bhi(unsigned w) { return __uint_as_float(w & 0xffff0000u); }

#define XB_TMO      128
#define XB_XCNT(j)  (256  + 64 * (j))
#define XB_XSUB(j)  (1280 + 64 * (j))
#define XB_XGEN(j)  (2304 + 64 * (j))
#define XB_TOP      3328
#define XB_TOPGEN   3392
#define XCD_BAR_WORDS 3456
#define XB_SPIN_CAP (1u << 22)
__device__ __forceinline__ unsigned xb_ld(unsigned* p)              { return __hip_atomic_load(p, __ATOMIC_RELAXED, __HIP_MEMORY_SCOPE_AGENT); }
__device__ __forceinline__ unsigned xb_add(unsigned* p, unsigned v) { return __hip_atomic_fetch_add(p, v, __ATOMIC_RELAXED, __HIP_MEMORY_SCOPE_AGENT); }
__device__ __forceinline__ unsigned xb_xcc_id() { return (unsigned)__builtin_amdgcn_s_getreg((3 << 11) | 20) & 0xFu; }
#define XB_SPIN(cond, bar) do { unsigned _sp = 0; while (cond) { __builtin_amdgcn_s_sleep(1); \
    if ((++_sp & 255u) == 0u) { if (xb_ld(&(bar)[XB_TMO])) break; if (_sp > XB_SPIN_CAP) { atomicAdd(&(bar)[XB_TMO], 1u); break; } } } } while (0)
struct XcdBarrier { unsigned* bar; unsigned x; volatile LAS unsigned* st; };
__device__ __forceinline__ XcdBarrier xcd_barrier_post(unsigned* bar, volatile LAS unsigned* st, bool leader) {
    XcdBarrier b; b.bar = bar; b.x = xb_xcc_id(); b.st = st;
    if (leader) (void)xb_add(&bar[XB_XCNT(b.x)], 1u);
    return b;
}
__device__ __forceinline__ void xcd_barrier_complete(unsigned* bar, unsigned x, unsigned& nloc, unsigned& nx) {
    const unsigned G = gridDim.x * gridDim.y * gridDim.z;
    unsigned sum, cnt, mine, sp = 0u;
    for (;;) {
        sum = 0u; cnt = 0u; mine = 0u;
#pragma unroll
        for (unsigned j = 0; j < 16; ++j) { const unsigned c = xb_ld(&bar[XB_XCNT(j)]); sum += c; cnt += (c > 0u) ? 1u : 0u; mine = (j == x) ? c : mine; }
        if (sum == G) break;
        __builtin_amdgcn_s_sleep(1);
        if ((++sp & 255u) == 0u) { if (xb_ld(&bar[XB_TMO])) break; if (sp > XB_SPIN_CAP) { atomicAdd(&bar[XB_TMO], 1u); break; } }
    }
    nloc = mine > 0u ? mine : 1u; nx = cnt > 0u ? cnt : 1u;
}
__device__ __forceinline__ void xcd_barrier(const XcdBarrier& b, bool leader) {
    asm volatile("s_waitcnt vmcnt(0)" ::: "memory");
    __syncthreads();
    if (leader) {
        unsigned* bar = b.bar;
        __builtin_amdgcn_s_waitcnt(0);
        unsigned nloc = b.st[0], nx = b.st[1];
        if (nloc == 0u) { xcd_barrier_complete(bar, b.x, nloc, nx); b.st[0] = nloc; b.st[1] = nx; }
        const unsigned old = xb_add(&bar[XB_XSUB(b.x)], 1u);
        const unsigned gen = old / nloc;
        if (old + 1u == (gen + 1u) * nloc) {
            __builtin_amdgcn_fence(__ATOMIC_RELEASE, "agent");
            asm volatile("s_waitcnt vmcnt(0)" ::: "memory");
            const unsigned og = xb_add(&bar[XB_TOP], 1u);
            const unsigned tg = og / nx;
            if (og + 1u == (tg + 1u) * nx) xb_add(&bar[XB_TOPGEN], 1u);
            else XB_SPIN(xb_ld(&bar[XB_TOPGEN]) == tg, bar);
            __builtin_amdgcn_fence(__ATOMIC_ACQUIRE, "agent");
            xb_add(&bar[XB_XGEN(b.x)], 1u);
            asm volatile("s_waitcnt vmcnt(0)" ::: "memory");
        } else {
            XB_SPIN(xb_ld(&bar[XB_XGEN(b.x)]) == gen, bar);
            __builtin_amdgcn_fence(__ATOMIC_ACQUIRE, "agent");
            asm volatile("s_waitcnt vmcnt(0)" ::: "memory");
        }
    }
    __syncthreads();
}

__device__ __forceinline__ float dpp_add(float v, const int ctrl) { return v; }
#define DPP_ADD(v, ctrl) ((v) + __builtin_bit_cast(float, __builtin_amdgcn_update_dpp(0, __builtin_bit_cast(int, (v)), (ctrl), 0xf, 0xf, false)))
__device__ __forceinline__ float row16_sum(float v) { v = DPP_ADD(v, 0xB1); v = DPP_ADD(v, 0x4E); v = DPP_ADD(v, 0x141); v = DPP_ADD(v, 0x140); return v; }
__device__ __forceinline__ float wave_sum(float v) { return xor32_sum(xor16_sum(row16_sum(v))); }
__device__ __forceinline__ float wave_max(float v) {
#pragma unroll
    for (int o = 1; o < 64; o <<= 1) v = fmaxf(v, __shfl_xor(v, o));
    return v;
}
__device__ __forceinline__ float half_sum(float v) {
#pragma unroll
    for (int o = 1; o < 32; o <<= 1) v += __shfl_xor(v, o);
    return v;
}
__device__ __forceinline__ float gelu_erf(float x) { return 0.5f * x * (1.0f + erff(x * 0.70710678118654752f)); }

struct Args {
    const float* in[28]; float* out; unsigned char* ws; int ph_lo, ph_hi;
};
enum { I_X = 0, I_MEM, I_POS, I_ATTN_G, I_MEM_G, I_WIN, I_BGATES, I_AQG, I_AKG, I_SINKS, I_WOA, I_LNG, I_LNB, I_WS, I_BS, I_WOB, I_WMKV, I_CQG, I_CKG, I_WOC, I_WOUT, I_FFN_G,
       I_RW, I_RB, I_WGU, I_BGU, I_WD, I_BD };

__device__ __forceinline__ void tr_item(const float* W, int ldw, int k0, int sc, bf16* WT, int ldt, int dr, int dk, LAS float* scr, int lane) {
#pragma unroll 8
    for (int i = 0; i < 32; ++i) { const int kk = 2 * i + (lane >> 5); scr[kk * 33 + (lane & 31)] = W[(size_t)(k0 + kk) * ldw + sc + (lane & 31)]; }
    LDS_WAIT(); asm volatile("" ::: "memory");
    const int c = lane & 7;
#pragma unroll
    for (int j = 0; j < 4; ++j) { const int n = (lane >> 3) + 8 * j; const LAS float* s = scr + (8 * c) * 33 + n;
        v4u o; o.x = pk2(s[0 * 33], s[1 * 33]); o.y = pk2(s[2 * 33], s[3 * 33]); o.z = pk2(s[4 * 33], s[5 * 33]); o.w = pk2(s[6 * 33], s[7 * 33]);
        *(GAS v4u*)(WT + (size_t)(dr + n) * ldt + dk + k0 + 8 * c) = o; }
    LDS_WAIT(); asm volatile("" ::: "memory");
}
struct TrItem { const float* W; int ldw, k0, sc; bf16* WT; int ldt, dr, dk; const float* ks; };
__device__ __forceinline__ void tr_load(const TrItem& it, int lane, f32x4 (&v)[8]) {
    const float* p = it.W + (size_t)(it.k0 + (lane >> 3)) * it.ldw + it.sc + 4 * (lane & 7);
#pragma unroll
    for (int i = 0; i < 8; ++i) v[i] = *(const GAS f32x4*)(p + (size_t)(8 * i) * it.ldw);
}
__device__ __forceinline__ void tr_store(const TrItem& it, const f32x4 (&v)[8], LAS float* scr, int lane) {
#pragma unroll
    for (int i = 0; i < 8; ++i) { LAS float* p = scr + ((lane >> 3) + 8 * i) * 33 + 4 * (lane & 7); p[0] = v[i].x; p[1] = v[i].y; p[2] = v[i].z; p[3] = v[i].w; }
    LDS_WAIT(); asm volatile("" ::: "memory");
    const int c = lane & 7;
#pragma unroll
    for (int j = 0; j < 4; ++j) { const int n = (lane >> 3) + 8 * j; const LAS float* s = scr + (8 * c) * 33 + n;
        v4u o; o.x = pk2(s[0 * 33], s[1 * 33]); o.y = pk2(s[2 * 33], s[3 * 33]); o.z = pk2(s[4 * 33], s[5 * 33]); o.w = pk2(s[6 * 33], s[7 * 33]);
        *(GAS v4u*)(it.WT + (size_t)(it.dr + n) * it.ldt + it.dk + it.k0 + 8 * c) = o; }
    LDS_WAIT(); asm volatile("" ::: "memory");
}
__device__ __forceinline__ void tr_store8(const TrItem& it, const f32x4 (&v)[8], LAS float* scr, int lane, float sc) {
#pragma unroll
    for (int i = 0; i < 8; ++i) { LAS float* p = scr + ((lane >> 3) + 8 * i) * 33 + 4 * (lane & 7); p[0] = v[i].x; p[1] = v[i].y; p[2] = v[i].z; p[3] = v[i].w; }
    LDS_WAIT(); asm volatile("" ::: "memory");
    const int c = lane & 7; unsigned char* WT8 = (unsigned char*)it.WT;
    f32x4 k0v = (f32x4){sc, sc, sc, sc}, k1v = k0v;
    if (it.ks) { k0v = *(const GAS f32x4*)(it.ks + it.k0 + 8 * c) * sc; k1v = *(const GAS f32x4*)(it.ks + it.k0 + 8 * c + 4) * sc; }
#pragma unroll
    for (int j = 0; j < 4; ++j) { const int n = (lane >> 3) + 8 * j; const LAS float* s = scr + (8 * c) * 33 + n;
        v2u o; o.x = pk4_fp8(s[0 * 33] * k0v.x, s[1 * 33] * k0v.y, s[2 * 33] * k0v.z, s[3 * 33] * k0v.w); o.y = pk4_fp8(s[4 * 33] * k1v.x, s[5 * 33] * k1v.y, s[6 * 33] * k1v.z, s[7 * 33] * k1v.w);
        *(GAS v2u*)(WT8 + (size_t)(it.dr + n) * it.ldt + it.dk + it.k0 + 8 * c) = o; }
    LDS_WAIT(); asm volatile("" ::: "memory");
}
template <class F> __device__ __forceinline__ void tr_range8(int nit, F f, int gw, int NGW, LAS float* scr, int lane, float sc) {
    for (int it = gw; it < nit; it += 2 * NGW) {
        const TrItem a = f(it); f32x4 va[8], vb[8]; tr_load(a, lane, va);
        const bool two = it + NGW < nit; TrItem b = a; if (two) { b = f(it + NGW); tr_load(b, lane, vb); }
        tr_store8(a, va, scr, lane, sc);
        if (two) tr_store8(b, vb, scr, lane, sc);
    }
}
template <class F> __device__ __forceinline__ void tr_range(int nit, F f, int gw, int NGW, LAS float* scr, int lane) {
    for (int it = gw; it < nit; it += 2 * NGW) {
        const TrItem a = f(it); f32x4 va[8], vb[8]; tr_load(a, lane, va);
        const bool two = it + NGW < nit; TrItem b = a; if (two) { b = f(it + NGW); tr_load(b, lane, vb); }
        tr_store(a, va, scr, lane);
        if (two) tr_store(b, vb, scr, lane);
    }
}
__device__ __forceinline__ int win_srccol(int r) {
    if (r < 1024) { const int pn = r >> 8, blk = (r >> 5) & 7, bj = blk >> 2, wc = blk & 3; return 64 * (4 * pn + wc) + 32 * bj; }
    if (r < 1536) return 1280 + (r - 1024);
    if (r < 2048) return 2304 + (r - 1536);
    if (r < 2304) { const int blk = (r - 2048) >> 5, bj = blk >> 2, wc = blk & 3; return ((wc & 1) ? 1152 : 1024) + 64 * (wc >> 1) + 32 * bj; }
    if (r < 2816) return 1792 + (r - 2304);
    return r;
}
__device__ __forceinline__ void rms_row_to_bf16(const float* xrow, const float* g, bf16* orow, int lane) {
    const GAS f32x4* xr = (const GAS f32x4*)xrow + lane; const GAS f32x4* gr = (const GAS f32x4*)g + lane;
    f32x4 v[4]; float s = 0.f;
#pragma unroll
    for (int j = 0; j < 4; ++j) { v[j] = xr[64 * j]; s += (v[j].x * v[j].x + v[j].y * v[j].y) + (v[j].z * v[j].z + v[j].w * v[j].w); }
    const float rstd = 1.0f / sqrtf(wave_sum(s) * (1.f / 1024.f) + EPS);
    GAS v2u* o8 = (GAS v2u*)orow + lane;
#pragma unroll
    for (int j = 0; j < 4; ++j) { const f32x4 gg = gr[64 * j]; v2u o; o.x = pk2(v[j].x * rstd * gg.x, v[j].y * rstd * gg.y); o.y = pk2(v[j].z * rstd * gg.z, v[j].w * rstd * gg.w); o8[64 * j] = o; }
}

__device__ __forceinline__ void rms_rows4_to_bf16(const float* xrow, const float* g, bf16* orow, int lane) {
    const GAS f32x4* xr = (const GAS f32x4*)xrow + lane; const GAS f32x4* gr = (const GAS f32x4*)g + lane;
    f32x4 v[16]; float s[4];
#pragma unroll
    for (int j = 0; j < 16; ++j) v[j] = xr[64 * j];
#pragma unroll
    for (int r = 0; r < 4; ++r) { float a = 0.f;
#pragma unroll
        for (int j = 0; j < 4; ++j) a += (v[4 * r + j].x * v[4 * r + j].x + v[4 * r + j].y * v[4 * r + j].y) + (v[4 * r + j].z * v[4 * r + j].z + v[4 * r + j].w * v[4 * r + j].w);
        s[r] = a; }
#pragma unroll
    for (int r = 0; r < 4; ++r) s[r] = row16_sum(s[r]);
#pragma unroll
    for (int r = 0; r < 4; ++r) s[r] = xor32_sum(xor16_sum(s[r]));
    GAS v2u* o8 = (GAS v2u*)orow + lane;
#pragma unroll
    for (int r = 0; r < 4; ++r) { const float rs = 1.0f / sqrtf(s[r] * (1.f / 1024.f) + EPS);
#pragma unroll
        for (int j = 0; j < 4; ++j) { const f32x4 gg = gr[64 * j]; const f32x4 a = v[4 * r + j];
            v2u o; o.x = pk2(a.x * rs * gg.x, a.y * rs * gg.y); o.y = pk2(a.z * rs * gg.z, a.w * rs * gg.w); o8[256 * r + 64 * j] = o; } }
}
__device__ __forceinline__ void rms_rows2_to_bf16(const float* xrow, const float* g, bf16* orow, int lane) {
    const GAS f32x4* xr = (const GAS f32x4*)xrow + lane; const GAS f32x4* gr = (const GAS f32x4*)g + lane;
    f32x4 v[8]; float s0 = 0.f, s1 = 0.f;
#pragma unroll
    for (int j = 0; j < 8; ++j) v[j] = xr[64 * j];
#pragma unroll
    for (int j = 0; j < 4; ++j) { s0 += (v[j].x * v[j].x + v[j].y * v[j].y) + (v[j].z * v[j].z + v[j].w * v[j].w); s1 += (v[4 + j].x * v[4 + j].x + v[4 + j].y * v[4 + j].y) + (v[4 + j].z * v[4 + j].z + v[4 + j].w * v[4 + j].w); }
    const float r0 = 1.0f / sqrtf(wave_sum(s0) * (1.f / 1024.f) + EPS), r1 = 1.0f / sqrtf(wave_sum(s1) * (1.f / 1024.f) + EPS);
    GAS v2u* o8 = (GAS v2u*)orow + lane;
#pragma unroll
    for (int j = 0; j < 4; ++j) { const f32x4 gg = gr[64 * j];
        v2u o; o.x = pk2(v[j].x * r0 * gg.x, v[j].y * r0 * gg.y); o.y = pk2(v[j].z * r0 * gg.z, v[j].w * r0 * gg.w); o8[64 * j] = o;
        v2u p; p.x = pk2(v[4 + j].x * r1 * gg.x, v[4 + j].y * r1 * gg.y); p.y = pk2(v[4 + j].z * r1 * gg.z, v[4 + j].w * r1 * gg.w); o8[256 + 64 * j] = p; }
}
namespace att {
typedef short bf16x8 __attribute__((ext_vector_type(8)));
typedef short s16x4 __attribute__((ext_vector_type(4)));
typedef short v4i16_t __attribute__((ext_vector_type(4)));
typedef float f32x16 __attribute__((ext_vector_type(16)));
typedef float f32x2_t __attribute__((ext_vector_type(2)));
typedef __bf16 bf16x2_t __attribute__((ext_vector_type(2)));
#define ATT_MFMA(a, b, c) __builtin_amdgcn_mfma_f32_32x32x16_bf16((a), (b), (c), 0, 0, 0)
__device__ __forceinline__ unsigned cvtpk(float lo, float hi) { f32x2_t v = {lo, hi}; bf16x2_t b = __builtin_convertvector(v, bf16x2_t); return __builtin_bit_cast(unsigned, b); }
__device__ __forceinline__ s16x4 vtr(const LAS unsigned char* p) { return __builtin_bit_cast(s16x4, __builtin_amdgcn_ds_read_tr16_b64_v4i16((LAS v4i16_t*)p)); }
__device__ __forceinline__ int crow(int r, int h) { return (r & 3) + 8 * (r >> 2) + 4 * h; }
__device__ __forceinline__ bf16x8 pack8(float a0, float a1, float a2, float a3, float a4, float a5, float a6, float a7) {
    v4u w; w.x = cvtpk(a0, a1); w.y = cvtpk(a2, a3); w.z = cvtpk(a4, a5); w.w = cvtpk(a6, a7); return __builtin_bit_cast(bf16x8, w); }
constexpr float LOG2E = 1.4426950408889634f;
constexpr int SWA_KP = 144, SWA_VP = 192, SWA_K_OFF = 0, SWA_V_OFF = 256 * SWA_KP;

__device__ __forceinline__ void swa_phase(LAS unsigned char* L, bf16* projp, const float* sinks, const float* gq, const float* gk, int bid, int G, int wave, int lane) {
    const int tid = wave * 64 + lane, r32 = lane & 31, h = lane >> 5, blk16 = (lane >> 4) & 1, q4 = (lane & 15) >> 2, p4 = lane & 3;
    const float bnd = 8.0f * wave_max(fabsf(gq[lane])) * wave_max(fabsf(gk[lane]));
    v4u kx[4], vx[4];
#define SWA_LOADKV(u_) do { const int blk_ = (u_) & 15, kvh_ = ((u_) >> 4) & 1, b_ = (u_) >> 5; const int tok0_ = b_ * SEQ + blk_ * 128; \
        _Pragma("unroll") for (int it = 0; it < 4; ++it) if (it >= 2 || blk_ != 0) { \
            const bf16* src = projp + (size_t)(tok0_ - 128 + (tid >> 3) + 64 * it) * LDP + 64 * kvh_ + 8 * (tid & 7); \
            kx[it] = *(const GAS v4u*)(src + C_K); vx[it] = *(const GAS v4u*)(src + C_V); } } while (0)
    if (bid < 1024) SWA_LOADKV(bid);
    for (int unit = bid; unit < 1024; unit += G) {
        const int blk = unit & 15, kvh = (unit >> 4) & 1, b = unit >> 5;
        const int tok0 = b * SEQ + blk * 128;
        __syncthreads();
#pragma unroll
        for (int it = 0; it < 4; ++it) if (it >= 2 || blk != 0) {
            const int row = (tid >> 3) + 64 * it, ch = tid & 7;
            *(LAS v4u*)(L + SWA_K_OFF + row * SWA_KP + ch * 16) = kx[it];
            *(LAS v4u*)(L + SWA_V_OFF + row * SWA_VP + ch * 16) = vx[it];
        }
        __syncthreads();
        if (unit + G < 1024) SWA_LOADKV(unit + G);
        const int hd = kvh * 8 + wave;
        const float sink = sinks[hd];
        const float m2 = fmaxf(bnd, sink) * LOG2E;
        const float esink = __builtin_amdgcn_exp2f(sink * LOG2E - m2);
        bf16x8 qnx[4];
#pragma unroll
        for (int ks = 0; ks < 4; ++ks) qnx[ks] = *(const GAS bf16x8*)(projp + (size_t)(tok0 + r32) * LDP + C_Q + 64 * hd + 16 * ks + 8 * h);
#pragma unroll 1
        for (int qi = 0; qi < 4; ++qi) {
            bf16* qrow = projp + (size_t)(tok0 + 32 * qi + r32) * LDP + C_Q + 64 * hd;
            bf16x8 qf[4];
#pragma unroll
            for (int ks = 0; ks < 4; ++ks) qf[ks] = qnx[ks];
            if (qi < 3) {
#pragma unroll
                for (int ks = 0; ks < 4; ++ks) qnx[ks] = *(const GAS bf16x8*)(qrow + (size_t)32 * LDP + 16 * ks + 8 * h); }
            f32x16 o0, o1;
#pragma unroll
            for (int r = 0; r < 16; ++r) { o0[r] = 0.f; o1[r] = 0.f; }
            float lsum = 0.f;
            const int kt0 = (blk == 0) ? 4 : qi;
#pragma unroll 1
            for (int kt = kt0; kt <= qi + 4; ++kt) {
                f32x16 s;
#pragma unroll
                for (int r = 0; r < 16; ++r) s[r] = 0.f;
                const LAS unsigned char* kp = L + SWA_K_OFF + (32 * kt + r32) * SWA_KP + 16 * h;
#pragma unroll
                for (int ks = 0; ks < 4; ++ks) { const bf16x8 kf = *(const LAS bf16x8*)(kp + 32 * ks); s = ATT_MFMA(kf, qf[ks], s); }
                float p[16];
                const bool first = (kt == qi), lastt = (kt == qi + 4);
#pragma unroll
                for (int r = 0; r < 16; ++r) { const float e = __builtin_amdgcn_exp2f(s[r] * (0.125f * LOG2E) - m2); const int cr = crow(r, h);
                    const bool ok = (!first || cr > r32) && (!lastt || cr <= r32); p[r] = ok ? e : 0.f; lsum += p[r]; }
#pragma unroll
                for (int s2 = 0; s2 < 2; ++s2) {
                    const bf16x8 pb = pack8(p[8 * s2], p[8 * s2 + 1], p[8 * s2 + 2], p[8 * s2 + 3], p[8 * s2 + 4], p[8 * s2 + 5], p[8 * s2 + 6], p[8 * s2 + 7]);
                    const LAS unsigned char* vp = L + SWA_V_OFF + (32 * kt + 16 * s2 + 4 * h + q4) * SWA_VP + (16 * blk16 + 4 * p4) * 2;
                    { const s16x4 lo = vtr(vp), hi = vtr(vp + 8 * SWA_VP); const bf16x8 vf = __builtin_shufflevector(lo, hi, 0, 1, 2, 3, 4, 5, 6, 7); o0 = ATT_MFMA(vf, pb, o0); }
                    { const s16x4 lo = vtr(vp + 64), hi = vtr(vp + 64 + 8 * SWA_VP); const bf16x8 vf = __builtin_shufflevector(lo, hi, 0, 1, 2, 3, 4, 5, 6, 7); o1 = ATT_MFMA(vf, pb, o1); }
                }
            }
            const float tot = xor32_sum(lsum); const float inv = 1.0f / (tot + esink);
#pragma unroll
            for (int g4 = 0; g4 < 4; ++g4) {
                v2u w0; w0.x = cvtpk(o0[4 * g4] * inv, o0[4 * g4 + 1] * inv); w0.y = cvtpk(o0[4 * g4 + 2] * inv, o0[4 * g4 + 3] * inv);
                v2u w1; w1.x = cvtpk(o1[4 * g4] * inv, o1[4 * g4 + 1] * inv); w1.y = cvtpk(o1[4 * g4 + 2] * inv, o1[4 * g4 + 3] * inv);
                *(GAS v2u*)(qrow + 8 * g4 + 4 * h) = w0; *(GAS v2u*)(qrow + 32 + 8 * g4 + 4 * h) = w1;
            }
        }
    }
}

constexpr int GM_P = 1088;
__device__ __forceinline__ void gmlp_phase(LAS unsigned char* L, bf16* projp, const bf16* Wb, const float* lng, const float* lnb, const float* bs, int bid, int G, int wave, int lane) {
    const int r32 = lane & 31, h = lane >> 5, blk16 = (lane >> 4) & 1, q4 = (lane & 15) >> 2, p4 = lane & 3;
    float lg[8], lb[8];
    { const f32x4 a = *(const f32x4*)(lng + 8 * lane), b = *(const f32x4*)(lng + 8 * lane + 4), c = *(const f32x4*)(lnb + 8 * lane), d = *(const f32x4*)(lnb + 8 * lane + 4);
      lg[0] = a.x; lg[1] = a.y; lg[2] = a.z; lg[3] = a.w; lg[4] = b.x; lg[5] = b.y; lg[6] = b.z; lg[7] = b.w;
      lb[0] = c.x; lb[1] = c.y; lb[2] = c.z; lb[3] = c.w; lb[4] = d.x; lb[5] = d.y; lb[6] = d.z; lb[7] = d.w; }
    for (int unit = bid; unit < T / 128; unit += G) {
        const int tok0 = unit * 128;
        __syncthreads();
#pragma unroll 1
        for (int i0 = 0; i0 < 16; i0 += 8) {
            v4u w[8]; float sm[8], q[8];
#pragma unroll
            for (int i = 0; i < 8; ++i) w[i] = *(const GAS v4u*)(projp + (size_t)(tok0 + 16 * wave + i0 + i) * LDP + C_VB + 8 * lane);
#pragma unroll
            for (int i = 0; i < 8; ++i) sm[i] = row16_sum(((blo(w[i].x) + bhi(w[i].x)) + (blo(w[i].y) + bhi(w[i].y))) + ((blo(w[i].z) + bhi(w[i].z)) + (blo(w[i].w) + bhi(w[i].w))));
#pragma unroll
            for (int i = 0; i < 8; ++i) sm[i] = xor32_sum(xor16_sum(sm[i])) * (1.f / 512.f);
#pragma unroll
            for (int i = 0; i < 8; ++i) { const float mu = sm[i];
                const float d0 = blo(w[i].x) - mu, d1 = bhi(w[i].x) - mu, d2 = blo(w[i].y) - mu, d3 = bhi(w[i].y) - mu, d4 = blo(w[i].z) - mu, d5 = bhi(w[i].z) - mu, d6 = blo(w[i].w) - mu, d7 = bhi(w[i].w) - mu;
                q[i] = row16_sum(((d0 * d0 + d1 * d1) + (d2 * d2 + d3 * d3)) + ((d4 * d4 + d5 * d5) + (d6 * d6 + d7 * d7))); }
#pragma unroll
            for (int i = 0; i < 8; ++i) q[i] = xor32_sum(xor16_sum(q[i]));
#pragma unroll
            for (int i = 0; i < 8; ++i) { const float mu = sm[i], rstd = 1.0f / sqrtf(q[i] * (1.f / 512.f) + EPS);
                v4u o; o.x = cvtpk((blo(w[i].x) - mu) * rstd * lg[0] + lb[0], (bhi(w[i].x) - mu) * rstd * lg[1] + lb[1]); o.y = cvtpk((blo(w[i].y) - mu) * rstd * lg[2] + lb[2], (bhi(w[i].y) - mu) * rstd * lg[3] + lb[3]);
                o.z = cvtpk((blo(w[i].z) - mu) * rstd * lg[4] + lb[4], (bhi(w[i].z) - mu) * rstd * lg[5] + lb[5]); o.w = cvtpk((blo(w[i].w) - mu) * rstd * lg[6] + lb[6], (bhi(w[i].w) - mu) * rstd * lg[7] + lb[7]);
                *(LAS v4u*)(L + (16 * wave + i0 + i) * GM_P + lane * 16) = o; }
        }
        __syncthreads();
        const int g = wave >> 1, th = wave & 1;
        f32x16 acc[4][2];
#pragma unroll
        for (int ct = 0; ct < 4; ++ct)
#pragma unroll
            for (int tt = 0; tt < 2; ++tt)
#pragma unroll
                for (int r = 0; r < 16; ++r) acc[ct][tt][r] = 0.f;
#pragma unroll 1
        for (int ks = 0; ks < 4 * th + 4; ++ks) {
            bf16x8 af[4];
#pragma unroll
            for (int ct = 0; ct < 4; ++ct) { const LAS unsigned char* vp = L + (16 * ks + 8 * h + q4) * GM_P + (128 * g + 32 * ct + 16 * blk16 + 4 * p4) * 2;
                const s16x4 lo = vtr(vp), hi = vtr(vp + 4 * GM_P); af[ct] = __builtin_shufflevector(lo, hi, 0, 1, 2, 3, 4, 5, 6, 7); }
#pragma unroll
            for (int tt = 0; tt < 2; ++tt) if (ks < 4 * th + 2 * tt + 2) {
                const bf16x8 bfr = *(const GAS bf16x8*)(Wb + (size_t)(g * 128 + 64 * th + 32 * tt + r32) * 128 + 16 * ks + 8 * h);
#pragma unroll
                for (int ct = 0; ct < 4; ++ct) acc[ct][tt] = ATT_MFMA(af[ct], bfr, acc[ct][tt]);
            }
        }
#pragma unroll
        for (int tt = 0; tt < 2; ++tt) { const int t = 64 * th + 32 * tt + r32; const float bsv = bs[g * 128 + t];
            bf16* urow = projp + (size_t)(tok0 + t) * LDP + C_U + 128 * g + 4 * h;
#pragma unroll
            for (int ct = 0; ct < 4; ++ct)
#pragma unroll
                for (int g4 = 0; g4 < 4; ++g4) { bf16* up = urow + 32 * ct + 8 * g4; const v2u uw = *(const GAS v2u*)up;
                    v2u o; o.x = cvtpk(blo(uw.x) * (acc[ct][tt][4 * g4] + bsv), bhi(uw.x) * (acc[ct][tt][4 * g4 + 1] + bsv));
                    o.y = cvtpk(blo(uw.y) * (acc[ct][tt][4 * g4 + 2] + bsv), bhi(uw.y) * (acc[ct][tt][4 * g4 + 3] + bsv)); *(GAS v2u*)up = o; } }
    }
}

constexpr int XA_K_OFF = 0, XA_V_OFF = 65536;
__device__ __forceinline__ unsigned off_b(unsigned row, unsigned ch) { return 256u * row + 16u * (ch ^ (((row & 3u) << 2) | ((row >> 2) & 3u))); }
__device__ __forceinline__ void xattn_phase(LAS unsigned char* L, bf16* projp, const bf16* kvp, const float* cqg, const float* ckg, int bid, int G, int wave, int lane) {
    const int tid = wave * 64 + lane, r32 = lane & 31, h = lane >> 5, blk16 = (lane >> 4) & 1, q4 = (lane & 15) >> 2, p4 = lane & 3;
    const int fch = tid & 15;
    float gg[8];
#pragma unroll
    for (int i = 0; i < 8; ++i) gg[i] = cqg[8 * fch + i] * ckg[8 * fch + i] * (0.08838834764831845f * LOG2E);
    const float mq = wave_max(fmaxf(fabsf(cqg[lane]), fabsf(cqg[lane + 64]))), mk = wave_max(fmaxf(fabsf(ckg[lane]), fabsf(ckg[lane + 64])));
    const float m2 = 11.313708499f * mq * mk * LOG2E;
    for (int unit = bid; unit < 256; unit += G) {
        const int qh = unit & 1, hd = (unit >> 1) & 3, b = unit >> 3;
        __syncthreads();
        {   v4u kx[8], vx[8];
#pragma unroll
            for (int it = 0; it < 8; ++it) { const bf16* src = kvp + (size_t)(b * MEM + (tid >> 4) + 32 * it) * D + 128 * hd + 8 * fch; kx[it] = *(const GAS v4u*)src; vx[it] = *(const GAS v4u*)(src + 512); }
#pragma unroll
            for (int it = 0; it < 8; ++it) { const int row = (tid >> 4) + 32 * it;
                float k[8] = {blo(kx[it].x), bhi(kx[it].x), blo(kx[it].y), bhi(kx[it].y), blo(kx[it].z), bhi(kx[it].z), blo(kx[it].w), bhi(kx[it].w)};
                float ss = 0.f;
#pragma unroll
                for (int e = 0; e < 8; ++e) ss += k[e] * k[e];
                ss = row16_sum(ss);
                const float rstd = 1.0f / sqrtf(ss * (1.f / 128.f) + EPS);
                v4u ko; ko.x = cvtpk(k[0] * rstd * gg[0], k[1] * rstd * gg[1]); ko.y = cvtpk(k[2] * rstd * gg[2], k[3] * rstd * gg[3]);
                ko.z = cvtpk(k[4] * rstd * gg[4], k[5] * rstd * gg[5]); ko.w = cvtpk(k[6] * rstd * gg[6], k[7] * rstd * gg[7]);
                const unsigned o = off_b((unsigned)row, (unsigned)fch);
                *(LAS v4u*)(L + XA_K_OFF + o) = ko; *(LAS v4u*)(L + XA_V_OFF + o) = vx[it]; } }
        bf16* qrow0 = projp + (size_t)(b * SEQ + 1024 * qh + 32 * wave + r32) * LDP + C_QC + 128 * hd + 8 * h;
        v4u qn[8];
#pragma unroll
        for (int ks = 0; ks < 8; ++ks) qn[ks] = *(const GAS v4u*)(qrow0 + 16 * ks);
        __syncthreads();
#pragma unroll 1
        for (int qt = 0; qt < 4; ++qt) {
            bf16* qrow = qrow0 + (size_t)(256 * qt) * LDP;
            bf16x8 qf[8]; float ss = 0.f;
#pragma unroll
            for (int ks = 0; ks < 8; ++ks) { const v4u w = qn[ks]; qf[ks] = __builtin_bit_cast(bf16x8, w);
                ss += (blo(w.x) * blo(w.x) + bhi(w.x) * bhi(w.x)) + (blo(w.y) * blo(w.y) + bhi(w.y) * bhi(w.y)) + (blo(w.z) * blo(w.z) + bhi(w.z) * bhi(w.z)) + (blo(w.w) * blo(w.w) + bhi(w.w) * bhi(w.w)); }
            if (qt < 3) {
#pragma unroll
                for (int ks = 0; ks < 8; ++ks) qn[ks] = *(const GAS v4u*)(qrow + (size_t)256 * LDP + 16 * ks); }
            ss = xor32_sum(ss);
            const float rq = 1.0f / sqrtf(ss * (1.f / 128.f) + EPS);
            f32x16 o[4];
#pragma unroll
            for (int dt = 0; dt < 4; ++dt)
#pragma unroll
                for (int r = 0; r < 16; ++r) o[dt][r] = 0.f;
            float lsum = 0.f;
#pragma unroll 1
            for (int kt = 0; kt < 8; ++kt) {
                f32x16 s;
#pragma unroll
                for (int r = 0; r < 16; ++r) s[r] = 0.f;
#pragma unroll
                for (int ks = 0; ks < 8; ++ks) { const bf16x8 kf = *(const LAS bf16x8*)(L + XA_K_OFF + off_b((unsigned)(32 * kt + r32), (unsigned)(2 * ks + h))); s = ATT_MFMA(kf, qf[ks], s); }
                float p[16];
#pragma unroll
                for (int r = 0; r < 16; ++r) { p[r] = __builtin_amdgcn_exp2f(s[r] * rq - m2); lsum += p[r]; }
#pragma unroll
                for (int s2 = 0; s2 < 2; ++s2) {
                    const bf16x8 pb = pack8(p[8 * s2], p[8 * s2 + 1], p[8 * s2 + 2], p[8 * s2 + 3], p[8 * s2 + 4], p[8 * s2 + 5], p[8 * s2 + 6], p[8 * s2 + 7]);
                    const unsigned r0 = (unsigned)(32 * kt + 16 * s2 + 4 * h + q4);
#pragma unroll
                    for (int dt = 0; dt < 4; ++dt) {
                        const unsigned ch = (unsigned)(4 * dt + 2 * blk16 + (p4 >> 1));
                        const s16x4 lo = vtr(L + XA_V_OFF + off_b(r0, ch) + 8 * (p4 & 1)), hi = vtr(L + XA_V_OFF + off_b(r0 + 8u, ch) + 8 * (p4 & 1));
                        const bf16x8 vf = __builtin_shufflevector(lo, hi, 0, 1, 2, 3, 4, 5, 6, 7); o[dt] = ATT_MFMA(vf, pb, o[dt]); }
                }
            }
            const float inv = 1.0f / xor32_sum(lsum);
#pragma unroll
            for (int dt = 0; dt < 4; ++dt)
#pragma unroll
                for (int g4 = 0; g4 < 4; ++g4) { v2u w; w.x = cvtpk(o[dt][4 * g4] * inv, o[dt][4 * g4 + 1] * inv); w.y = cvtpk(o[dt][4 * g4 + 2] * inv, o[dt][4 * g4 + 3] * inv);
                    *(GAS v2u*)(qrow - 8 * h + 32 * dt + 8 * g4 + 4 * h) = w; }
        }
    }
}
}

constexpr int NPHASE = 11;
__global__ void __launch_bounds__(NTHR, 2) fwd(Args args) {
    extern __shared__ __attribute__((aligned(16))) unsigned char lds[];
    LAS unsigned char* L = (LAS unsigned char*)lds;
    volatile LAS unsigned* MISC = (volatile LAS unsigned*)(L + MISC_OFF);
    const int wave_s = __builtin_amdgcn_readfirstlane((int)threadIdx.x >> 6);
    for (int u = threadIdx.x; u < (LDS_BYTES - LDSCTL_OFF) / 4; u += NTHR) ((LAS unsigned*)(L + LDSCTL_OFF))[u] = 0u;
    __syncthreads();
#define LANE_ID ((int)__builtin_amdgcn_mbcnt_hi(~0u, __builtin_amdgcn_mbcnt_lo(~0u, 0u)))
#if MK_FUSED
    XcdBarrier bar = xcd_barrier_post((unsigned*)(args.ws + WS_CTL) + CW_BAR, MISC + 8, wave_s == 0 && LANE_ID == 0);
#define GRID_BAR() xcd_barrier(bar, wave_s == 0 && LANE_ID == 0)
#else
    (void)MISC;
#define GRID_BAR() do {} while (0)
#endif
    const int lo = args.ph_lo, hi = args.ph_hi;
#define IN(k) (lo <= (k) && (k) < hi)
#if PROBE_MASK
#define STAMP(k) do { if (blockIdx.x == 0 && wave_s == 0 && LANE_ID == 0) ((LAS unsigned*)(L + LDSCTL_OFF + 640))[(k) + 1] = (unsigned)__builtin_amdgcn_s_memrealtime(); } while (0)
#define STAMPX(i) do { if (blockIdx.x == 0 && wave_s == 0 && LANE_ID == 0) ((LAS unsigned*)(L + LDSCTL_OFF + 640))[16 + (i)] = (unsigned)__builtin_amdgcn_s_memrealtime(); } while (0)
#else
#define STAMP(k) do {} while (0)
#define STAMPX(i) do {} while (0)
#endif
#define SEAM(k) do { if (IN(k) && IN((k) + 1)) GRID_BAR(); STAMP(k); } while (0)
    STAMP(-1);
#define PV \
    int wave = wave_s; asm volatile("" : "+s"(wave)); int bid = blockIdx.x; asm volatile("" : "+s"(bid)); \
    const int lane = LANE_ID, tid = wave * 64 + lane; \
    const int G = gridDim.x, gw = bid * NWAVES + wave, NGW = G * NWAVES, gtid = bid * NTHR + tid, NT = G * NTHR; \
    GAS unsigned char* ws = (GAS unsigned char*)args.ws; asm volatile("" : "+s"(ws));     \
    gu32* ctl = (gu32*)(ws + WS_CTL); \
    LAS float* scr = (LAS float*)(L + RING_OFF + wave * 16384); \
    (void)lane; (void)tid; (void)bid; (void)gw; (void)NGW; (void)gtid; (void)NT; (void)ctl; (void)scr; (void)G;
#define Win_t ((bf16*)(ws + WS_WIN))
#define Wo_t ((bf16*)(ws + WS_WO))
#define Wmkv_t ((bf16*)(ws + WS_WMKV))
#define Wout_t ((bf16*)(ws + WS_WOUT))
#define Hb ((bf16*)(ws + WS_H))
#define proj ((bf16*)(ws + WS_PROJ))
#define memn ((bf16*)(ws + WS_MEMN))
#define kv ((bf16*)(ws + WS_KV))
#define rope ((float2*)(ws + WS_ROPE))
#define Wgu_t ((bf16*)(ws + WS_WGU))
#define Wd_t ((bf16*)(ws + WS_WD))
#define ybuf ((bf16*)(ws + WS_Y))
#define act ((bf16*)(ws + WS_ACT))
#define topk_idx ((int*)(ws + WS_META + MT_IDX))
#define topk_gate ((float*)(ws + WS_META + MT_GATE))
#define slot_of ((int*)(ws + WS_META + MT_SASG))
#define slot_tok ((int*)(ws + WS_META + MT_STOK))
#define slot_gate ((float*)(ws + WS_META + MT_SGATE))
#define tile_e ((int*)(ws + WS_META + MT_TILEE))
#define Wsb ((bf16*)(ws + WS_META + MT_WSB))
#define Cmat ((int*)(ws + WS_META + MT_CMAT))
#define Rwp ((float*)(ws + WS_META + MT_RWP))
#define rstd_tok ((float*)(ws + WS_META + MT_RSTD))
#define slot_rstd ((float*)(ws + WS_SRSTD))
#define X8 ((unsigned char*)(ws + WS_X8))
#define x1b ((bf16*)(ws + WS_X1B))

    if (IN(0)) { PV
        const float* x = args.in[I_X]; (void)x;
        {
            const float* Wi = args.in[I_WIN]; const float* Wa = args.in[I_WOA]; const float* Wb = args.in[I_WOB]; const float* Wc = args.in[I_WOC]; const float* Wm = args.in[I_WMKV]; const float* Wu = args.in[I_WOUT];
            bf16* Oi = Win_t; bf16* Oo = Wo_t; bf16* Om = Wmkv_t; bf16* Ou = Wout_t;
            constexpr int N0 = (D / 64) * (DIN / 32), N1 = N0 + 16 * 32, N2 = N1 + 8 * 32, N3 = N2 + 8 * 32, N4 = N3 + 16 * 32, N5 = N4 + 16 * 32;
            tr_range(N5, [=](int it) {
                if (it < N0) { const int kb = it / (DIN / 32), rb = it % (DIN / 32); return TrItem{Wi, DIN, 64 * kb, win_srccol(32 * rb), Oi, D, 32 * rb, 0, nullptr}; }
                if (it < N1) { const int r = it - N0; return TrItem{Wa, D, 64 * (r >> 5), 32 * (r & 31), Oo, 2048, 32 * (r & 31), 0, nullptr}; }
                if (it < N2) { const int r = it - N1; return TrItem{Wb, D, 64 * (r >> 5), 32 * (r & 31), Oo, 2048, 32 * (r & 31), 1024, nullptr}; }
                if (it < N3) { const int r = it - N2; return TrItem{Wc, D, 64 * (r >> 5), 32 * (r & 31), Oo, 2048, 32 * (r & 31), 1536, nullptr}; }
                if (it < N4) { const int r = it - N3; return TrItem{Wm, D, 64 * (r >> 5), 32 * (r & 31), Om, D, 32 * (r & 31), 0, nullptr}; }
                const int r = it - N4; return TrItem{Wu, D, 64 * (r >> 5), 32 * (r & 31), Ou, D, 32 * (r & 31), 0, nullptr}; }, gw, NGW, scr, lane);
        }
        STAMPX(8);
        for (int i = gtid; i < D * 32; i += NT) { const int k = i >> 5, e = i & 31; Rwp[(k >> 2) * 128 + e * 4 + (k & 3)] = args.in[I_FFN_G][k] * args.in[I_RW][i]; }
        { const int* pos = (const int*)args.in[I_POS];
          for (int i = gtid; i < T * 32; i += NT) { const int t = i >> 5, f = i & 31;
              const float inv = powf(10000.0f, -(float)(2 * f) / 64.0f); const float ang = (float)pos[t] * inv;
              float sn, cs; sincosf(ang, &sn, &cs); rope[i] = make_float2(cs, sn); } }
        for (int i = gtid; i < 4 * 128 * 128; i += NT) { const int tt = (i >> 7) & 127, sp = i & 127; Wsb[i] = (bf16)(sp <= tt ? f2bf(args.in[I_WS][i]) : 0u); }
        STAMPX(9);
        {
            f32x4 gg[4];
#pragma unroll
            for (int j = 0; j < 4; ++j) gg[j] = *((const GAS f32x4*)args.in[I_ATTN_G] + lane + 64 * j);
            f32x4 va[16], vb[16];
            int m = gw;
            if (m < T / 4) { const GAS f32x4* xr = (const GAS f32x4*)(x + (size_t)m * 4 * D) + lane;
#pragma unroll
                for (int j = 0; j < 16; ++j) va[j] = xr[64 * j]; }
#define ROWS4_FINISH(v, mm) do { float s_[4]; \
                _Pragma("unroll") for (int r = 0; r < 4; ++r) { float a_ = 0.f; \
                    _Pragma("unroll") for (int j = 0; j < 4; ++j) a_ += (v[4 * r + j].x * v[4 * r + j].x + v[4 * r + j].y * v[4 * r + j].y) + (v[4 * r + j].z * v[4 * r + j].z + v[4 * r + j].w * v[4 * r + j].w); \
                    s_[r] = row16_sum(a_); } \
                _Pragma("unroll") for (int r = 0; r < 4; ++r) s_[r] = xor32_sum(xor16_sum(s_[r])); \
                GAS v2u* o8_ = (GAS v2u*)(Hb + (size_t)(mm) * 4 * D) + lane; \
                _Pragma("unroll") for (int r = 0; r < 4; ++r) { const float rs_ = 1.0f / sqrtf(s_[r] * (1.f / 1024.f) + EPS); \
                    _Pragma("unroll") for (int j = 0; j < 4; ++j) { const f32x4 a_ = v[4 * r + j]; \
                        v2u o_; o_.x = pk2(a_.x * rs_ * gg[j].x, a_.y * rs_ * gg[j].y); o_.y = pk2(a_.z * rs_ * gg[j].z, a_.w * rs_ * gg[j].w); o8_[256 * r + 64 * j] = o_; } } } while (0)
            for (; m < T / 4; m += 2 * NGW) {
                const int m2 = m + NGW; const bool two = m2 < T / 4;
                if (two) { const GAS f32x4* xr = (const GAS f32x4*)(x + (size_t)m2 * 4 * D) + lane;
#pragma unroll
                    for (int j = 0; j < 16; ++j) vb[j] = xr[64 * j]; }
                ROWS4_FINISH(va, m);
                const int m3 = m + 2 * NGW;
                if (m3 < T / 4) { const GAS f32x4* xr = (const GAS f32x4*)(x + (size_t)m3 * 4 * D) + lane;
#pragma unroll
                    for (int j = 0; j < 16; ++j) va[j] = xr[64 * j]; }
                if (two) ROWS4_FINISH(vb, m2);
            }
#undef ROWS4_FINISH
        }
        STAMPX(10);
        for (int m = gw; m < TM; m += NGW) rms_row_to_bf16(args.in[I_MEM] + (size_t)m * D, args.in[I_MEM_G], memn + (size_t)m * D, lane);
    }
    SEAM(0);
    if (IN(1)) { PV
        { pg8::Gemm g{Hb, Win_t, D, D, D}; pg8::StaticOrder S; S.init(T, DIN, G, bid);
          pg8::EpiProj E{proj, LDP, (const float*)rope, args.in[I_AQG], args.in[I_AKG], args.in[I_BGATES], EPS, C_Q, C_K, C_V, C_G};
          pg8::gemm_phase<pg8::EpiProj, pg8::StaticOrder>(L + RING_OFF, g, S, E, wave); }
        { pg8::Gemm g{memn, Wmkv_t, D, D, D}; pg8::StaticOrder S; S.init(TM, D, G, bid); pg8::EpiBf16 E{kv, D};
          pg8::gemm_phase<pg8::EpiBf16, pg8::StaticOrder>(L + RING_OFF, g, S, E, wave); }
        if (G == 256 && bid >= 128) { const float* W = args.in[I_WD]; unsigned char* O = (unsigned char*)Wd_t; constexpr int nrb = D / 32, per = (D / 64) * nrb;
          tr_range8(WD_P1_ITEMS, [=](int it) { const int e = it / per, r0 = it % per, kb = r0 / nrb, rb2 = r0 % nrb;
              return TrItem{W + (size_t)e * D * D, D, 64 * kb, 32 * rb2, (bf16*)(O + (size_t)e * D * D), D, 32 * rb2, 0, nullptr}; }, (bid - 128) * NWAVES + wave, 128 * NWAVES, scr, lane, WSCALE); }
    }
    if (IN(1) && IN(3)) GRID_BAR();
    STAMP(1); STAMP(2);
    if (IN(3)) { PV
        STAMPX(4);
        att::swa_phase(L + RING_OFF, proj, args.in[I_SINKS], args.in[I_AQG], args.in[I_AKG], bid, G, wave, lane);
        __syncthreads();
        STAMPX(5);
        att::gmlp_phase(L + RING_OFF, proj, Wsb, args.in[I_LNG], args.in[I_LNB], args.in[I_BS], bid, G, wave, lane);
        __syncthreads();
        STAMPX(6);
        att::xattn_phase(L + RING_OFF, proj, kv, args.in[I_CQG], args.in[I_CKG], bid, G, wave, lane);
        __syncthreads();
    }
    SEAM(3);
    if (IN(4)) { PV
        pg8::StaticOrder S; S.init(T, D, G, bid);
        pg8::Gemm g{proj + C_Q, Wo_t, 2048, LDP, 2048}; pg8::EpiMergeK E{Hb, D, (const unsigned char*)(proj + C_G), LDP * 2};
        pg8::gemm_phase<pg8::EpiMergeK, pg8::StaticOrder>(L + RING_OFF, g, S, E, wave);
    }
    SEAM(4);
    if (IN(5)) { PV
        const float* x = args.in[I_X];
        pg8::Gemm g{Hb, Wout_t, D, D, D}; pg8::StaticOrder S; S.init(T, D, G, bid); pg8::EpiResF32 E{x1b, x, X8, D};
        pg8::gemm_phase<pg8::EpiResF32, pg8::StaticOrder>(L + RING_OFF, g, S, E, wave);
    }
    SEAM(5);
    if (IN(6)) { PV
        const float* rb = args.in[I_RB]; const float* fg = args.in[I_FFN_G];
        LAS unsigned* hist = (LAS unsigned*)(L + LDSCTL_OFF + 512);
        const int r32 = lane & 31, hh = lane >> 5;
        STAMPX(0);
        for (int i = tid; i < 8192; i += NTHR) *(LAS f32x4*)(L + RING_OFF + i * 16) = *(const GAS f32x4*)(Rwp + 4 * i);
        for (int vb = bid; vb < T / 256; vb += G) {
            __syncthreads();
            if (tid < 32) hist[tid] = 0u;
            __syncthreads();
            const int tok0 = vb * 256 + wave * 32;
            att::f32x16 acc;
#pragma unroll
            for (int r = 0; r < 16; ++r) acc[r] = 0.f;
            float ss = 0.f;
            const bf16* xp = x1b + (size_t)(tok0 + r32) * D + 16 * hh;
            const LAS unsigned char* wl = L + RING_OFF + (4 * hh) * 512 + r32 * 16;
#define RT_LOAD(xs, it) do { _Pragma("unroll") for (int q = 0; q < 4; ++q) xs[q] = *(const GAS v2u*)(xp + 32 * (it) + 4 * q); } while (0)
#define RT_COMP(xs, it) do { _Pragma("unroll") for (int q = 0; q < 4; ++q) { const f32x4 wa = *(const LAS f32x4*)(wl + (8 * (it) + q) * 512); \
                    const f32x4 xv = (f32x4){blo(xs[q].x), bhi(xs[q].x), blo(xs[q].y), bhi(xs[q].y)}; \
                    ss += (xv.x * xv.x + xv.y * xv.y) + (xv.z * xv.z + xv.w * xv.w); \
                    acc = __builtin_amdgcn_mfma_f32_32x32x2f32(wa.x, xv.x, acc, 0, 0, 0); acc = __builtin_amdgcn_mfma_f32_32x32x2f32(wa.y, xv.y, acc, 0, 0, 0); \
                    acc = __builtin_amdgcn_mfma_f32_32x32x2f32(wa.z, xv.z, acc, 0, 0, 0); acc = __builtin_amdgcn_mfma_f32_32x32x2f32(wa.w, xv.w, acc, 0, 0, 0); } } while (0)
            v2u x0[4], x1[4], x2[4];
            RT_LOAD(x0, 0); RT_LOAD(x1, 1);
#pragma unroll 1
            for (int it = 0; it < 30; it += 3) {
                RT_LOAD(x2, it + 2); RT_COMP(x0, it);
                RT_LOAD(x0, it + 3); RT_COMP(x1, it + 1);
                RT_LOAD(x1, it + 4); RT_COMP(x2, it + 2);
            }
            RT_COMP(x0, 30); RT_COMP(x1, 31);
#undef RT_LOAD
#undef RT_COMP
            ss = xor32_sum(ss);
            const float rstd = 1.0f / sqrtf(ss * (1.f / 1024.f) + EPS);
            float v[16];
#pragma unroll
            for (int r = 0; r < 16; ++r) v[r] = acc[r] * rstd + rb[att::crow(r, hh)];
            float cv[8]; int ci[8];
#pragma unroll
            for (int k = 0; k < 4; ++k) { float best = -INFINITY; int bi = 99;
#pragma unroll
                for (int r = 0; r < 16; ++r) if (v[r] > best) { best = v[r]; bi = att::crow(r, hh); }
                cv[k] = best; ci[k] = bi;
#pragma unroll
                for (int r = 0; r < 16; ++r) v[r] = (att::crow(r, hh) == bi) ? -INFINITY : v[r]; }
#pragma unroll
            for (int k = 0; k < 4; ++k) { cv[4 + k] = __builtin_bit_cast(float, xor32_get(__builtin_bit_cast(unsigned, cv[k]), hh != 0)); ci[4 + k] = (int)xor32_get((unsigned)ci[k], hh != 0); }
            float bv[4]; int be[4];
#pragma unroll
            for (int k = 0; k < 4; ++k) { float best = -INFINITY; int bi = 99;
#pragma unroll
                for (int c = 0; c < 8; ++c) if (cv[c] > best || (cv[c] == best && ci[c] < bi)) { best = cv[c]; bi = ci[c]; }
                bv[k] = best; be[k] = bi;
#pragma unroll
                for (int c = 0; c < 8; ++c) cv[c] = (ci[c] == bi) ? -INFINITY : cv[c]; }
            const float p1 = expf(bv[1] - bv[0]), p2 = expf(bv[2] - bv[0]), p3 = expf(bv[3] - bv[0]); const float inv = 1.0f / (1.0f + p1 + p2 + p3);
            if (hh == 0) {
                int4 iw; float4 gw4;
                iw.x = be[0] | (int)(__hip_atomic_fetch_add(hist + be[0], 1u, __ATOMIC_RELAXED, __HIP_MEMORY_SCOPE_WORKGROUP) << 8);
                iw.y = be[1] | (int)(__hip_atomic_fetch_add(hist + be[1], 1u, __ATOMIC_RELAXED, __HIP_MEMORY_SCOPE_WORKGROUP) << 8);
                iw.z = be[2] | (int)(__hip_atomic_fetch_add(hist + be[2], 1u, __ATOMIC_RELAXED, __HIP_MEMORY_SCOPE_WORKGROUP) << 8);
                iw.w = be[3] | (int)(__hip_atomic_fetch_add(hist + be[3], 1u, __ATOMIC_RELAXED, __HIP_MEMORY_SCOPE_WORKGROUP) << 8);
                gw4.x = inv; gw4.y = p1 * inv; gw4.z = p2 * inv; gw4.w = p3 * inv;
                *(int4*)(topk_idx + (size_t)(tok0 + r32) * 4) = iw; *(float4*)(topk_gate + (size_t)(tok0 + r32) * 4) = gw4; }
            if (hh == 0) rstd_tok[tok0 + r32] = rstd;
            if (vb == 0) STAMPX(3);
            __syncthreads();
            if (tid < 32) Cmat[vb * 32 + tid] = (int)hist[tid];
        }
        STAMPX(1);
        { const float* W = args.in[I_WGU]; unsigned char* O = (unsigned char*)Wgu_t; constexpr int nrb = 2048 / 32, per = (D / 64) * nrb;
          tr_range8(NEXP * per, [=](int it) { const int e = it / per, r0 = it % per, kb = r0 / nrb, rb2 = r0 % nrb; const int r = 32 * rb2, j = r >> 8, rr = r & 255;
              const int sc = rr < 128 ? 128 * j + rr : 1024 + 128 * j + (rr - 128);
              return TrItem{W + (size_t)e * D * 2048, 2048, 64 * kb, sc, (bf16*)(O + (size_t)e * 2048 * D), D, r, 0, fg}; }, gw, NGW, scr, lane, WSCALE); }
        STAMPX(2);
        { const float* W = args.in[I_WD]; unsigned char* O = (unsigned char*)Wd_t; constexpr int nrb = D / 32, per = (D / 64) * nrb; const int first = (G == 256) ? WD_P1_ITEMS : 0;
          tr_range8(NEXP * per - first, [=](int it0) { const int it = it0 + first; const int e = it / per, r0 = it % per, kb = r0 / nrb, rb2 = r0 % nrb;
              return TrItem{W + (size_t)e * D * D, D, 64 * kb, 32 * rb2, (bf16*)(O + (size_t)e * D * D), D, 32 * rb2, 0, nullptr}; }, gw, NGW, scr, lane, WSCALE); }
    }
    SEAM(6);
    if (IN(7)) { PV
        LAS int* psum = (LAS int*)(L + RING_OFF);
        LAS int* tot = psum + 512;
        LAS int* startv = tot + 32;
        LAS int* basev = startv + 32;
        LAS int* ntl = basev + 32;
        for (int vb = bid; vb < T / 256; vb += G) {
            __syncthreads();
            { const int e = tid & 31, part = tid >> 5; int ps = 0;
#pragma unroll 4
              for (int i = 0; i < 16; ++i) ps += Cmat[(part * 16 + i) * 32 + e];
              psum[part * 32 + e] = ps; }
            __syncthreads();
            if (tid < 32) { int tt = 0;
#pragma unroll
                for (int p = 0; p < 16; ++p) tt += psum[p * 32 + tid];
                tot[tid] = tt; }
            __syncthreads();
            if (tid == 0) { int row = 0; for (int e = 0; e < 32; ++e) { startv[e] = row; row += (tot[e] + 255) & ~255; } ntl[0] = row >> 8; }
            __syncthreads();
            const int part = vb >> 4;
            if (tid < 32) { int bs = startv[tid];
                for (int p = 0; p < part; ++p) bs += psum[p * 32 + tid];
                for (int v2 = part * 16; v2 < vb; ++v2) bs += Cmat[v2 * 32 + tid];
                basev[tid] = bs; }
            __syncthreads();
            for (int i = tid; i < 1024; i += NTHR) { const int a = vb * 1024 + i; const int v = topk_idx[a]; const int e = v & 255, rank = v >> 8;
                const int slot = basev[e] + rank;
                slot_tok[slot] = a >> 2; slot_of[a] = slot; slot_rstd[slot] = rstd_tok[a >> 2]; }
            if (vb < 32) { const int e = vb; const int t0 = tot[e], st = startv[e], pd = ((t0 + 255) & ~255) - t0;
                if (tid < pd) { slot_tok[st + t0 + tid] = -1; slot_rstd[st + t0 + tid] = 0.f; } }
            if (vb == 32) {
                if (tid < 32) { const int nt = (tot[tid] + 255) >> 8, first = startv[tid] >> 8; for (int i = 0; i < nt; ++i) tile_e[first + i] = tid; }
                if (tid == 0) ((unsigned*)(ctl + CW_NTILE))[0] = (unsigned)ntl[0]; }
        }
    }
    SEAM(7);
#define NTILE_ALL ((int)__hip_atomic_load((unsigned*)(ctl + CW_NTILE), RLX_AGENT))
    if (IN(8)) { PV const int ntile = NTILE_ALL;
        pg8::Gemm g{(const bf16*)X8, Wgu_t, D / 2, D / 2, D / 2};
        pg8::GroupedOrder S{tile_e, ntile, 8, G, bid}; pg8::EpiSwiglu8 E{(unsigned char*)act, args.in[I_BGU], slot_rstd, 1.0f / WSCALE};
        pg8::gemm_phase_gather<pg8::EpiSwiglu8, pg8::GroupedOrder, true>(L + RING_OFF, g, S, E, wave, slot_tok);
    }
    SEAM(8);
    if (IN(9)) { PV const int ntile = NTILE_ALL;
        pg8::Gemm g{act, Wd_t, D / 2, D / 2, D / 2}; pg8::GroupedOrder S{tile_e, ntile, 4, G, bid}; static_assert(YSCALE == 16.0f, "EpiDown scales the bias by 16"); pg8::EpiDown E{(unsigned char*)ybuf, args.in[I_BD], YSCALE / WSCALE};
        pg8::gemm_phase<pg8::EpiDown, pg8::GroupedOrder, true>(L + RING_OFF, g, S, E, wave);
    }
    SEAM(9);
    if (IN(10)) { PV
        typedef float f2t __attribute__((ext_vector_type(2)));
        int4 sl = *(const int4*)(slot_of + (size_t)gw * 4); float4 gt = *(const float4*)(topk_gate + (size_t)gw * 4);
        for (int t = gw; t < T; t += NGW) {
            GAS f32x4* op = (GAS f32x4*)(args.out + (size_t)t * D) + lane;
            const GAS v2u* xq = (const GAS v2u*)(x1b + (size_t)t * D) + lane;
            const unsigned char* yb = (const unsigned char*)ybuf + 4 * lane;
            f32x4 o[4]; unsigned ya[4][4];
#pragma unroll
            for (int j = 0; j < 4; ++j) { const v2u xw = xq[64 * j]; o[j] = (f32x4){blo(xw.x), bhi(xw.x), blo(xw.y), bhi(xw.y)};
                ya[0][j] = *(const GAS unsigned*)(yb + (size_t)sl.x * D + 256 * j); ya[1][j] = *(const GAS unsigned*)(yb + (size_t)sl.y * D + 256 * j);
                ya[2][j] = *(const GAS unsigned*)(yb + (size_t)sl.z * D + 256 * j); ya[3][j] = *(const GAS unsigned*)(yb + (size_t)sl.w * D + 256 * j); }
            const float g0 = gt.x * (1.0f / YSCALE), g1 = gt.y * (1.0f / YSCALE), g2 = gt.z * (1.0f / YSCALE), g3 = gt.w * (1.0f / YSCALE);
            if (t + NGW < T) { sl = *(const int4*)(slot_of + (size_t)(t + NGW) * 4); gt = *(const float4*)(topk_gate + (size_t)(t + NGW) * 4); }
#pragma unroll
            for (int j = 0; j < 4; ++j) {
                const f2t l0 = __builtin_amdgcn_cvt_pk_f32_fp8((int)ya[0][j], false), h0 = __builtin_amdgcn_cvt_pk_f32_fp8((int)ya[0][j], true);
                const f2t l1 = __builtin_amdgcn_cvt_pk_f32_fp8((int)ya[1][j], false), h1 = __builtin_amdgcn_cvt_pk_f32_fp8((int)ya[1][j], true);
                const f2t l2 = __builtin_amdgcn_cvt_pk_f32_fp8((int)ya[2][j], false), h2 = __builtin_amdgcn_cvt_pk_f32_fp8((int)ya[2][j], true);
                const f2t l3 = __builtin_amdgcn_cvt_pk_f32_fp8((int)ya[3][j], false), h3 = __builtin_amdgcn_cvt_pk_f32_fp8((int)ya[3][j], true);
                const f2t lo = ((l0 * g0 + l1 * g1) + l2 * g2) + l3 * g3, hi = ((h0 * g0 + h1 * g1) + h2 * g2) + h3 * g3;
                o[j].x += lo.x; o[j].y += lo.y; o[j].z += hi.x; o[j].w += hi.y;
                op[64 * j] = o[j]; }
        }
    }
#if PROBE_MASK
    __syncthreads(); STAMP(10);
    if (blockIdx.x == 0 && wave_s == 0 && LANE_ID == 0) { const LAS unsigned* st = (const LAS unsigned*)(L + LDSCTL_OFF + 640); unsigned d = 0;
        for (int k = 0; k < NPHASE; ++k) if ((PROBE_MASK >> k) & 1) d += st[k + 1] - st[k];
        if (PROBE_SUBA >= 0) d = st[16 + PROBE_SUBB] - st[16 + PROBE_SUBA];
        const unsigned long long t0 = __builtin_amdgcn_s_memrealtime(); while (__builtin_amdgcn_s_memrealtime() - t0 < (unsigned long long)d * PROBE_AMP) __builtin_amdgcn_s_sleep(16); }
#endif
#undef IN
#undef SEAM
}

extern "C" void kernel_launch(void* const* d_in, const int* in_sizes, int n_in, void* d_out, int out_size, void* d_ws, size_t ws_size, hipStream_t stream) {
    static int grid = 0;
    if (grid == 0) {
        if (n_in != 28 || out_size != T * D || ws_size < WS_END) { fprintf(stderr, "kernel_launch: unexpected shapes: n_in %d out %d ws %zu (need %zu)\n", n_in, out_size, ws_size, (size_t)WS_END); grid = -1; return; }
        int dev = 0, cus = 0, per_cu = 0;
        if (hipGetDevice(&dev) != hipSuccess || hipDeviceGetAttribute(&cus, hipDeviceAttributeMultiprocessorCount, dev) != hipSuccess) { grid = -1; return; }
        if (hipFuncSetAttribute((const void*)fwd, hipFuncAttributeMaxDynamicSharedMemorySize, LDS_BYTES) != hipSuccess) { fprintf(stderr, "kernel_launch: hipFuncSetAttribute failed\n"); grid = -1; return; }
        if (hipOccupancyMaxActiveBlocksPerMultiprocessor(&per_cu, (const void*)fwd, NTHR, LDS_BYTES) != hipSuccess || per_cu < 1) { fprintf(stderr, "kernel_launch: occupancy query says %d\n", per_cu); }
        (void)hipGetLastError();
        grid = cus;
    }
    if (grid < 0) return;
    if (hipMemsetAsync((char*)d_ws + WS_CTL, 0, CTL_ZERO_BYTES, stream) != hipSuccess) { fprintf(stderr, "kernel_launch: memset failed\n"); return; }
    Args a{};
    for (int i = 0; i < 28; ++i) a.in[i] = (const float*)d_in[i];
    a.out = (float*)d_out; a.ws = (unsigned char*)d_ws;
#if MK_FUSED
    a.ph_lo = 0; a.ph_hi = NPHASE;
    hipLaunchKernelGGL(fwd, dim3(grid), dim3(NTHR), LDS_BYTES, stream, a);
#else
    for (int p = 0; p < NPHASE; ++p) { a.ph_lo = p; a.ph_hi = p + 1; hipLaunchKernelGGL(fwd, dim3(grid), dim3(NTHR), LDS_BYTES, stream, a); }
#endif
    const hipError_t le = hipPeekAtLastError();
    if (le != hipSuccess) fprintf(stderr, "kernel_launch: launch failed: %s\n", hipGetErrorName(le));
}
```

```cpp
#include <hip/hip_runtime.h>
#include <cstdio>
#include <cstdint>

#ifndef MK_FUSED
#define MK_FUSED 1
#endif
#ifndef PROBE_MASK
#define PROBE_MASK 0
#endif
#ifndef PROBE_AMP
#define PROBE_AMP 4
#endif
#ifndef PROBE_SUBA
#define PROBE_SUBA -1
#endif
#ifndef PROBE_SUBB
#define PROBE_SUBB -1
#endif

__device__ __forceinline__ float xor16_sum(float v) { float a = v, b = v; asm("s_nop 1\n\tv_permlane16_swap_b32 %0, %1" : "+v"(a), "+v"(b)); return a + b; }
__device__ __forceinline__ float xor32_sum(float v) { float a = v, b = v; asm("s_nop 1\n\tv_permlane32_swap_b32 %0, %1" : "+v"(a), "+v"(b)); return a + b; }
__device__ __forceinline__ unsigned xor32_get(unsigned v, bool upper) { unsigned a = v, b = v; asm("s_nop 1\n\tv_permlane32_swap_b32 %0, %1" : "+v"(a), "+v"(b)); return upper ? a : b; }
namespace pg8 {
#define PG8_LAS __attribute__((address_space(3)))
typedef unsigned short bf16_t;
typedef short bf16x8 __attribute__((ext_vector_type(8)));
typedef float f32x4 __attribute__((ext_vector_type(4)));
typedef unsigned u32x4 __attribute__((ext_vector_type(4)));
typedef float f32x2 __attribute__((ext_vector_type(2)));
constexpr int BM = 256, BK = 64, HALF = 128, HTB = HALF * BK * 2, STAGE_BYTES = 8 * HTB, NXCD = 8, WGM = 8;

__host__ __device__ __forceinline__ int lds_byte(int r, int c) { const int st = (r >> 4) * 2 + (c >> 5), rr = r & 15, cc = c & 31, ob = rr * 64 + cc * 2; return st * 1024 + (ob ^ (((ob >> 9) & 1) << 5)); }
__host__ __device__ __forceinline__ void stage_rc(int b, int& R, int& C) { const int st = b / 1024, sb = b % 1024, swz = sb ^ (((sb >> 9) & 1) << 5); R = (st >> 1) * 16 + swz / 64; C = (st & 1) * 32 + (swz % 64) / 2; }
__host__ __device__ __forceinline__ int perm32(int rho) { const int n = rho >> 4, i = rho & 15; return 8 * (i >> 2) + 4 * n + (i & 3); }

struct Unit { int pm, pn; };
struct Gemm { const bf16_t* A; const bf16_t* Bt; int K, lda, ldb; };

struct StaticOrder {
    int nM, nN, nwg, G, c;
    __host__ __device__ void init(int M, int N, int G_, int c_) { nM = M / BM; nN = N / BM; nwg = nM * nN; G = G_; c = c_; }
    __host__ __device__ bool next(int i, Unit& u) const {
        const long L = (long)i * G + c; if (L >= nwg) return false;
        int wgid = (int)L; { const int q = nwg / NXCD, r = nwg % NXCD, xcd = wgid % NXCD, off = wgid / NXCD; wgid = (xcd < r ? xcd * (q + 1) : r * (q + 1) + (xcd - r) * q) + off; }
        const int nig = WGM * nN, gid = wgid / nig, fm = gid * WGM, gsz = (nM - fm) < WGM ? (nM - fm) : WGM;
        u.pm = fm + ((wgid % nig) % gsz); u.pn = (wgid % nig) / gsz; return true;
    }
};
struct GroupedOrder {
    const int* tile_e; int ntile, nN, G, c;
    __device__ bool next(int i, Unit& u) const {
        if ((G & 7) == 0) {
            const int x = c & 7, k = c >> 3, per = G >> 3;
            const unsigned q = (unsigned)i * (unsigned)per + (unsigned)k;
            const int tl = (int)(q / (unsigned)nN), j = (int)(q % (unsigned)nN), tile = tl * 8 + x;
            if (tile >= ntile) return false;
            u.pm = tile; u.pn = tile_e[tile] * nN + j; return true;
        }
        const unsigned L = (unsigned)i * (unsigned)G + (unsigned)c; if (L >= (unsigned)(ntile * nN)) return false;
        const int tile = (int)(L / (unsigned)nN), j = (int)(L % (unsigned)nN);
        u.pm = tile; u.pn = tile_e[tile] * nN + j; return true;
    }
};
typedef int v8i __attribute__((ext_vector_type(8)));
typedef int v4i __attribute__((ext_vector_type(4)));
__device__ __forceinline__ v8i cat8(bf16x8 lo, bf16x8 hi) { return __builtin_shufflevector(__builtin_bit_cast(v4i, lo), __builtin_bit_cast(v4i, hi), 0, 1, 2, 3, 4, 5, 6, 7); }
__device__ __forceinline__ bf16x8 lo8(v8i v) { return __builtin_bit_cast(bf16x8, (v4i)__builtin_shufflevector(v, v, 0, 1, 2, 3)); }
__device__ __forceinline__ bf16x8 hi8(v8i v) { return __builtin_bit_cast(bf16x8, (v4i)__builtin_shufflevector(v, v, 4, 5, 6, 7)); }
__device__ __forceinline__ unsigned cvt_pk_bf16(float lo, float hi) { unsigned r; asm volatile("v_cvt_pk_bf16_f32 %0, %1, %2" : "=v"(r) : "v"(lo), "v"(hi)); return r; }
__device__ __forceinline__ float bflo(unsigned w) { return __uint_as_float(w << 16); }
__device__ __forceinline__ float bfhi(unsigned w) { return __uint_as_float(w & 0xffff0000u); }


struct EpiBf16 {
    static constexpr bool PERM = true, HAS_MID = false;
    bf16_t* O; int ldc;
    __device__ __forceinline__ void operator()(const f32x4 (&acc)[2][2][4][2], const Unit& u, int wr, int wc, int fr, int fq) const {
        const int row0 = u.pm * BM + wr * 64 + fr, col0 = u.pn * BM + wc * 32 + 8 * fq;
#pragma unroll
        for (int ai = 0; ai < 2; ++ai)
#pragma unroll
            for (int m = 0; m < 4; ++m) { bf16_t* rowp = O + (size_t)(row0 + ai * HALF + m * 16) * ldc + col0;
#pragma unroll
                for (int bj = 0; bj < 2; ++bj) { const f32x4 v0 = acc[ai][bj][m][0], v1 = acc[ai][bj][m][1];
                    u32x4 w; w.x = cvt_pk_bf16(v0[0], v0[1]); w.y = cvt_pk_bf16(v0[2], v0[3]); w.z = cvt_pk_bf16(v1[0], v1[1]); w.w = cvt_pk_bf16(v1[2], v1[3]);
                    *(u32x4*)(rowp + bj * HALF) = w; } }
    }
};
__device__ __forceinline__ f32x2 gelu_pk(f32x2 v) {
    const f32x2 av = __builtin_elementwise_abs(v), d = av * 0.2316418882f + 1.0f;
    f32x2 t; t.x = __builtin_amdgcn_rcpf(d.x); t.y = __builtin_amdgcn_rcpf(d.y);
    f32x2 q = t * 0.5307027145f + (-0.7265760135f); q = q * t + 0.7107068705f; q = q * t + (-0.142248368f); q = q * t + 0.127414796f; q = q * t;
    const f32x2 s = (v * v) * (-0.72134752044f);
    f32x2 e; e.x = __builtin_amdgcn_exp2f(s.x); e.y = __builtin_amdgcn_exp2f(s.y);
    const f32x2 m = v * (q * e), r = v - m;
    f32x2 o; o.x = v.x < 0.f ? m.x : r.x; o.y = v.y < 0.f ? m.y : r.y; return o;
}
struct EpiProj {
    static constexpr bool PERM = true, HAS_MID = false;
    bf16_t* __restrict__ P; int ldp; const float* __restrict__ rope; const float* __restrict__ gq; const float* __restrict__ gk; const float* __restrict__ bgates; float eps;
    int c_q, c_k, c_v, c_g;
    int pn_off; float gsc;
    __device__ __forceinline__ void operator()(const f32x4 (&acc)[2][2][4][2], const Unit& u, int wr, int wc, int fr, int fq) const {
        const int pn = u.pn + pn_off, row0 = u.pm * BM + wr * 64 + fr;
        if (pn < 4 || pn == 8) {
            const bool isq = pn < 4, isv = (!isq) && (wc & 1);
            const int colbase = (isq ? c_q + 64 * (4 * pn + wc) : (isv ? c_v : c_k) + 64 * (wc >> 1)) + 8 * fq;
            if (isv) {
#pragma unroll
                for (int ai = 0; ai < 2; ++ai)
#pragma unroll
                    for (int m = 0; m < 4; ++m) { bf16_t* rowp = P + (size_t)(row0 + ai * HALF + m * 16) * ldp + colbase;
#pragma unroll
                        for (int bj = 0; bj < 2; ++bj) { const f32x4 v0 = acc[ai][bj][m][0], v1 = acc[ai][bj][m][1];
                            u32x4 w; w.x = cvt_pk_bf16(v0[0], v0[1]); w.y = cvt_pk_bf16(v0[2], v0[3]); w.z = cvt_pk_bf16(v1[0], v1[1]); w.w = cvt_pk_bf16(v1[2], v1[3]);
                            *(u32x4*)(rowp + 32 * bj) = w; } }
            } else {
                const float* gn = (isq ? gq : gk) + 8 * fq;
                const f32x4 ga0 = *(const f32x4*)gn, ga1 = *(const f32x4*)(gn + 4), gb0 = *(const f32x4*)(gn + 32), gb1 = *(const f32x4*)(gn + 36);
#pragma unroll
                for (int am = 0; am < 4; ++am) { const int ai = am >> 1;
                    f32x4 cs[4][4];
#pragma unroll
                    for (int m2 = 0; m2 < 2; ++m2) { const int m = (am & 1) * 2 + m2; const float* rp = rope + ((size_t)(row0 + ai * HALF + m * 16) * 32 + 8 * fq) * 2;
                        cs[m][0] = *(const f32x4*)rp; cs[m][1] = *(const f32x4*)(rp + 4); cs[m][2] = *(const f32x4*)(rp + 8); cs[m][3] = *(const f32x4*)(rp + 12); }
#pragma unroll
                    for (int m2 = 0; m2 < 2; ++m2) { const int m = (am & 1) * 2 + m2;
                        const int r = row0 + ai * HALF + m * 16;
                        const f32x4 x10 = acc[ai][0][m][0], x11 = acc[ai][0][m][1], x20 = acc[ai][1][m][0], x21 = acc[ai][1][m][1];
                        float ss = ((x10[0] * x10[0] + x10[1] * x10[1]) + (x10[2] * x10[2] + x10[3] * x10[3])) + ((x11[0] * x11[0] + x11[1] * x11[1]) + (x11[2] * x11[2] + x11[3] * x11[3]))
                                 + ((x20[0] * x20[0] + x20[1] * x20[1]) + (x20[2] * x20[2] + x20[3] * x20[3])) + ((x21[0] * x21[0] + x21[1] * x21[1]) + (x21[2] * x21[2] + x21[3] * x21[3]));
                        ss = xor32_sum(xor16_sum(ss));
                        const float rstd = 1.0f / sqrtf(ss * (1.f / 64.f) + eps);
                        const f32x4 cs0 = cs[m][0], cs1 = cs[m][1], cs2 = cs[m][2], cs3 = cs[m][3];
                        const f32x4 y10 = x10 * ga0 * rstd, y11 = x11 * ga1 * rstd, y20 = x20 * gb0 * rstd, y21 = x21 * gb1 * rstd;
                        float o1[8], o2[8];
                        o1[0] = y10[0] * cs0[0] - y20[0] * cs0[1]; o2[0] = y20[0] * cs0[0] + y10[0] * cs0[1];
                        o1[1] = y10[1] * cs0[2] - y20[1] * cs0[3]; o2[1] = y20[1] * cs0[2] + y10[1] * cs0[3];
                        o1[2] = y10[2] * cs1[0] - y20[2] * cs1[1]; o2[2] = y20[2] * cs1[0] + y10[2] * cs1[1];
                        o1[3] = y10[3] * cs1[2] - y20[3] * cs1[3]; o2[3] = y20[3] * cs1[2] + y10[3] * cs1[3];
                        o1[4] = y11[0] * cs2[0] - y21[0] * cs2[1]; o2[4] = y21[0] * cs2[0] + y11[0] * cs2[1];
                        o1[5] = y11[1] * cs2[2] - y21[1] * cs2[3]; o2[5] = y21[1] * cs2[2] + y11[1] * cs2[3];
                        o1[6] = y11[2] * cs3[0] - y21[2] * cs3[1]; o2[6] = y21[2] * cs3[0] + y11[2] * cs3[1];
                        o1[7] = y11[3] * cs3[2] - y21[3] * cs3[3]; o2[7] = y21[3] * cs3[2] + y11[3] * cs3[3];
                        bf16_t* rowp = P + (size_t)r * ldp + colbase;
                        u32x4 w; w.x = cvt_pk_bf16(o1[0], o1[1]); w.y = cvt_pk_bf16(o1[2], o1[3]); w.z = cvt_pk_bf16(o1[4], o1[5]); w.w = cvt_pk_bf16(o1[6], o1[7]);
                        *(u32x4*)rowp = w;
                        w.x = cvt_pk_bf16(o2[0], o2[1]); w.y = cvt_pk_bf16(o2[2], o2[3]); w.z = cvt_pk_bf16(o2[4], o2[5]); w.w = cvt_pk_bf16(o2[6], o2[7]);
                        *(u32x4*)(rowp + 32) = w;
                    }
                }
            }
        } else {
            const int col0 = pn * BM + wc * 32 + 8 * fq;
            const int mode = (pn == 4 || pn == 5 || pn == 9 || pn == 10) ? 1 : (pn >= 11 ? 2 : 0);
            f32x4 bb[2][2] = {{(f32x4){0.f, 0.f, 0.f, 0.f}, (f32x4){0.f, 0.f, 0.f, 0.f}}, {(f32x4){0.f, 0.f, 0.f, 0.f}, (f32x4){0.f, 0.f, 0.f, 0.f}}};
            if (mode == 2) { const float* bp = bgates + (col0 - c_g);
                bb[0][0] = *(const f32x4*)bp; bb[0][1] = *(const f32x4*)(bp + 4); bb[1][0] = *(const f32x4*)(bp + HALF); bb[1][1] = *(const f32x4*)(bp + HALF + 4); }
#pragma unroll
            for (int bj = 0; bj < 2; ++bj) {
                const f32x4 nb0 = bb[bj][0] * (-1.4426950408889634f), nb1 = bb[bj][1] * (-1.4426950408889634f);
#pragma unroll
                for (int ai = 0; ai < 2; ++ai)
#pragma unroll
                    for (int m = 0; m < 4; ++m) {
                        f32x4 v0 = acc[ai][bj][m][0], v1 = acc[ai][bj][m][1];
                        if (mode == 1) { const f32x2 a = gelu_pk((f32x2){v0[0], v0[1]}), b = gelu_pk((f32x2){v0[2], v0[3]}), c = gelu_pk((f32x2){v1[0], v1[1]}), d = gelu_pk((f32x2){v1[2], v1[3]});
                            v0 = (f32x4){a.x, a.y, b.x, b.y}; v1 = (f32x4){c.x, c.y, d.x, d.y}; }
                        if (mode == 2) {
                            typedef unsigned u32x2 __attribute__((ext_vector_type(2)));
                            u32x2 w8; unsigned wq[2] = {0u, 0u};
#pragma unroll
                            for (int p = 0; p < 4; ++p) {
                                const int n = p >> 1, i0 = (p & 1) * 2;
                                const f32x2 zv = n ? (f32x2){v1[i0], v1[i0 + 1]} : (f32x2){v0[i0], v0[i0 + 1]}, bv2 = n ? (f32x2){nb1[i0], nb1[i0 + 1]} : (f32x2){nb0[i0], nb0[i0 + 1]};
                                const f32x2 tv = zv * (-1.4426950408889634f * gsc) + bv2;
                                f32x2 ev; ev.x = __builtin_amdgcn_exp2f(tv.x); ev.y = __builtin_amdgcn_exp2f(tv.y);
                                const f32x2 dv = ev + 1.0f;
                                f32x2 gv; gv.x = __builtin_amdgcn_rcpf(dv.x); gv.y = __builtin_amdgcn_rcpf(dv.y);
                                const f32x2 cv = gv * 256.0f + (-0.5f);
                                wq[n] = __builtin_amdgcn_cvt_pk_u8_f32(cv.x, i0, wq[n]); wq[n] = __builtin_amdgcn_cvt_pk_u8_f32(cv.y, i0 + 1, wq[n]);
                            }
                            w8.x = wq[0]; w8.y = wq[1];
                            *(u32x2*)((unsigned char*)(P + (size_t)(row0 + ai * HALF + m * 16) * ldp + c_g) + (col0 - c_g) + bj * HALF) = w8;
                        } else {
                        u32x4 w; w.x = cvt_pk_bf16(v0[0], v0[1]); w.y = cvt_pk_bf16(v0[2], v0[3]); w.z = cvt_pk_bf16(v1[0], v1[1]); w.w = cvt_pk_bf16(v1[2], v1[3]);
                        *(u32x4*)(P + (size_t)(row0 + ai * HALF + m * 16) * ldp + col0 + bj * HALF) = w;
                        }
                    }
            }
        }
    }
};
template <int ACCUM> struct EpiMerge {
    static constexpr bool PERM = true, HAS_MID = false;
    bf16_t* Mg; int ldm; const bf16_t* gate; int ldg;
    __device__ __forceinline__ void operator()(const f32x4 (&acc)[2][2][4][2], const Unit& u, int wr, int wc, int fr, int fq) const {
        const int row0 = u.pm * BM + wr * 64 + fr, col0 = u.pn * BM + wc * 32 + 8 * fq;
#pragma unroll
        for (int bj = 0; bj < 2; ++bj) {
#pragma unroll
            for (int ai = 0; ai < 2; ++ai)
#pragma unroll
                for (int m = 0; m < 4; ++m) {
                    const size_t r = (size_t)(row0 + ai * HALF + m * 16);
                    const u32x4 gw = *(const u32x4*)(gate + r * ldg + col0 + bj * HALF);
                    const f32x4 a0 = acc[ai][bj][m][0], a1 = acc[ai][bj][m][1];
                    float o[8] = {bflo(gw.x) * a0[0], bfhi(gw.x) * a0[1], bflo(gw.y) * a0[2], bfhi(gw.y) * a0[3], bflo(gw.z) * a1[0], bfhi(gw.z) * a1[1], bflo(gw.w) * a1[2], bfhi(gw.w) * a1[3]};
                    bf16_t* mp = Mg + r * ldm + col0 + bj * HALF;
                    if (ACCUM) { const u32x4 pw = *(const u32x4*)mp;
                        o[0] += bflo(pw.x); o[1] += bfhi(pw.x); o[2] += bflo(pw.y); o[3] += bfhi(pw.y); o[4] += bflo(pw.z); o[5] += bfhi(pw.z); o[6] += bflo(pw.w); o[7] += bfhi(pw.w); }
                    u32x4 w; w.x = cvt_pk_bf16(o[0], o[1]); w.y = cvt_pk_bf16(o[2], o[3]); w.z = cvt_pk_bf16(o[4], o[5]); w.w = cvt_pk_bf16(o[6], o[7]);
                    *(u32x4*)mp = w;
                }
        }
    }
};
struct EpiMergeK {
    static constexpr bool PERM = true, HAS_MID = true; static constexpr int MID0 = 16, MID1 = 24;
    bf16_t* __restrict__ Mg; int ldm; const unsigned char* __restrict__ gates; int ldgb;
    typedef unsigned u32x2 __attribute__((ext_vector_type(2)));
    static __device__ __forceinline__ float gq(unsigned w, int i) { return ((float)((w >> (8 * i)) & 255u) + 0.5f) * (1.0f / 256.0f); }
    __device__ __forceinline__ void mid(f32x4 (&acc)[2][2][4][2], const Unit& u, int t, int wr, int wc, int fr, int fq) const {
        int row0 = u.pm * BM + wr * 64 + fr, col0 = u.pn * BM + wc * 32 + 8 * fq + (t == MID0 ? 0 : 1024);
        asm volatile("" : "+v"(row0), "+v"(col0));
#pragma unroll
        for (int bj = 0; bj < 2; ++bj)
#pragma unroll
            for (int ai = 0; ai < 2; ++ai)
#pragma unroll
                for (int m = 0; m < 4; ++m) {
                    const unsigned char* gp = gates + (size_t)(row0 + ai * HALF + m * 16) * ldgb + col0 + bj * HALF;
                    const u32x2 nw = *(const u32x2*)gp, dw = *(const u32x2*)(gp + 1024);
                    f32x4 r0, r1;
#pragma unroll
                    for (int i = 0; i < 4; ++i) { r0[i] = gq(nw.x, i) * __builtin_amdgcn_rcpf(gq(dw.x, i)); r1[i] = gq(nw.y, i) * __builtin_amdgcn_rcpf(gq(dw.y, i)); }
                    acc[ai][bj][m][0] *= r0; acc[ai][bj][m][1] *= r1;
                }
    }
    __device__ __forceinline__ void operator()(const f32x4 (&acc)[2][2][4][2], const Unit& u, int wr, int wc, int fr, int fq) const {
        const int row0 = u.pm * BM + wr * 64 + fr, col0 = u.pn * BM + wc * 32 + 8 * fq;
        u32x2 gw[2][2][4];
#pragma unroll
        for (int bj = 0; bj < 2; ++bj)
#pragma unroll
            for (int ai = 0; ai < 2; ++ai)
#pragma unroll
                for (int m = 0; m < 4; ++m) gw[bj][ai][m] = *(const u32x2*)(gates + (size_t)(row0 + ai * HALF + m * 16) * ldgb + 2048 + col0 + bj * HALF);
#pragma unroll
        for (int bj = 0; bj < 2; ++bj)
#pragma unroll
            for (int ai = 0; ai < 2; ++ai)
#pragma unroll
                for (int m = 0; m < 4; ++m) {
                    const size_t r = (size_t)(row0 + ai * HALF + m * 16);
                    const u32x2 g2 = gw[bj][ai][m];
                    const f32x4 a0 = acc[ai][bj][m][0], a1 = acc[ai][bj][m][1];
                    u32x4 w; w.x = cvt_pk_bf16(gq(g2.x, 0) * a0[0], gq(g2.x, 1) * a0[1]); w.y = cvt_pk_bf16(gq(g2.x, 2) * a0[2], gq(g2.x, 3) * a0[3]);
                    w.z = cvt_pk_bf16(gq(g2.y, 0) * a1[0], gq(g2.y, 1) * a1[1]); w.w = cvt_pk_bf16(gq(g2.y, 2) * a1[2], gq(g2.y, 3) * a1[3]);
                    *(u32x4*)(Mg + r * ldm + col0 + bj * HALF) = w;
                }
    }
};
__device__ __forceinline__ unsigned pk4_e4m3(float a, float b, float c, float d) { int w = 0; w = __builtin_amdgcn_cvt_pk_fp8_f32(a, b, w, false); w = __builtin_amdgcn_cvt_pk_fp8_f32(c, d, w, true); return (unsigned)w; }
struct EpiResF32 {
    static constexpr bool PERM = true, HAS_MID = false;
    bf16_t* __restrict__ X1; const float* __restrict__ R; unsigned char* __restrict__ X8p; int ldc;
    __device__ __forceinline__ void operator()(const f32x4 (&acc)[2][2][4][2], const Unit& u, int wr, int wc, int fr, int fq) const {
        const int row0 = u.pm * BM + wr * 64 + fr, col0 = u.pn * BM + wc * 32 + 8 * fq;
        typedef unsigned u32x2 __attribute__((ext_vector_type(2)));
#pragma unroll
        for (int ai = 0; ai < 2; ++ai) {
            f32x4 rv[4][2][2];
#pragma unroll
            for (int m = 0; m < 4; ++m) { const size_t ro = (size_t)(row0 + ai * HALF + m * 16) * ldc + col0;
#pragma unroll
                for (int bj = 0; bj < 2; ++bj) { rv[m][bj][0] = *(const f32x4*)(R + ro + bj * HALF); rv[m][bj][1] = *(const f32x4*)(R + ro + bj * HALF + 4); } }
#pragma unroll
            for (int m = 0; m < 4; ++m) { const size_t ro = (size_t)(row0 + ai * HALF + m * 16) * ldc + col0;
#pragma unroll
                for (int bj = 0; bj < 2; ++bj) { const f32x4 v0 = acc[ai][bj][m][0] + rv[m][bj][0], v1 = acc[ai][bj][m][1] + rv[m][bj][1];
                    u32x4 w; w.x = cvt_pk_bf16(v0[0], v0[1]); w.y = cvt_pk_bf16(v0[2], v0[3]); w.z = cvt_pk_bf16(v1[0], v1[1]); w.w = cvt_pk_bf16(v1[2], v1[3]);
                    *(u32x4*)(X1 + ro + bj * HALF) = w;
                    *(u32x2*)(X8p + ro + bj * HALF) = (u32x2){pk4_e4m3(v0[0], v0[1], v0[2], v0[3]), pk4_e4m3(v1[0], v1[1], v1[2], v1[3])}; } }
        }
    }
};
struct EpiSwiglu {
    static constexpr bool PERM = true, HAS_MID = false;
    bf16_t* act; const float* bgu;
    __device__ __forceinline__ void operator()(const f32x4 (&acc)[2][2][4][2], const Unit& u, int wr, int wc, int fr, int fq) const {
        const int e = u.pn >> 3, j = u.pn & 7;
        const int row0 = u.pm * BM + wr * 64 + fr, col0 = j * 128 + wc * 32 + 8 * fq;
        const float* bg = bgu + (size_t)e * 2048 + col0;
        const f32x4 g0 = *(const f32x4*)bg, g1 = *(const f32x4*)(bg + 4), u0 = *(const f32x4*)(bg + 1024), u1 = *(const f32x4*)(bg + 1028);
#pragma unroll
        for (int ai = 0; ai < 2; ++ai)
#pragma unroll
            for (int m = 0; m < 4; ++m) {
                float o[8];
#pragma unroll
                for (int i = 0; i < 8; ++i) {
                    float gt = (i < 4 ? acc[ai][0][m][0][i] + g0[i] : acc[ai][0][m][1][i - 4] + g1[i - 4]);
                    float up = (i < 4 ? acc[ai][1][m][0][i] + u0[i] : acc[ai][1][m][1][i - 4] + u1[i - 4]);
                    gt = fminf(gt, 7.0f); up = fminf(fmaxf(up, -7.0f), 7.0f);
                    const float sg = __builtin_amdgcn_rcpf(1.0f + __builtin_amdgcn_exp2f(-1.702f * 1.4426950408889634f * gt));
                    o[i] = (up + 1.0f) * (gt * sg);
                }
                u32x4 w; w.x = cvt_pk_bf16(o[0], o[1]); w.y = cvt_pk_bf16(o[2], o[3]); w.z = cvt_pk_bf16(o[4], o[5]); w.w = cvt_pk_bf16(o[6], o[7]);
                *(u32x4*)(act + (size_t)(row0 + ai * HALF + m * 16) * 1024 + col0) = w;
            }
    }
};
struct EpiSwiglu8 {
    static constexpr bool PERM = true, HAS_MID = false;
    unsigned char* __restrict__ act; const float* __restrict__ bgu; const float* __restrict__ srstd; float inv;
    __device__ __forceinline__ void operator()(const f32x4 (&acc)[2][2][4][2], const Unit& u, int wr, int wc, int fr, int fq) const {
        const int e = u.pn >> 3, j = u.pn & 7;
        const int row0 = u.pm * BM + wr * 64 + fr, col0 = j * 128 + wc * 32 + 8 * fq;
        const float* bg = bgu + (size_t)e * 2048 + col0;
        const f32x4 g0 = *(const f32x4*)bg, g1 = *(const f32x4*)(bg + 4), u0 = *(const f32x4*)(bg + 1024), u1 = *(const f32x4*)(bg + 1028);
        float rsv[8];
#pragma unroll
        for (int i = 0; i < 8; ++i) rsv[i] = srstd[row0 + (i >> 2) * HALF + (i & 3) * 16] * this->inv;
#pragma unroll
        for (int ai = 0; ai < 2; ++ai)
#pragma unroll
            for (int m = 0; m < 4; ++m) {
                float o[8]; const float inv = rsv[ai * 4 + m];
#pragma unroll
                for (int p = 0; p < 4; ++p) {
                    const int n = p >> 1, i0 = (p & 1) * 2;
                    const f32x2 ag = (f32x2){acc[ai][0][m][n][i0], acc[ai][0][m][n][i0 + 1]}, au = (f32x2){acc[ai][1][m][n][i0], acc[ai][1][m][n][i0 + 1]};
                    const f32x2 bgv = n ? (f32x2){g1[i0], g1[i0 + 1]} : (f32x2){g0[i0], g0[i0 + 1]}, buv = n ? (f32x2){u1[i0], u1[i0 + 1]} : (f32x2){u0[i0], u0[i0 + 1]};
                    f32x2 gt = ag * inv + bgv, up = au * inv + buv;
                    gt.x = fminf(gt.x, 7.0f); gt.y = fminf(gt.y, 7.0f);
                    up.x = __builtin_amdgcn_fmed3f(up.x, -7.0f, 7.0f); up.y = __builtin_amdgcn_fmed3f(up.y, -7.0f, 7.0f);
                    const f32x2 tt = gt * (-1.702f * 1.4426950408889634f);
                    f32x2 ev; ev.x = __builtin_amdgcn_exp2f(tt.x); ev.y = __builtin_amdgcn_exp2f(tt.y);
                    const f32x2 dv = ev + 1.0f;
                    f32x2 rv2; rv2.x = __builtin_amdgcn_rcpf(dv.x); rv2.y = __builtin_amdgcn_rcpf(dv.y);
                    const f32x2 ov = (up + 1.0f) * (gt * rv2);
                    o[2 * p] = ov.x; o[2 * p + 1] = ov.y;
                }
                f32x2 w; unsigned w0 = pk4_e4m3(o[0], o[1], o[2], o[3]), w1 = pk4_e4m3(o[4], o[5], o[6], o[7]);
                typedef unsigned u32x2 __attribute__((ext_vector_type(2)));
                *(u32x2*)(act + (size_t)(row0 + ai * HALF + m * 16) * 1024 + col0) = (u32x2){w0, w1}; (void)w;
            }
    }
};
struct EpiDown {
    static constexpr bool PERM = true, HAS_MID = false;
    unsigned char* __restrict__ Y; const float* __restrict__ bd; float inv;
    __device__ __forceinline__ void operator()(const f32x4 (&acc)[2][2][4][2], const Unit& u, int wr, int wc, int fr, int fq) const {
        const int e = u.pn >> 2, j = u.pn & 3;
        const int row0 = u.pm * BM + wr * 64 + fr, col0 = j * 256 + wc * 32 + 8 * fq;
        const float* bp = bd + (size_t)e * 1024 + col0;
        typedef unsigned u32x2 __attribute__((ext_vector_type(2)));
        const f32x4 b00 = *(const f32x4*)bp * 16.0f, b01 = *(const f32x4*)(bp + 4) * 16.0f, b10 = *(const f32x4*)(bp + HALF) * 16.0f, b11 = *(const f32x4*)(bp + HALF + 4) * 16.0f;
#pragma unroll
        for (int ai = 0; ai < 2; ++ai)
#pragma unroll
            for (int m = 0; m < 4; ++m) {
                unsigned char* yp = Y + (size_t)(row0 + ai * HALF + m * 16) * 1024 + col0;
                { const f32x4 v0 = acc[ai][0][m][0] * inv + b00, v1 = acc[ai][0][m][1] * inv + b01;
                  *(u32x2*)yp = (u32x2){pk4_e4m3(v0[0], v0[1], v0[2], v0[3]), pk4_e4m3(v1[0], v1[1], v1[2], v1[3])}; }
                { const f32x4 v0 = acc[ai][1][m][0] * inv + b10, v1 = acc[ai][1][m][1] * inv + b11;
                  *(u32x2*)(yp + HALF) = (u32x2){pk4_e4m3(v0[0], v0[1], v0[2], v0[3]), pk4_e4m3(v1[0], v1[1], v1[2], v1[3])}; }
            }
    }
};

template <class Epi, class Sched, bool F8 = false, bool ALIGN_EPI = true>
__device__ __forceinline__ void gemm_phase(PG8_LAS unsigned char* lds, const Gemm g, const Sched& S, const Epi& E, const int wid_in) {
    const int wid = __builtin_amdgcn_readfirstlane(wid_in), lane = (int)__builtin_amdgcn_mbcnt_hi(~0u, __builtin_amdgcn_mbcnt_lo(~0u, 0u)), tid = wid * 64 + lane, wr = wid >> 2, wc = wid & 3, fr = lane & 15, fq = lane >> 4;
    int K = g.K; asm volatile("" : "+s"(K));
    const int nt = K / BK;
    unsigned voffA[2], voffB[2];
#pragma unroll
    for (int i = 0; i < 2; ++i) { int R, C; stage_rc(tid * 16 + i * 8192, R, C); const int Rb = Epi::PERM ? ((R & ~31) + perm32(R & 31)) : R;
        voffA[i] = (unsigned)(R * g.lda + C) * 2u; voffB[i] = (unsigned)(Rb * g.ldb + C) * 2u; }
    const size_t kstep = (size_t)(BK * 2);
    const size_t hstepA = (size_t)HALF * g.lda * 2, hstepB = (size_t)HALF * g.ldb * 2;
    const size_t tstepA = 2 * hstepA, tstepB = 2 * hstepB;
    const unsigned ldsw = (unsigned)wid * 1024u;
    const int aoff = lds_byte(wr * 64 + fr, fq * 8), boff = lds_byte(wc * 32 + fr, fq * 8);
#define PG8_SA(b, h) (((b) * 2 + (h)) * HTB)
#define PG8_SB(b, h) ((4 + (b) * 2 + (h)) * HTB)
#define PG8_STAGE(bufoff, gbase, voff) do { _Pragma("unroll") for (int _i = 0; _i < 2; ++_i) \
        __builtin_amdgcn_global_load_lds((const unsigned*)((const char*)(gbase) + (voff)[_i]), (PG8_LAS unsigned*)(lds + (bufoff) + ldsw + _i * 8192), 16, 0, 0); } while (0)
#define PG8_LDA(dst, b, h) do { _Pragma("unroll") for (int m = 0; m < 4; ++m) dst[m] = cat8(*(const PG8_LAS bf16x8*)(lds + PG8_SA(b, h) + aoff + m * 2048), *(const PG8_LAS bf16x8*)(lds + PG8_SA(b, h) + aoff + m * 2048 + 1024)); } while (0)
#define PG8_LDB(dst, b, h) do { _Pragma("unroll") for (int n = 0; n < 2; ++n) dst[n] = cat8(*(const PG8_LAS bf16x8*)(lds + PG8_SB(b, h) + boff + n * 2048), *(const PG8_LAS bf16x8*)(lds + PG8_SB(b, h) + boff + n * 2048 + 1024)); } while (0)
#define PG8_MMA(ai, bj, At, Bt) do { __builtin_amdgcn_s_setprio(1); \
        if constexpr (F8) { asm volatile("s_nop 1"); _Pragma("unroll") for (int m = 0; m < 4; ++m) _Pragma("unroll") for (int n = 0; n < 2; ++n) \
            asm volatile("v_mfma_scale_f32_16x16x128_f8f6f4 %0, %1, %2, %0, %3, %3 op_sel_hi:[0,0,0]" : "+v"(acc[ai][bj][m][n]) : "v"(Bt[n]), "v"(At[m]), "v"(sc127)); } \
        else { _Pragma("unroll") for (int m = 0; m < 4; ++m) _Pragma("unroll") for (int n = 0; n < 2; ++n) { \
            acc[ai][bj][m][n] = __builtin_amdgcn_mfma_f32_16x16x32_bf16(lo8(Bt[n]), lo8(At[m]), acc[ai][bj][m][n], 0, 0, 0); \
            acc[ai][bj][m][n] = __builtin_amdgcn_mfma_f32_16x16x32_bf16(hi8(Bt[n]), hi8(At[m]), acc[ai][bj][m][n], 0, 0, 0); } } \
        __builtin_amdgcn_s_setprio(0); } while (0)
#define PG8_WAIT_V(n) asm volatile("s_waitcnt vmcnt(" #n ")" ::: "memory")
#define PG8_WAIT_L(n) asm volatile("s_waitcnt lgkmcnt(" #n ")" ::: "memory")
#define PG8_BAR __builtin_amdgcn_s_barrier()
#define PG8_SCHED __builtin_amdgcn_sched_barrier(0)
    const int sc127 = 0x7F7F7F7F; (void)sc127;
    Unit cur, nxt; int ui = 0;
    if (!S.next(0, cur)) return;
    f32x4 acc[2][2][4][2];
#pragma unroll
    for (int a = 0; a < 2; ++a)
#pragma unroll
        for (int b = 0; b < 2; ++b)
#pragma unroll
            for (int m = 0; m < 4; ++m)
#pragma unroll
                for (int n = 0; n < 2; ++n) acc[a][b][m][n] = (f32x4){0.f, 0.f, 0.f, 0.f};
    v8i At[4], B0[2], B1[2];
    const char* cA = (const char*)g.A + (size_t)cur.pm * tstepA; const char* cB = (const char*)g.Bt + (size_t)cur.pn * tstepB;
    PG8_STAGE(PG8_SB(0, 0), cB, voffB); PG8_STAGE(PG8_SB(0, 1), cB + hstepB, voffB); PG8_STAGE(PG8_SA(0, 0), cA, voffA); PG8_STAGE(PG8_SA(0, 1), cA + hstepA, voffA);
    if (wr == 1) PG8_BAR;
    PG8_WAIT_V(2); PG8_BAR;
    PG8_STAGE(PG8_SB(1, 0), cB + kstep, voffB); PG8_STAGE(PG8_SA(1, 0), cA + kstep, voffA); PG8_STAGE(PG8_SB(1, 1), cB + hstepB + kstep, voffB);
    PG8_WAIT_V(6); PG8_BAR;
    for (;;) {
        const bool has_next = S.next(ui + 1, nxt);
        const char* nA = has_next ? (const char*)g.A + (size_t)nxt.pm * tstepA : cA; const char* nB = has_next ? (const char*)g.Bt + (size_t)nxt.pn * tstepB : cB;
        for (int t = 0; t < nt; t += 2) {
            if constexpr (Epi::HAS_MID) { if (t == Epi::MID0 || t == Epi::MID1) E.mid(acc, cur, t, wr, wc, fr, fq); }
            const bool last = (t == nt - 2);
            const char* a1 = cA + (size_t)(t + 1) * kstep;
            const char* a2 = last ? nA : cA + (size_t)(t + 2) * kstep; const char* b2 = last ? nB : cB + (size_t)(t + 2) * kstep;
            const char* a3 = a2 + kstep; const char* b3 = b2 + kstep;
            PG8_LDB(B0, 0, 0); PG8_LDB(B1, 0, 1); PG8_SCHED; PG8_LDA(At, 0, 0); PG8_STAGE(PG8_SA(1, 1), a1 + hstepA, voffA);
            PG8_WAIT_V(8); PG8_WAIT_L(0); PG8_BAR; PG8_MMA(0, 0, At, B0); PG8_MMA(0, 1, At, B1); PG8_BAR; PG8_SCHED;
            PG8_LDA(At, 0, 1); PG8_STAGE(PG8_SB(0, 0), b2, voffB); PG8_STAGE(PG8_SB(0, 1), b2 + hstepB, voffB); PG8_STAGE(PG8_SA(0, 0), a2, voffA);
            PG8_WAIT_V(8); PG8_WAIT_L(0); PG8_BAR; PG8_MMA(1, 0, At, B0); PG8_MMA(1, 1, At, B1); PG8_BAR; PG8_SCHED;
            PG8_LDB(B0, 1, 0); PG8_LDB(B1, 1, 1); PG8_SCHED; PG8_LDA(At, 1, 0); PG8_STAGE(PG8_SA(0, 1), a2 + hstepA, voffA);
            PG8_WAIT_V(8); PG8_WAIT_L(0); PG8_BAR; PG8_MMA(0, 0, At, B0); PG8_MMA(0, 1, At, B1); PG8_BAR; PG8_SCHED;
            PG8_LDA(At, 1, 1); PG8_STAGE(PG8_SB(1, 0), b3, voffB); PG8_STAGE(PG8_SB(1, 1), b3 + hstepB, voffB); PG8_STAGE(PG8_SA(1, 0), a3, voffA);
            PG8_WAIT_V(8); PG8_WAIT_L(0); PG8_BAR; PG8_MMA(1, 0, At, B0); PG8_MMA(1, 1, At, B1); PG8_BAR; PG8_SCHED;
        }
        if constexpr (ALIGN_EPI) { if (wr == 0) PG8_BAR; }
        if constexpr (F8) asm volatile("s_nop 15\n\ts_nop 15" ::: "memory");
        E(acc, cur, wr, wc, fr, fq);
        if (!has_next) break;
#pragma unroll
        for (int a = 0; a < 2; ++a)
#pragma unroll
            for (int b = 0; b < 2; ++b)
#pragma unroll
                for (int m = 0; m < 4; ++m)
#pragma unroll
                    for (int n = 0; n < 2; ++n) acc[a][b][m][n] = (f32x4){0.f, 0.f, 0.f, 0.f};
        cur = nxt; cA = nA; cB = nB; ++ui;
        if constexpr (ALIGN_EPI) { if (wr == 1) PG8_BAR; }
    }
    PG8_WAIT_V(0);
    if constexpr (!ALIGN_EPI) { if (wr == 0) PG8_BAR; }
    PG8_BAR;
#undef PG8_SA
#undef PG8_SB
#undef PG8_STAGE
#undef PG8_LDA
#undef PG8_LDB
#undef PG8_MMA
#undef PG8_WAIT_V
#undef PG8_WAIT_L
#undef PG8_BAR
#undef PG8_SCHED
}
template <class Epi, class Sched, bool F8 = false, bool ALIGN_EPI = true>
__device__ __forceinline__ void gemm_phase_gather(PG8_LAS unsigned char* lds, const Gemm g, const Sched& S, const Epi& E, const int wid_in, const int* rowmap) {
    const int wid = __builtin_amdgcn_readfirstlane(wid_in), lane = (int)__builtin_amdgcn_mbcnt_hi(~0u, __builtin_amdgcn_mbcnt_lo(~0u, 0u)), tid = wid * 64 + lane, wr = wid >> 2, wc = wid & 3, fr = lane & 15, fq = lane >> 4;
    int K = g.K; asm volatile("" : "+s"(K));
    const int nt = K / BK;
    unsigned voffB[2]; int RA[2]; unsigned CA2[2];
#pragma unroll
    for (int i = 0; i < 2; ++i) { int R, C; stage_rc(tid * 16 + i * 8192, R, C); const int Rb = Epi::PERM ? ((R & ~31) + perm32(R & 31)) : R;
        RA[i] = R; CA2[i] = (unsigned)C * 2u; voffB[i] = (unsigned)(Rb * g.ldb + C) * 2u; }
    const unsigned rowb = (unsigned)g.lda * 2u;
    unsigned ca0[2], ca1[2], na0[2], na1[2]; int raw0[2], raw1[2];
#define PG8_LOADIDX(d0, d1, pm_) do { _Pragma("unroll") for (int _i = 0; _i < 2; ++_i) { d0[_i] = rowmap[(pm_) * BM + RA[_i]]; d1[_i] = rowmap[(pm_) * BM + HALF + RA[_i]]; } } while (0)
#define PG8_CVTIDX(o0, o1, d0, d1) do { _Pragma("unroll") for (int _i = 0; _i < 2; ++_i) { o0[_i] = (unsigned)(d0[_i] < 0 ? 0 : d0[_i]) * rowb + CA2[_i]; o1[_i] = (unsigned)(d1[_i] < 0 ? 0 : d1[_i]) * rowb + CA2[_i]; } } while (0)
    const size_t kstep = (size_t)(BK * 2);
    const size_t hstepB = (size_t)HALF * g.ldb * 2;
    const size_t tstepB = 2 * hstepB;
    const unsigned ldsw = (unsigned)wid * 1024u;
    const int aoff = lds_byte(wr * 64 + fr, fq * 8), boff = lds_byte(wc * 32 + fr, fq * 8);
#define PG8_SA(b, h) (((b) * 2 + (h)) * HTB)
#define PG8_SB(b, h) ((4 + (b) * 2 + (h)) * HTB)
#define PG8_STAGE(bufoff, gbase, voff) do { _Pragma("unroll") for (int _i = 0; _i < 2; ++_i) \
        __builtin_amdgcn_global_load_lds((const unsigned*)((const char*)(gbase) + (voff)[_i]), (PG8_LAS unsigned*)(lds + (bufoff) + ldsw + _i * 8192), 16, 0, 0); } while (0)
#define PG8_LDA(dst, b, h) do { _Pragma("unroll") for (int m = 0; m < 4; ++m) dst[m] = cat8(*(const PG8_LAS bf16x8*)(lds + PG8_SA(b, h) + aoff + m * 2048), *(const PG8_LAS bf16x8*)(lds + PG8_SA(b, h) + aoff + m * 2048 + 1024)); } while (0)
#define PG8_LDB(dst, b, h) do { _Pragma("unroll") for (int n = 0; n < 2; ++n) dst[n] = cat8(*(const PG8_LAS bf16x8*)(lds + PG8_SB(b, h) + boff + n * 2048), *(const PG8_LAS bf16x8*)(lds + PG8_SB(b, h) + boff + n * 2048 + 1024)); } while (0)
#define PG8_MMA(ai, bj, At, Bt) do { __builtin_amdgcn_s_setprio(1); \
        if constexpr (F8) { asm volatile("s_nop 1"); _Pragma("unroll") for (int m = 0; m < 4; ++m) _Pragma("unroll") for (int n = 0; n < 2; ++n) \
            asm volatile("v_mfma_scale_f32_16x16x128_f8f6f4 %0, %1, %2, %0, %3, %3 op_sel_hi:[0,0,0]" : "+v"(acc[ai][bj][m][n]) : "v"(Bt[n]), "v"(At[m]), "v"(sc127)); } \
        else { _Pragma("unroll") for (int m = 0; m < 4; ++m) _Pragma("unroll") for (int n = 0; n < 2; ++n) { \
            acc[ai][bj][m][n] = __builtin_amdgcn_mfma_f32_16x16x32_bf16(lo8(Bt[n]), lo8(At[m]), acc[ai][bj][m][n], 0, 0, 0); \
            acc[ai][bj][m][n] = __builtin_amdgcn_mfma_f32_16x16x32_bf16(hi8(Bt[n]), hi8(At[m]), acc[ai][bj][m][n], 0, 0, 0); } } \
        __builtin_amdgcn_s_setprio(0); } while (0)
#define PG8_WAIT_V(n) asm volatile("s_waitcnt vmcnt(" #n ")" ::: "memory")
#define PG8_WAIT_L(n) asm volatile("s_waitcnt lgkmcnt(" #n ")" ::: "memory")
#define PG8_BAR __builtin_amdgcn_s_barrier()
#define PG8_SCHED __builtin_amdgcn_sched_barrier(0)
    const int sc127 = 0x7F7F7F7F; (void)sc127;
    Unit cur, nxt, nn; int ui = 0;
    if (!S.next(0, cur)) return;
    bool has_next = S.next(1, nxt);
    PG8_LOADIDX(raw0, raw1, cur.pm); PG8_CVTIDX(ca0, ca1, raw0, raw1);
    if (has_next) { PG8_LOADIDX(raw0, raw1, nxt.pm); PG8_CVTIDX(na0, na1, raw0, raw1); } else { na0[0] = ca0[0]; na0[1] = ca0[1]; na1[0] = ca1[0]; na1[1] = ca1[1]; }
    f32x4 acc[2][2][4][2];
#pragma unroll
    for (int a = 0; a < 2; ++a)
#pragma unroll
        for (int b = 0; b < 2; ++b)
#pragma unroll
            for (int m = 0; m < 4; ++m)
#pragma unroll
                for (int n = 0; n < 2; ++n) acc[a][b][m][n] = (f32x4){0.f, 0.f, 0.f, 0.f};
    v8i At[4], B0[2], B1[2];
    const char* const cA = (const char*)g.A; const char* cB = (const char*)g.Bt + (size_t)cur.pn * tstepB;
    PG8_STAGE(PG8_SB(0, 0), cB, voffB); PG8_STAGE(PG8_SB(0, 1), cB + hstepB, voffB); PG8_STAGE(PG8_SA(0, 0), cA, ca0); PG8_STAGE(PG8_SA(0, 1), cA, ca1);
    if (wr == 1) PG8_BAR;
    PG8_WAIT_V(2); PG8_BAR;
    PG8_STAGE(PG8_SB(1, 0), cB + kstep, voffB); PG8_STAGE(PG8_SA(1, 0), cA + kstep, ca0); PG8_STAGE(PG8_SB(1, 1), cB + hstepB + kstep, voffB);
    PG8_WAIT_V(6); PG8_BAR;
    for (;;) {
        const bool has_next2 = has_next && S.next(ui + 2, nn);
        if (has_next2) PG8_LOADIDX(raw0, raw1, nn.pm);
        const char* nB = has_next ? (const char*)g.Bt + (size_t)nxt.pn * tstepB : cB;
        for (int t = 0; t < nt; t += 2) {
            const bool last = (t == nt - 2);
            const char* a1 = cA + (size_t)(t + 1) * kstep;
            const char* a2 = last ? cA : cA + (size_t)(t + 2) * kstep; const char* b2 = last ? nB : cB + (size_t)(t + 2) * kstep;
            const char* a3 = a2 + kstep; const char* b3 = b2 + kstep;
            unsigned s0[2], s1[2];
            s0[0] = last ? na0[0] : ca0[0]; s0[1] = last ? na0[1] : ca0[1]; s1[0] = last ? na1[0] : ca1[0]; s1[1] = last ? na1[1] : ca1[1];
            PG8_LDB(B0, 0, 0); PG8_LDB(B1, 0, 1); PG8_SCHED; PG8_LDA(At, 0, 0); PG8_STAGE(PG8_SA(1, 1), a1, ca1);
            PG8_WAIT_V(8); PG8_WAIT_L(0); PG8_BAR; PG8_MMA(0, 0, At, B0); PG8_MMA(0, 1, At, B1); PG8_BAR; PG8_SCHED;
            PG8_LDA(At, 0, 1); PG8_STAGE(PG8_SB(0, 0), b2, voffB); PG8_STAGE(PG8_SB(0, 1), b2 + hstepB, voffB); PG8_STAGE(PG8_SA(0, 0), a2, s0);
            PG8_WAIT_V(8); PG8_WAIT_L(0); PG8_BAR; PG8_MMA(1, 0, At, B0); PG8_MMA(1, 1, At, B1); PG8_BAR; PG8_SCHED;
            PG8_LDB(B0, 1, 0); PG8_LDB(B1, 1, 1); PG8_SCHED; PG8_LDA(At, 1, 0); PG8_STAGE(PG8_SA(0, 1), a2, s1);
            PG8_WAIT_V(8); PG8_WAIT_L(0); PG8_BAR; PG8_MMA(0, 0, At, B0); PG8_MMA(0, 1, At, B1); PG8_BAR; PG8_SCHED;
            PG8_LDA(At, 1, 1); PG8_STAGE(PG8_SB(1, 0), b3, voffB); PG8_STAGE(PG8_SB(1, 1), b3 + hstepB, voffB); PG8_STAGE(PG8_SA(1, 0), a3, s0);
            PG8_WAIT_V(8); PG8_WAIT_L(0); PG8_BAR; PG8_MMA(1, 0, At, B0); PG8_MMA(1, 1, At, B1); PG8_BAR; PG8_SCHED;
        }
        if constexpr (ALIGN_EPI) { if (wr == 0) PG8_BAR; }
        if constexpr (F8) asm volatile("s_nop 15\n\ts_nop 15" ::: "memory");
        E(acc, cur, wr, wc, fr, fq);
        if (!has_next) break;
#pragma unroll
        for (int a = 0; a < 2; ++a)
#pragma unroll
            for (int b = 0; b < 2; ++b)
#pragma unroll
                for (int m = 0; m < 4; ++m)
#pragma unroll
                    for (int n = 0; n < 2; ++n) acc[a][b][m][n] = (f32x4){0.f, 0.f, 0.f, 0.f};
        cur = nxt; cB = nB; ++ui;
        ca0[0] = na0[0]; ca0[1] = na0[1]; ca1[0] = na1[0]; ca1[1] = na1[1];
        if (has_next2) { PG8_CVTIDX(na0, na1, raw0, raw1); nxt = nn; }
        has_next = has_next2;
        if constexpr (ALIGN_EPI) { if (wr == 1) PG8_BAR; }
    }
    PG8_WAIT_V(0);
    if constexpr (!ALIGN_EPI) { if (wr == 0) PG8_BAR; }
    PG8_BAR;
#undef PG8_LOADIDX
#undef PG8_CVTIDX
#undef PG8_SA
#undef PG8_SB
#undef PG8_STAGE
#undef PG8_LDA
#undef PG8_LDB
#undef PG8_MMA
#undef PG8_WAIT_V
#undef PG8_WAIT_L
#undef PG8_BAR
#undef PG8_SCHED
}
}

constexpr int NWAVES = 8, NTHR = 512;
constexpr int BATCH = 32, SEQ = 2048, D = 1024, T = BATCH * SEQ, MEM = 256, TM = BATCH * MEM;
constexpr int DIN = 5888;
constexpr float EPS = 1e-6f;
constexpr int LDP = DIN, C_Q = 0, C_U = 1024, C_QC = 1536, C_K = 2048, C_V = 2176, C_VB = 2304, C_G = 2816;
constexpr int WD_P1_ITEMS = 8192;
constexpr float YSCALE = 16.0f;
constexpr float WSCALE = 64.0f;
constexpr int NEXP = 32, TOPK = 4;
constexpr int PS = T * TOPK + NEXP * 256;
constexpr int MAXTILE = PS / 256;

constexpr size_t MiB = 1u << 20;
constexpr size_t WS_CTL = 0, CTL_ZERO_BYTES = 1 * MiB;
constexpr size_t WS_WOUT = 1 * MiB;
constexpr size_t WS_ROPE = 3 * MiB;
constexpr size_t WS_WIN = 19 * MiB;
constexpr size_t WS_WO = 31 * MiB;
constexpr size_t WS_WMKV = 35 * MiB;
constexpr size_t WS_X8 = 3 * MiB;
constexpr size_t WS_SRSTD = 67 * MiB;
constexpr size_t WS_MEMN = 37 * MiB;
constexpr size_t WS_KV = 53 * MiB;
constexpr size_t WS_META = 69 * MiB;
constexpr size_t WS_H = 77 * MiB;
constexpr size_t WS_PROJ = 205 * MiB;
constexpr size_t WS_WGU = 141 * MiB;
constexpr size_t WS_WD = 941 * MiB;
constexpr size_t WS_ACT = 237 * MiB;
constexpr size_t WS_Y = 501 * MiB;
constexpr size_t WS_X1B = 765 * MiB;
constexpr size_t WS_END = 1013 * MiB;
static_assert(WS_PROJ + (size_t)T * LDP * 2 <= WS_END && WS_ACT + (size_t)PS * 1024 <= WS_Y && WS_Y + (size_t)T * TOPK * 2048 <= WS_END && WS_WGU + (size_t)NEXP * 2048 * 1024 <= WS_PROJ && WS_WD + (size_t)NEXP * 1024 * 1024 <= WS_END, "ws map");
constexpr size_t MT_IDX = 0;
constexpr size_t MT_GATE = 1 * MiB;
constexpr size_t MT_STOK = 2 * MiB;
constexpr size_t MT_SGATE = 3 * MiB + 512 * 1024;
constexpr size_t MT_SASG = 5 * MiB;
constexpr size_t MT_TILEE = 6 * MiB + 512 * 1024;
constexpr size_t MT_WSB = 7 * MiB;
constexpr size_t MT_RSTD = 7 * MiB + 128 * 1024;
constexpr size_t MT_CMAT = 7 * MiB + 512 * 1024;
constexpr size_t MT_RWP = 7 * MiB + 768 * 1024;
constexpr int CW_BAR = 4096;
constexpr int CW_NTILE = 1024;

constexpr int RING_OFF = 0, RING_BYTES = 131072;
constexpr int LDS_BYTES = 147456;
constexpr int LDSCTL_OFF = LDS_BYTES - 1024, MISC_OFF = LDSCTL_OFF + 320;

#define GAS __attribute__((address_space(1)))
#define LAS __attribute__((address_space(3)))
typedef unsigned short bf16;
typedef unsigned v4u __attribute__((ext_vector_type(4)));
typedef unsigned v2u __attribute__((ext_vector_type(2)));
typedef float f32x4 __attribute__((ext_vector_type(4)));
typedef GAS unsigned gu32;
#define RLX_AGENT __ATOMIC_RELAXED, __HIP_MEMORY_SCOPE_AGENT
#define LDS_WAIT() asm volatile("s_waitcnt lgkmcnt(0)" ::: "memory")
#define VM_WAIT() asm volatile("s_waitcnt vmcnt(0)" ::: "memory")
__device__ __forceinline__ unsigned f2bf(float f) { unsigned u = __builtin_bit_cast(unsigned, f); return (u + 0x7fffu + ((u >> 16) & 1u)) >> 16; }
__device__ __forceinline__ unsigned pk2(float lo, float hi) { return f2bf(lo) | (f2bf(hi) << 16); }
__device__ __forceinline__ unsigned pk4_fp8(float a, float b, float c, float d) { int w = 0; w = __builtin_amdgcn_cvt_pk_fp8_f32(a, b, w, false); w = __builtin_amdgcn_cvt_pk_fp8_f32(c, d, w, true); return (unsigned)w; }
__device__ __forceinline__ float bf2f(bf16 b) { return __uint_as_float(((unsigned)b) << 16); }
__device__ __forceinline__ float blo(unsigned w) { return __uint_as_float(w << 16); }
__device__ __forceinline__ float bhi(unsigned w) { return __uint_as_float(w & 0xffff0000u); }

#define XB_TMO      128
#define XB_XCNT(j)  (256  + 64 * (j))
#define XB_XSUB(j)  (1280 + 64 * (j))
#define XB_XGEN(j)  (2304 + 64 * (j))
#define XB_TOP      3328
#define XB_TOPGEN   3392
#define XCD_BAR_WORDS 3456
#define XB_SPIN_CAP (1u << 22)
__device__ __forceinline__ unsigned xb_ld(unsigned* p)              { return __hip_atomic_load(p, __ATOMIC_RELAXED, __HIP_MEMORY_SCOPE_AGENT); }
__device__ __forceinline__ unsigned xb_add(unsigned* p, unsigned v) { return __hip_atomic_fetch_add(p, v, __ATOMIC_RELAXED, __HIP_MEMORY_SCOPE_AGENT); }
__device__ __forceinline__ unsigned xb_xcc_id() { return (unsigned)__builtin_amdgcn_s_getreg((3 << 11) | 20) & 0xFu; }
#define XB_SPIN(cond, bar) do { unsigned _sp = 0; while (cond) { __builtin_amdgcn_s_sleep(1); \
    if ((++_sp & 255u) == 0u) { if (xb_ld(&(bar)[XB_TMO])) break; if (_sp > XB_SPIN_CAP) { atomicAdd(&(bar)[XB_TMO], 1u); break; } } } } while (0)
struct XcdBarrier { unsigned* bar; unsigned x; volatile LAS unsigned* st; };
__device__ __forceinline__ XcdBarrier xcd_barrier_post(unsigned* bar, volatile LAS unsigned* st, bool leader) {
    XcdBarrier b; b.bar = bar; b.x = xb_xcc_id(); b.st = st;
    if (leader) (void)xb_add(&bar[XB_XCNT(b.x)], 1u);
    return b;
}
__device__ __forceinline__ void xcd_barrier_complete(unsigned* bar, unsigned x, unsigned& nloc, unsigned& nx) {
    const unsigned G = gridDim.x * gridDim.y * gridDim.z;
    unsigned sum, cnt, mine, sp = 0u;
    for (;;) {
        sum = 0u; cnt = 0u; mine = 0u;
#pragma unroll
        for (unsigned j = 0; j < 16; ++j) { const unsigned c = xb_ld(&bar[XB_XCNT(j)]); sum += c; cnt += (c > 0u) ? 1u : 0u; mine = (j == x) ? c : mine; }
        if (sum == G) break;
        __builtin_amdgcn_s_sleep(1);
        if ((++sp & 255u) == 0u) { if (xb_ld(&bar[XB_TMO])) break; if (sp > XB_SPIN_CAP) { atomicAdd(&bar[XB_TMO], 1u); break; } }
    }
    nloc = mine > 0u ? mine : 1u; nx = cnt > 0u ? cnt : 1u;
}
__device__ __forceinline__ void xcd_barrier(const XcdBarrier& b, bool leader) {
    asm volatile("s_waitcnt vmcnt(0)" ::: "memory");
    __syncthreads();
    if (leader) {
        unsigned* bar = b.bar;
        __builtin_amdgcn_s_waitcnt(0);
        unsigned nloc = b.st[0], nx = b.st[1];
        if (nloc == 0u) { xcd_barrier_complete(bar, b.x, nloc, nx); b.st[0] = nloc; b.st[1] = nx; }
        const unsigned old = xb_add(&bar[XB_XSUB(b.x)], 1u);
        const unsigned gen = old / nloc;
        if (old + 1u == (gen + 1u) * nloc) {
            __builtin_amdgcn_fence(__ATOMIC_RELEASE, "agent");
            asm volatile("s_waitcnt vmcnt(0)" ::: "memory");
            const unsigned og = xb_add(&bar[XB_TOP], 1u);
            const unsigned tg = og / nx;
            if (og + 1u == (tg + 1u) * nx) xb_add(&bar[XB_TOPGEN], 1u);
            else XB_SPIN(xb_ld(&bar[XB_TOPGEN]) == tg, bar);
            __builtin_amdgcn_fence(__ATOMIC_ACQUIRE, "agent");
            xb_add(&bar[XB_XGEN(b.x)], 1u);
            asm volatile("s_waitcnt vmcnt(0)" ::: "memory");
        } else {
            XB_SPIN(xb_ld(&bar[XB_XGEN(b.x)]) == gen, bar);
            __builtin_amdgcn_fence(__ATOMIC_ACQUIRE, "agent");
            asm volatile("s_waitcnt vmcnt(0)" ::: "memory");
        }
    }
    __syncthreads();
}

__device__ __forceinline__ float dpp_add(float v, const int ctrl) { return v; }
#define DPP_ADD(v, ctrl) ((v) + __builtin_bit_cast(float, __builtin_amdgcn_update_dpp(0, __builtin_bit_cast(int, (v)), (ctrl), 0xf, 0xf, false)))
__device__ __forceinline__ float row16_sum(float v) { v = DPP_ADD(v, 0xB1); v = DPP_ADD(v, 0x4E); v = DPP_ADD(v, 0x141); v = DPP_ADD(v, 0x140); return v; }
__device__ __forceinline__ float wave_sum(float v) { return xor32_sum(xor16_sum(row16_sum(v))); }
__device__ __forceinline__ float wave_max(float v) {
#pragma unroll
    for (int o = 1; o < 64; o <<= 1) v = fmaxf(v, __shfl_xor(v, o));
    return v;
}
__device__ __forceinline__ float half_sum(float v) {
#pragma unroll
    for (int o = 1; o < 32; o <<= 1) v += __shfl_xor(v, o);
    return v;
}
__device__ __forceinline__ float gelu_erf(float x) { return 0.5f * x * (1.0f + erff(x * 0.70710678118654752f)); }

struct Args {
    const float* in[28]; float* out; unsigned char* ws; int ph_lo, ph_hi;
};
enum { I_X = 0, I_MEM, I_POS, I_ATTN_G, I_MEM_G, I_WIN, I_BGATES, I_AQG, I_AKG, I_SINKS, I_WOA, I_LNG, I_LNB, I_WS, I_BS, I_WOB, I_WMKV, I_CQG, I_CKG, I_WOC, I_WOUT, I_FFN_G,
       I_RW, I_RB, I_WGU, I_BGU, I_WD, I_BD };

__device__ __forceinline__ void tr_item(const float* W, int ldw, int k0, int sc, bf16* WT, int ldt, int dr, int dk, LAS float* scr, int lane) {
#pragma unroll 8
    for (int i = 0; i < 32; ++i) { const int kk = 2 * i + (lane >> 5); scr[kk * 33 + (lane & 31)] = W[(size_t)(k0 + kk) * ldw + sc + (lane & 31)]; }
    LDS_WAIT(); asm volatile("" ::: "memory");
    const int c = lane & 7;
#pragma unroll
    for (int j = 0; j < 4; ++j) { const int n = (lane >> 3) + 8 * j; const LAS float* s = scr + (8 * c) * 33 + n;
        v4u o; o.x = pk2(s[0 * 33], s[1 * 33]); o.y = pk2(s[2 * 33], s[3 * 33]); o.z = pk2(s[4 * 33], s[5 * 33]); o.w = pk2(s[6 * 33], s[7 * 33]);
        *(GAS v4u*)(WT + (size_t)(dr + n) * ldt + dk + k0 + 8 * c) = o; }
    LDS_WAIT(); asm volatile("" ::: "memory");
}
struct TrItem { const float* W; int ldw, k0, sc; bf16* WT; int ldt, dr, dk; const float* ks; };
__device__ __forceinline__ void tr_load(const TrItem& it, int lane, f32x4 (&v)[8]) {
    const float* p = it.W + (size_t)(it.k0 + (lane >> 3)) * it.ldw + it.sc + 4 * (lane & 7);
#pragma unroll
    for (int i = 0; i < 8; ++i) v[i] = *(const GAS f32x4*)(p + (size_t)(8 * i) * it.ldw);
}
__device__ __forceinline__ void tr_store(const TrItem& it, const f32x4 (&v)[8], LAS float* scr, int lane) {
#pragma unroll
    for (int i = 0; i < 8; ++i) { LAS float* p = scr + ((lane >> 3) + 8 * i) * 33 + 4 * (lane & 7); p[0] = v[i].x; p[1] = v[i].y; p[2] = v[i].z; p[3] = v[i].w; }
    LDS_WAIT(); asm volatile("" ::: "memory");
    const int c = lane & 7;
#pragma unroll
    for (int j = 0; j < 4; ++j) { const int n = (lane >> 3) + 8 * j; const LAS float* s = scr + (8 * c) * 33 + n;
        v4u o; o.x = pk2(s[0 * 33], s[1 * 33]); o.y = pk2(s[2 * 33], s[3 * 33]); o.z = pk2(s[4 * 33], s[5 * 33]); o.w = pk2(s[6 * 33], s[7 * 33]);
        *(GAS v4u*)(it.WT + (size_t)(it.dr + n) * it.ldt + it.dk + it.k0 + 8 * c) = o; }
    LDS_WAIT(); asm volatile("" ::: "memory");
}
__device__ __forceinline__ void tr_store8(const TrItem& it, const f32x4 (&v)[8], LAS float* scr, int lane, float sc) {
#pragma unroll
    for (int i = 0; i < 8; ++i) { LAS float* p = scr + ((lane >> 3) + 8 * i) * 33 + 4 * (lane & 7); p[0] = v[i].x; p[1] = v[i].y; p[2] = v[i].z; p[3] = v[i].w; }
    LDS_WAIT(); asm volatile("" ::: "memory");
    const int c = lane & 7; unsigned char* WT8 = (unsigned char*)it.WT;
    f32x4 k0v = (f32x4){sc, sc, sc, sc}, k1v = k0v;
    if (it.ks) { k0v = *(const GAS f32x4*)(it.ks + it.k0 + 8 * c) * sc; k1v = *(const GAS f32x4*)(it.ks + it.k0 + 8 * c + 4) * sc; }
#pragma unroll
    for (int j = 0; j < 4; ++j) { const int n = (lane >> 3) + 8 * j; const LAS float* s = scr + (8 * c) * 33 + n;
        v2u o; o.x = pk4_fp8(s[0 * 33] * k0v.x, s[1 * 33] * k0v.y, s[2 * 33] * k0v.z, s[3 * 33] * k0v.w); o.y = pk4_fp8(s[4 * 33] * k1v.x, s[5 * 33] * k1v.y, s[6 * 33] * k1v.z, s[7 * 33] * k1v.w);
        *(GAS v2u*)(WT8 + (size_t)(it.dr + n) * it.ldt + it.dk + it.k0 + 8 * c) = o; }
    LDS_WAIT(); asm volatile("" ::: "memory");
}
template <class F> __device__ __forceinline__ void tr_range8(int nit, F f, int gw, int NGW, LAS float* scr, int lane, float sc) {
    for (int it = gw; it < nit; it += 2 * NGW) {
        const TrItem a = f(it); f32x4 va[8], vb[8]; tr_load(a, lane, va);
        const bool two = it + NGW < nit; TrItem b = a; if (two) { b = f(it + NGW); tr_load(b, lane, vb); }
        tr_store8(a, va, scr, lane, sc);
        if (two) tr_store8(b, vb, scr, lane, sc);
    }
}
template <class F> __device__ __forceinline__ void tr_range(int nit, F f, int gw, int NGW, LAS float* scr, int lane) {
    for (int it = gw; it < nit; it += 2 * NGW) {
        const TrItem a = f(it); f32x4 va[8], vb[8]; tr_load(a, lane, va);
        const bool two = it + NGW < nit; TrItem b = a; if (two) { b = f(it + NGW); tr_load(b, lane, vb); }
        tr_store(a, va, scr, lane);
        if (two) tr_store(b, vb, scr, lane);
    }
}
__device__ __forceinline__ int win_srccol(int r) {
    if (r < 1024) { const int pn = r >> 8, blk = (r >> 5) & 7, bj = blk >> 2, wc = blk & 3; return 64 * (4 * pn + wc) + 32 * bj; }
    if (r < 1536) return 1280 + (r - 1024);
    if (r < 2048) return 2304 + (r - 1536);
    if (r < 2304) { const int blk = (r - 2048) >> 5, bj = blk >> 2, wc = blk & 3; return ((wc & 1) ? 1152 : 1024) + 64 * (wc >> 1) + 32 * bj; }
    if (r < 2816) return 1792 + (r - 2304);
    return r;
}
__device__ __forceinline__ void rms_row_to_bf16(const float* xrow, const float* g, bf16* orow, int lane) {
    const GAS f32x4* xr = (const GAS f32x4*)xrow + lane; const GAS f32x4* gr = (const GAS f32x4*)g + lane;
    f32x4 v[4]; float s = 0.f;
#pragma unroll
    for (int j = 0; j < 4; ++j) { v[j] = xr[64 * j]; s += (v[j].x * v[j].x + v[j].y * v[j].y) + (v[j].z * v[j].z + v[j].w * v[j].w); }
    const float rstd = 1.0f / sqrtf(wave_sum(s) * (1.f / 1024.f) + EPS);
    GAS v2u* o8 = (GAS v2u*)orow + lane;
#pragma unroll
    for (int j = 0; j < 4; ++j) { const f32x4 gg = gr[64 * j]; v2u o; o.x = pk2(v[j].x * rstd * gg.x, v[j].y * rstd * gg.y); o.y = pk2(v[j].z * rstd * gg.z, v[j].w * rstd * gg.w); o8[64 * j] = o; }
}

__device__ __forceinline__ void rms_rows4_to_bf16(const float* xrow, const float* g, bf16* orow, int lane) {
    const GAS f32x4* xr = (const GAS f32x4*)xrow + lane; const GAS f32x4* gr = (const GAS f32x4*)g + lane;
    f32x4 v[16]; float s[4];
#pragma unroll
    for (int j = 0; j < 16; ++j) v[j] = xr[64 * j];
#pragma unroll
    for (int r = 0; r < 4; ++r) { float a = 0.f;
#pragma unroll
        for (int j = 0; j < 4; ++j) a += (v[4 * r + j].x * v[4 * r + j].x + v[4 * r + j].y * v[4 * r + j].y) + (v[4 * r + j].z * v[4 * r + j].z + v[4 * r + j].w * v[4 * r + j].w);
        s[r] = a; }
#pragma unroll
    for (int r = 0; r < 4; ++r) s[r] = row16_sum(s[r]);
#pragma unroll
    for (int r = 0; r < 4; ++r) s[r] = xor32_sum(xor16_sum(s[r]));
    GAS v2u* o8 = (GAS v2u*)orow + lane;
#pragma unroll
    for (int r = 0; r < 4; ++r) { const float rs = 1.0f / sqrtf(s[r] * (1.f / 1024.f) + EPS);
#pragma unroll
        for (int j = 0; j < 4; ++j) { const f32x4 gg = gr[64 * j]; const f32x4 a = v[4 * r + j];
            v2u o; o.x = pk2(a.x * rs * gg.x, a.y * rs * gg.y); o.y = pk2(a.z * rs * gg.z, a.w * rs * gg.w); o8[256 * r + 64 * j] = o; } }
}
__device__ __forceinline__ void rms_rows2_to_bf16(const float* xrow, const float* g, bf16* orow, int lane) {
    const GAS f32x4* xr = (const GAS f32x4*)xrow + lane; const GAS f32x4* gr = (const GAS f32x4*)g + lane;
    f32x4 v[8]; float s0 = 0.f, s1 = 0.f;
#pragma unroll
    for (int j = 0; j < 8; ++j) v[j] = xr[64 * j];
#pragma unroll
    for (int j = 0; j < 4; ++j) { s0 += (v[j].x * v[j].x + v[j].y * v[j].y) + (v[j].z * v[j].z + v[j].w * v[j].w); s1 += (v[4 + j].x * v[4 + j].x + v[4 + j].y * v[4 + j].y) + (v[4 + j].z * v[4 + j].z + v[4 + j].w * v[4 + j].w); }
    const float r0 = 1.0f / sqrtf(wave_sum(s0) * (1.f / 1024.f) + EPS), r1 = 1.0f / sqrtf(wave_sum(s1) * (1.f / 1024.f) + EPS);
    GAS v2u* o8 = (GAS v2u*)orow + lane;
#pragma unroll
    for (int j = 0; j < 4; ++j) { const f32x4 gg = gr[64 * j];
        v2u o; o.x = pk2(v[j].x * r0 * gg.x, v[j].y * r0 * gg.y); o.y = pk2(v[j].z * r0 * gg.z, v[j].w * r0 * gg.w); o8[64 * j] = o;
        v2u p; p.x = pk2(v[4 + j].x * r1 * gg.x, v[4 + j].y * r1 * gg.y); p.y = pk2(v[4 + j].z * r1 * gg.z, v[4 + j].w * r1 * gg.w); o8[256 + 64 * j] = p; }
}
namespace att {
typedef short bf16x8 __attribute__((ext_vector_type(8)));
typedef short s16x4 __attribute__((ext_vector_type(4)));
typedef short v4i16_t __attribute__((ext_vector_type(4)));
typedef float f32x16 __attribute__((ext_vector_type(16)));
typedef float f32x2_t __attribute__((ext_vector_type(2)));
typedef __bf16 bf16x2_t __attribute__((ext_vector_type(2)));
#define ATT_MFMA(a, b, c) __builtin_amdgcn_mfma_f32_32x32x16_bf16((a), (b), (c), 0, 0, 0)
__device__ __forceinline__ unsigned cvtpk(float lo, float hi) { f32x2_t v = {lo, hi}; bf16x2_t b = __builtin_convertvector(v, bf16x2_t); return __builtin_bit_cast(unsigned, b); }
__device__ __forceinline__ s16x4 vtr(const LAS unsigned char* p) { return __builtin_bit_cast(s16x4, __builtin_amdgcn_ds_read_tr16_b64_v4i16((LAS v4i16_t*)p)); }
__device__ __forceinline__ int crow(int r, int h) { return (r & 3) + 8 * (r >> 2) + 4 * h; }
__device__ __forceinline__ bf16x8 pack8(float a0, float a1, float a2, float a3, float a4, float a5, float a6, float a7) {
    v4u w; w.x = cvtpk(a0, a1); w.y = cvtpk(a2, a3); w.z = cvtpk(a4, a5); w.w = cvtpk(a6, a7); return __builtin_bit_cast(bf16x8, w); }
constexpr float LOG2E = 1.4426950408889634f;
constexpr int SWA_KP = 144, SWA_VP = 192, SWA_K_OFF = 0, SWA_V_OFF = 256 * SWA_KP;

__device__ __forceinline__ void swa_phase(LAS unsigned char* L, bf16* projp, const float* sinks, const float* gq, const float* gk, int bid, int G, int wave, int lane) {
    const int tid = wave * 64 + lane, r32 = lane & 31, h = lane >> 5, blk16 = (lane >> 4) & 1, q4 = (lane & 15) >> 2, p4 = lane & 3;
    const float bnd = 8.0f * wave_max(fabsf(gq[lane])) * wave_max(fabsf(gk[lane]));
    v4u kx[4], vx[4];
#define SWA_LOADKV(u_) do { const int blk_ = (u_) & 15, kvh_ = ((u_) >> 4) & 1, b_ = (u_) >> 5; const int tok0_ = b_ * SEQ + blk_ * 128; \
        _Pragma("unroll") for (int it = 0; it < 4; ++it) if (it >= 2 || blk_ != 0) { \
            const bf16* src = projp + (size_t)(tok0_ - 128 + (tid >> 3) + 64 * it) * LDP + 64 * kvh_ + 8 * (tid & 7); \
            kx[it] = *(const GAS v4u*)(src + C_K); vx[it] = *(const GAS v4u*)(src + C_V); } } while (0)
    if (bid < 1024) SWA_LOADKV(bid);
    for (int unit = bid; unit < 1024; unit += G) {
        const int blk = unit & 15, kvh = (unit >> 4) & 1, b = unit >> 5;
        const int tok0 = b * SEQ + blk * 128;
        __syncthreads();
#pragma unroll
        for (int it = 0; it < 4; ++it) if (it >= 2 || blk != 0) {
            const int row = (tid >> 3) + 64 * it, ch = tid & 7;
            *(LAS v4u*)(L + SWA_K_OFF + row * SWA_KP + ch * 16) = kx[it];
            *(LAS v4u*)(L + SWA_V_OFF + row * SWA_VP + ch * 16) = vx[it];
        }
        __syncthreads();
        if (unit + G < 1024) SWA_LOADKV(unit + G);
        const int hd = kvh * 8 + wave;
        const float sink = sinks[hd];
        const float m2 = fmaxf(bnd, sink) * LOG2E;
        const float esink = __builtin_amdgcn_exp2f(sink * LOG2E - m2);
        bf16x8 qnx[4];
#pragma unroll
        for (int ks = 0; ks < 4; ++ks) qnx[ks] = *(const GAS bf16x8*)(projp + (size_t)(tok0 + r32) * LDP + C_Q + 64 * hd + 16 * ks + 8 * h);
#pragma unroll 1
        for (int qi = 0; qi < 4; ++qi) {
            bf16* qrow = projp + (size_t)(tok0 + 32 * qi + r32) * LDP + C_Q + 64 * hd;
            bf16x8 qf[4];
#pragma unroll
            for (int ks = 0; ks < 4; ++ks) qf[ks] = qnx[ks];
            if (qi < 3) {
#pragma unroll
                for (int ks = 0; ks < 4; ++ks) qnx[ks] = *(const GAS bf16x8*)(qrow + (size_t)32 * LDP + 16 * ks + 8 * h); }
            f32x16 o0, o1;
#pragma unroll
            for (int r = 0; r < 16; ++r) { o0[r] = 0.f; o1[r] = 0.f; }
            float lsum = 0.f;
            const int kt0 = (blk == 0) ? 4 : qi;
#pragma unroll 1
            for (int kt = kt0; kt <= qi + 4; ++kt) {
                f32x16 s;
#pragma unroll
                for (int r = 0; r < 16; ++r) s[r] = 0.f;
                const LAS unsigned char* kp = L + SWA_K_OFF + (32 * kt + r32) * SWA_KP + 16 * h;
#pragma unroll
                for (int ks = 0; ks < 4; ++ks) { const bf16x8 kf = *(const LAS bf16x8*)(kp + 32 * ks); s = ATT_MFMA(kf, qf[ks], s); }
                float p[16];
                const bool first = (kt == qi), lastt = (kt == qi + 4);
#pragma unroll
                for (int r = 0; r < 16; ++r) { const float e = __builtin_amdgcn_exp2f(s[r] * (0.125f * LOG2E) - m2); const int cr = crow(r, h);
                    const bool ok = (!first || cr > r32) && (!lastt || cr <= r32); p[r] = ok ? e : 0.f; lsum += p[r]; }
#pragma unroll
                for (int s2 = 0; s2 < 2; ++s2) {
                    const bf16x8 pb = pack8(p[8 * s2], p[8 * s2 + 1], p[8 * s2 + 2], p[8 * s2 + 3], p[8 * s2 + 4], p[8 * s2 + 5], p[8 * s2 + 6], p[8 * s2 + 7]);
                    const LAS unsigned char* vp = L + SWA_V_OFF + (32 * kt + 16 * s2 + 4 * h + q4) * SWA_VP + (16 * blk16 + 4 * p4) * 2;
                    { const s16x4 lo = vtr(vp), hi = vtr(vp + 8 * SWA_VP); const bf16x8 vf = __builtin_shufflevector(lo, hi, 0, 1, 2, 3, 4, 5, 6, 7); o0 = ATT_MFMA(vf, pb, o0); }
                    { const s16x4 lo = vtr(vp + 64), hi = vtr(vp + 64 + 8 * SWA_VP); const bf16x8 vf = __builtin_shufflevector(lo, hi, 0, 1, 2, 3, 4, 5, 6, 7); o1 = ATT_MFMA(vf, pb, o1); }
                }
            }
            const float tot = xor32_sum(lsum); const float inv = 1.0f / (tot + esink);
#pragma unroll
            for (int g4 = 0; g4 < 4; ++g4) {
                v2u w0; w0.x = cvtpk(o0[4 * g4] * inv, o0[4 * g4 + 1] * inv); w0.y = cvtpk(o0[4 * g4 + 2] * inv, o0[4 * g4 + 3] * inv);
                v2u w1; w1.x = cvtpk(o1[4 * g4] * inv, o1[4 * g4 + 1] * inv); w1.y = cvtpk(o1[4 * g4 + 2] * inv, o1[4 * g4 + 3] * inv);
                *(GAS v2u*)(qrow + 8 * g4 + 4 * h) = w0; *(GAS v2u*)(qrow + 32 + 8 * g4 + 4 * h) = w1;
            }
        }
    }
}

constexpr int GM_P = 1088;
__device__ __forceinline__ void gmlp_phase(LAS unsigned char* L, bf16* projp, const bf16* Wb, const float* lng, const float* lnb, const float* bs, int bid, int G, int wave, int lane) {
    const int r32 = lane & 31, h = lane >> 5, blk16 = (lane >> 4) & 1, q4 = (lane & 15) >> 2, p4 = lane & 3;
    float lg[8], lb[8];
    { const f32x4 a = *(const f32x4*)(lng + 8 * lane), b = *(const f32x4*)(lng + 8 * lane + 4), c = *(const f32x4*)(lnb + 8 * lane), d = *(const f32x4*)(lnb + 8 * lane + 4);
      lg[0] = a.x; lg[1] = a.y; lg[2] = a.z; lg[3] = a.w; lg[4] = b.x; lg[5] = b.y; lg[6] = b.z; lg[7] = b.w;
      lb[0] = c.x; lb[1] = c.y; lb[2] = c.z; lb[3] = c.w; lb[4] = d.x; lb[5] = d.y; lb[6] = d.z; lb[7] = d.w; }
    for (int unit = bid; unit < T / 128; unit += G) {
        const int tok0 = unit * 128;
        __syncthreads();
#pragma unroll 1
        for (int i0 = 0; i0 < 16; i0 += 8) {
            v4u w[8]; float sm[8], q[8];
#pragma unroll
            for (int i = 0; i < 8; ++i) w[i] = *(const GAS v4u*)(projp + (size_t)(tok0 + 16 * wave + i0 + i) * LDP + C_VB + 8 * lane);
#pragma unroll
            for (int i = 0; i < 8; ++i) sm[i] = row16_sum(((blo(w[i].x) + bhi(w[i].x)) + (blo(w[i].y) + bhi(w[i].y))) + ((blo(w[i].z) + bhi(w[i].z)) + (blo(w[i].w) + bhi(w[i].w))));
#pragma unroll
            for (int i = 0; i < 8; ++i) sm[i] = xor32_sum(xor16_sum(sm[i])) * (1.f / 512.f);
#pragma unroll
            for (int i = 0; i < 8; ++i) { const float mu = sm[i];
                const float d0 = blo(w[i].x) - mu, d1 = bhi(w[i].x) - mu, d2 = blo(w[i].y) - mu, d3 = bhi(w[i].y) - mu, d4 = blo(w[i].z) - mu, d5 = bhi(w[i].z) - mu, d6 = blo(w[i].w) - mu, d7 = bhi(w[i].w) - mu;
                q[i] = row16_sum(((d0 * d0 + d1 * d1) + (d2 * d2 + d3 * d3)) + ((d4 * d4 + d5 * d5) + (d6 * d6 + d7 * d7))); }
#pragma unroll
            for (int i = 0; i < 8; ++i) q[i] = xor32_sum(xor16_sum(q[i]));
#pragma unroll
            for (int i = 0; i < 8; ++i) { const float mu = sm[i], rstd = 1.0f / sqrtf(q[i] * (1.f / 512.f) + EPS);
                v4u o; o.x = cvtpk((blo(w[i].x) - mu) * rstd * lg[0] + lb[0], (bhi(w[i].x) - mu) * rstd * lg[1] + lb[1]); o.y = cvtpk((blo(w[i].y) - mu) * rstd * lg[2] + lb[2], (bhi(w[i].y) - mu) * rstd * lg[3] + lb[3]);
                o.z = cvtpk((blo(w[i].z) - mu) * rstd * lg[4] + lb[4], (bhi(w[i].z) - mu) * rstd * lg[5] + lb[5]); o.w = cvtpk((blo(w[i].w) - mu) * rstd * lg[6] + lb[6], (bhi(w[i].w) - mu) * rstd * lg[7] + lb[7]);
                *(LAS v4u*)(L + (16 * wave + i0 + i) * GM_P + lane * 16) = o; }
        }
        __syncthreads();
        const int g = wave >> 1, th = wave & 1;
        f32x16 acc[4][2];
#pragma unroll
        for (int ct = 0; ct < 4; ++ct)
#pragma unroll
            for (int tt = 0; tt < 2; ++tt)
#pragma unroll
                for (int r = 0; r < 16; ++r) acc[ct][tt][r] = 0.f;
#pragma unroll 1
        for (int ks = 0; ks < 4 * th + 4; ++ks) {
            bf16x8 af[4];
#pragma unroll
            for (int ct = 0; ct < 4; ++ct) { const LAS unsigned char* vp = L + (16 * ks + 8 * h + q4) * GM_P + (128 * g + 32 * ct + 16 * blk16 + 4 * p4) * 2;
                const s16x4 lo = vtr(vp), hi = vtr(vp + 4 * GM_P); af[ct] = __builtin_shufflevector(lo, hi, 0, 1, 2, 3, 4, 5, 6, 7); }
#pragma unroll
            for (int tt = 0; tt < 2; ++tt) if (ks < 4 * th + 2 * tt + 2) {
                const bf16x8 bfr = *(const GAS bf16x8*)(Wb + (size_t)(g * 128 + 64 * th + 32 * tt + r32) * 128 + 16 * ks + 8 * h);
#pragma unroll
                for (int ct = 0; ct < 4; ++ct) acc[ct][tt] = ATT_MFMA(af[ct], bfr, acc[ct][tt]);
            }
        }
#pragma unroll
        for (int tt = 0; tt < 2; ++tt) { const int t = 64 * th + 32 * tt + r32; const float bsv = bs[g * 128 + t];
            bf16* urow = projp + (size_t)(tok0 + t) * LDP + C_U + 128 * g + 4 * h;
#pragma unroll
            for (int ct = 0; ct < 4; ++ct)
#pragma unroll
                for (int g4 = 0; g4 < 4; ++g4) { bf16* up = urow + 32 * ct + 8 * g4; const v2u uw = *(const GAS v2u*)up;
                    v2u o; o.x = cvtpk(blo(uw.x) * (acc[ct][tt][4 * g4] + bsv), bhi(uw.x) * (acc[ct][tt][4 * g4 + 1] + bsv));
                    o.y = cvtpk(blo(uw.y) * (acc[ct][tt][4 * g4 + 2] + bsv), bhi(uw.y) * (acc[ct][tt][4 * g4 + 3] + bsv)); *(GAS v2u*)up = o; } }
    }
}

constexpr int XA_K_OFF = 0, XA_V_OFF = 65536;
__device__ __forceinline__ unsigned off_b(unsigned row, unsigned ch) { return 256u * row + 16u * (ch ^ (((row & 3u) << 2) | ((row >> 2) & 3u))); }
__device__ __forceinline__ void xattn_phase(LAS unsigned char* L, bf16* projp, const bf16* kvp, const float* cqg, const float* ckg, int bid, int G, int wave, int lane) {
    const int tid = wave * 64 + lane, r32 = lane & 31, h = lane >> 5, blk16 = (lane >> 4) & 1, q4 = (lane & 15) >> 2, p4 = lane & 3;
    const int fch = tid & 15;
    float gg[8];
#pragma unroll
    for (int i = 0; i < 8; ++i) gg[i] = cqg[8 * fch + i] * ckg[8 * fch + i] * (0.08838834764831845f * LOG2E);
    const float mq = wave_max(fmaxf(fabsf(cqg[lane]), fabsf(cqg[lane + 64]))), mk = wave_max(fmaxf(fabsf(ckg[lane]), fabsf(ckg[lane + 64])));
    const float m2 = 11.313708499f * mq * mk * LOG2E;
    for (int unit = bid; unit < 256; unit += G) {
        const int qh = unit & 1, hd = (unit >> 1) & 3, b = unit >> 3;
        __syncthreads();
        {   v4u kx[8], vx[8];
#pragma unroll
            for (int it = 0; it < 8; ++it) { const bf16* src = kvp + (size_t)(b * MEM + (tid >> 4) + 32 * it) * D + 128 * hd + 8 * fch; kx[it] = *(const GAS v4u*)src; vx[it] = *(const GAS v4u*)(src + 512); }
#pragma unroll
            for (int it = 0; it < 8; ++it) { const int row = (tid >> 4) + 32 * it;
                float k[8] = {blo(kx[it].x), bhi(kx[it].x), blo(kx[it].y), bhi(kx[it].y), blo(kx[it].z), bhi(kx[it].z), blo(kx[it].w), bhi(kx[it].w)};
                float ss = 0.f;
#pragma unroll
                for (int e = 0; e < 8; ++e) ss += k[e] * k[e];
                ss = row16_sum(ss);
                const float rstd = 1.0f / sqrtf(ss * (1.f / 128.f) + EPS);
                v4u ko; ko.x = cvtpk(k[0] * rstd * gg[0], k[1] * rstd * gg[1]); ko.y = cvtpk(k[2] * rstd * gg[2], k[3] * rstd * gg[3]);
                ko.z = cvtpk(k[4] * rstd * gg[4], k[5] * rstd * gg[5]); ko.w = cvtpk(k[6] * rstd * gg[6], k[7] * rstd * gg[7]);
                const unsigned o = off_b((unsigned)row, (unsigned)fch);
                *(LAS v4u*)(L + XA_K_OFF + o) = ko; *(LAS v4u*)(L + XA_V_OFF + o) = vx[it]; } }
        bf16* qrow0 = projp + (size_t)(b * SEQ + 1024 * qh + 32 * wave + r32) * LDP + C_QC + 128 * hd + 8 * h;
        v4u qn[8];
#pragma unroll
        for (int ks = 0; ks < 8; ++ks) qn[ks] = *(const GAS v4u*)(qrow0 + 16 * ks);
        __syncthreads();
#pragma unroll 1
        for (int qt = 0; qt < 4; ++qt) {
            bf16* qrow = qrow0 + (size_t)(256 * qt) * LDP;
            bf16x8 qf[8]; float ss = 0.f;
#pragma unroll
            for (int ks = 0; ks < 8; ++ks) { const v4u w = qn[ks]; qf[ks] = __builtin_bit_cast(bf16x8, w);
                ss += (blo(w.x) * blo(w.x) + bhi(w.x) * bhi(w.x)) + (blo(w.y) * blo(w.y) + bhi(w.y) * bhi(w.y)) + (blo(w.z) * blo(w.z) + bhi(w.z) * bhi(w.z)) + (blo(w.w) * blo(w.w) + bhi(w.w) * bhi(w.w)); }
            if (qt < 3) {
#pragma unroll
                for (int ks = 0; ks < 8; ++ks) qn[ks] = *(const GAS v4u*)(qrow + (size_t)256 * LDP + 16 * ks); }
            ss = xor32_sum(ss);
            const float rq = 1.0f / sqrtf(ss * (1.f / 128.f) + EPS);
            f32x16 o[4];
#pragma unroll
            for (int dt = 0; dt < 4; ++dt)
#pragma unroll
                for (int r = 0; r < 16; ++r) o[dt][r] = 0.f;
            float lsum = 0.f;
#pragma unroll 1
            for (int kt = 0; kt < 8; ++kt) {
                f32x16 s;
#pragma unroll
                for (int r = 0; r < 16; ++r) s[r] = 0.f;
#pragma unroll
                for (int ks = 0; ks < 8; ++ks) { const bf16x8 kf = *(const LAS bf16x8*)(L + XA_K_OFF + off_b((unsigned)(32 * kt + r32), (unsigned)(2 * ks + h))); s = ATT_MFMA(kf, qf[ks], s); }
                float p[16];
#pragma unroll
                for (int r = 0; r < 16; ++r) { p[r] = __builtin_amdgcn_exp2f(s[r] * rq - m2); lsum += p[r]; }
#pragma unroll
                for (int s2 = 0; s2 < 2; ++s2) {
                    const bf16x8 pb = pack8(p[8 * s2], p[8 * s2 + 1], p[8 * s2 + 2], p[8 * s2 + 3], p[8 * s2 + 4], p[8 * s2 + 5], p[8 * s2 + 6], p[8 * s2 + 7]);
                    const unsigned r0 = (unsigned)(32 * kt + 16 * s2 + 4 * h + q4);
#pragma unroll
                    for (int dt = 0; dt < 4; ++dt) {
                        const unsigned ch = (unsigned)(4 * dt + 2 * blk16 + (p4 >> 1));
                        const s16x4 lo = vtr(L + XA_V_OFF + off_b(r0, ch) + 8 * (p4 & 1)), hi = vtr(L + XA_V_OFF + off_b(r0 + 8u, ch) + 8 * (p4 & 1));
                        const bf16x8 vf = __builtin_shufflevector(lo, hi, 0, 1, 2, 3, 4, 5, 6, 7); o[dt] = ATT_MFMA(vf, pb, o[dt]); }
                }
            }
            const float inv = 1.0f / xor32_sum(lsum);
#pragma unroll
            for (int dt = 0; dt < 4; ++dt)
#pragma unroll
                for (int g4 = 0; g4 < 4; ++g4) { v2u w; w.x = cvtpk(o[dt][4 * g4] * inv, o[dt][4 * g4 + 1] * inv); w.y = cvtpk(o[dt][4 * g4 + 2] * inv, o[dt][4 * g4 + 3] * inv);
                    *(GAS v2u*)(qrow - 8 * h + 32 * dt + 8 * g4 + 4 * h) = w; }
        }
    }
}
}

constexpr int NPHASE = 11;
__global__ void __launch_bounds__(NTHR, 2) fwd(Args args) {
    extern __shared__ __attribute__((aligned(16))) unsigned char lds[];
    LAS unsigned char* L = (LAS unsigned char*)lds;
    volatile LAS unsigned* MISC = (volatile LAS unsigned*)(L + MISC_OFF);
    const int wave_s = __builtin_amdgcn_readfirstlane((int)threadIdx.x >> 6);
    for (int u = threadIdx.x; u < (LDS_BYTES - LDSCTL_OFF) / 4; u += NTHR) ((LAS unsigned*)(L + LDSCTL_OFF))[u] = 0u;
    __syncthreads();
#define LANE_ID ((int)__builtin_amdgcn_mbcnt_hi(~0u, __builtin_amdgcn_mbcnt_lo(~0u, 0u)))
#if MK_FUSED
    XcdBarrier bar = xcd_barrier_post((unsigned*)(args.ws + WS_CTL) + CW_BAR, MISC + 8, wave_s == 0 && LANE_ID == 0);
#define GRID_BAR() xcd_barrier(bar, wave_s == 0 && LANE_ID == 0)
#else
    (void)MISC;
#define GRID_BAR() do {} while (0)
#endif
    const int lo = args.ph_lo, hi = args.ph_hi;
#define IN(k) (lo <= (k) && (k) < hi)
#if PROBE_MASK
#define STAMP(k) do { if (blockIdx.x == 0 && wave_s == 0 && LANE_ID == 0) ((LAS unsigned*)(L + LDSCTL_OFF + 640))[(k) + 1] = (unsigned)__builtin_amdgcn_s_memrealtime(); } while (0)
#define STAMPX(i) do { if (blockIdx.x == 0 && wave_s == 0 && LANE_ID == 0) ((LAS unsigned*)(L + LDSCTL_OFF + 640))[16 + (i)] = (unsigned)__builtin_amdgcn_s_memrealtime(); } while (0)
#else
#define STAMP(k) do {} while (0)
#define STAMPX(i) do {} while (0)
#endif
#define SEAM(k) do { if (IN(k) && IN((k) + 1)) GRID_BAR(); STAMP(k); } while (0)
    STAMP(-1);
#define PV \
    int wave = wave_s; asm volatile("" : "+s"(wave)); int bid = blockIdx.x; asm volatile("" : "+s"(bid)); \
    const int lane = LANE_ID, tid = wave * 64 + lane; \
    const int G = gridDim.x, gw = bid * NWAVES + wave, NGW = G * NWAVES, gtid = bid * NTHR + tid, NT = G * NTHR; \
    GAS unsigned char* ws = (GAS unsigned char*)args.ws; asm volatile("" : "+s"(ws));     \
    gu32* ctl = (gu32*)(ws + WS_CTL); \
    LAS float* scr = (LAS float*)(L + RING_OFF + wave * 16384); \
    (void)lane; (void)tid; (void)bid; (void)gw; (void)NGW; (void)gtid; (void)NT; (void)ctl; (void)scr; (void)G;
#define Win_t ((bf16*)(ws + WS_WIN))
#define Wo_t ((bf16*)(ws + WS_WO))
#define Wmkv_t ((bf16*)(ws + WS_WMKV))
#define Wout_t ((bf16*)(ws + WS_WOUT))
#define Hb ((bf16*)(ws + WS_H))
#define proj ((bf16*)(ws + WS_PROJ))
#define memn ((bf16*)(ws + WS_MEMN))
#define kv ((bf16*)(ws + WS_KV))
#define rope ((float2*)(ws + WS_ROPE))
#define Wgu_t ((bf16*)(ws + WS_WGU))
#define Wd_t ((bf16*)(ws + WS_WD))
#define ybuf ((bf16*)(ws + WS_Y))
#define act ((bf16*)(ws + WS_ACT))
#define topk_idx ((int*)(ws + WS_META + MT_IDX))
#define topk_gate ((float*)(ws + WS_META + MT_GATE))
#define slot_of ((int*)(ws + WS_META + MT_SASG))
#define slot_tok ((int*)(ws + WS_META + MT_STOK))
#define slot_gate ((float*)(ws + WS_META + MT_SGATE))
#define tile_e ((int*)(ws + WS_META + MT_TILEE))
#define Wsb ((bf16*)(ws + WS_META + MT_WSB))
#define Cmat ((int*)(ws + WS_META + MT_CMAT))
#define Rwp ((float*)(ws + WS_META + MT_RWP))
#define rstd_tok ((float*)(ws + WS_META + MT_RSTD))
#define slot_rstd ((float*)(ws + WS_SRSTD))
#define X8 ((unsigned char*)(ws + WS_X8))
#define H8 ((unsigned char*)args.out)
#define Wg8 ((unsigned char*)args.out + (size_t)T * D)
#define x1b ((bf16*)(ws + WS_X1B))

    if (IN(0)) { PV
        const float* x = args.in[I_X]; (void)x;
        {
            const float* Wi = args.in[I_WIN]; const float* Wa = args.in[I_WOA]; const float* Wb = args.in[I_WOB]; const float* Wc = args.in[I_WOC]; const float* Wm = args.in[I_WMKV]; const float* Wu = args.in[I_WOUT];
            bf16* Oi = Win_t; bf16* Oo = Wo_t; bf16* Om = Wmkv_t; bf16* Ou = Wout_t;
            constexpr int NRB = C_G / 32;
            constexpr int N0 = (D / 64) * NRB, N1 = N0 + 16 * 32, N2 = N1 + 8 * 32, N3 = N2 + 8 * 32, N4 = N3 + 16 * 32, N5 = N4 + 16 * 32;
            tr_range(N5, [=](int it) {
                if (it < N0) { const int kb = it / NRB, rb = it % NRB; return TrItem{Wi, DIN, 64 * kb, win_srccol(32 * rb), Oi, D, 32 * rb, 0, nullptr}; }
                if (it < N1) { const int r = it - N0; return TrItem{Wa, D, 64 * (r >> 5), 32 * (r & 31), Oo, 2048, 32 * (r & 31), 0, nullptr}; }
                if (it < N2) { const int r = it - N1; return TrItem{Wb, D, 64 * (r >> 5), 32 * (r & 31), Oo, 2048, 32 * (r & 31), 1024, nullptr}; }
                if (it < N3) { const int r = it - N2; return TrItem{Wc, D, 64 * (r >> 5), 32 * (r & 31), Oo, 2048, 32 * (r & 31), 1536, nullptr}; }
                if (it < N4) { const int r = it - N3; return TrItem{Wm, D, 64 * (r >> 5), 32 * (r & 31), Om, D, 32 * (r & 31), 0, nullptr}; }
                const int r = it - N4; return TrItem{Wu, D, 64 * (r >> 5), 32 * (r & 31), Ou, D, 32 * (r & 31), 0, nullptr}; }, gw, NGW, scr, lane);
        }
        {
            const float* Wi = args.in[I_WIN]; unsigned char* O = Wg8; constexpr int nrb = (DIN - C_G) / 32;
            tr_range8((D / 64) * nrb, [=](int it) { const int kb = it / nrb, rb = it % nrb; return TrItem{Wi, DIN, 64 * kb, C_G + 32 * rb, (bf16*)O, D, 32 * rb, 0, nullptr}; }, gw, NGW, scr, lane, WSCALE);
        }
        STAMPX(8);
        for (int i = gtid; i < D * 32; i += NT) { const int k = i >> 5, e = i & 31; Rwp[(k >> 2) * 128 + e * 4 + (k & 3)] = args.in[I_FFN_G][k] * args.in[I_RW][i]; }
        { const int* pos = (const int*)args.in[I_POS];
          for (int i = gtid; i < T * 32; i += NT) { const int t = i >> 5, f = i & 31;
              const float inv = powf(10000.0f, -(float)(2 * f) / 64.0f); const float ang = (float)pos[t] * inv;
              float sn, cs; sincosf(ang, &sn, &cs); rope[i] = make_float2(cs, sn); } }
        for (int i = gtid; i < 4 * 128 * 128; i += NT) { const int tt = (i >> 7) & 127, sp = i & 127; Wsb[i] = (bf16)(sp <= tt ? f2bf(args.in[I_WS][i]) : 0u); }
        STAMPX(9);
        {
            f32x4 gg[4];
#pragma unroll
            for (int j = 0; j < 4; ++j) gg[j] = *((const GAS f32x4*)args.in[I_ATTN_G] + lane + 64 * j);
            f32x4 va[16], vb[16];
            int m = gw;
            if (m < T / 4) { const GAS f32x4* xr = (const GAS f32x4*)(x + (size_t)m * 4 * D) + lane;
#pragma unroll
                for (int j = 0; j < 16; ++j) va[j] = xr[64 * j]; }
#define ROWS4_FINISH(v, mm) do { float s_[4]; \
                _Pragma("unroll") for (int r = 0; r < 4; ++r) { float a_ = 0.f; \
                    _Pragma("unroll") for (int j = 0; j < 4; ++j) a_ += (v[4 * r + j].x * v[4 * r + j].x + v[4 * r + j].y * v[4 * r + j].y) + (v[4 * r + j].z * v[4 * r + j].z + v[4 * r + j].w * v[4 * r + j].w); \
                    s_[r] = row16_sum(a_); } \
                _Pragma("unroll") for (int r = 0; r < 4; ++r) s_[r] = xor32_sum(xor16_sum(s_[r])); \
                GAS v2u* o8_ = (GAS v2u*)(Hb + (size_t)(mm) * 4 * D) + lane; \
                _Pragma("unroll") for (int r = 0; r < 4; ++r) { const float rs_ = 1.0f / sqrtf(s_[r] * (1.f / 1024.f) + EPS); \
                    _Pragma("unroll") for (int j = 0; j < 4; ++j) { const f32x4 a_ = v[4 * r + j]; \
                        const float h0_ = a_.x * rs_ * gg[j].x, h1_ = a_.y * rs_ * gg[j].y, h2_ = a_.z * rs_ * gg[j].z, h3_ = a_.w * rs_ * gg[j].w; \
                        v2u o_; o_.x = pk2(h0_, h1_); o_.y = pk2(h2_, h3_); o8_[256 * r + 64 * j] = o_; \
                        ((GAS unsigned*)(H8 + ((size_t)(mm) * 4 + r) * D))[lane + 64 * j] = pk4_fp8(h0_, h1_, h2_, h3_); } } } while (0)
            for (; m < T / 4; m += 2 * NGW) {
                const int m2 = m + NGW; const bool two = m2 < T / 4;
                if (two) { const GAS f32x4* xr = (const GAS f32x4*)(x + (size_t)m2 * 4 * D) + lane;
#pragma unroll
                    for (int j = 0; j < 16; ++j) vb[j] = xr[64 * j]; }
                ROWS4_FINISH(va, m);
                const int m3 = m + 2 * NGW;
                if (m3 < T / 4) { const GAS f32x4* xr = (const GAS f32x4*)(x + (size_t)m3 * 4 * D) + lane;
#pragma unroll
                    for (int j = 0; j < 16; ++j) va[j] = xr[64 * j]; }
                if (two) ROWS4_FINISH(vb, m2);
            }
#undef ROWS4_FINISH
        }
        STAMPX(10);
        for (int m = gw; m < TM; m += NGW) rms_row_to_bf16(args.in[I_MEM] + (size_t)m * D, args.in[I_MEM_G], memn + (size_t)m * D, lane);
    }
    SEAM(0);
    if (IN(1)) { PV
        { pg8::Gemm g{Hb, Win_t, D, D, D}; pg8::StaticOrder S; S.init(T, C_G, G, bid);
          pg8::EpiProj E{proj, LDP, (const float*)rope, args.in[I_AQG], args.in[I_AKG], args.in[I_BGATES], EPS, C_Q, C_K, C_V, C_G, 0, 1.0f};
          pg8::gemm_phase<pg8::EpiProj, pg8::StaticOrder>(L + RING_OFF, g, S, E, wave); }
        { pg8::Gemm g{(const bf16*)H8, (const bf16*)Wg8, D / 2, D / 2, D / 2}; pg8::StaticOrder S; S.init(T, DIN - C_G, G, bid);
          pg8::EpiProj E{proj, LDP, (const float*)rope, args.in[I_AQG], args.in[I_AKG], args.in[I_BGATES], EPS, C_Q, C_K, C_V, C_G, C_G / 256, 1.0f / WSCALE};
          pg8::gemm_phase<pg8::EpiProj, pg8::StaticOrder, true>(L + RING_OFF, g, S, E, wave); }
        { pg8::Gemm g{memn, Wmkv_t, D, D, D}; pg8::StaticOrder S; S.init(TM, D, G, bid); pg8::EpiBf16 E{kv, D};
          pg8::gemm_phase<pg8::EpiBf16, pg8::StaticOrder>(L + RING_OFF, g, S, E, wave); }
        if (G == 256 && bid >= 128) { const float* W = args.in[I_WD]; unsigned char* O = (unsigned char*)Wd_t; constexpr int nrb = D / 32, per = (D / 64) * nrb;
          tr_range8(WD_P1_ITEMS, [=](int it) { const int e = it / per, r0 = it % per, kb = r0 / nrb, rb2 = r0 % nrb;
              return TrItem{W + (size_t)e * D * D, D, 64 * kb, 32 * rb2, (bf16*)(O + (size_t)e * D * D), D, 32 * rb2, 0, nullptr}; }, (bid - 128) * NWAVES + wave, 128 * NWAVES, scr, lane, WSCALE); }
    }
    if (IN(1) && IN(3)) GRID_BAR();
    STAMP(1); STAMP(2);
    if (IN(3)) { PV
        STAMPX(4);
        att::swa_phase(L + RING_OFF, proj, args.in[I_SINKS], args.in[I_AQG], args.in[I_AKG], bid, G, wave, lane);
        __syncthreads();
        STAMPX(5);
        att::gmlp_phase(L + RING_OFF, proj, Wsb, args.in[I_LNG], args.in[I_LNB], args.in[I_BS], bid, G, wave, lane);
        __syncthreads();
        STAMPX(6);
        att::xattn_phase(L + RING_OFF, proj, kv, args.in[I_CQG], args.in[I_CKG], bid, G, wave, lane);
        __syncthreads();
    }
    SEAM(3);
    if (IN(4)) { PV
        pg8::StaticOrder S; S.init(T, D, G, bid);
        pg8::Gemm g{proj + C_Q, Wo_t, 2048, LDP, 2048}; pg8::EpiMergeK E{Hb, D, (const unsigned char*)(proj + C_G), LDP * 2};
        pg8::gemm_phase<pg8::EpiMergeK, pg8::StaticOrder>(L + RING_OFF, g, S, E, wave);
    }
    SEAM(4);
    if (IN(5)) { PV
        const float* x = args.in[I_X];
        pg8::Gemm g{Hb, Wout_t, D, D, D}; pg8::StaticOrder S; S.init(T, D, G, bid); pg8::EpiResF32 E{x1b, x, X8, D};
        pg8::gemm_phase<pg8::EpiResF32, pg8::StaticOrder>(L + RING_OFF, g, S, E, wave);
    }
    SEAM(5);
    if (IN(6)) { PV
        const float* rb = args.in[I_RB]; const float* fg = args.in[I_FFN_G];
        LAS unsigned* hist = (LAS unsigned*)(L + LDSCTL_OFF + 512);
        const int r32 = lane & 31, hh = lane >> 5;
        STAMPX(0);
        for (int i = tid; i < 8192; i += NTHR) *(LAS f32x4*)(L + RING_OFF + i * 16) = *(const GAS f32x4*)(Rwp + 4 * i);
        for (int vb = bid; vb < T / 256; vb += G) {
            __syncthreads();
            if (tid < 32) hist[tid] = 0u;
            __syncthreads();
            const int tok0 = vb * 256 + wave * 32;
            att::f32x16 acc;
#pragma unroll
            for (int r = 0; r < 16; ++r) acc[r] = 0.f;
            float ss = 0.f;
            const bf16* xp = x1b + (size_t)(tok0 + r32) * D + 16 * hh;
            const LAS unsigned char* wl = L + RING_OFF + (4 * hh) * 512 + r32 * 16;
#define RT_LOAD(xs, it) do { _Pragma("unroll") for (int q = 0; q < 4; ++q) xs[q] = *(const GAS v2u*)(xp + 32 * (it) + 4 * q); } while (0)
#define RT_COMP(xs, it) do { _Pragma("unroll") for (int q = 0; q < 4; ++q) { const f32x4 wa = *(const LAS f32x4*)(wl + (8 * (it) + q) * 512); \
                    const f32x4 xv = (f32x4){blo(xs[q].x), bhi(xs[q].x), blo(xs[q].y), bhi(xs[q].y)}; \
                    ss += (xv.x * xv.x + xv.y * xv.y) + (xv.z * xv.z + xv.w * xv.w); \
                    acc = __builtin_amdgcn_mfma_f32_32x32x2f32(wa.x, xv.x, acc, 0, 0, 0); acc = __builtin_amdgcn_mfma_f32_32x32x2f32(wa.y, xv.y, acc, 0, 0, 0); \
                    acc = __builtin_amdgcn_mfma_f32_32x32x2f32(wa.z, xv.z, acc, 0, 0, 0); acc = __builtin_amdgcn_mfma_f32_32x32x2f32(wa.w, xv.w, acc, 0, 0, 0); } } while (0)
            v2u x0[4], x1[4], x2[4];
            RT_LOAD(x0, 0); RT_LOAD(x1, 1);
#pragma unroll 1
            for (int it = 0; it < 30; it += 3) {
                RT_LOAD(x2, it + 2); RT_COMP(x0, it);
                RT_LOAD(x0, it + 3); RT_COMP(x1, it + 1);
                RT_LOAD(x1, it + 4); RT_COMP(x2, it + 2);
            }
            RT_COMP(x0, 30); RT_COMP(x1, 31);
#undef RT_LOAD
#undef RT_COMP
            ss = xor32_sum(ss);
            const float rstd = 1.0f / sqrtf(ss * (1.f / 1024.f) + EPS);
            float v[16];
#pragma unroll
            for (int r = 0; r < 16; ++r) v[r] = acc[r] * rstd + rb[att::crow(r, hh)];
            float cv[8]; int ci[8];
#pragma unroll
            for (int k = 0; k < 4; ++k) { float best = -INFINITY; int bi = 99;
#pragma unroll
                for (int r = 0; r < 16; ++r) if (v[r] > best) { best = v[r]; bi = att::crow(r, hh); }
                cv[k] = best; ci[k] = bi;
#pragma unroll
                for (int r = 0; r < 16; ++r) v[r] = (att::crow(r, hh) == bi) ? -INFINITY : v[r]; }
#pragma unroll
            for (int k = 0; k < 4; ++k) { cv[4 + k] = __builtin_bit_cast(float, xor32_get(__builtin_bit_cast(unsigned, cv[k]), hh != 0)); ci[4 + k] = (int)xor32_get((unsigned)ci[k], hh != 0); }
            float bv[4]; int be[4];
#pragma unroll
            for (int k = 0; k < 4; ++k) { float best = -INFINITY; int bi = 99;
#pragma unroll
                for (int c = 0; c < 8; ++c) if (cv[c] > best || (cv[c] == best && ci[c] < bi)) { best = cv[c]; bi = ci[c]; }
                bv[k] = best; be[k] = bi;
#pragma unroll
                for (int c = 0; c < 8; ++c) cv[c] = (ci[c] == bi) ? -INFINITY : cv[c]; }
            const float p1 = expf(bv[1] - bv[0]), p2 = expf(bv[2] - bv[0]), p3 = expf(bv[3] - bv[0]); const float inv = 1.0f / (1.0f + p1 + p2 + p3);
            if (hh == 0) {
                int4 iw; float4 gw4;
                iw.x = be[0] | (int)(__hip_atomic_fetch_add(hist + be[0], 1u, __ATOMIC_RELAXED, __HIP_MEMORY_SCOPE_WORKGROUP) << 8);
                iw.y = be[1] | (int)(__hip_atomic_fetch_add(hist + be[1], 1u, __ATOMIC_RELAXED, __HIP_MEMORY_SCOPE_WORKGROUP) << 8);
                iw.z = be[2] | (int)(__hip_atomic_fetch_add(hist + be[2], 1u, __ATOMIC_RELAXED, __HIP_MEMORY_SCOPE_WORKGROUP) << 8);
                iw.w = be[3] | (int)(__hip_atomic_fetch_add(hist + be[3], 1u, __ATOMIC_RELAXED, __HIP_MEMORY_SCOPE_WORKGROUP) << 8);
                gw4.x = inv; gw4.y = p1 * inv; gw4.z = p2 * inv; gw4.w = p3 * inv;
                *(int4*)(topk_idx + (size_t)(tok0 + r32) * 4) = iw; *(float4*)(topk_gate + (size_t)(tok0 + r32) * 4) = gw4; }
            if (hh == 0) rstd_tok[tok0 + r32] = rstd;
            if (vb == 0) STAMPX(3);
            __syncthreads();
            if (tid < 32) Cmat[vb * 32 + tid] = (int)hist[tid];
        }
        STAMPX(1);
        { const float* W = args.in[I_WGU]; unsigned char* O = (unsigned char*)Wgu_t; constexpr int nrb = 2048 / 32, per = (D / 64) * nrb;
          tr_range8(NEXP * per, [=](int it) { const int e = it / per, r0 = it % per, kb = r0 / nrb, rb2 = r0 % nrb; const int r = 32 * rb2, j = r >> 8, rr = r & 255;
              const int sc = rr < 128 ? 128 * j + rr : 1024 + 128 * j + (rr - 128);
              return TrItem{W + (size_t)e * D * 2048, 2048, 64 * kb, sc, (bf16*)(O + (size_t)e * 2048 * D), D, r, 0, fg}; }, gw, NGW, scr, lane, WSCALE); }
        STAMPX(2);
        { const float* W = args.in[I_WD]; unsigned char* O = (unsigned char*)Wd_t; constexpr int nrb = D / 32, per = (D / 64) * nrb; const int first = (G == 256) ? WD_P1_ITEMS : 0;
          tr_range8(NEXP * per - first, [=](int it0) { const int it = it0 + first; const int e = it / per, r0 = it % per, kb = r0 / nrb, rb2 = r0 % nrb;
              return TrItem{W + (size_t)e * D * D, D, 64 * kb, 32 * rb2, (bf16*)(O + (size_t)e * D * D), D, 32 * rb2, 0, nullptr}; }, gw, NGW, scr, lane, WSCALE); }
    }
    SEAM(6);
    if (IN(7)) { PV
        LAS int* psum = (LAS int*)(L + RING_OFF);
        LAS int* tot = psum + 512;
        LAS int* startv = tot + 32;
        LAS int* basev = startv + 32;
        LAS int* ntl = basev + 32;
        for (int vb = bid; vb < T / 256; vb += G) {
            __syncthreads();
            { const int e = tid & 31, part = tid >> 5; int ps = 0;
#pragma unroll 4
              for (int i = 0; i < 16; ++i) ps += Cmat[(part * 16 + i) * 32 + e];
              psum[part * 32 + e] = ps; }
            __syncthreads();
            if (tid < 32) { int tt = 0;
#pragma unroll
                for (int p = 0; p < 16; ++p) tt += psum[p * 32 + tid];
                tot[tid] = tt; }
            __syncthreads();
            if (tid == 0) { int row = 0; for (int e = 0; e < 32; ++e) { startv[e] = row; row += (tot[e] + 255) & ~255; } ntl[0] = row >> 8; }
            __syncthreads();
            const int part = vb >> 4;
            if (tid < 32) { int bs = startv[tid];
                for (int p = 0; p < part; ++p) bs += psum[p * 32 + tid];
                for (int v2 = part * 16; v2 < vb; ++v2) bs += Cmat[v2 * 32 + tid];
                basev[tid] = bs; }
            __syncthreads();
            for (int i = tid; i < 1024; i += NTHR) { const int a = vb * 1024 + i; const int v = topk_idx[a]; const int e = v & 255, rank = v >> 8;
                const int slot = basev[e] + rank;
                slot_tok[slot] = a >> 2; slot_of[a] = slot; slot_rstd[slot] = rstd_tok[a >> 2]; }
            if (vb < 32) { const int e = vb; const int t0 = tot[e], st = startv[e], pd = ((t0 + 255) & ~255) - t0;
                if (tid < pd) { slot_tok[st + t0 + tid] = -1; slot_rstd[st + t0 + tid] = 0.f; } }
            if (vb == 32) {
                if (tid < 32) { const int nt = (tot[tid] + 255) >> 8, first = startv[tid] >> 8; for (int i = 0; i < nt; ++i) tile_e[first + i] = tid; }
                if (tid == 0) ((unsigned*)(ctl + CW_NTILE))[0] = (unsigned)ntl[0]; }
        }
    }
    SEAM(7);
#define NTILE_ALL ((int)__hip_atomic_load((unsigned*)(ctl + CW_NTILE), RLX_AGENT))
    if (IN(8)) { PV const int ntile = NTILE_ALL;
        pg8::Gemm g{(const bf16*)X8, Wgu_t, D / 2, D / 2, D / 2};
        pg8::GroupedOrder S{tile_e, ntile, 8, G, bid}; pg8::EpiSwiglu8 E{(unsigned char*)act, args.in[I_BGU], slot_rstd, 1.0f / WSCALE};
        pg8::gemm_phase_gather<pg8::EpiSwiglu8, pg8::GroupedOrder, true>(L + RING_OFF, g, S, E, wave, slot_tok);
    }
    SEAM(8);
    if (IN(9)) { PV const int ntile = NTILE_ALL;
        pg8::Gemm g{act, Wd_t, D / 2, D / 2, D / 2}; pg8::GroupedOrder S{tile_e, ntile, 4, G, bid}; static_assert(YSCALE == 16.0f, "EpiDown scales the bias by 16"); pg8::EpiDown E{(unsigned char*)ybuf, args.in[I_BD], YSCALE / WSCALE};
        pg8::gemm_phase<pg8::EpiDown, pg8::GroupedOrder, true>(L + RING_OFF, g, S, E, wave);
    }
    SEAM(9);
    if (IN(10)) { PV
        typedef float f2t __attribute__((ext_vector_type(2)));
        int4 sl = *(const int4*)(slot_of + (size_t)gw * 4); float4 gt = *(const float4*)(topk_gate + (size_t)gw * 4);
        for (int t = gw; t < T; t += NGW) {
            GAS f32x4* op = (GAS f32x4*)(args.out + (size_t)t * D) + lane;
            const GAS v2u* xq = (const GAS v2u*)(x1b + (size_t)t * D) + lane;
            const unsigned char* yb = (const unsigned char*)ybuf + 4 * lane;
            f32x4 o[4]; unsigned ya[4][4];
#pragma unroll
            for (int j = 0; j < 4; ++j) { const v2u xw = xq[64 * j]; o[j] = (f32x4){blo(xw.x), bhi(xw.x), blo(xw.y), bhi(xw.y)};
                ya[0][j] = *(const GAS unsigned*)(yb + (size_t)sl.x * D + 256 * j); ya[1][j] = *(const GAS unsigned*)(yb + (size_t)sl.y * D + 256 * j);
                ya[2][j] = *(const GAS unsigned*)(yb + (size_t)sl.z * D + 256 * j); ya[3][j] = *(const GAS unsigned*)(yb + (size_t)sl.w * D + 256 * j); }
            const float g0 = gt.x * (1.0f / YSCALE), g1 = gt.y * (1.0f / YSCALE), g2 = gt.z * (1.0f / YSCALE), g3 = gt.w * (1.0f / YSCALE);
            if (t + NGW < T) { sl = *(const int4*)(slot_of + (size_t)(t + NGW) * 4); gt = *(const float4*)(topk_gate + (size_t)(t + NGW) * 4); }
#pragma unroll
            for (int j = 0; j < 4; ++j) {
                const f2t l0 = __builtin_amdgcn_cvt_pk_f32_fp8((int)ya[0][j], false), h0 = __builtin_amdgcn_cvt_pk_f32_fp8((int)ya[0][j], true);
                const f2t l1 = __builtin_amdgcn_cvt_pk_f32_fp8((int)ya[1][j], false), h1 = __builtin_amdgcn_cvt_pk_f32_fp8((int)ya[1][j], true);
                const f2t l2 = __builtin_amdgcn_cvt_pk_f32_fp8((int)ya[2][j], false), h2 = __builtin_amdgcn_cvt_pk_f32_fp8((int)ya[2][j], true);
                const f2t l3 = __builtin_amdgcn_cvt_pk_f32_fp8((int)ya[3][j], false), h3 = __builtin_amdgcn_cvt_pk_f32_fp8((int)ya[3][j], true);
                const f2t lo = ((l0 * g0 + l1 * g1) + l2 * g2) + l3 * g3, hi = ((h0 * g0 + h1 * g1) + h2 * g2) + h3 * g3;
                o[j].x += lo.x; o[j].y += lo.y; o[j].z += hi.x; o[j].w += hi.y;
                op[64 * j] = o[j]; }
        }
    }
#if PROBE_MASK
    __syncthreads(); STAMP(10);
    if (blockIdx.x == 0 && wave_s == 0 && LANE_ID == 0) { const LAS unsigned* st = (const LAS unsigned*)(L + LDSCTL_OFF + 640); unsigned d = 0;
        for (int k = 0; k < NPHASE; ++k) if ((PROBE_MASK >> k) & 1) d += st[k + 1] - st[k];
        if (PROBE_SUBA >= 0) d = st[16 + PROBE_SUBB] - st[16 + PROBE_SUBA];
        const unsigned long long t0 = __builtin_amdgcn_s_memrealtime(); while (__builtin_amdgcn_s_memrealtime() - t0 < (unsigned long long)d * PROBE_AMP) __builtin_amdgcn_s_sleep(16); }
#endif
#undef IN
#undef SEAM
}

extern "C" void kernel_launch(void* const* d_in, const int* in_sizes, int n_in, void* d_out, int out_size, void* d_ws, size_t ws_size, hipStream_t stream) {
    static int grid = 0;
    if (grid == 0) {
        if (n_in != 28 || out_size != T * D || ws_size < WS_END) { fprintf(stderr, "kernel_launch: unexpected shapes: n_in %d out %d ws %zu (need %zu)\n", n_in, out_size, ws_size, (size_t)WS_END); grid = -1; return; }
        int dev = 0, cus = 0, per_cu = 0;
        if (hipGetDevice(&dev) != hipSuccess || hipDeviceGetAttribute(&cus, hipDeviceAttributeMultiprocessorCount, dev) != hipSuccess) { grid = -1; return; }
        if (hipFuncSetAttribute((const void*)fwd, hipFuncAttributeMaxDynamicSharedMemorySize, LDS_BYTES) != hipSuccess) { fprintf(stderr, "kernel_launch: hipFuncSetAttribute failed\n"); grid = -1; return; }
        if (hipOccupancyMaxActiveBlocksPerMultiprocessor(&per_cu, (const void*)fwd, NTHR, LDS_BYTES) != hipSuccess || per_cu < 1) { fprintf(stderr, "kernel_launch: occupancy query says %d\n", per_cu); }
        (void)hipGetLastError();
        grid = cus;
    }
    if (grid < 0) return;
    if (hipMemsetAsync((char*)d_ws + WS_CTL, 0, CTL_ZERO_BYTES, stream) != hipSuccess) { fprintf(stderr, "kernel_launch: memset failed\n"); return; }
    Args a{};
    for (int i = 0; i < 28; ++i) a.in[i] = (const float*)d_in[i];
    a.out = (float*)d_out; a.ws = (unsigned char*)d_ws;
#if MK_FUSED
    a.ph_lo = 0; a.ph_hi = NPHASE;
    hipLaunchKernelGGL(fwd, dim3(grid), dim3(NTHR), LDS_BYTES, stream, a);
#else
    for (int p = 0; p < NPHASE; ++p) { a.ph_lo = p; a.ph_hi = p + 1; hipLaunchKernelGGL(fwd, dim3(grid), dim3(NTHR), LDS_BYTES, stream, a); }
#endif
    const hipError_t le = hipPeekAtLastError();
    if (le != hipSuccess) fprintf(stderr, "kernel_launch: launch failed: %s\n", hipGetErrorName(le));
}
```

```cpp
#include <hip/hip_runtime.h>
#include <cstdio>
#include <cstdint>

#ifndef MK_FUSED
#define MK_FUSED 1
#endif
#ifndef PROBE_MASK
#define PROBE_MASK 0
#endif
#ifndef PROBE_AMP
#define PROBE_AMP 4
#endif
#ifndef PROBE_SUBA
#define PROBE_SUBA -1
#endif
#ifndef PROBE_SUBB
#define PROBE_SUBB -1
#endif

__device__ __forceinline__ float xor16_sum(float v) { float a = v, b = v; asm("s_nop 1\n\tv_permlane16_swap_b32 %0, %1" : "+v"(a), "+v"(b)); return a + b; }
__device__ __forceinline__ void pair16(unsigned& a, unsigned& b) { asm("s_nop 1\n\tv_permlane16_swap_b32 %0, %1" : "+v"(a), "+v"(b)); }
__device__ __forceinline__ float xor32_sum(float v) { float a = v, b = v; asm("s_nop 1\n\tv_permlane32_swap_b32 %0, %1" : "+v"(a), "+v"(b)); return a + b; }
__device__ __forceinline__ unsigned xor32_get(unsigned v, bool upper) { unsigned a = v, b = v; asm("s_nop 1\n\tv_permlane32_swap_b32 %0, %1" : "+v"(a), "+v"(b)); return upper ? a : b; }
namespace pg8 {
#define PG8_LAS __attribute__((address_space(3)))
typedef unsigned short bf16_t;
typedef short bf16x8 __attribute__((ext_vector_type(8)));
typedef float f32x4 __attribute__((ext_vector_type(4)));
typedef unsigned u32x4 __attribute__((ext_vector_type(4)));
typedef float f32x2 __attribute__((ext_vector_type(2)));
constexpr int BM = 256, BK = 64, HALF = 128, HTB = HALF * BK * 2, STAGE_BYTES = 8 * HTB, NXCD = 8, WGM = 8;

__host__ __device__ __forceinline__ int lds_byte(int r, int c) { const int st = (r >> 4) * 2 + (c >> 5), rr = r & 15, cc = c & 31, ob = rr * 64 + cc * 2; return st * 1024 + (ob ^ (((ob >> 9) & 1) << 5)); }
__host__ __device__ __forceinline__ void stage_rc(int b, int& R, int& C) { const int st = b / 1024, sb = b % 1024, swz = sb ^ (((sb >> 9) & 1) << 5); R = (st >> 1) * 16 + swz / 64; C = (st & 1) * 32 + (swz % 64) / 2; }
__host__ __device__ __forceinline__ int perm32(int rho) { const int n = rho >> 4, i = rho & 15; return 8 * (i >> 2) + 4 * n + (i & 3); }

struct Unit { int pm, pn; };
struct Gemm { const bf16_t* A; const bf16_t* Bt; int K, lda, ldb; };

struct StaticOrder {
    int nM, nN, nwg, G, c;
    __host__ __device__ void init(int M, int N, int G_, int c_) { nM = M / BM; nN = N / BM; nwg = nM * nN; G = G_; c = c_; }
    __host__ __device__ bool next(int i, Unit& u) const {
        const long L = (long)i * G + c; if (L >= nwg) return false;
        int wgid = (int)L; { const int q = nwg / NXCD, r = nwg % NXCD, xcd = wgid % NXCD, off = wgid / NXCD; wgid = (xcd < r ? xcd * (q + 1) : r * (q + 1) + (xcd - r) * q) + off; }
        const int nig = WGM * nN, gid = wgid / nig, fm = gid * WGM, gsz = (nM - fm) < WGM ? (nM - fm) : WGM;
        u.pm = fm + ((wgid % nig) % gsz); u.pn = (wgid % nig) / gsz; return true;
    }
};
struct GroupedOrder {
    const int* tile_e; int ntile, nN, G, c;
    __device__ bool next(int i, Unit& u) const {
        if ((G & 7) == 0) {
            const int x = c & 7, k = c >> 3, per = G >> 3;
            const unsigned q = (unsigned)i * (unsigned)per + (unsigned)k;
            const int pt = (ntile + 7) >> 3;
            const int tl = (int)(q / (unsigned)nN), j = (int)(q % (unsigned)nN), tile = x * pt + tl;
            if (tl >= pt || tile >= ntile) return false;
            u.pm = tile; u.pn = tile_e[tile] * nN + j; return true;
        }
        const unsigned L = (unsigned)i * (unsigned)G + (unsigned)c; if (L >= (unsigned)(ntile * nN)) return false;
        const int tile = (int)(L / (unsigned)nN), j = (int)(L % (unsigned)nN);
        u.pm = tile; u.pn = tile_e[tile] * nN + j; return true;
    }
};
typedef int v8i __attribute__((ext_vector_type(8)));
typedef int v4i __attribute__((ext_vector_type(4)));
__device__ __forceinline__ v8i cat8(bf16x8 lo, bf16x8 hi) { return __builtin_shufflevector(__builtin_bit_cast(v4i, lo), __builtin_bit_cast(v4i, hi), 0, 1, 2, 3, 4, 5, 6, 7); }
__device__ __forceinline__ bf16x8 lo8(v8i v) { return __builtin_bit_cast(bf16x8, (v4i)__builtin_shufflevector(v, v, 0, 1, 2, 3)); }
__device__ __forceinline__ bf16x8 hi8(v8i v) { return __builtin_bit_cast(bf16x8, (v4i)__builtin_shufflevector(v, v, 4, 5, 6, 7)); }
__device__ __forceinline__ unsigned cvt_pk_bf16(float lo, float hi) { unsigned r; asm volatile("v_cvt_pk_bf16_f32 %0, %1, %2" : "=v"(r) : "v"(lo), "v"(hi)); return r; }
__device__ __forceinline__ float bflo(unsigned w) { return __uint_as_float(w << 16); }
__device__ __forceinline__ float bfhi(unsigned w) { return __uint_as_float(w & 0xffff0000u); }


struct EpiBf16 {
    static constexpr bool PERM = true, HAS_MID = false;
    bf16_t* O; int ldc;
    __device__ __forceinline__ void operator()(const f32x4 (&acc)[2][2][4][2], const Unit& u, int wr, int wc, int fr, int fq) const {
        const int row0 = u.pm * BM + wr * 64 + fr, col0 = u.pn * BM + wc * 32 + 8 * fq;
#pragma unroll
        for (int ai = 0; ai < 2; ++ai)
#pragma unroll
            for (int m = 0; m < 4; ++m) { bf16_t* rowp = O + (size_t)(row0 + ai * HALF + m * 16) * ldc + col0;
#pragma unroll
                for (int bj = 0; bj < 2; ++bj) { const f32x4 v0 = acc[ai][bj][m][0], v1 = acc[ai][bj][m][1];
                    u32x4 w; w.x = cvt_pk_bf16(v0[0], v0[1]); w.y = cvt_pk_bf16(v0[2], v0[3]); w.z = cvt_pk_bf16(v1[0], v1[1]); w.w = cvt_pk_bf16(v1[2], v1[3]);
                    *(u32x4*)(rowp + bj * HALF) = w; } }
    }
};
__device__ __forceinline__ f32x2 gelu_pk(f32x2 v) {
    const f32x2 y = __builtin_elementwise_abs(v) * 0.70710678118654752f;
    f32x2 p = y * 0.0000430638f + 0.0002765672f; p = p * y + 0.0001520143f; p = p * y + 0.0092705272f; p = p * y + 0.0422820123f; p = p * y + 0.0705230784f; p = p * y + 1.0f;
    p = p * p; p = p * p; p = p * p; p = p * p;
    f32x2 h; h.x = __builtin_amdgcn_rcpf(p.x); h.y = __builtin_amdgcn_rcpf(p.y);
    h = h * 0.5f;
    const f32x2 g = 1.0f - h;
    f32x2 w; w.x = v.x < 0.f ? h.x : g.x; w.y = v.y < 0.f ? h.y : g.y;
    return v * w;
}
struct EpiProj {
    static constexpr bool PERM = true, HAS_MID = false;
    bf16_t* __restrict__ P; int ldp; const float* __restrict__ rope; const float* __restrict__ gq; const float* __restrict__ gk; const float* __restrict__ bgates; float eps;
    int c_q, c_k, c_v, c_g;
    int pn_off; float gsc;
    __device__ __forceinline__ void operator()(const f32x4 (&acc)[2][2][4][2], const Unit& u, int wr, int wc, int fr, int fq) const {
        const int pn = u.pn + pn_off, row0 = u.pm * BM + wr * 64 + fr;
        if (pn < 4 || pn == 8) {
            const bool isq = pn < 4, isv = (!isq) && (wc & 1);
            const int colbase = (isq ? c_q + 64 * (4 * pn + wc) : (isv ? c_v : c_k) + 64 * (wc >> 1)) + 8 * fq;
            if (isv) {
#pragma unroll
                for (int ai = 0; ai < 2; ++ai)
#pragma unroll
                    for (int m = 0; m < 4; ++m) { bf16_t* rowp = P + (size_t)(row0 + ai * HALF + m * 16) * ldp + colbase;
#pragma unroll
                        for (int bj = 0; bj < 2; ++bj) { const f32x4 v0 = acc[ai][bj][m][0], v1 = acc[ai][bj][m][1];
                            u32x4 w; w.x = cvt_pk_bf16(v0[0], v0[1]); w.y = cvt_pk_bf16(v0[2], v0[3]); w.z = cvt_pk_bf16(v1[0], v1[1]); w.w = cvt_pk_bf16(v1[2], v1[3]);
                            *(u32x4*)(rowp + 32 * bj) = w; } }
            } else {
                const float* gn = (isq ? gq : gk) + 8 * fq;
                const f32x4 ga0 = *(const f32x4*)gn, ga1 = *(const f32x4*)(gn + 4), gb0 = *(const f32x4*)(gn + 32), gb1 = *(const f32x4*)(gn + 36);
#pragma unroll
                for (int am = 0; am < 4; ++am) { const int ai = am >> 1;
                    f32x4 cs[4][4];
#pragma unroll
                    for (int m2 = 0; m2 < 2; ++m2) { const int m = (am & 1) * 2 + m2; const float* rp = rope + ((size_t)(row0 + ai * HALF + m * 16) * 32 + 8 * fq) * 2;
                        cs[m][0] = *(const f32x4*)rp; cs[m][1] = *(const f32x4*)(rp + 4); cs[m][2] = *(const f32x4*)(rp + 8); cs[m][3] = *(const f32x4*)(rp + 12); }
#pragma unroll
                    for (int m2 = 0; m2 < 2; ++m2) { const int m = (am & 1) * 2 + m2;
                        const int r = row0 + ai * HALF + m * 16;
                        const f32x4 x10 = acc[ai][0][m][0], x11 = acc[ai][0][m][1], x20 = acc[ai][1][m][0], x21 = acc[ai][1][m][1];
                        float ss = ((x10[0] * x10[0] + x10[1] * x10[1]) + (x10[2] * x10[2] + x10[3] * x10[3])) + ((x11[0] * x11[0] + x11[1] * x11[1]) + (x11[2] * x11[2] + x11[3] * x11[3]))
                                 + ((x20[0] * x20[0] + x20[1] * x20[1]) + (x20[2] * x20[2] + x20[3] * x20[3])) + ((x21[0] * x21[0] + x21[1] * x21[1]) + (x21[2] * x21[2] + x21[3] * x21[3]));
                        ss = xor32_sum(xor16_sum(ss));
                        const float rstd = __builtin_amdgcn_rsqf(ss * (1.f / 64.f) + eps);
                        const f32x4 cs0 = cs[m][0], cs1 = cs[m][1], cs2 = cs[m][2], cs3 = cs[m][3];
                        const f32x4 y10 = x10 * ga0 * rstd, y11 = x11 * ga1 * rstd, y20 = x20 * gb0 * rstd, y21 = x21 * gb1 * rstd;
                        float o1[8], o2[8];
                        o1[0] = y10[0] * cs0[0] - y20[0] * cs0[1]; o2[0] = y20[0] * cs0[0] + y10[0] * cs0[1];
                        o1[1] = y10[1] * cs0[2] - y20[1] * cs0[3]; o2[1] = y20[1] * cs0[2] + y10[1] * cs0[3];
                        o1[2] = y10[2] * cs1[0] - y20[2] * cs1[1]; o2[2] = y20[2] * cs1[0] + y10[2] * cs1[1];
                        o1[3] = y10[3] * cs1[2] - y20[3] * cs1[3]; o2[3] = y20[3] * cs1[2] + y10[3] * cs1[3];
                        o1[4] = y11[0] * cs2[0] - y21[0] * cs2[1]; o2[4] = y21[0] * cs2[0] + y11[0] * cs2[1];
                        o1[5] = y11[1] * cs2[2] - y21[1] * cs2[3]; o2[5] = y21[1] * cs2[2] + y11[1] * cs2[3];
                        o1[6] = y11[2] * cs3[0] - y21[2] * cs3[1]; o2[6] = y21[2] * cs3[0] + y11[2] * cs3[1];
                        o1[7] = y11[3] * cs3[2] - y21[3] * cs3[3]; o2[7] = y21[3] * cs3[2] + y11[3] * cs3[3];
                        bf16_t* rowp = P + (size_t)r * ldp + colbase;
                        u32x4 w; w.x = cvt_pk_bf16(o1[0], o1[1]); w.y = cvt_pk_bf16(o1[2], o1[3]); w.z = cvt_pk_bf16(o1[4], o1[5]); w.w = cvt_pk_bf16(o1[6], o1[7]);
                        *(u32x4*)rowp = w;
                        w.x = cvt_pk_bf16(o2[0], o2[1]); w.y = cvt_pk_bf16(o2[2], o2[3]); w.z = cvt_pk_bf16(o2[4], o2[5]); w.w = cvt_pk_bf16(o2[6], o2[7]);
                        *(u32x4*)(rowp + 32) = w;
                    }
                }
            }
        } else {
            const int col0 = pn * BM + wc * 32 + 8 * fq;
            const int mode = (pn == 4 || pn == 5 || pn == 9 || pn == 10) ? 1 : (pn >= 11 ? 2 : 0);
            f32x4 bb[2][2] = {{(f32x4){0.f, 0.f, 0.f, 0.f}, (f32x4){0.f, 0.f, 0.f, 0.f}}, {(f32x4){0.f, 0.f, 0.f, 0.f}, (f32x4){0.f, 0.f, 0.f, 0.f}}};
            if (mode == 2) { const float* bp = bgates + (col0 - c_g);
                bb[0][0] = *(const f32x4*)bp; bb[0][1] = *(const f32x4*)(bp + 4); bb[1][0] = *(const f32x4*)(bp + HALF); bb[1][1] = *(const f32x4*)(bp + HALF + 4); }
#pragma unroll
            for (int bj = 0; bj < 2; ++bj) {
                const f32x4 nb0 = bb[bj][0] * (-1.4426950408889634f), nb1 = bb[bj][1] * (-1.4426950408889634f);
#pragma unroll
                for (int ai = 0; ai < 2; ++ai) {
                    unsigned kx = 0u, ky = 0u;
#pragma unroll
                    for (int m = 0; m < 4; ++m) {
                        f32x4 v0 = acc[ai][bj][m][0], v1 = acc[ai][bj][m][1];
                        if (mode == 1) { const f32x2 a = gelu_pk((f32x2){v0[0], v0[1]}), b = gelu_pk((f32x2){v0[2], v0[3]}), c = gelu_pk((f32x2){v1[0], v1[1]}), d = gelu_pk((f32x2){v1[2], v1[3]});
                            v0 = (f32x4){a.x, a.y, b.x, b.y}; v1 = (f32x4){c.x, c.y, d.x, d.y}; }
                        if (mode == 2) {
                            typedef unsigned u32x2 __attribute__((ext_vector_type(2)));
                            u32x2 w8; unsigned wq[2] = {0u, 0u};
#pragma unroll
                            for (int p = 0; p < 4; ++p) {
                                const int n = p >> 1, i0 = (p & 1) * 2;
                                const f32x2 zv = n ? (f32x2){v1[i0], v1[i0 + 1]} : (f32x2){v0[i0], v0[i0 + 1]}, bv2 = n ? (f32x2){nb1[i0], nb1[i0 + 1]} : (f32x2){nb0[i0], nb0[i0 + 1]};
                                const f32x2 tv = zv * (-1.4426950408889634f * gsc) + bv2;
                                f32x2 ev; ev.x = __builtin_amdgcn_exp2f(tv.x); ev.y = __builtin_amdgcn_exp2f(tv.y);
                                const f32x2 dv = ev + 1.0f;
                                f32x2 gv; gv.x = __builtin_amdgcn_rcpf(dv.x); gv.y = __builtin_amdgcn_rcpf(dv.y);
                                const f32x2 cv = gv * 256.0f + (-0.5f);
                                wq[n] = __builtin_amdgcn_cvt_pk_u8_f32(cv.x, i0, wq[n]); wq[n] = __builtin_amdgcn_cvt_pk_u8_f32(cv.y, i0 + 1, wq[n]);
                            }
                            w8.x = wq[0]; w8.y = wq[1]; (void)w8;
                            if (m & 1) { unsigned w0 = wq[0], w1 = wq[1]; pair16(kx, w0); pair16(ky, w1);
                                *(u32x4*)((unsigned char*)(P + (size_t)(row0 + ai * HALF + (m - 1) * 16 + (fq & 1) * 16) * ldp + c_g) + (pn * BM + wc * 32 + 16 * (fq >> 1) - c_g) + bj * HALF) = (u32x4){kx, ky, w0, w1}; }
                            else { kx = wq[0]; ky = wq[1]; }
                        } else {
                        u32x4 w; w.x = cvt_pk_bf16(v0[0], v0[1]); w.y = cvt_pk_bf16(v0[2], v0[3]); w.z = cvt_pk_bf16(v1[0], v1[1]); w.w = cvt_pk_bf16(v1[2], v1[3]);
                        *(u32x4*)(P + (size_t)(row0 + ai * HALF + m * 16) * ldp + col0 + bj * HALF) = w;
                        }
                    }
                }
            }
        }
    }
};
template <int ACCUM> struct EpiMerge {
    static constexpr bool PERM = true, HAS_MID = false;
    bf16_t* Mg; int ldm; const bf16_t* gate; int ldg;
    __device__ __forceinline__ void operator()(const f32x4 (&acc)[2][2][4][2], const Unit& u, int wr, int wc, int fr, int fq) const {
        const int row0 = u.pm * BM + wr * 64 + fr, col0 = u.pn * BM + wc * 32 + 8 * fq;
#pragma unroll
        for (int bj = 0; bj < 2; ++bj) {
#pragma unroll
            for (int ai = 0; ai < 2; ++ai)
#pragma unroll
                for (int m = 0; m < 4; ++m) {
                    const size_t r = (size_t)(row0 + ai * HALF + m * 16);
                    const u32x4 gw = *(const u32x4*)(gate + r * ldg + col0 + bj * HALF);
                    const f32x4 a0 = acc[ai][bj][m][0], a1 = acc[ai][bj][m][1];
                    float o[8] = {bflo(gw.x) * a0[0], bfhi(gw.x) * a0[1], bflo(gw.y) * a0[2], bfhi(gw.y) * a0[3], bflo(gw.z) * a1[0], bfhi(gw.z) * a1[1], bflo(gw.w) * a1[2], bfhi(gw.w) * a1[3]};
                    bf16_t* mp = Mg + r * ldm + col0 + bj * HALF;
                    if (ACCUM) { const u32x4 pw = *(const u32x4*)mp;
                        o[0] += bflo(pw.x); o[1] += bfhi(pw.x); o[2] += bflo(pw.y); o[3] += bfhi(pw.y); o[4] += bflo(pw.z); o[5] += bfhi(pw.z); o[6] += bflo(pw.w); o[7] += bfhi(pw.w); }
                    u32x4 w; w.x = cvt_pk_bf16(o[0], o[1]); w.y = cvt_pk_bf16(o[2], o[3]); w.z = cvt_pk_bf16(o[4], o[5]); w.w = cvt_pk_bf16(o[6], o[7]);
                    *(u32x4*)mp = w;
                }
        }
    }
};
struct EpiMergeK {
    static constexpr bool PERM = true, HAS_MID = true; static constexpr int MID0 = 16, MID1 = 24;
    bf16_t* __restrict__ Mg; int ldm; const unsigned char* __restrict__ gates; int ldgb;
    typedef unsigned u32x2 __attribute__((ext_vector_type(2)));
    static __device__ __forceinline__ float gq(unsigned w, int i) { return ((float)((w >> (8 * i)) & 255u) + 0.5f) * (1.0f / 256.0f); }
    static __device__ __forceinline__ f32x4 rescale(f32x4 a, unsigned nw, unsigned dw) {
        f32x2 n0 = {(float)(nw & 255u), (float)((nw >> 8) & 255u)}, n1 = {(float)((nw >> 16) & 255u), (float)(nw >> 24)};
        f32x2 d0 = {(float)(dw & 255u), (float)((dw >> 8) & 255u)}, d1 = {(float)((dw >> 16) & 255u), (float)(dw >> 24)};
        n0 = n0 + 0.5f; n1 = n1 + 0.5f; d0 = d0 + 0.5f; d1 = d1 + 0.5f;
        f32x2 r0, r1; r0.x = __builtin_amdgcn_rcpf(d0.x); r0.y = __builtin_amdgcn_rcpf(d0.y); r1.x = __builtin_amdgcn_rcpf(d1.x); r1.y = __builtin_amdgcn_rcpf(d1.y);
        const f32x2 q0 = n0 * r0, q1 = n1 * r1;
        const f32x2 o0 = (f32x2){a[0], a[1]} * q0, o1 = (f32x2){a[2], a[3]} * q1;
        return (f32x4){o0.x, o0.y, o1.x, o1.y};
    }
    static __device__ __forceinline__ u32x4 unpair(u32x4 g) { unsigned x = g.x, y = g.y, z = g.z, w = g.w; pair16(x, z); pair16(y, w); return (u32x4){x, y, z, w}; }
    __device__ __forceinline__ void mid(f32x4 (&acc)[2][2][4][2], const Unit& u, int t, int wr, int wc, int fr, int fq) const {
        int row0 = u.pm * BM + wr * 64 + fr + 16 * (fq & 1), col0 = u.pn * BM + wc * 32 + 16 * (fq >> 1) + (t == MID0 ? 0 : 1024);
        asm volatile("" : "+v"(row0), "+v"(col0));
#pragma unroll
        for (int bj = 0; bj < 2; ++bj)
#pragma unroll
            for (int ai = 0; ai < 2; ++ai)
#pragma unroll
                for (int mp = 0; mp < 2; ++mp) {
                    const unsigned char* gp = gates + (size_t)(row0 + ai * HALF + mp * 32) * ldgb + col0 + bj * HALF;
                    const u32x4 nw = unpair(*(const u32x4*)gp), dw = unpair(*(const u32x4*)(gp + 1024));
                    acc[ai][bj][2 * mp][0] = rescale(acc[ai][bj][2 * mp][0], nw.x, dw.x); acc[ai][bj][2 * mp][1] = rescale(acc[ai][bj][2 * mp][1], nw.y, dw.y);
                    acc[ai][bj][2 * mp + 1][0] = rescale(acc[ai][bj][2 * mp + 1][0], nw.z, dw.z); acc[ai][bj][2 * mp + 1][1] = rescale(acc[ai][bj][2 * mp + 1][1], nw.w, dw.w);
                }
    }
    __device__ __forceinline__ void operator()(const f32x4 (&acc)[2][2][4][2], const Unit& u, int wr, int wc, int fr, int fq) const {
        const int row0 = u.pm * BM + wr * 64 + fr, col0 = u.pn * BM + wc * 32 + 8 * fq;
        const unsigned char* gp0 = gates + (size_t)(row0 + 16 * (fq & 1)) * ldgb + 2048 + u.pn * BM + wc * 32 + 16 * (fq >> 1);
        u32x4 gw[2][2][2];
#pragma unroll
        for (int bj = 0; bj < 2; ++bj)
#pragma unroll
            for (int ai = 0; ai < 2; ++ai)
#pragma unroll
                for (int mp = 0; mp < 2; ++mp) gw[bj][ai][mp] = *(const u32x4*)(gp0 + (size_t)(ai * HALF + mp * 32) * ldgb + bj * HALF);
#pragma unroll
        for (int bj = 0; bj < 2; ++bj)
#pragma unroll
            for (int ai = 0; ai < 2; ++ai)
#pragma unroll
                for (int mp = 0; mp < 2; ++mp) {
                    const u32x4 g4 = unpair(gw[bj][ai][mp]);
#pragma unroll
                    for (int m2 = 0; m2 < 2; ++m2) { const int m = 2 * mp + m2;
                        const size_t r = (size_t)(row0 + ai * HALF + m * 16);
                        const unsigned gx = m2 ? g4.z : g4.x, gy = m2 ? g4.w : g4.y;
                        const f32x4 a0 = acc[ai][bj][m][0], a1 = acc[ai][bj][m][1];
                        u32x4 w; w.x = cvt_pk_bf16(gq(gx, 0) * a0[0], gq(gx, 1) * a0[1]); w.y = cvt_pk_bf16(gq(gx, 2) * a0[2], gq(gx, 3) * a0[3]);
                        w.z = cvt_pk_bf16(gq(gy, 0) * a1[0], gq(gy, 1) * a1[1]); w.w = cvt_pk_bf16(gq(gy, 2) * a1[2], gq(gy, 3) * a1[3]);
                        *(u32x4*)(Mg + r * ldm + col0 + bj * HALF) = w; }
                }
    }
};
__device__ __forceinline__ unsigned pk4_e4m3(float a, float b, float c, float d) { int w = 0; w = __builtin_amdgcn_cvt_pk_fp8_f32(a, b, w, false); w = __builtin_amdgcn_cvt_pk_fp8_f32(c, d, w, true); return (unsigned)w; }
struct EpiResF32 {
    static constexpr bool PERM = true, HAS_MID = false;
    bf16_t* __restrict__ X1; const float* __restrict__ R; unsigned char* __restrict__ X8p; int ldc;
    __device__ __forceinline__ void operator()(const f32x4 (&acc)[2][2][4][2], const Unit& u, int wr, int wc, int fr, int fq) const {
        const int row0 = u.pm * BM + wr * 64 + fr, col0 = u.pn * BM + wc * 32 + 8 * fq;
        typedef unsigned u32x2 __attribute__((ext_vector_type(2)));
#pragma unroll
        for (int ai = 0; ai < 2; ++ai) {
            f32x4 rv[4][2][2];
#pragma unroll
            for (int m = 0; m < 4; ++m) { const size_t ro = (size_t)(row0 + ai * HALF + m * 16) * ldc + col0;
#pragma unroll
                for (int bj = 0; bj < 2; ++bj) { rv[m][bj][0] = *(const f32x4*)(R + ro + bj * HALF); rv[m][bj][1] = *(const f32x4*)(R + ro + bj * HALF + 4); } }
            unsigned kx[2] = {0u, 0u}, ky[2] = {0u, 0u};
#pragma unroll
            for (int m = 0; m < 4; ++m) { const size_t ro = (size_t)(row0 + ai * HALF + m * 16) * ldc + col0;
#pragma unroll
                for (int bj = 0; bj < 2; ++bj) { const f32x4 v0 = acc[ai][bj][m][0] + rv[m][bj][0], v1 = acc[ai][bj][m][1] + rv[m][bj][1];
                    u32x4 w; w.x = cvt_pk_bf16(v0[0], v0[1]); w.y = cvt_pk_bf16(v0[2], v0[3]); w.z = cvt_pk_bf16(v1[0], v1[1]); w.w = cvt_pk_bf16(v1[2], v1[3]);
                    *(u32x4*)(X1 + ro + bj * HALF) = w;
                    unsigned w0 = pk4_e4m3(v0[0], v0[1], v0[2], v0[3]), w1 = pk4_e4m3(v1[0], v1[1], v1[2], v1[3]);
                    if (m & 1) {
                        pair16(kx[bj], w0); pair16(ky[bj], w1);
                        *(u32x4*)(X8p + (size_t)(row0 + ai * HALF + (m - 1) * 16 + (fq & 1) * 16) * ldc + u.pn * BM + wc * 32 + 16 * (fq >> 1) + bj * HALF) = (u32x4){kx[bj], ky[bj], w0, w1};
                    } else { kx[bj] = w0; ky[bj] = w1; } } }
        }
    }
};
struct EpiSwiglu {
    static constexpr bool PERM = true, HAS_MID = false;
    bf16_t* act; const float* bgu;
    __device__ __forceinline__ void operator()(const f32x4 (&acc)[2][2][4][2], const Unit& u, int wr, int wc, int fr, int fq) const {
        const int e = u.pn >> 3, j = u.pn & 7;
        const int row0 = u.pm * BM + wr * 64 + fr, col0 = j * 128 + wc * 32 + 8 * fq;
        const float* bg = bgu + (size_t)e * 2048 + col0;
        const f32x4 g0 = *(const f32x4*)bg, g1 = *(const f32x4*)(bg + 4), u0 = *(const f32x4*)(bg + 1024), u1 = *(const f32x4*)(bg + 1028);
#pragma unroll
        for (int ai = 0; ai < 2; ++ai)
#pragma unroll
            for (int m = 0; m < 4; ++m) {
                float o[8];
#pragma unroll
                for (int i = 0; i < 8; ++i) {
                    float gt = (i < 4 ? acc[ai][0][m][0][i] + g0[i] : acc[ai][0][m][1][i - 4] + g1[i - 4]);
                    float up = (i < 4 ? acc[ai][1][m][0][i] + u0[i] : acc[ai][1][m][1][i - 4] + u1[i - 4]);
                    gt = fminf(gt, 7.0f); up = fminf(fmaxf(up, -7.0f), 7.0f);
                    const float sg = __builtin_amdgcn_rcpf(1.0f + __builtin_amdgcn_exp2f(-1.702f * 1.4426950408889634f * gt));
                    o[i] = (up + 1.0f) * (gt * sg);
                }
                u32x4 w; w.x = cvt_pk_bf16(o[0], o[1]); w.y = cvt_pk_bf16(o[2], o[3]); w.z = cvt_pk_bf16(o[4], o[5]); w.w = cvt_pk_bf16(o[6], o[7]);
                *(u32x4*)(act + (size_t)(row0 + ai * HALF + m * 16) * 1024 + col0) = w;
            }
    }
};
struct EpiSwiglu8 {
    static constexpr bool PERM = true, HAS_MID = false;
    unsigned char* __restrict__ act; const float* __restrict__ bgu; const float* __restrict__ srstd; float inv;
    __device__ __forceinline__ void operator()(const f32x4 (&acc)[2][2][4][2], const Unit& u, int wr, int wc, int fr, int fq) const {
        const int e = u.pn >> 3, j = u.pn & 7;
        const int row0 = u.pm * BM + wr * 64 + fr, col0 = j * 128 + wc * 32 + 8 * fq;
        const float* bg = bgu + (size_t)e * 2048 + col0;
        const f32x4 g0 = *(const f32x4*)bg, g1 = *(const f32x4*)(bg + 4), u0 = *(const f32x4*)(bg + 1024), u1 = *(const f32x4*)(bg + 1028);
        float rsv[8];
        {
            const int ln = fq * 16 + fr;
            const float v0 = srstd[u.pm * BM + wr * 64 + ln] * this->inv, v1 = srstd[u.pm * BM + HALF + wr * 64 + ln] * this->inv;
#pragma unroll
            for (int i = 0; i < 8; ++i) rsv[i] = __builtin_bit_cast(float, __builtin_amdgcn_ds_bpermute((fr + 16 * (i & 3)) * 4, __builtin_bit_cast(int, (i >> 2) ? v1 : v0)));
        }
#pragma unroll
        for (int ai = 0; ai < 2; ++ai) {
            unsigned kx = 0u, ky = 0u;
#pragma unroll
            for (int m = 0; m < 4; ++m) {
                float o[8]; const float inv = rsv[ai * 4 + m];
#pragma unroll
                for (int p = 0; p < 4; ++p) {
                    const int n = p >> 1, i0 = (p & 1) * 2;
                    const f32x2 ag = (f32x2){acc[ai][0][m][n][i0], acc[ai][0][m][n][i0 + 1]}, au = (f32x2){acc[ai][1][m][n][i0], acc[ai][1][m][n][i0 + 1]};
                    const f32x2 bgv = n ? (f32x2){g1[i0], g1[i0 + 1]} : (f32x2){g0[i0], g0[i0 + 1]}, buv = n ? (f32x2){u1[i0], u1[i0 + 1]} : (f32x2){u0[i0], u0[i0 + 1]};
                    f32x2 gt = ag * inv + bgv, up = au * inv + buv;
                    gt.x = fminf(gt.x, 7.0f); gt.y = fminf(gt.y, 7.0f);
                    up.x = __builtin_amdgcn_fmed3f(up.x, -7.0f, 7.0f); up.y = __builtin_amdgcn_fmed3f(up.y, -7.0f, 7.0f);
                    const f32x2 tt = gt * (-1.702f * 1.4426950408889634f);
                    f32x2 ev; ev.x = __builtin_amdgcn_exp2f(tt.x); ev.y = __builtin_amdgcn_exp2f(tt.y);
                    const f32x2 dv = ev + 1.0f;
                    f32x2 rv2; rv2.x = __builtin_amdgcn_rcpf(dv.x); rv2.y = __builtin_amdgcn_rcpf(dv.y);
                    const f32x2 ov = (up + 1.0f) * (gt * rv2);
                    o[2 * p] = ov.x; o[2 * p + 1] = ov.y;
                }
                unsigned w0 = pk4_e4m3(o[0], o[1], o[2], o[3]), w1 = pk4_e4m3(o[4], o[5], o[6], o[7]);
                if (m & 1) {
                    pair16(kx, w0); pair16(ky, w1);
                    *(u32x4*)(act + (size_t)(row0 + ai * HALF + (m - 1) * 16 + (fq & 1) * 16) * 1024 + j * 128 + wc * 32 + 16 * (fq >> 1)) = (u32x4){kx, ky, w0, w1};
                } else { kx = w0; ky = w1; }
            }
        }
    }
};
struct EpiDown {
    static constexpr bool PERM = true, HAS_MID = false;
    unsigned char* __restrict__ Y; const float* __restrict__ bd; float inv;
    __device__ __forceinline__ void operator()(const f32x4 (&acc)[2][2][4][2], const Unit& u, int wr, int wc, int fr, int fq) const {
        const int e = u.pn >> 2, j = u.pn & 3;
        const int row0 = u.pm * BM + wr * 64 + fr, col0 = j * 256 + wc * 32 + 8 * fq;
        const float* bp = bd + (size_t)e * 1024 + col0;
        typedef unsigned u32x2 __attribute__((ext_vector_type(2)));
        const f32x4 b00 = *(const f32x4*)bp * 16.0f, b01 = *(const f32x4*)(bp + 4) * 16.0f, b10 = *(const f32x4*)(bp + HALF) * 16.0f, b11 = *(const f32x4*)(bp + HALF + 4) * 16.0f;
        const int colw = j * 256 + wc * 32 + 16 * (fq >> 1), rsel = (fq & 1) * 16;
#pragma unroll
        for (int ai = 0; ai < 2; ++ai)
#pragma unroll
            for (int mp = 0; mp < 2; ++mp) {
                unsigned char* yp = Y + (size_t)(row0 + ai * HALF + mp * 32 + rsel) * 1024 + colw;
#pragma unroll
                for (int bj = 0; bj < 2; ++bj) {
                    const f32x4 c0 = bj ? b10 : b00, c1 = bj ? b11 : b01;
                    const f32x4 p0 = acc[ai][bj][2 * mp][0] * inv + c0, p1 = acc[ai][bj][2 * mp][1] * inv + c1, q0 = acc[ai][bj][2 * mp + 1][0] * inv + c0, q1 = acc[ai][bj][2 * mp + 1][1] * inv + c1;
                    unsigned ax = pk4_e4m3(p0[0], p0[1], p0[2], p0[3]), ay = pk4_e4m3(p1[0], p1[1], p1[2], p1[3]), bx = pk4_e4m3(q0[0], q0[1], q0[2], q0[3]), by = pk4_e4m3(q1[0], q1[1], q1[2], q1[3]);
                    pair16(ax, bx); pair16(ay, by);
                    *(u32x4*)(yp + bj * HALF) = (u32x4){ax, ay, bx, by};
                }
            }
    }
};

template <class Epi, class Sched, bool F8 = false, bool ALIGN_EPI = true, bool A5 = true>
__device__ __forceinline__ void gemm_phase(PG8_LAS unsigned char* lds, const Gemm g, const Sched& S, const Epi& E, const int wid_in) {
    const int wid = __builtin_amdgcn_readfirstlane(wid_in), lane = (int)__builtin_amdgcn_mbcnt_hi(~0u, __builtin_amdgcn_mbcnt_lo(~0u, 0u)), tid = wid * 64 + lane, wr = wid >> 2, wc = wid & 3, fr = lane & 15, fq = lane >> 4;
    int K = g.K; asm volatile("" : "+s"(K));
    const int nt = K / BK;
    unsigned voffA[2], voffB[2];
#pragma unroll
    for (int i = 0; i < 2; ++i) { int R, C; stage_rc(tid * 16 + i * 8192, R, C); const int Rb = Epi::PERM ? ((R & ~31) + perm32(R & 31)) : R;
        voffA[i] = (unsigned)(R * g.lda + C) * 2u; voffB[i] = (unsigned)(Rb * g.ldb + C) * 2u; }
    const size_t kstep = (size_t)(BK * 2);
    const size_t hstepA = (size_t)HALF * g.lda * 2, hstepB = (size_t)HALF * g.ldb * 2;
    const size_t tstepA = 2 * hstepA, tstepB = 2 * hstepB;
    const unsigned ldsw = (unsigned)wid * 1024u;
    const int aoff = lds_byte(wr * 64 + fr, fq * 8), boff = lds_byte(wc * 32 + fr, fq * 8);
#define PG8_SA(b, h) (((b) * 2 + (h)) * HTB)
#define PG8_SB(b, h) (((A5 ? 5 : 4) + (b) * 2 + (h)) * HTB)
#define PG8_LDAD(dst, off) do { _Pragma("unroll") for (int m = 0; m < 4; ++m) dst[m] = cat8(*(const PG8_LAS bf16x8*)(lds + (off) + aoff + m * 2048), *(const PG8_LAS bf16x8*)(lds + (off) + aoff + m * 2048 + 1024)); } while (0)
#define PG8_M5(v) ((v) >= 5 ? (v) - 5 : (v))
#define PG8_STAGE(bufoff, gbase, voff) do { _Pragma("unroll") for (int _i = 0; _i < 2; ++_i) \
        __builtin_amdgcn_global_load_lds((const unsigned*)((const char*)(gbase) + (voff)[_i]), (PG8_LAS unsigned*)(lds + (bufoff) + ldsw + _i * 8192), 16, 0, 0); } while (0)
#define PG8_LDA(dst, b, h) do { _Pragma("unroll") for (int m = 0; m < 4; ++m) dst[m] = cat8(*(const PG8_LAS bf16x8*)(lds + PG8_SA(b, h) + aoff + m * 2048), *(const PG8_LAS bf16x8*)(lds + PG8_SA(b, h) + aoff + m * 2048 + 1024)); } while (0)
#define PG8_LDB(dst, b, h) do { _Pragma("unroll") for (int n = 0; n < 2; ++n) dst[n] = cat8(*(const PG8_LAS bf16x8*)(lds + PG8_SB(b, h) + boff + n * 2048), *(const PG8_LAS bf16x8*)(lds + PG8_SB(b, h) + boff + n * 2048 + 1024)); } while (0)
#define PG8_MMA(ai, bj, At, Bt) do { __builtin_amdgcn_s_setprio(1); \
        if constexpr (F8) { asm volatile("s_nop 1"); _Pragma("unroll") for (int m = 0; m < 4; ++m) _Pragma("unroll") for (int n = 0; n < 2; ++n) \
            asm volatile("v_mfma_scale_f32_16x16x128_f8f6f4 %0, %1, %2, %0, %3, %3 op_sel_hi:[0,0,0]" : "+v"(acc[ai][bj][m][n]) : "v"(Bt[n]), "v"(At[m]), "v"(sc127)); } \
        else { _Pragma("unroll") for (int m = 0; m < 4; ++m) _Pragma("unroll") for (int n = 0; n < 2; ++n) { \
            acc[ai][bj][m][n] = __builtin_amdgcn_mfma_f32_16x16x32_bf16(lo8(Bt[n]), lo8(At[m]), acc[ai][bj][m][n], 0, 0, 0); \
            acc[ai][bj][m][n] = __builtin_amdgcn_mfma_f32_16x16x32_bf16(hi8(Bt[n]), hi8(At[m]), acc[ai][bj][m][n], 0, 0, 0); } } \
        __builtin_amdgcn_s_setprio(0); } while (0)
#define PG8_WAIT_V(n) asm volatile("s_waitcnt vmcnt(" #n ")" ::: "memory")
#define PG8_WAIT_L(n) asm volatile("s_waitcnt lgkmcnt(" #n ")" ::: "memory")
#define PG8_BAR __builtin_amdgcn_s_barrier()
#define PG8_SCHED __builtin_amdgcn_sched_barrier(0)
    const int sc127 = 0x7F7F7F7F; (void)sc127;
    Unit cur, nxt; int ui = 0;
    if (!S.next(0, cur)) return;
    f32x4 acc[2][2][4][2];
#pragma unroll
    for (int a = 0; a < 2; ++a)
#pragma unroll
        for (int b = 0; b < 2; ++b)
#pragma unroll
            for (int m = 0; m < 4; ++m)
#pragma unroll
                for (int n = 0; n < 2; ++n) acc[a][b][m][n] = (f32x4){0.f, 0.f, 0.f, 0.f};
    v8i At[4], B0[2], B1[2];
    const char* cA = (const char*)g.A + (size_t)cur.pm * tstepA; const char* cB = (const char*)g.Bt + (size_t)cur.pn * tstepB;
    int sa = 0; (void)sa;
    if constexpr (A5) {
        PG8_STAGE(0 * HTB, cA, voffA); PG8_STAGE(PG8_SB(0, 0), cB, voffB); PG8_STAGE(PG8_SB(0, 1), cB + hstepB, voffB); PG8_STAGE(1 * HTB, cA + hstepA, voffA);
        PG8_STAGE(2 * HTB, cA + kstep, voffA); PG8_STAGE(PG8_SB(1, 0), cB + kstep, voffB); PG8_STAGE(PG8_SB(1, 1), cB + hstepB + kstep, voffB); PG8_STAGE(3 * HTB, cA + hstepA + kstep, voffA);
        if (wr == 1) PG8_BAR;
        PG8_WAIT_V(10); PG8_BAR; PG8_BAR;
    } else {
    PG8_STAGE(PG8_SB(0, 0), cB, voffB); PG8_STAGE(PG8_SB(0, 1), cB + hstepB, voffB); PG8_STAGE(PG8_SA(0, 0), cA, voffA); PG8_STAGE(PG8_SA(0, 1), cA + hstepA, voffA);
    if (wr == 1) PG8_BAR;
    PG8_WAIT_V(2); PG8_BAR;
    PG8_STAGE(PG8_SB(1, 0), cB + kstep, voffB); PG8_STAGE(PG8_SA(1, 0), cA + kstep, voffA); PG8_STAGE(PG8_SB(1, 1), cB + hstepB + kstep, voffB);
    PG8_WAIT_V(6); PG8_BAR;
    }
    for (;;) {
        const bool has_next = S.next(ui + 1, nxt);
        const char* nA = has_next ? (const char*)g.A + (size_t)nxt.pm * tstepA : cA; const char* nB = has_next ? (const char*)g.Bt + (size_t)nxt.pn * tstepB : cB;
        for (int t = 0; t < nt; t += 2) {
            if constexpr (Epi::HAS_MID) { if (t == Epi::MID0 || t == Epi::MID1) E.mid(acc, cur, t, wr, wc, fr, fq); }
            const bool last = (t == nt - 2);
            const char* a1 = cA + (size_t)(t + 1) * kstep;
            const char* a2 = last ? nA : cA + (size_t)(t + 2) * kstep; const char* b2 = last ? nB : cB + (size_t)(t + 2) * kstep;
            const char* a3 = a2 + kstep; const char* b3 = b2 + kstep;
            if constexpr (A5) {
            const int o0 = sa * HTB, o1 = PG8_M5(sa + 1) * HTB, o2 = PG8_M5(sa + 2) * HTB, o3 = PG8_M5(sa + 3) * HTB, o4 = PG8_M5(sa + 4) * HTB;
            PG8_LDB(B0, 0, 0); PG8_LDB(B1, 0, 1); PG8_SCHED; PG8_LDAD(At, o0); PG8_STAGE(o4, a2, voffA);
            PG8_WAIT_V(10); PG8_WAIT_L(0); PG8_BAR; PG8_MMA(0, 0, At, B0); PG8_MMA(0, 1, At, B1); PG8_BAR; PG8_SCHED;
            PG8_LDAD(At, o1); PG8_STAGE(PG8_SB(0, 0), b2, voffB); PG8_STAGE(PG8_SB(0, 1), b2 + hstepB, voffB); PG8_STAGE(o0, a2 + hstepA, voffA);
            PG8_WAIT_V(10); PG8_WAIT_L(0); PG8_BAR; PG8_MMA(1, 0, At, B0); PG8_MMA(1, 1, At, B1); PG8_BAR; PG8_SCHED;
            PG8_LDB(B0, 1, 0); PG8_LDB(B1, 1, 1); PG8_SCHED; PG8_LDAD(At, o2); PG8_STAGE(o1, a3, voffA);
            PG8_WAIT_V(10); PG8_WAIT_L(0); PG8_BAR; PG8_MMA(0, 0, At, B0); PG8_MMA(0, 1, At, B1); PG8_BAR; PG8_SCHED;
            PG8_LDAD(At, o3); PG8_STAGE(PG8_SB(1, 0), b3, voffB); PG8_STAGE(PG8_SB(1, 1), b3 + hstepB, voffB); PG8_STAGE(o2, a3 + hstepA, voffA);
            PG8_WAIT_V(10); PG8_WAIT_L(0); PG8_BAR; PG8_MMA(1, 0, At, B0); PG8_MMA(1, 1, At, B1); PG8_BAR; PG8_SCHED;
            sa = PG8_M5(sa + 4);
            continue;
            }
            PG8_LDB(B0, 0, 0); PG8_LDB(B1, 0, 1); PG8_SCHED; PG8_LDA(At, 0, 0); PG8_STAGE(PG8_SA(1, 1), a1 + hstepA, voffA);
            PG8_WAIT_V(8); PG8_WAIT_L(0); PG8_BAR; PG8_MMA(0, 0, At, B0); PG8_MMA(0, 1, At, B1); PG8_BAR; PG8_SCHED;
            PG8_LDA(At, 0, 1); PG8_STAGE(PG8_SB(0, 0), b2, voffB); PG8_STAGE(PG8_SB(0, 1), b2 + hstepB, voffB); PG8_STAGE(PG8_SA(0, 0), a2, voffA);
            PG8_WAIT_V(8); PG8_WAIT_L(0); PG8_BAR; PG8_MMA(1, 0, At, B0); PG8_MMA(1, 1, At, B1); PG8_BAR; PG8_SCHED;
            PG8_LDB(B0, 1, 0); PG8_LDB(B1, 1, 1); PG8_SCHED; PG8_LDA(At, 1, 0); PG8_STAGE(PG8_SA(0, 1), a2 + hstepA, voffA);
            PG8_WAIT_V(8); PG8_WAIT_L(0); PG8_BAR; PG8_MMA(0, 0, At, B0); PG8_MMA(0, 1, At, B1); PG8_BAR; PG8_SCHED;
            PG8_LDA(At, 1, 1); PG8_STAGE(PG8_SB(1, 0), b3, voffB); PG8_STAGE(PG8_SB(1, 1), b3 + hstepB, voffB); PG8_STAGE(PG8_SA(1, 0), a3, voffA);
            PG8_WAIT_V(8); PG8_WAIT_L(0); PG8_BAR; PG8_MMA(1, 0, At, B0); PG8_MMA(1, 1, At, B1); PG8_BAR; PG8_SCHED;
        }
        if constexpr (ALIGN_EPI) { if (wr == 0) PG8_BAR; }
        if constexpr (F8) asm volatile("s_nop 15\n\ts_nop 15" ::: "memory");
        E(acc, cur, wr, wc, fr, fq);
        if (!has_next) break;
#pragma unroll
        for (int a = 0; a < 2; ++a)
#pragma unroll
            for (int b = 0; b < 2; ++b)
#pragma unroll
                for (int m = 0; m < 4; ++m)
#pragma unroll
                    for (int n = 0; n < 2; ++n) acc[a][b][m][n] = (f32x4){0.f, 0.f, 0.f, 0.f};
        cur = nxt; cA = nA; cB = nB; ++ui;
        if constexpr (ALIGN_EPI) { if (wr == 1) PG8_BAR; }
    }
    PG8_WAIT_V(0);
    if constexpr (!ALIGN_EPI) { if (wr == 0) PG8_BAR; }
    PG8_BAR;
#undef PG8_SA
#undef PG8_SB
#undef PG8_LDAD
#undef PG8_M5
#undef PG8_STAGE
#undef PG8_LDA
#undef PG8_LDB
#undef PG8_MMA
#undef PG8_WAIT_V
#undef PG8_WAIT_L
#undef PG8_BAR
#undef PG8_SCHED
}
template <class Epi, class Sched, bool F8 = false, bool ALIGN_EPI = true, bool A5 = true>
__device__ __forceinline__ void gemm_phase_gather(PG8_LAS unsigned char* lds, const Gemm g, const Sched& S, const Epi& E, const int wid_in, const int* rowmap) {
    const int wid = __builtin_amdgcn_readfirstlane(wid_in), lane = (int)__builtin_amdgcn_mbcnt_hi(~0u, __builtin_amdgcn_mbcnt_lo(~0u, 0u)), tid = wid * 64 + lane, wr = wid >> 2, wc = wid & 3, fr = lane & 15, fq = lane >> 4;
    int K = g.K; asm volatile("" : "+s"(K));
    const int nt = K / BK;
    unsigned voffB[2]; int RA[2]; unsigned CA2[2];
#pragma unroll
    for (int i = 0; i < 2; ++i) { int R, C; stage_rc(tid * 16 + i * 8192, R, C); const int Rb = Epi::PERM ? ((R & ~31) + perm32(R & 31)) : R;
        RA[i] = R; CA2[i] = (unsigned)C * 2u; voffB[i] = (unsigned)(Rb * g.ldb + C) * 2u; }
    const unsigned rowb = (unsigned)g.lda * 2u;
    unsigned ca0[2], ca1[2], na0[2], na1[2]; int raw0[2], raw1[2];
#define PG8_LOADIDX(d0, d1, pm_) do { _Pragma("unroll") for (int _i = 0; _i < 2; ++_i) { d0[_i] = rowmap[(pm_) * BM + RA[_i]]; d1[_i] = rowmap[(pm_) * BM + HALF + RA[_i]]; } } while (0)
#define PG8_CVTIDX(o0, o1, d0, d1) do { _Pragma("unroll") for (int _i = 0; _i < 2; ++_i) { o0[_i] = (unsigned)(d0[_i] < 0 ? 0 : d0[_i]) * rowb + CA2[_i]; o1[_i] = (unsigned)(d1[_i] < 0 ? 0 : d1[_i]) * rowb + CA2[_i]; } } while (0)
    const size_t kstep = (size_t)(BK * 2);
    const size_t hstepB = (size_t)HALF * g.ldb * 2;
    const size_t tstepB = 2 * hstepB;
    const unsigned ldsw = (unsigned)wid * 1024u;
    const int aoff = lds_byte(wr * 64 + fr, fq * 8), boff = lds_byte(wc * 32 + fr, fq * 8);
#define PG8_SA(b, h) (((b) * 2 + (h)) * HTB)
#define PG8_SB(b, h) (((A5 ? 5 : 4) + (b) * 2 + (h)) * HTB)
#define PG8_LDAD(dst, off) do { _Pragma("unroll") for (int m = 0; m < 4; ++m) dst[m] = cat8(*(const PG8_LAS bf16x8*)(lds + (off) + aoff + m * 2048), *(const PG8_LAS bf16x8*)(lds + (off) + aoff + m * 2048 + 1024)); } while (0)
#define PG8_M5(v) ((v) >= 5 ? (v) - 5 : (v))
#define PG8_STAGE(bufoff, gbase, voff) do { _Pragma("unroll") for (int _i = 0; _i < 2; ++_i) \
        __builtin_amdgcn_global_load_lds((const unsigned*)((const char*)(gbase) + (voff)[_i]), (PG8_LAS unsigned*)(lds + (bufoff) + ldsw + _i * 8192), 16, 0, 0); } while (0)
#define PG8_LDA(dst, b, h) do { _Pragma("unroll") for (int m = 0; m < 4; ++m) dst[m] = cat8(*(const PG8_LAS bf16x8*)(lds + PG8_SA(b, h) + aoff + m * 2048), *(const PG8_LAS bf16x8*)(lds + PG8_SA(b, h) + aoff + m * 2048 + 1024)); } while (0)
#define PG8_LDB(dst, b, h) do { _Pragma("unroll") for (int n = 0; n < 2; ++n) dst[n] = cat8(*(const PG8_LAS bf16x8*)(lds + PG8_SB(b, h) + boff + n * 2048), *(const PG8_LAS bf16x8*)(lds + PG8_SB(b, h) + boff + n * 2048 + 1024)); } while (0)
#define PG8_MMA(ai, bj, At, Bt) do { __builtin_amdgcn_s_setprio(1); \
        if constexpr (F8) { asm volatile("s_nop 1"); _Pragma("unroll") for (int m = 0; m < 4; ++m) _Pragma("unroll") for (int n = 0; n < 2; ++n) \
            asm volatile("v_mfma_scale_f32_16x16x128_f8f6f4 %0, %1, %2, %0, %3, %3 op_sel_hi:[0,0,0]" : "+v"(acc[ai][bj][m][n]) : "v"(Bt[n]), "v"(At[m]), "v"(sc127)); } \
        else { _Pragma("unroll") for (int m = 0; m < 4; ++m) _Pragma("unroll") for (int n = 0; n < 2; ++n) { \
            acc[ai][bj][m][n] = __builtin_amdgcn_mfma_f32_16x16x32_bf16(lo8(Bt[n]), lo8(At[m]), acc[ai][bj][m][n], 0, 0, 0); \
            acc[ai][bj][m][n] = __builtin_amdgcn_mfma_f32_16x16x32_bf16(hi8(Bt[n]), hi8(At[m]), acc[ai][bj][m][n], 0, 0, 0); } } \
        __builtin_amdgcn_s_setprio(0); } while (0)
#define PG8_WAIT_V(n) asm volatile("s_waitcnt vmcnt(" #n ")" ::: "memory")
#define PG8_WAIT_L(n) asm volatile("s_waitcnt lgkmcnt(" #n ")" ::: "memory")
#define PG8_BAR __builtin_amdgcn_s_barrier()
#define PG8_SCHED __builtin_amdgcn_sched_barrier(0)
    const int sc127 = 0x7F7F7F7F; (void)sc127;
    Unit cur, nxt, nn; int ui = 0;
    if (!S.next(0, cur)) return;
    bool has_next = S.next(1, nxt);
    PG8_LOADIDX(raw0, raw1, cur.pm); PG8_CVTIDX(ca0, ca1, raw0, raw1);
    if (has_next) { PG8_LOADIDX(raw0, raw1, nxt.pm); PG8_CVTIDX(na0, na1, raw0, raw1); } else { na0[0] = ca0[0]; na0[1] = ca0[1]; na1[0] = ca1[0]; na1[1] = ca1[1]; }
    f32x4 acc[2][2][4][2];
#pragma unroll
    for (int a = 0; a < 2; ++a)
#pragma unroll
        for (int b = 0; b < 2; ++b)
#pragma unroll
            for (int m = 0; m < 4; ++m)
#pragma unroll
                for (int n = 0; n < 2; ++n) acc[a][b][m][n] = (f32x4){0.f, 0.f, 0.f, 0.f};
    v8i At[4], B0[2], B1[2];
    const char* const cA = (const char*)g.A; const char* cB = (const char*)g.Bt + (size_t)cur.pn * tstepB;
    int sa = 0; (void)sa;
    if constexpr (A5) {
        PG8_STAGE(0 * HTB, cA, ca0); PG8_STAGE(PG8_SB(0, 0), cB, voffB); PG8_STAGE(PG8_SB(0, 1), cB + hstepB, voffB); PG8_STAGE(1 * HTB, cA, ca1);
        PG8_STAGE(2 * HTB, cA + kstep, ca0); PG8_STAGE(PG8_SB(1, 0), cB + kstep, voffB); PG8_STAGE(PG8_SB(1, 1), cB + hstepB + kstep, voffB); PG8_STAGE(3 * HTB, cA + kstep, ca1);
        if (wr == 1) PG8_BAR;
        PG8_WAIT_V(10); PG8_BAR; PG8_BAR;
    } else {
    PG8_STAGE(PG8_SB(0, 0), cB, voffB); PG8_STAGE(PG8_SB(0, 1), cB + hstepB, voffB); PG8_STAGE(PG8_SA(0, 0), cA, ca0); PG8_STAGE(PG8_SA(0, 1), cA, ca1);
    if (wr == 1) PG8_BAR;
    PG8_WAIT_V(2); PG8_BAR;
    PG8_STAGE(PG8_SB(1, 0), cB + kstep, voffB); PG8_STAGE(PG8_SA(1, 0), cA + kstep, ca0); PG8_STAGE(PG8_SB(1, 1), cB + hstepB + kstep, voffB);
    PG8_WAIT_V(6); PG8_BAR;
    }
    for (;;) {
        const bool has_next2 = has_next && S.next(ui + 2, nn);
        if (has_next2) PG8_LOADIDX(raw0, raw1, nn.pm);
        const char* nB = has_next ? (const char*)g.Bt + (size_t)nxt.pn * tstepB : cB;
        for (int t = 0; t < nt; t += 2) {
            const bool last = (t == nt - 2);
            const char* a1 = cA + (size_t)(t + 1) * kstep;
            const char* a2 = last ? cA : cA + (size_t)(t + 2) * kstep; const char* b2 = last ? nB : cB + (size_t)(t + 2) * kstep;
            const char* a3 = a2 + kstep; const char* b3 = b2 + kstep;
            unsigned s0[2], s1[2];
            s0[0] = last ? na0[0] : ca0[0]; s0[1] = last ? na0[1] : ca0[1]; s1[0] = last ? na1[0] : ca1[0]; s1[1] = last ? na1[1] : ca1[1];
            if constexpr (A5) {
            (void)a1;
            const int o0 = sa * HTB, o1 = PG8_M5(sa + 1) * HTB, o2 = PG8_M5(sa + 2) * HTB, o3 = PG8_M5(sa + 3) * HTB, o4 = PG8_M5(sa + 4) * HTB;
            PG8_LDB(B0, 0, 0); PG8_LDB(B1, 0, 1); PG8_SCHED; PG8_LDAD(At, o0); PG8_STAGE(o4, a2, s0);
            PG8_WAIT_V(10); PG8_WAIT_L(0); PG8_BAR; PG8_MMA(0, 0, At, B0); PG8_MMA(0, 1, At, B1); PG8_BAR; PG8_SCHED;
            PG8_LDAD(At, o1); PG8_STAGE(PG8_SB(0, 0), b2, voffB); PG8_STAGE(PG8_SB(0, 1), b2 + hstepB, voffB); PG8_STAGE(o0, a2, s1);
            PG8_WAIT_V(10); PG8_WAIT_L(0); PG8_BAR; PG8_MMA(1, 0, At, B0); PG8_MMA(1, 1, At, B1); PG8_BAR; PG8_SCHED;
            PG8_LDB(B0, 1, 0); PG8_LDB(B1, 1, 1); PG8_SCHED; PG8_LDAD(At, o2); PG8_STAGE(o1, a3, s0);
            PG8_WAIT_V(10); PG8_WAIT_L(0); PG8_BAR; PG8_MMA(0, 0, At, B0); PG8_MMA(0, 1, At, B1); PG8_BAR; PG8_SCHED;
            PG8_LDAD(At, o3); PG8_STAGE(PG8_SB(1, 0), b3, voffB); PG8_STAGE(PG8_SB(1, 1), b3 + hstepB, voffB); PG8_STAGE(o2, a3, s1);
            PG8_WAIT_V(10); PG8_WAIT_L(0); PG8_BAR; PG8_MMA(1, 0, At, B0); PG8_MMA(1, 1, At, B1); PG8_BAR; PG8_SCHED;
            sa = PG8_M5(sa + 4);
            continue;
            }
            PG8_LDB(B0, 0, 0); PG8_LDB(B1, 0, 1); PG8_SCHED; PG8_LDA(At, 0, 0); PG8_STAGE(PG8_SA(1, 1), a1, ca1);
            PG8_WAIT_V(8); PG8_WAIT_L(0); PG8_BAR; PG8_MMA(0, 0, At, B0); PG8_MMA(0, 1, At, B1); PG8_BAR; PG8_SCHED;
            PG8_LDA(At, 0, 1); PG8_STAGE(PG8_SB(0, 0), b2, voffB); PG8_STAGE(PG8_SB(0, 1), b2 + hstepB, voffB); PG8_STAGE(PG8_SA(0, 0), a2, s0);
            PG8_WAIT_V(8); PG8_WAIT_L(0); PG8_BAR; PG8_MMA(1, 0, At, B0); PG8_MMA(1, 1, At, B1); PG8_BAR; PG8_SCHED;
            PG8_LDB(B0, 1, 0); PG8_LDB(B1, 1, 1); PG8_SCHED; PG8_LDA(At, 1, 0); PG8_STAGE(PG8_SA(0, 1), a2, s1);
            PG8_WAIT_V(8); PG8_WAIT_L(0); PG8_BAR; PG8_MMA(0, 0, At, B0); PG8_MMA(0, 1, At, B1); PG8_BAR; PG8_SCHED;
            PG8_LDA(At, 1, 1); PG8_STAGE(PG8_SB(1, 0), b3, voffB); PG8_STAGE(PG8_SB(1, 1), b3 + hstepB, voffB); PG8_STAGE(PG8_SA(1, 0), a3, s0);
            PG8_WAIT_V(8); PG8_WAIT_L(0); PG8_BAR; PG8_MMA(1, 0, At, B0); PG8_MMA(1, 1, At, B1); PG8_BAR; PG8_SCHED;
        }
        if constexpr (ALIGN_EPI) { if (wr == 0) PG8_BAR; }
        if constexpr (F8) asm volatile("s_nop 15\n\ts_nop 15" ::: "memory");
        E(acc, cur, wr, wc, fr, fq);
        if (!has_next) break;
#pragma unroll
        for (int a = 0; a < 2; ++a)
#pragma unroll
            for (int b = 0; b < 2; ++b)
#pragma unroll
                for (int m = 0; m < 4; ++m)
#pragma unroll
                    for (int n = 0; n < 2; ++n) acc[a][b][m][n] = (f32x4){0.f, 0.f, 0.f, 0.f};
        cur = nxt; cB = nB; ++ui;
        ca0[0] = na0[0]; ca0[1] = na0[1]; ca1[0] = na1[0]; ca1[1] = na1[1];
        if (has_next2) { PG8_CVTIDX(na0, na1, raw0, raw1); nxt = nn; }
        has_next = has_next2;
        if constexpr (ALIGN_EPI) { if (wr == 1) PG8_BAR; }
    }
    PG8_WAIT_V(0);
    if constexpr (!ALIGN_EPI) { if (wr == 0) PG8_BAR; }
    PG8_BAR;
#undef PG8_LOADIDX
#undef PG8_CVTIDX
#undef PG8_SA
#undef PG8_SB
#undef PG8_LDAD
#undef PG8_M5
#undef PG8_STAGE
#undef PG8_LDA
#undef PG8_LDB
#undef PG8_MMA
#undef PG8_WAIT_V
#undef PG8_WAIT_L
#undef PG8_BAR
#undef PG8_SCHED
}
}

constexpr int NWAVES = 8, NTHR = 512;
constexpr int BATCH = 32, SEQ = 2048, D = 1024, T = BATCH * SEQ, MEM = 256, TM = BATCH * MEM;
constexpr int DIN = 5888;
constexpr float EPS = 1e-6f;
constexpr int LDP = DIN, C_Q = 0, C_U = 1024, C_QC = 1536, C_K = 2048, C_V = 2176, C_VB = 2304, C_G = 2816;
constexpr int WD_P1_ITEMS = 8192;
constexpr float YSCALE = 16.0f;
constexpr float WSCALE = 64.0f;
constexpr int NEXP = 32, TOPK = 4;
constexpr int PS = T * TOPK + NEXP * 256;
constexpr int MAXTILE = PS / 256;

constexpr size_t MiB = 1u << 20;
constexpr size_t WS_CTL = 0, CTL_ZERO_BYTES = 1 * MiB;
constexpr size_t WS_WOUT = 1 * MiB;
constexpr size_t WS_ROPE = 3 * MiB;
constexpr size_t WS_WIN = 19 * MiB;
constexpr size_t WS_WO = 31 * MiB;
constexpr size_t WS_WMKV = 35 * MiB;
constexpr size_t WS_X8 = 3 * MiB;
constexpr size_t WS_SRSTD = 67 * MiB;
constexpr size_t WS_MEMN = 37 * MiB;
constexpr size_t WS_KV = 53 * MiB;
constexpr size_t WS_META = 69 * MiB;
constexpr size_t WS_H = 77 * MiB;
constexpr size_t WS_PROJ = 205 * MiB;
constexpr size_t WS_WGU = 141 * MiB;
constexpr size_t WS_WD = 941 * MiB;
constexpr size_t WS_ACT = 237 * MiB;
constexpr size_t WS_Y = 501 * MiB;
constexpr size_t WS_X1B = 765 * MiB;
constexpr size_t WS_END = 1013 * MiB;
static_assert(WS_PROJ + (size_t)T * LDP * 2 <= WS_END && WS_ACT + (size_t)PS * 1024 <= WS_Y && WS_Y + (size_t)T * TOPK * 2048 <= WS_END && WS_WGU + (size_t)NEXP * 2048 * 1024 <= WS_PROJ && WS_WD + (size_t)NEXP * 1024 * 1024 <= WS_END, "ws map");
constexpr size_t MT_IDX = 0;
constexpr size_t MT_GATE = 1 * MiB;
constexpr size_t MT_STOK = 2 * MiB;
constexpr size_t MT_SGATE = 3 * MiB + 512 * 1024;
constexpr size_t MT_SASG = 5 * MiB;
constexpr size_t MT_TILEE = 6 * MiB + 512 * 1024;
constexpr size_t MT_WSB = 7 * MiB;
constexpr size_t MT_RSTD = 7 * MiB + 128 * 1024;
constexpr size_t MT_CMAT = 7 * MiB + 512 * 1024;
constexpr size_t MT_RWP = 7 * MiB + 768 * 1024;
constexpr int CW_BAR = 4096;
constexpr int CW_NTILE = 1024;

constexpr int RING_OFF = 0, RING_BYTES = 147456;
constexpr int LDS_BYTES = 151552;
constexpr int LDSCTL_OFF = LDS_BYTES - 1024, MISC_OFF = LDSCTL_OFF + 320;

#define GAS __attribute__((address_space(1)))
#define LAS __attribute__((address_space(3)))
typedef unsigned short bf16;
typedef unsigned v4u __attribute__((ext_vector_type(4)));
typedef unsigned v2u __attribute__((ext_vector_type(2)));
typedef float f32x4 __attribute__((ext_vector_type(4)));
typedef GAS unsigned gu32;
#define RLX_AGENT __ATOMIC_RELAXED, __HIP_MEMORY_SCOPE_AGENT
#define LDS_WAIT() asm volatile("s_waitcnt lgkmcnt(0)" ::: "memory")
#define VM_WAIT() asm volatile("s_waitcnt vmcnt(0)" ::: "memory")
__device__ __forceinline__ unsigned f2bf(float f) { unsigned u = __builtin_bit_cast(unsigned, f); return (u + 0x7fffu + ((u >> 16) & 1u)) >> 16; }
typedef float pk_f2_t __attribute__((ext_vector_type(2))); typedef __bf16 pk_b2_t __attribute__((ext_vector_type(2)));
__device__ __forceinline__ unsigned pk2(float lo, float hi) { const pk_f2_t v = {lo, hi}; const pk_b2_t b = __builtin_convertvector(v, pk_b2_t); return __builtin_bit_cast(unsigned, b); }
__device__ __forceinline__ unsigned pk4_fp8(float a, float b, float c, float d) { int w = 0; w = __builtin_amdgcn_cvt_pk_fp8_f32(a, b, w, false); w = __builtin_amdgcn_cvt_pk_fp8_f32(c, d, w, true); return (unsigned)w; }
__device__ __forceinline__ float bf2f(bf16 b) { return __uint_as_float(((unsigned)b) << 16); }
__device__ __forceinline__ float blo(unsigned w) { return __uint_as_float(w << 16); }
__device__ __forceinline__ float bhi(unsigned w) { return __uint_as_float(w & 0xffff0000u); }

#define XB_TMO      128
#define XB_XCNT(j)  (256  + 64 * (j))
#define XB_XSUB(j)  (1280 + 64 * (j))
#define XB_XGEN(j)  (2304 + 64 * (j))
#define XB_TOP      3328
#define XB_TOPGEN   3392
#define XCD_BAR_WORDS 3456
#define XB_SPIN_CAP (1u << 22)
__device__ __forceinline__ unsigned xb_ld(unsigned* p)              { return __hip_atomic_load(p, __ATOMIC_RELAXED, __HIP_MEMORY_SCOPE_AGENT); }
__device__ __forceinline__ unsigned xb_add(unsigned* p, unsigned v) { return __hip_atomic_fetch_add(p, v, __ATOMIC_RELAXED, __HIP_MEMORY_SCOPE_AGENT); }
__device__ __forceinline__ unsigned xb_xcc_id() { return (unsigned)__builtin_amdgcn_s_getreg((3 << 11) | 20) & 0xFu; }
#define XB_SPIN(cond, bar) do { unsigned _sp = 0; while (cond) { __builtin_amdgcn_s_sleep(1); \
    if ((++_sp & 255u) == 0u) { if (xb_ld(&(bar)[XB_TMO])) break; if (_sp > XB_SPIN_CAP) { atomicAdd(&(bar)[XB_TMO], 1u); break; } } } } while (0)
struct XcdBarrier { unsigned* bar; unsigned x; volatile LAS unsigned* st; };
__device__ __forceinline__ XcdBarrier xcd_barrier_post(unsigned* bar, volatile LAS unsigned* st, bool leader) {
    XcdBarrier b; b.bar = bar; b.x = xb_xcc_id(); b.st = st;
    if (leader) (void)xb_add(&bar[XB_XCNT(b.x)], 1u);
    return b;
}
__device__ __forceinline__ void xcd_barrier_complete(unsigned* bar, unsigned x, unsigned& nloc, unsigned& nx) {
    const unsigned G = gridDim.x * gridDim.y * gridDim.z;
    unsigned sum, cnt, mine, sp = 0u;
    for (;;) {
        sum = 0u; cnt = 0u; mine = 0u;
#pragma unroll
        for (unsigned j = 0; j < 16; ++j) { const unsigned c = xb_ld(&bar[XB_XCNT(j)]); sum += c; cnt += (c > 0u) ? 1u : 0u; mine = (j == x) ? c : mine; }
        if (sum == G) break;
        __builtin_amdgcn_s_sleep(1);
        if ((++sp & 255u) == 0u) { if (xb_ld(&bar[XB_TMO])) break; if (sp > XB_SPIN_CAP) { atomicAdd(&bar[XB_TMO], 1u); break; } }
    }
    nloc = mine > 0u ? mine : 1u; nx = cnt > 0u ? cnt : 1u;
}
__device__ __forceinline__ void xcd_barrier(const XcdBarrier& b, bool leader) {
    asm volatile("s_waitcnt vmcnt(0)" ::: "memory");
    __syncthreads();
    if (leader) {
        unsigned* bar = b.bar;
        __builtin_amdgcn_s_waitcnt(0);
        unsigned nloc = b.st[0], nx = b.st[1];
        if (nloc == 0u) { xcd_barrier_complete(bar, b.x, nloc, nx); b.st[0] = nloc; b.st[1] = nx; }
        const unsigned old = xb_add(&bar[XB_XSUB(b.x)], 1u);
        const unsigned gen = old / nloc;
        if (old + 1u == (gen + 1u) * nloc) {
            __builtin_amdgcn_fence(__ATOMIC_RELEASE, "agent");
            asm volatile("s_waitcnt vmcnt(0)" ::: "memory");
            const unsigned og = xb_add(&bar[XB_TOP], 1u);
            const unsigned tg = og / nx;
            if (og + 1u == (tg + 1u) * nx) xb_add(&bar[XB_TOPGEN], 1u);
            else XB_SPIN(xb_ld(&bar[XB_TOPGEN]) == tg, bar);
            __builtin_amdgcn_fence(__ATOMIC_ACQUIRE, "agent");
            xb_add(&bar[XB_XGEN(b.x)], 1u);
            asm volatile("s_waitcnt vmcnt(0)" ::: "memory");
        } else {
            XB_SPIN(xb_ld(&bar[XB_XGEN(b.x)]) == gen, bar);
            __builtin_amdgcn_fence(__ATOMIC_ACQUIRE, "agent");
            asm volatile("s_waitcnt vmcnt(0)" ::: "memory");
        }
    }
    __syncthreads();
}

__device__ __forceinline__ float dpp_add(float v, const int ctrl) { return v; }
#define DPP_ADD(v, ctrl) ((v) + __builtin_bit_cast(float, __builtin_amdgcn_update_dpp(0, __builtin_bit_cast(int, (v)), (ctrl), 0xf, 0xf, false)))
__device__ __forceinline__ float row16_sum(float v) { v = DPP_ADD(v, 0xB1); v = DPP_ADD(v, 0x4E); v = DPP_ADD(v, 0x141); v = DPP_ADD(v, 0x140); return v; }
__device__ __forceinline__ float wave_sum(float v) { return xor32_sum(xor16_sum(row16_sum(v))); }
__device__ __forceinline__ float wave_max(float v) {
#pragma unroll
    for (int o = 1; o < 64; o <<= 1) v = fmaxf(v, __shfl_xor(v, o));
    return v;
}
__device__ __forceinline__ float half_sum(float v) {
#pragma unroll
    for (int o = 1; o < 32; o <<= 1) v += __shfl_xor(v, o);
    return v;
}
__device__ __forceinline__ float gelu_erf(float x) { return 0.5f * x * (1.0f + erff(x * 0.70710678118654752f)); }

struct Args {
    const float* in[28]; float* out; unsigned char* ws; int ph_lo, ph_hi;
};
enum { I_X = 0, I_MEM, I_POS, I_ATTN_G, I_MEM_G, I_WIN, I_BGATES, I_AQG, I_AKG, I_SINKS, I_WOA, I_LNG, I_LNB, I_WS, I_BS, I_WOB, I_WMKV, I_CQG, I_CKG, I_WOC, I_WOUT, I_FFN_G,
       I_RW, I_RB, I_WGU, I_BGU, I_WD, I_BD };

__device__ __forceinline__ void tr_item(const float* W, int ldw, int k0, int sc, bf16* WT, int ldt, int dr, int dk, LAS float* scr, int lane) {
#pragma unroll 8
    for (int i = 0; i < 32; ++i) { const int kk = 2 * i + (lane >> 5); scr[kk * 33 + (lane & 31)] = W[(size_t)(k0 + kk) * ldw + sc + (lane & 31)]; }
    LDS_WAIT(); asm volatile("" ::: "memory");
    const int c = lane & 7;
#pragma unroll
    for (int j = 0; j < 4; ++j) { const int n = (lane >> 3) + 8 * j; const LAS float* s = scr + (8 * c) * 33 + n;
        v4u o; o.x = pk2(s[0 * 33], s[1 * 33]); o.y = pk2(s[2 * 33], s[3 * 33]); o.z = pk2(s[4 * 33], s[5 * 33]); o.w = pk2(s[6 * 33], s[7 * 33]);
        *(GAS v4u*)(WT + (size_t)(dr + n) * ldt + dk + k0 + 8 * c) = o; }
    LDS_WAIT(); asm volatile("" ::: "memory");
}
struct TrItem { const float* W; int ldw, k0, sc; bf16* WT; int ldt, dr, dk; const float* ks; };
__device__ __forceinline__ void tr_load(const TrItem& it, int lane, f32x4 (&v)[8]) {
    const float* p = it.W + (size_t)(it.k0 + (lane >> 3)) * it.ldw + it.sc + 4 * (lane & 7);
#pragma unroll
    for (int i = 0; i < 8; ++i) v[i] = *(const GAS f32x4*)(p + (size_t)(8 * i) * it.ldw);
}
__device__ __forceinline__ void tr_store(const TrItem& it, const f32x4 (&v)[8], LAS float* scr, int lane) {
#pragma unroll
    for (int i = 0; i < 8; ++i) { LAS float* p = scr + ((lane >> 3) + 8 * i) * 33 + 4 * (lane & 7); p[0] = v[i].x; p[1] = v[i].y; p[2] = v[i].z; p[3] = v[i].w; }
    LDS_WAIT(); asm volatile("" ::: "memory");
    const int c = lane & 7;
#pragma unroll
    for (int j = 0; j < 4; ++j) { const int n = (lane >> 3) + 8 * j; const LAS float* s = scr + (8 * c) * 33 + n;
        v4u o; o.x = pk2(s[0 * 33], s[1 * 33]); o.y = pk2(s[2 * 33], s[3 * 33]); o.z = pk2(s[4 * 33], s[5 * 33]); o.w = pk2(s[6 * 33], s[7 * 33]);
        *(GAS v4u*)(it.WT + (size_t)(it.dr + n) * it.ldt + it.dk + it.k0 + 8 * c) = o; }
    LDS_WAIT(); asm volatile("" ::: "memory");
}
__device__ __forceinline__ void tr_store8(const TrItem& it, const f32x4 (&v)[8], LAS float* scr, int lane, float sc) {
#pragma unroll
    for (int i = 0; i < 8; ++i) { LAS float* p = scr + ((lane >> 3) + 8 * i) * 33 + 4 * (lane & 7); p[0] = v[i].x; p[1] = v[i].y; p[2] = v[i].z; p[3] = v[i].w; }
    LDS_WAIT(); asm volatile("" ::: "memory");
    const int c = lane & 3; unsigned char* WT8 = (unsigned char*)it.WT;
    f32x4 kv[4] = {(f32x4){sc, sc, sc, sc}, (f32x4){sc, sc, sc, sc}, (f32x4){sc, sc, sc, sc}, (f32x4){sc, sc, sc, sc}};
    if (it.ks) {
#pragma unroll
        for (int q = 0; q < 4; ++q) kv[q] = *(const GAS f32x4*)(it.ks + it.k0 + 16 * c + 4 * q) * sc; }
#pragma unroll
    for (int j = 0; j < 2; ++j) { const int n = (lane >> 2) + 16 * j; const LAS float* s = scr + (16 * c) * 33 + n;
        v4u o;
        o.x = pk4_fp8(s[0 * 33] * kv[0].x, s[1 * 33] * kv[0].y, s[2 * 33] * kv[0].z, s[3 * 33] * kv[0].w);
        o.y = pk4_fp8(s[4 * 33] * kv[1].x, s[5 * 33] * kv[1].y, s[6 * 33] * kv[1].z, s[7 * 33] * kv[1].w);
        o.z = pk4_fp8(s[8 * 33] * kv[2].x, s[9 * 33] * kv[2].y, s[10 * 33] * kv[2].z, s[11 * 33] * kv[2].w);
        o.w = pk4_fp8(s[12 * 33] * kv[3].x, s[13 * 33] * kv[3].y, s[14 * 33] * kv[3].z, s[15 * 33] * kv[3].w);
        *(GAS v4u*)(WT8 + (size_t)(it.dr + n) * it.ldt + it.dk + it.k0 + 16 * c) = o; }
    LDS_WAIT(); asm volatile("" ::: "memory");
}
template <class F> __device__ __forceinline__ void tr_range8(int nit, F f, int gw, int NGW, LAS float* scr, int lane, float sc) {
    for (int it = gw; it < nit; it += 2 * NGW) {
        const TrItem a = f(it); f32x4 va[8], vb[8]; tr_load(a, lane, va);
        const bool two = it + NGW < nit; TrItem b = a; if (two) { b = f(it + NGW); tr_load(b, lane, vb); }
        tr_store8(a, va, scr, lane, sc);
        if (two) tr_store8(b, vb, scr, lane, sc);
    }
}
template <class F> __device__ __forceinline__ void tr_range(int nit, F f, int gw, int NGW, LAS float* scr, int lane) {
    for (int it = gw; it < nit; it += 2 * NGW) {
        const TrItem a = f(it); f32x4 va[8], vb[8]; tr_load(a, lane, va);
        const bool two = it + NGW < nit; TrItem b = a; if (two) { b = f(it + NGW); tr_load(b, lane, vb); }
        tr_store(a, va, scr, lane);
        if (two) tr_store(b, vb, scr, lane);
    }
}
__device__ __forceinline__ int win_srccol(int r) {
    if (r < 1024) { const int pn = r >> 8, blk = (r >> 5) & 7, bj = blk >> 2, wc = blk & 3; return 64 * (4 * pn + wc) + 32 * bj; }
    if (r < 1536) return 1280 + (r - 1024);
    if (r < 2048) return 2304 + (r - 1536);
    if (r < 2304) { const int blk = (r - 2048) >> 5, bj = blk >> 2, wc = blk & 3; return ((wc & 1) ? 1152 : 1024) + 64 * (wc >> 1) + 32 * bj; }
    if (r < 2816) return 1792 + (r - 2304);
    return r;
}
__device__ __forceinline__ void rms_row_to_bf16(const float* xrow, const float* g, bf16* orow, int lane) {
    const GAS f32x4* xr = (const GAS f32x4*)xrow + lane; const GAS f32x4* gr = (const GAS f32x4*)g + lane;
    f32x4 v[4]; float s = 0.f;
#pragma unroll
    for (int j = 0; j < 4; ++j) { v[j] = xr[64 * j]; s += (v[j].x * v[j].x + v[j].y * v[j].y) + (v[j].z * v[j].z + v[j].w * v[j].w); }
    const float rstd = __builtin_amdgcn_rsqf(wave_sum(s) * (1.f / 1024.f) + EPS);
    GAS v2u* o8 = (GAS v2u*)orow + lane;
#pragma unroll
    for (int j = 0; j < 4; ++j) { const f32x4 gg = gr[64 * j]; v2u o; o.x = pk2(v[j].x * rstd * gg.x, v[j].y * rstd * gg.y); o.y = pk2(v[j].z * rstd * gg.z, v[j].w * rstd * gg.w); o8[64 * j] = o; }
}

__device__ __forceinline__ void rms_rows4_to_bf16(const float* xrow, const float* g, bf16* orow, int lane) {
    const GAS f32x4* xr = (const GAS f32x4*)xrow + lane; const GAS f32x4* gr = (const GAS f32x4*)g + lane;
    f32x4 v[16]; float s[4];
#pragma unroll
    for (int j = 0; j < 16; ++j) v[j] = xr[64 * j];
#pragma unroll
    for (int r = 0; r < 4; ++r) { float a = 0.f;
#pragma unroll
        for (int j = 0; j < 4; ++j) a += (v[4 * r + j].x * v[4 * r + j].x + v[4 * r + j].y * v[4 * r + j].y) + (v[4 * r + j].z * v[4 * r + j].z + v[4 * r + j].w * v[4 * r + j].w);
        s[r] = a; }
#pragma unroll
    for (int r = 0; r < 4; ++r) s[r] = row16_sum(s[r]);
#pragma unroll
    for (int r = 0; r < 4; ++r) s[r] = xor32_sum(xor16_sum(s[r]));
    GAS v2u* o8 = (GAS v2u*)orow + lane;
#pragma unroll
    for (int r = 0; r < 4; ++r) { const float rs = __builtin_amdgcn_rsqf(s[r] * (1.f / 1024.f) + EPS);
#pragma unroll
        for (int j = 0; j < 4; ++j) { const f32x4 gg = gr[64 * j]; const f32x4 a = v[4 * r + j];
            v2u o; o.x = pk2(a.x * rs * gg.x, a.y * rs * gg.y); o.y = pk2(a.z * rs * gg.z, a.w * rs * gg.w); o8[256 * r + 64 * j] = o; } }
}
__device__ __forceinline__ void rms_rows2_to_bf16(const float* xrow, const float* g, bf16* orow, int lane) {
    const GAS f32x4* xr = (const GAS f32x4*)xrow + lane; const GAS f32x4* gr = (const GAS f32x4*)g + lane;
    f32x4 v[8]; float s0 = 0.f, s1 = 0.f;
#pragma unroll
    for (int j = 0; j < 8; ++j) v[j] = xr[64 * j];
#pragma unroll
    for (int j = 0; j < 4; ++j) { s0 += (v[j].x * v[j].x + v[j].y * v[j].y) + (v[j].z * v[j].z + v[j].w * v[j].w); s1 += (v[4 + j].x * v[4 + j].x + v[4 + j].y * v[4 + j].y) + (v[4 + j].z * v[4 + j].z + v[4 + j].w * v[4 + j].w); }
    const float r0 = __builtin_amdgcn_rsqf(wave_sum(s0) * (1.f / 1024.f) + EPS), r1 = __builtin_amdgcn_rsqf(wave_sum(s1) * (1.f / 1024.f) + EPS);
    GAS v2u* o8 = (GAS v2u*)orow + lane;
#pragma unroll
    for (int j = 0; j < 4; ++j) { const f32x4 gg = gr[64 * j];
        v2u o; o.x = pk2(v[j].x * r0 * gg.x, v[j].y * r0 * gg.y); o.y = pk2(v[j].z * r0 * gg.z, v[j].w * r0 * gg.w); o8[64 * j] = o;
        v2u p; p.x = pk2(v[4 + j].x * r1 * gg.x, v[4 + j].y * r1 * gg.y); p.y = pk2(v[4 + j].z * r1 * gg.z, v[4 + j].w * r1 * gg.w); o8[256 + 64 * j] = p; }
}
namespace att {
typedef short bf16x8 __attribute__((ext_vector_type(8)));
typedef short s16x4 __attribute__((ext_vector_type(4)));
typedef short v4i16_t __attribute__((ext_vector_type(4)));
typedef float f32x16 __attribute__((ext_vector_type(16)));
typedef float f32x2_t __attribute__((ext_vector_type(2)));
typedef __bf16 bf16x2_t __attribute__((ext_vector_type(2)));
#define ATT_MFMA(a, b, c) __builtin_amdgcn_mfma_f32_32x32x16_bf16((a), (b), (c), 0, 0, 0)
__device__ __forceinline__ unsigned cvtpk(float lo, float hi) { f32x2_t v = {lo, hi}; bf16x2_t b = __builtin_convertvector(v, bf16x2_t); return __builtin_bit_cast(unsigned, b); }
__device__ __forceinline__ s16x4 vtr(const LAS unsigned char* p) { return __builtin_bit_cast(s16x4, __builtin_amdgcn_ds_read_tr16_b64_v4i16((LAS v4i16_t*)p)); }
__device__ __forceinline__ void pair32(unsigned& a, unsigned& b) { asm("s_nop 1\n\tv_permlane32_swap_b32 %0, %1" : "+v"(a), "+v"(b)); }
__device__ __forceinline__ v4u pair32v(v4u w) { unsigned x = w.x, y = w.y, z = w.z, q = w.w; pair32(x, z); pair32(y, q); return (v4u){x, y, z, q}; }
__device__ __forceinline__ int crow(int r, int h) { return (r & 3) + 8 * (r >> 2) + 4 * h; }
__device__ __forceinline__ bf16x8 pack8(float a0, float a1, float a2, float a3, float a4, float a5, float a6, float a7) {
    v4u w; w.x = cvtpk(a0, a1); w.y = cvtpk(a2, a3); w.z = cvtpk(a4, a5); w.w = cvtpk(a6, a7); return __builtin_bit_cast(bf16x8, w); }
constexpr float LOG2E = 1.4426950408889634f;
constexpr int SWA_KP = 144, SWA_VP = 192, SWA_K_OFF = 0, SWA_V_OFF = 256 * SWA_KP;
constexpr int SWA_X_OFF = SWA_V_OFF + 256 * SWA_VP, SWA_XP = 144;

__device__ __forceinline__ void swa_phase(LAS unsigned char* L, bf16* projp, const float* sinks, const float* gq, const float* gk, int bid, int G, int wave, int lane) {
    const int tid = wave * 64 + lane, r32 = lane & 31, h = lane >> 5, blk16 = (lane >> 4) & 1, q4 = (lane & 15) >> 2, p4 = lane & 3;
    const float bnd = 8.0f * wave_max(fabsf(gq[lane])) * wave_max(fabsf(gk[lane]));
    v4u kx[4], vx[4];
#define SWA_LOADKV(u_) do { const int blk_ = (u_) & 15, kvh_ = ((u_) >> 4) & 1, b_ = (u_) >> 5; const int tok0_ = b_ * SEQ + blk_ * 128; \
        _Pragma("unroll") for (int it = 0; it < 4; ++it) if (it >= 2 || blk_ != 0) { \
            const bf16* src = projp + (size_t)(tok0_ - 128 + (tid >> 3) + 64 * it) * LDP + 64 * kvh_ + 8 * (tid & 7); \
            kx[it] = *(const GAS v4u*)(src + C_K); vx[it] = *(const GAS v4u*)(src + C_V); } } while (0)
    if (bid < 1024) SWA_LOADKV(bid);
    for (int unit = bid; unit < 1024; unit += G) {
        const int blk = unit & 15, kvh = (unit >> 4) & 1, b = unit >> 5;
        const int tok0 = b * SEQ + blk * 128;
        __syncthreads();
#pragma unroll
        for (int it = 0; it < 4; ++it) if (it >= 2 || blk != 0) {
            const int row = (tid >> 3) + 64 * it, ch = tid & 7;
            *(LAS v4u*)(L + SWA_K_OFF + row * SWA_KP + ch * 16) = kx[it];
            *(LAS v4u*)(L + SWA_V_OFF + row * SWA_VP + ch * 16) = vx[it];
        }
        __syncthreads();
        if (unit + G < 1024) SWA_LOADKV(unit + G);
        const int hd = kvh * 8 + wave;
        const float sink = sinks[hd];
        const float m2 = fmaxf(bnd, sink) * LOG2E;
        const float esink = __builtin_amdgcn_exp2f(sink * LOG2E - m2);
        LAS unsigned char* xt = L + SWA_X_OFF + wave * (32 * SWA_XP);
        v4u qnx[4];
#pragma unroll
        for (int i = 0; i < 4; ++i) qnx[i] = *(const GAS v4u*)(projp + (size_t)(tok0 + (lane >> 3) + 8 * i) * LDP + C_Q + 64 * hd + 8 * (lane & 7));
#pragma unroll 1
        for (int qi = 0; qi < 4; ++qi) {
            bf16* qrow = projp + (size_t)(tok0 + 32 * qi + (lane >> 3)) * LDP + C_Q + 64 * hd + 8 * (lane & 7);
            bf16x8 qf[4];
#pragma unroll
            for (int i = 0; i < 4; ++i) *(LAS v4u*)(xt + ((lane >> 3) + 8 * i) * SWA_XP + 16 * (lane & 7)) = qnx[i];
            LDS_WAIT();
#pragma unroll
            for (int ks = 0; ks < 4; ++ks) qf[ks] = *(const LAS bf16x8*)(xt + r32 * SWA_XP + 32 * ks + 16 * h);
            LDS_WAIT();
            if (qi < 3) {
#pragma unroll
                for (int i = 0; i < 4; ++i) qnx[i] = *(const GAS v4u*)(qrow + (size_t)(32 + 8 * i) * LDP); }
            f32x16 o0, o1;
#pragma unroll
            for (int r = 0; r < 16; ++r) { o0[r] = 0.f; o1[r] = 0.f; }
            float lsum = 0.f;
            const int kt0 = (blk == 0) ? 4 : qi;
#pragma unroll 1
            for (int kt = kt0; kt <= qi + 4; ++kt) {
                f32x16 s;
#pragma unroll
                for (int r = 0; r < 16; ++r) s[r] = 0.f;
                const LAS unsigned char* kp = L + SWA_K_OFF + (32 * kt + r32) * SWA_KP + 16 * h;
#pragma unroll
                for (int ks = 0; ks < 4; ++ks) { const bf16x8 kf = *(const LAS bf16x8*)(kp + 32 * ks); s = ATT_MFMA(kf, qf[ks], s); }
                float p[16];
                const bool first = (kt == qi), lastt = (kt == qi + 4);
#pragma unroll
                for (int r = 0; r < 16; ++r) { const float e = __builtin_amdgcn_exp2f(s[r] * (0.125f * LOG2E) - m2); const int cr = crow(r, h);
                    const bool ok = (!first || cr > r32) && (!lastt || cr <= r32); p[r] = ok ? e : 0.f; lsum += p[r]; }
#pragma unroll
                for (int s2 = 0; s2 < 2; ++s2) {
                    const bf16x8 pb = pack8(p[8 * s2], p[8 * s2 + 1], p[8 * s2 + 2], p[8 * s2 + 3], p[8 * s2 + 4], p[8 * s2 + 5], p[8 * s2 + 6], p[8 * s2 + 7]);
                    const LAS unsigned char* vp = L + SWA_V_OFF + (32 * kt + 16 * s2 + 4 * h + q4) * SWA_VP + (16 * blk16 + 4 * p4) * 2;
                    { const s16x4 lo = vtr(vp), hi = vtr(vp + 8 * SWA_VP); const bf16x8 vf = __builtin_shufflevector(lo, hi, 0, 1, 2, 3, 4, 5, 6, 7); o0 = ATT_MFMA(vf, pb, o0); }
                    { const s16x4 lo = vtr(vp + 64), hi = vtr(vp + 64 + 8 * SWA_VP); const bf16x8 vf = __builtin_shufflevector(lo, hi, 0, 1, 2, 3, 4, 5, 6, 7); o1 = ATT_MFMA(vf, pb, o1); }
                }
            }
            const float tot = xor32_sum(lsum); const float inv = 1.0f / (tot + esink);
#pragma unroll
            for (int g4 = 0; g4 < 4; ++g4) {
                v2u w0; w0.x = cvtpk(o0[4 * g4] * inv, o0[4 * g4 + 1] * inv); w0.y = cvtpk(o0[4 * g4 + 2] * inv, o0[4 * g4 + 3] * inv);
                v2u w1; w1.x = cvtpk(o1[4 * g4] * inv, o1[4 * g4 + 1] * inv); w1.y = cvtpk(o1[4 * g4 + 2] * inv, o1[4 * g4 + 3] * inv);
                *(LAS v2u*)(xt + r32 * SWA_XP + (8 * g4 + 4 * h) * 2) = w0; *(LAS v2u*)(xt + r32 * SWA_XP + (32 + 8 * g4 + 4 * h) * 2) = w1;
            }
            LDS_WAIT();
#pragma unroll
            for (int i = 0; i < 4; ++i) *(GAS v4u*)(qrow + (size_t)(8 * i) * LDP) = *(const LAS v4u*)(xt + ((lane >> 3) + 8 * i) * SWA_XP + 16 * (lane & 7));
            LDS_WAIT();
        }
    }
}

constexpr int GM_P = 1088;
__device__ __forceinline__ void gmlp_phase(LAS unsigned char* L, bf16* projp, const bf16* Wb, const float* lng, const float* lnb, const float* bs, int bid, int G, int wave, int lane) {
    const int r32 = lane & 31, h = lane >> 5, blk16 = (lane >> 4) & 1, q4 = (lane & 15) >> 2, p4 = lane & 3;
    float lg[8], lb[8];
    { const f32x4 a = *(const f32x4*)(lng + 8 * lane), b = *(const f32x4*)(lng + 8 * lane + 4), c = *(const f32x4*)(lnb + 8 * lane), d = *(const f32x4*)(lnb + 8 * lane + 4);
      lg[0] = a.x; lg[1] = a.y; lg[2] = a.z; lg[3] = a.w; lg[4] = b.x; lg[5] = b.y; lg[6] = b.z; lg[7] = b.w;
      lb[0] = c.x; lb[1] = c.y; lb[2] = c.z; lb[3] = c.w; lb[4] = d.x; lb[5] = d.y; lb[6] = d.z; lb[7] = d.w; }
    for (int unit = bid; unit < T / 128; unit += G) {
        const int tok0 = unit * 128;
        __syncthreads();
#pragma unroll 1
        for (int i0 = 0; i0 < 16; i0 += 8) {
            v4u w[8]; float sm[8], q[8];
#pragma unroll
            for (int i = 0; i < 8; ++i) w[i] = *(const GAS v4u*)(projp + (size_t)(tok0 + 16 * wave + i0 + i) * LDP + C_VB + 8 * lane);
#pragma unroll
            for (int i = 0; i < 8; ++i) sm[i] = row16_sum(((blo(w[i].x) + bhi(w[i].x)) + (blo(w[i].y) + bhi(w[i].y))) + ((blo(w[i].z) + bhi(w[i].z)) + (blo(w[i].w) + bhi(w[i].w))));
#pragma unroll
            for (int i = 0; i < 8; ++i) sm[i] = xor32_sum(xor16_sum(sm[i])) * (1.f / 512.f);
#pragma unroll
            for (int i = 0; i < 8; ++i) { const float mu = sm[i];
                const float d0 = blo(w[i].x) - mu, d1 = bhi(w[i].x) - mu, d2 = blo(w[i].y) - mu, d3 = bhi(w[i].y) - mu, d4 = blo(w[i].z) - mu, d5 = bhi(w[i].z) - mu, d6 = blo(w[i].w) - mu, d7 = bhi(w[i].w) - mu;
                q[i] = row16_sum(((d0 * d0 + d1 * d1) + (d2 * d2 + d3 * d3)) + ((d4 * d4 + d5 * d5) + (d6 * d6 + d7 * d7))); }
#pragma unroll
            for (int i = 0; i < 8; ++i) q[i] = xor32_sum(xor16_sum(q[i]));
#pragma unroll
            for (int i = 0; i < 8; ++i) { const float mu = sm[i], rstd = __builtin_amdgcn_rsqf(q[i] * (1.f / 512.f) + EPS);
                v4u o; o.x = cvtpk((blo(w[i].x) - mu) * rstd * lg[0] + lb[0], (bhi(w[i].x) - mu) * rstd * lg[1] + lb[1]); o.y = cvtpk((blo(w[i].y) - mu) * rstd * lg[2] + lb[2], (bhi(w[i].y) - mu) * rstd * lg[3] + lb[3]);
                o.z = cvtpk((blo(w[i].z) - mu) * rstd * lg[4] + lb[4], (bhi(w[i].z) - mu) * rstd * lg[5] + lb[5]); o.w = cvtpk((blo(w[i].w) - mu) * rstd * lg[6] + lb[6], (bhi(w[i].w) - mu) * rstd * lg[7] + lb[7]);
                *(LAS v4u*)(L + (16 * wave + i0 + i) * GM_P + lane * 16) = o; }
        }
        __syncthreads();
        const int g = wave >> 1, th = wave & 1;
        f32x16 acc[4][2];
#pragma unroll
        for (int ct = 0; ct < 4; ++ct)
#pragma unroll
            for (int tt = 0; tt < 2; ++tt)
#pragma unroll
                for (int r = 0; r < 16; ++r) acc[ct][tt][r] = 0.f;
        const int b0 = th, b1 = 3 - th, n0 = 2 * b0 + 2, n1 = 2 * b1 + 2;
        const bf16* wrow0 = Wb + (size_t)(g * 128 + 32 * b0 + r32) * 128 + 8 * h; const bf16* wrow1 = Wb + (size_t)(g * 128 + 32 * b1 + r32) * 128 + 8 * h;
        bf16x8 bn0 = *(const GAS bf16x8*)wrow0, bn1 = *(const GAS bf16x8*)wrow1;
#pragma unroll 1
        for (int ks = 0; ks < n1; ++ks) {
            bf16x8 af[4];
            const bf16x8 bc0 = bn0, bc1 = bn1;
            if (ks + 1 < n0) bn0 = *(const GAS bf16x8*)(wrow0 + 16 * (ks + 1));
            if (ks + 1 < n1) bn1 = *(const GAS bf16x8*)(wrow1 + 16 * (ks + 1));
#pragma unroll
            for (int ct = 0; ct < 4; ++ct) { const LAS unsigned char* vp = L + (16 * ks + 8 * h + q4) * GM_P + (128 * g + 32 * ct + 16 * blk16 + 4 * p4) * 2;
                const s16x4 lo = vtr(vp), hi = vtr(vp + 4 * GM_P); af[ct] = __builtin_shufflevector(lo, hi, 0, 1, 2, 3, 4, 5, 6, 7); }
            if (ks < n0) {
#pragma unroll
                for (int ct = 0; ct < 4; ++ct) acc[ct][0] = ATT_MFMA(af[ct], bc0, acc[ct][0]); }
#pragma unroll
            for (int ct = 0; ct < 4; ++ct) acc[ct][1] = ATT_MFMA(af[ct], bc1, acc[ct][1]);
        }
#pragma unroll
        for (int tt = 0; tt < 2; ++tt) { const int t = 32 * (tt ? b1 : b0) + r32; const float bsv = bs[g * 128 + t];
            bf16* urow = projp + (size_t)(tok0 + t) * LDP + C_U + 128 * g + 8 * h;
#pragma unroll
            for (int ct = 0; ct < 4; ++ct)
#pragma unroll
                for (int gp = 0; gp < 2; ++gp) { bf16* up = urow + 32 * ct + 16 * gp; v4u uw = *(const GAS v4u*)up;
                    uw = pair32v(uw);
                    const int g0 = 2 * gp, g1 = 2 * gp + 1;
                    v4u o; o.x = cvtpk(blo(uw.x) * (acc[ct][tt][4 * g0] + bsv), bhi(uw.x) * (acc[ct][tt][4 * g0 + 1] + bsv));
                    o.y = cvtpk(blo(uw.y) * (acc[ct][tt][4 * g0 + 2] + bsv), bhi(uw.y) * (acc[ct][tt][4 * g0 + 3] + bsv));
                    o.z = cvtpk(blo(uw.z) * (acc[ct][tt][4 * g1] + bsv), bhi(uw.z) * (acc[ct][tt][4 * g1 + 1] + bsv));
                    o.w = cvtpk(blo(uw.w) * (acc[ct][tt][4 * g1 + 2] + bsv), bhi(uw.w) * (acc[ct][tt][4 * g1 + 3] + bsv));
                    *(GAS v4u*)up = pair32v(o); } }
    }
}

constexpr int XA_K_OFF = 0, XA_V_OFF = 65536;
__device__ __forceinline__ unsigned off_b(unsigned row, unsigned ch) { return 256u * row + 16u * (ch ^ (((row & 3u) << 2) | ((row >> 2) & 3u))); }
__device__ __forceinline__ void xattn_phase(LAS unsigned char* L, bf16* projp, const bf16* kvp, const float* cqg, const float* ckg, int bid, int G, int wave, int lane) {
    const int tid = wave * 64 + lane, r32 = lane & 31, h = lane >> 5, blk16 = (lane >> 4) & 1, q4 = (lane & 15) >> 2, p4 = lane & 3;
    const int fch = tid & 15;
    float gg[8];
#pragma unroll
    for (int i = 0; i < 8; ++i) gg[i] = cqg[8 * fch + i] * ckg[8 * fch + i] * (0.08838834764831845f * LOG2E);
    const float mq = wave_max(fmaxf(fabsf(cqg[lane]), fabsf(cqg[lane + 64]))), mk = wave_max(fmaxf(fabsf(ckg[lane]), fabsf(ckg[lane + 64])));
    const float m2 = 11.313708499f * mq * mk * LOG2E;
    for (int unit = bid; unit < 256; unit += G) {
        const int qh = unit & 1, hd = (unit >> 1) & 3, b = unit >> 3;
        __syncthreads();
        {   v4u kx[8], vx[8];
#pragma unroll
            for (int it = 0; it < 8; ++it) { const bf16* src = kvp + (size_t)(b * MEM + (tid >> 4) + 32 * it) * D + 128 * hd + 8 * fch; kx[it] = *(const GAS v4u*)src; vx[it] = *(const GAS v4u*)(src + 512); }
#pragma unroll
            for (int it = 0; it < 8; ++it) { const int row = (tid >> 4) + 32 * it;
                float k[8] = {blo(kx[it].x), bhi(kx[it].x), blo(kx[it].y), bhi(kx[it].y), blo(kx[it].z), bhi(kx[it].z), blo(kx[it].w), bhi(kx[it].w)};
                float ss = 0.f;
#pragma unroll
                for (int e = 0; e < 8; ++e) ss += k[e] * k[e];
                ss = row16_sum(ss);
                const float rstd = __builtin_amdgcn_rsqf(ss * (1.f / 128.f) + EPS);
                v4u ko; ko.x = cvtpk(k[0] * rstd * gg[0], k[1] * rstd * gg[1]); ko.y = cvtpk(k[2] * rstd * gg[2], k[3] * rstd * gg[3]);
                ko.z = cvtpk(k[4] * rstd * gg[4], k[5] * rstd * gg[5]); ko.w = cvtpk(k[6] * rstd * gg[6], k[7] * rstd * gg[7]);
                const unsigned o = off_b((unsigned)row, (unsigned)fch);
                *(LAS v4u*)(L + XA_K_OFF + o) = ko; *(LAS v4u*)(L + XA_V_OFF + o) = vx[it]; } }
        bf16* qrow0 = projp + (size_t)(b * SEQ + 1024 * qh + 32 * wave + r32) * LDP + C_QC + 128 * hd + 8 * h;
        v4u qn[8];
#pragma unroll
        for (int ks = 0; ks < 8; ++ks) qn[ks] = *(const GAS v4u*)(qrow0 + 16 * ks);
        __syncthreads();
#pragma unroll 1
        for (int qt = 0; qt < 4; ++qt) {
            bf16* qrow = qrow0 + (size_t)(256 * qt) * LDP;
            bf16x8 qf[8]; float ss = 0.f;
#pragma unroll
            for (int ks = 0; ks < 8; ++ks) { const v4u w = qn[ks]; qf[ks] = __builtin_bit_cast(bf16x8, w);
                ss += (blo(w.x) * blo(w.x) + bhi(w.x) * bhi(w.x)) + (blo(w.y) * blo(w.y) + bhi(w.y) * bhi(w.y)) + (blo(w.z) * blo(w.z) + bhi(w.z) * bhi(w.z)) + (blo(w.w) * blo(w.w) + bhi(w.w) * bhi(w.w)); }
            if (qt < 3) {
#pragma unroll
                for (int ks = 0; ks < 8; ++ks) qn[ks] = *(const GAS v4u*)(qrow + (size_t)256 * LDP + 16 * ks); }
            ss = xor32_sum(ss);
            const float rq = __builtin_amdgcn_rsqf(ss * (1.f / 128.f) + EPS);
            f32x16 o[4];
#pragma unroll
            for (int dt = 0; dt < 4; ++dt)
#pragma unroll
                for (int r = 0; r < 16; ++r) o[dt][r] = 0.f;
            float lsum = 0.f;
#pragma unroll 1
            for (int kt = 0; kt < 8; ++kt) {
                f32x16 s;
#pragma unroll
                for (int r = 0; r < 16; ++r) s[r] = 0.f;
#pragma unroll
                for (int ks = 0; ks < 8; ++ks) { const bf16x8 kf = *(const LAS bf16x8*)(L + XA_K_OFF + off_b((unsigned)(32 * kt + r32), (unsigned)(2 * ks + h))); s = ATT_MFMA(kf, qf[ks], s); }
                float p[16];
#pragma unroll
                for (int r = 0; r < 16; ++r) { p[r] = __builtin_amdgcn_exp2f(s[r] * rq - m2); lsum += p[r]; }
#pragma unroll
                for (int s2 = 0; s2 < 2; ++s2) {
                    const bf16x8 pb = pack8(p[8 * s2], p[8 * s2 + 1], p[8 * s2 + 2], p[8 * s2 + 3], p[8 * s2 + 4], p[8 * s2 + 5], p[8 * s2 + 6], p[8 * s2 + 7]);
                    const unsigned r0 = (unsigned)(32 * kt + 16 * s2 + 4 * h + q4);
#pragma unroll
                    for (int dt = 0; dt < 4; ++dt) {
                        const unsigned ch = (unsigned)(4 * dt + 2 * blk16 + (p4 >> 1));
                        const s16x4 lo = vtr(L + XA_V_OFF + off_b(r0, ch) + 8 * (p4 & 1)), hi = vtr(L + XA_V_OFF + off_b(r0 + 8u, ch) + 8 * (p4 & 1));
                        const bf16x8 vf = __builtin_shufflevector(lo, hi, 0, 1, 2, 3, 4, 5, 6, 7); o[dt] = ATT_MFMA(vf, pb, o[dt]); }
                }
            }
            const float inv = 1.0f / xor32_sum(lsum);
#pragma unroll
            for (int dt = 0; dt < 4; ++dt)
#pragma unroll
                for (int gp = 0; gp < 2; ++gp) { const int g0 = 2 * gp, g1 = 2 * gp + 1;
                    v4u w; w.x = cvtpk(o[dt][4 * g0] * inv, o[dt][4 * g0 + 1] * inv); w.y = cvtpk(o[dt][4 * g0 + 2] * inv, o[dt][4 * g0 + 3] * inv);
                    w.z = cvtpk(o[dt][4 * g1] * inv, o[dt][4 * g1 + 1] * inv); w.w = cvtpk(o[dt][4 * g1 + 2] * inv, o[dt][4 * g1 + 3] * inv);
                    *(GAS v4u*)(qrow - 8 * h + 32 * dt + 16 * gp + 8 * h) = pair32v(w); }
        }
    }
}
}

constexpr int NPHASE = 11;
__global__ void __launch_bounds__(NTHR, 2) fwd(Args args) {
    extern __shared__ __attribute__((aligned(16))) unsigned char lds[];
    LAS unsigned char* L = (LAS unsigned char*)lds;
    volatile LAS unsigned* MISC = (volatile LAS unsigned*)(L + MISC_OFF);
    const int wave_s = __builtin_amdgcn_readfirstlane((int)threadIdx.x >> 6);
    for (int u = threadIdx.x; u < (LDS_BYTES - LDSCTL_OFF) / 4; u += NTHR) ((LAS unsigned*)(L + LDSCTL_OFF))[u] = 0u;
    __syncthreads();
#define LANE_ID ((int)__builtin_amdgcn_mbcnt_hi(~0u, __builtin_amdgcn_mbcnt_lo(~0u, 0u)))
#if MK_FUSED
    XcdBarrier bar = xcd_barrier_post((unsigned*)(args.ws + WS_CTL) + CW_BAR, MISC + 8, wave_s == 0 && LANE_ID == 0);
#define GRID_BAR() xcd_barrier(bar, wave_s == 0 && LANE_ID == 0)
#else
    (void)MISC;
#define GRID_BAR() do {} while (0)
#endif
    const int lo = args.ph_lo, hi = args.ph_hi;
#define IN(k) (lo <= (k) && (k) < hi)
#if PROBE_MASK
#define STAMP(k) do { if (blockIdx.x == 0 && wave_s == 0 && LANE_ID == 0) ((LAS unsigned*)(L + LDSCTL_OFF + 640))[(k) + 1] = (unsigned)__builtin_amdgcn_s_memrealtime(); } while (0)
#define STAMPX(i) do { if (blockIdx.x == 0 && wave_s == 0 && LANE_ID == 0) ((LAS unsigned*)(L + LDSCTL_OFF + 640))[16 + (i)] = (unsigned)__builtin_amdgcn_s_memrealtime(); } while (0)
#else
#define STAMP(k) do {} while (0)
#define STAMPX(i) do {} while (0)
#endif
#define SEAM(k) do { if (IN(k) && IN((k) + 1)) GRID_BAR(); STAMP(k); } while (0)
    STAMP(-1);
#define PV \
    int wave = wave_s; asm volatile("" : "+s"(wave)); int bid = blockIdx.x; asm volatile("" : "+s"(bid)); \
    const int lane = LANE_ID, tid = wave * 64 + lane; \
    const int G = gridDim.x, gw = bid * NWAVES + wave, NGW = G * NWAVES, gtid = bid * NTHR + tid, NT = G * NTHR; \
    GAS unsigned char* ws = (GAS unsigned char*)args.ws; asm volatile("" : "+s"(ws));     \
    gu32* ctl = (gu32*)(ws + WS_CTL); \
    LAS float* scr = (LAS float*)(L + RING_OFF + wave * 16384); \
    (void)lane; (void)tid; (void)bid; (void)gw; (void)NGW; (void)gtid; (void)NT; (void)ctl; (void)scr; (void)G;
#define Win_t ((bf16*)(ws + WS_WIN))
#define Wo_t ((bf16*)(ws + WS_WO))
#define Wmkv_t ((bf16*)(ws + WS_WMKV))
#define Wout_t ((bf16*)(ws + WS_WOUT))
#define Hb ((bf16*)(ws + WS_H))
#define proj ((bf16*)(ws + WS_PROJ))
#define memn ((bf16*)(ws + WS_MEMN))
#define kv ((bf16*)(ws + WS_KV))
#define rope ((float2*)(ws + WS_ROPE))
#define Wgu_t ((bf16*)(ws + WS_WGU))
#define Wd_t ((bf16*)(ws + WS_WD))
#define ybuf ((bf16*)(ws + WS_Y))
#define act ((bf16*)(ws + WS_ACT))
#define topk_idx ((int*)(ws + WS_META + MT_IDX))
#define topk_gate ((float*)(ws + WS_META + MT_GATE))
#define slot_of ((int*)(ws + WS_META + MT_SASG))
#define slot_tok ((int*)(ws + WS_META + MT_STOK))
#define slot_gate ((float*)(ws + WS_META + MT_SGATE))
#define tile_e ((int*)(ws + WS_META + MT_TILEE))
#define Wsb ((bf16*)(ws + WS_META + MT_WSB))
#define Cmat ((int*)(ws + WS_META + MT_CMAT))
#define Rwp ((float*)(ws + WS_META + MT_RWP))
#define rstd_tok ((float*)(ws + WS_META + MT_RSTD))
#define slot_rstd ((float*)(ws + WS_SRSTD))
#define X8 ((unsigned char*)(ws + WS_X8))
#define H8 ((unsigned char*)args.out)
#define Wg8 ((unsigned char*)args.out + (size_t)T * D)
#define x1b ((bf16*)(ws + WS_X1B))

    if (IN(0)) { PV
        const float* x = args.in[I_X]; (void)x;
        {
            const float* Wi = args.in[I_WIN]; const float* Wa = args.in[I_WOA]; const float* Wb = args.in[I_WOB]; const float* Wc = args.in[I_WOC]; const float* Wm = args.in[I_WMKV]; const float* Wu = args.in[I_WOUT];
            bf16* Oi = Win_t; bf16* Oo = Wo_t; bf16* Om = Wmkv_t; bf16* Ou = Wout_t;
            constexpr int NRB = C_G / 32;
            constexpr int N0 = (D / 64) * NRB, N1 = N0 + 16 * 32, N2 = N1 + 8 * 32, N3 = N2 + 8 * 32, N4 = N3 + 16 * 32, N5 = N4 + 16 * 32;
            tr_range(N5, [=](int it) {
                if (it < N0) { const int kb = it / NRB, rb = it % NRB; return TrItem{Wi, DIN, 64 * kb, win_srccol(32 * rb), Oi, D, 32 * rb, 0, nullptr}; }
                if (it < N1) { const int r = it - N0; return TrItem{Wa, D, 64 * (r >> 5), 32 * (r & 31), Oo, 2048, 32 * (r & 31), 0, nullptr}; }
                if (it < N2) { const int r = it - N1; return TrItem{Wb, D, 64 * (r >> 5), 32 * (r & 31), Oo, 2048, 32 * (r & 31), 1024, nullptr}; }
                if (it < N3) { const int r = it - N2; return TrItem{Wc, D, 64 * (r >> 5), 32 * (r & 31), Oo, 2048, 32 * (r & 31), 1536, nullptr}; }
                if (it < N4) { const int r = it - N3; return TrItem{Wm, D, 64 * (r >> 5), 32 * (r & 31), Om, D, 32 * (r & 31), 0, nullptr}; }
                const int r = it - N4; return TrItem{Wu, D, 64 * (r >> 5), 32 * (r & 31), Ou, D, 32 * (r & 31), 0, nullptr}; }, gw, NGW, scr, lane);
        }
        {
            const float* Wi = args.in[I_WIN]; unsigned char* O = Wg8; constexpr int nrb = (DIN - C_G) / 32;
            tr_range8((D / 64) * nrb, [=](int it) { const int kb = it / nrb, rb = it % nrb; return TrItem{Wi, DIN, 64 * kb, C_G + 32 * rb, (bf16*)O, D, 32 * rb, 0, nullptr}; }, gw, NGW, scr, lane, WSCALE);
        }
        STAMPX(8);
        for (int i = gtid; i < D * 32; i += NT) { const int k = i >> 5, e = i & 31; Rwp[(k >> 2) * 128 + e * 4 + (k & 3)] = args.in[I_FFN_G][k] * args.in[I_RW][i]; }
        { const int* pos = (const int*)args.in[I_POS];
          for (int i = gtid; i < T * 32; i += NT) { const int t = i >> 5, f = i & 31;
              const float inv = powf(10000.0f, -(float)(2 * f) / 64.0f); const float ang = (float)pos[t] * inv;
              float sn, cs; sincosf(ang, &sn, &cs); rope[i] = make_float2(cs, sn); } }
        for (int i = gtid; i < 4 * 128 * 128; i += NT) { const int tt = (i >> 7) & 127, sp = i & 127; Wsb[i] = (bf16)(sp <= tt ? f2bf(args.in[I_WS][i]) : 0u); }
        STAMPX(9);
        {
            f32x4 gg[4];
#pragma unroll
            for (int j = 0; j < 4; ++j) gg[j] = *((const GAS f32x4*)args.in[I_ATTN_G] + 2 * lane + 128 * (j >> 1) + (j & 1));
            f32x4 va[16], vb[16];
            int m = gw;
#define ROWS4_LOAD(v, mm) do { const GAS f32x4* xr_ = (const GAS f32x4*)(x + (size_t)(mm) * 4 * D) + 2 * lane; \
                _Pragma("unroll") for (int j = 0; j < 16; ++j) v[j] = xr_[256 * (j >> 2) + 128 * ((j >> 1) & 1) + (j & 1)]; } while (0)
            if (m < T / 4) ROWS4_LOAD(va, m);
#define ROWS4_FINISH(v, mm) do { float s_[4]; \
                _Pragma("unroll") for (int r = 0; r < 4; ++r) { float a_ = 0.f; \
                    _Pragma("unroll") for (int j = 0; j < 4; ++j) a_ += (v[4 * r + j].x * v[4 * r + j].x + v[4 * r + j].y * v[4 * r + j].y) + (v[4 * r + j].z * v[4 * r + j].z + v[4 * r + j].w * v[4 * r + j].w); \
                    s_[r] = row16_sum(a_); } \
                _Pragma("unroll") for (int r = 0; r < 4; ++r) s_[r] = xor32_sum(xor16_sum(s_[r])); \
                GAS v4u* o16_ = (GAS v4u*)(Hb + (size_t)(mm) * 4 * D) + lane; \
                _Pragma("unroll") for (int r = 0; r < 4; ++r) { const float rs_ = __builtin_amdgcn_rsqf(s_[r] * (1.f / 1024.f) + EPS); \
                    _Pragma("unroll") for (int jj = 0; jj < 2; ++jj) { const f32x4 a_ = v[4 * r + 2 * jj], b_ = v[4 * r + 2 * jj + 1]; \
                        const float h0_ = a_.x * rs_ * gg[2 * jj].x, h1_ = a_.y * rs_ * gg[2 * jj].y, h2_ = a_.z * rs_ * gg[2 * jj].z, h3_ = a_.w * rs_ * gg[2 * jj].w; \
                        const float h4_ = b_.x * rs_ * gg[2 * jj + 1].x, h5_ = b_.y * rs_ * gg[2 * jj + 1].y, h6_ = b_.z * rs_ * gg[2 * jj + 1].z, h7_ = b_.w * rs_ * gg[2 * jj + 1].w; \
                        v4u o_; o_.x = pk2(h0_, h1_); o_.y = pk2(h2_, h3_); o_.z = pk2(h4_, h5_); o_.w = pk2(h6_, h7_); o16_[128 * r + 64 * jj] = o_; \
                        v2u q_; q_.x = pk4_fp8(h0_, h1_, h2_, h3_); q_.y = pk4_fp8(h4_, h5_, h6_, h7_); \
                        ((GAS v2u*)(H8 + ((size_t)(mm) * 4 + r) * D))[lane + 64 * jj] = q_; } } } while (0)
            for (; m < T / 4; m += 2 * NGW) {
                const int m2 = m + NGW; const bool two = m2 < T / 4;
                if (two) ROWS4_LOAD(vb, m2);
                ROWS4_FINISH(va, m);
                const int m3 = m + 2 * NGW;
                if (m3 < T / 4) ROWS4_LOAD(va, m3);
                if (two) ROWS4_FINISH(vb, m2);
            }
#undef ROWS4_FINISH
#undef ROWS4_LOAD
        }
        STAMPX(10);
        for (int m = gw; m < TM; m += NGW) rms_row_to_bf16(args.in[I_MEM] + (size_t)m * D, args.in[I_MEM_G], memn + (size_t)m * D, lane);
    }
    SEAM(0);
    if (IN(1)) { PV
        { pg8::Gemm g{Hb, Win_t, D, D, D}; pg8::StaticOrder S; S.init(T, C_G, G, bid);
          pg8::EpiProj E{proj, LDP, (const float*)rope, args.in[I_AQG], args.in[I_AKG], args.in[I_BGATES], EPS, C_Q, C_K, C_V, C_G, 0, 1.0f};
          pg8::gemm_phase<pg8::EpiProj, pg8::StaticOrder>(L + RING_OFF, g, S, E, wave); }
        { pg8::Gemm g{(const bf16*)H8, (const bf16*)Wg8, D / 2, D / 2, D / 2}; pg8::StaticOrder S; S.init(T, DIN - C_G, G, bid);
          pg8::EpiProj E{proj, LDP, (const float*)rope, args.in[I_AQG], args.in[I_AKG], args.in[I_BGATES], EPS, C_Q, C_K, C_V, C_G, C_G / 256, 1.0f / WSCALE};
          pg8::gemm_phase<pg8::EpiProj, pg8::StaticOrder, true>(L + RING_OFF, g, S, E, wave); }
        { pg8::Gemm g{memn, Wmkv_t, D, D, D}; pg8::StaticOrder S; S.init(TM, D, G, bid); pg8::EpiBf16 E{kv, D};
          pg8::gemm_phase<pg8::EpiBf16, pg8::StaticOrder>(L + RING_OFF, g, S, E, wave); }
        if (G == 256 && bid >= 128) { const float* W = args.in[I_WD]; unsigned char* O = (unsigned char*)Wd_t; constexpr int nrb = D / 32, per = (D / 64) * nrb;
          tr_range8(WD_P1_ITEMS, [=](int it) { const int e = it / per, r0 = it % per, kb = r0 / nrb, rb2 = r0 % nrb;
              return TrItem{W + (size_t)e * D * D, D, 64 * kb, 32 * rb2, (bf16*)(O + (size_t)e * D * D), D, 32 * rb2, 0, nullptr}; }, (bid - 128) * NWAVES + wave, 128 * NWAVES, scr, lane, WSCALE); }
    }
    if (IN(1) && IN(3)) GRID_BAR();
    STAMP(1); STAMP(2);
    if (IN(3)) { PV
        STAMPX(4);
        att::swa_phase(L + RING_OFF, proj, args.in[I_SINKS], args.in[I_AQG], args.in[I_AKG], bid, G, wave, lane);
        __syncthreads();
        STAMPX(5);
        att::gmlp_phase(L + RING_OFF, proj, Wsb, args.in[I_LNG], args.in[I_LNB], args.in[I_BS], bid, G, wave, lane);
        __syncthreads();
        STAMPX(6);
        att::xattn_phase(L + RING_OFF, proj, kv, args.in[I_CQG], args.in[I_CKG], bid, G, wave, lane);
        __syncthreads();
    }
    SEAM(3);
    if (IN(4)) { PV
        pg8::StaticOrder S; S.init(T, D, G, bid);
        pg8::Gemm g{proj + C_Q, Wo_t, 2048, LDP, 2048}; pg8::EpiMergeK E{Hb, D, (const unsigned char*)(proj + C_G), LDP * 2};
        pg8::gemm_phase<pg8::EpiMergeK, pg8::StaticOrder>(L + RING_OFF, g, S, E, wave);
    }
    SEAM(4);
    if (IN(5)) { PV
        const float* x = args.in[I_X];
        pg8::Gemm g{Hb, Wout_t, D, D, D}; pg8::StaticOrder S; S.init(T, D, G, bid); pg8::EpiResF32 E{x1b, x, X8, D};
        pg8::gemm_phase<pg8::EpiResF32, pg8::StaticOrder>(L + RING_OFF, g, S, E, wave);
    }
    SEAM(5);
    if (IN(6)) { PV
        const float* rb = args.in[I_RB]; const float* fg = args.in[I_FFN_G];
        LAS unsigned* hist = (LAS unsigned*)(L + LDSCTL_OFF + 512);
        const int r32 = lane & 31, hh = lane >> 5;
        STAMPX(0);
        constexpr int RW = 4;
        bool conv_done = false;
        for (int vb = bid; vb < T / 256; vb += G) {
            __syncthreads();
            if (tid < 32) hist[tid] = 0u;
            __syncthreads();
            if (wave < RW) {
#pragma unroll 1
            for (int tl = 0; tl < 8 / RW; ++tl) {
            const int tok0 = vb * 256 + (wave * (8 / RW) + tl) * 32;
            att::f32x16 acc;
#pragma unroll
            for (int r = 0; r < 16; ++r) acc[r] = 0.f;
            float ss = 0.f;
            const bf16* xp = x1b + (size_t)(tok0 + r32) * D + 16 * hh;
            const float* wg = Rwp + (size_t)(4 * hh) * 128 + r32 * 4;
#define RT_LOAD(xs, ws_, it) do { _Pragma("unroll") for (int q = 0; q < 4; ++q) { xs[q] = *(const GAS v2u*)(xp + 32 * (it) + 4 * q); ws_[q] = *(const GAS f32x4*)(wg + (size_t)(8 * (it) + q) * 128); } } while (0)
#define RT_COMP(xs, ws_, it) do { _Pragma("unroll") for (int q = 0; q < 4; ++q) { const f32x4 wa = ws_[q]; \
                    const f32x4 xv = (f32x4){blo(xs[q].x), bhi(xs[q].x), blo(xs[q].y), bhi(xs[q].y)}; \
                    ss += (xv.x * xv.x + xv.y * xv.y) + (xv.z * xv.z + xv.w * xv.w); \
                    acc = __builtin_amdgcn_mfma_f32_32x32x2f32(wa.x, xv.x, acc, 0, 0, 0); acc = __builtin_amdgcn_mfma_f32_32x32x2f32(wa.y, xv.y, acc, 0, 0, 0); \
                    acc = __builtin_amdgcn_mfma_f32_32x32x2f32(wa.z, xv.z, acc, 0, 0, 0); acc = __builtin_amdgcn_mfma_f32_32x32x2f32(wa.w, xv.w, acc, 0, 0, 0); } } while (0)
            v2u x0[4], x1[4], x2[4]; f32x4 w0[4], w1[4], w2[4];
            RT_LOAD(x0, w0, 0); RT_LOAD(x1, w1, 1);
#pragma unroll 1
            for (int it = 0; it < 30; it += 3) {
                RT_LOAD(x2, w2, it + 2); RT_COMP(x0, w0, it);
                RT_LOAD(x0, w0, it + 3); RT_COMP(x1, w1, it + 1);
                RT_LOAD(x1, w1, it + 4); RT_COMP(x2, w2, it + 2);
            }
            RT_COMP(x0, w0, 30); RT_COMP(x1, w1, 31);
#undef RT_LOAD
#undef RT_COMP
            ss = xor32_sum(ss);
            const float rstd = 1.0f / sqrtf(ss * (1.f / 1024.f) + EPS);
            float v[16];
#pragma unroll
            for (int r = 0; r < 16; ++r) v[r] = acc[r] * rstd + rb[att::crow(r, hh)];
            float cv[8]; int ci[8];
#pragma unroll
            for (int k = 0; k < 4; ++k) { float best = -INFINITY; int bi = 99;
#pragma unroll
                for (int r = 0; r < 16; ++r) if (v[r] > best) { best = v[r]; bi = att::crow(r, hh); }
                cv[k] = best; ci[k] = bi;
#pragma unroll
                for (int r = 0; r < 16; ++r) v[r] = (att::crow(r, hh) == bi) ? -INFINITY : v[r]; }
#pragma unroll
            for (int k = 0; k < 4; ++k) { cv[4 + k] = __builtin_bit_cast(float, xor32_get(__builtin_bit_cast(unsigned, cv[k]), hh != 0)); ci[4 + k] = (int)xor32_get((unsigned)ci[k], hh != 0); }
            float bv[4]; int be[4];
#pragma unroll
            for (int k = 0; k < 4; ++k) { float best = -INFINITY; int bi = 99;
#pragma unroll
                for (int c = 0; c < 8; ++c) if (cv[c] > best || (cv[c] == best && ci[c] < bi)) { best = cv[c]; bi = ci[c]; }
                bv[k] = best; be[k] = bi;
#pragma unroll
                for (int c = 0; c < 8; ++c) cv[c] = (ci[c] == bi) ? -INFINITY : cv[c]; }
            const float p1 = expf(bv[1] - bv[0]), p2 = expf(bv[2] - bv[0]), p3 = expf(bv[3] - bv[0]); const float inv = 1.0f / (1.0f + p1 + p2 + p3);
            if (hh == 0) {
                int4 iw; float4 gw4;
                iw.x = be[0] | (int)(__hip_atomic_fetch_add(hist + be[0], 1u, __ATOMIC_RELAXED, __HIP_MEMORY_SCOPE_WORKGROUP) << 8);
                iw.y = be[1] | (int)(__hip_atomic_fetch_add(hist + be[1], 1u, __ATOMIC_RELAXED, __HIP_MEMORY_SCOPE_WORKGROUP) << 8);
                iw.z = be[2] | (int)(__hip_atomic_fetch_add(hist + be[2], 1u, __ATOMIC_RELAXED, __HIP_MEMORY_SCOPE_WORKGROUP) << 8);
                iw.w = be[3] | (int)(__hip_atomic_fetch_add(hist + be[3], 1u, __ATOMIC_RELAXED, __HIP_MEMORY_SCOPE_WORKGROUP) << 8);
                gw4.x = inv; gw4.y = p1 * inv; gw4.z = p2 * inv; gw4.w = p3 * inv;
                *(int4*)(topk_idx + (size_t)(tok0 + r32) * 4) = iw; *(float4*)(topk_gate + (size_t)(tok0 + r32) * 4) = gw4; }
            if (hh == 0) rstd_tok[tok0 + r32] = rstd;
            }
            } else if (!conv_done) {
                const int cgw = bid * (NWAVES - RW) + (wave - RW), cngw = G * (NWAVES - RW);
        { const float* W = args.in[I_WGU]; unsigned char* O = (unsigned char*)Wgu_t; constexpr int nrb = 2048 / 32, per = (D / 64) * nrb;
          tr_range8(NEXP * per, [=](int it) { const int e = it / per, r0 = it % per, kb = r0 / nrb, rb2 = r0 % nrb; const int r = 32 * rb2, j = r >> 8, rr = r & 255;
              const int sc = rr < 128 ? 128 * j + rr : 1024 + 128 * j + (rr - 128);
              return TrItem{W + (size_t)e * D * 2048, 2048, 64 * kb, sc, (bf16*)(O + (size_t)e * 2048 * D), D, r, 0, fg}; }, cgw, cngw, scr, lane, WSCALE); }
        { const float* W = args.in[I_WD]; unsigned char* O = (unsigned char*)Wd_t; constexpr int nrb = D / 32, per = (D / 64) * nrb; const int first = (G == 256) ? WD_P1_ITEMS : 0;
          tr_range8(NEXP * per - first, [=](int it0) { const int it = it0 + first; const int e = it / per, r0 = it % per, kb = r0 / nrb, rb2 = r0 % nrb;
              return TrItem{W + (size_t)e * D * D, D, 64 * kb, 32 * rb2, (bf16*)(O + (size_t)e * D * D), D, 32 * rb2, 0, nullptr}; }, cgw, cngw, scr, lane, WSCALE); }
            }
            conv_done = true;
            if (vb == 0) STAMPX(3);
            __syncthreads();
            if (tid < 32) Cmat[vb * 32 + tid] = (int)hist[tid];
        }
        STAMPX(1);
    }
    SEAM(6);
    if (IN(7)) { PV
        LAS int* psum = (LAS int*)(L + RING_OFF);
        LAS int* tot = psum + 512;
        LAS int* startv = tot + 32;
        LAS int* basev = startv + 32;
        LAS int* ntl = basev + 32;
        for (int vb = bid; vb < T / 256; vb += G) {
            __syncthreads();
            { const int e = tid & 31, part = tid >> 5; int ps = 0;
#pragma unroll 4
              for (int i = 0; i < 16; ++i) ps += Cmat[(part * 16 + i) * 32 + e];
              psum[part * 32 + e] = ps; }
            __syncthreads();
            if (tid < 32) { int tt = 0;
#pragma unroll
                for (int p = 0; p < 16; ++p) tt += psum[p * 32 + tid];
                tot[tid] = tt; }
            __syncthreads();
            if (tid == 0) { int row = 0; for (int e = 0; e < 32; ++e) { startv[e] = row; row += (tot[e] + 255) & ~255; } ntl[0] = row >> 8; }
            __syncthreads();
            const int part = vb >> 4;
            if (tid < 32) { int bs = startv[tid];
                for (int p = 0; p < part; ++p) bs += psum[p * 32 + tid];
                for (int v2 = part * 16; v2 < vb; ++v2) bs += Cmat[v2 * 32 + tid];
                basev[tid] = bs; }
            __syncthreads();
            for (int i = tid; i < 1024; i += NTHR) { const int a = vb * 1024 + i; const int v = topk_idx[a]; const int e = v & 255, rank = v >> 8;
                const int slot = basev[e] + rank;
                slot_tok[slot] = a >> 2; slot_of[a] = slot; slot_rstd[slot] = rstd_tok[a >> 2]; }
            if (vb < 32) { const int e = vb; const int t0 = tot[e], st = startv[e], pd = ((t0 + 255) & ~255) - t0;
                if (tid < pd) { slot_tok[st + t0 + tid] = -1; slot_rstd[st + t0 + tid] = 0.f; } }
            if (vb == 32) {
                if (tid < 32) { const int nt = (tot[tid] + 255) >> 8, first = startv[tid] >> 8; for (int i = 0; i < nt; ++i) tile_e[first + i] = tid; }
                if (tid == 0) ((unsigned*)(ctl + CW_NTILE))[0] = (unsigned)ntl[0]; }
        }
    }
    SEAM(7);
#define NTILE_ALL ((int)__hip_atomic_load((unsigned*)(ctl + CW_NTILE), RLX_AGENT))
    if (IN(8)) { PV const int ntile = NTILE_ALL;
        pg8::Gemm g{(const bf16*)X8, Wgu_t, D / 2, D / 2, D / 2};
        pg8::GroupedOrder S{tile_e, ntile, 8, G, bid}; pg8::EpiSwiglu8 E{(unsigned char*)act, args.in[I_BGU], slot_rstd, 1.0f / WSCALE};
        pg8::gemm_phase_gather<pg8::EpiSwiglu8, pg8::GroupedOrder, true>(L + RING_OFF, g, S, E, wave, slot_tok);
    }
    SEAM(8);
    if (IN(9)) { PV const int ntile = NTILE_ALL;
        pg8::Gemm g{act, Wd_t, D / 2, D / 2, D / 2}; pg8::GroupedOrder S{tile_e, ntile, 4, G, bid}; static_assert(YSCALE == 16.0f, "EpiDown scales the bias by 16"); pg8::EpiDown E{(unsigned char*)ybuf, args.in[I_BD], YSCALE / WSCALE};
        pg8::gemm_phase<pg8::EpiDown, pg8::GroupedOrder, true>(L + RING_OFF, g, S, E, wave);
    }
    SEAM(9);
    if (IN(10)) { PV
        typedef float f2t __attribute__((ext_vector_type(2)));
        int4 sl = *(const int4*)(slot_of + (size_t)gw * 4); float4 gt = *(const float4*)(topk_gate + (size_t)gw * 4);
        for (int t = gw; t < T; t += NGW) {
            GAS f32x4* op = (GAS f32x4*)(args.out + (size_t)t * D) + lane;
            const GAS v2u* xq = (const GAS v2u*)(x1b + (size_t)t * D) + lane;
            const unsigned char* yb = (const unsigned char*)ybuf + 4 * lane;
            f32x4 o[4]; unsigned ya[4][4];
#pragma unroll
            for (int j = 0; j < 4; ++j) { const v2u xw = xq[64 * j]; o[j] = (f32x4){blo(xw.x), bhi(xw.x), blo(xw.y), bhi(xw.y)};
                ya[0][j] = *(const GAS unsigned*)(yb + (size_t)sl.x * D + 256 * j); ya[1][j] = *(const GAS unsigned*)(yb + (size_t)sl.y * D + 256 * j);
                ya[2][j] = *(const GAS unsigned*)(yb + (size_t)sl.z * D + 256 * j); ya[3][j] = *(const GAS unsigned*)(yb + (size_t)sl.w * D + 256 * j); }
            const float g0 = gt.x * (1.0f / YSCALE), g1 = gt.y * (1.0f / YSCALE), g2 = gt.z * (1.0f / YSCALE), g3 = gt.w * (1.0f / YSCALE);
            if (t + NGW < T) { sl = *(const int4*)(slot_of + (size_t)(t + NGW) * 4); gt = *(const float4*)(topk_gate + (size_t)(t + NGW) * 4); }
#pragma unroll
            for (int j = 0; j < 4; ++j) {
                const f2t l0 = __builtin_amdgcn_cvt_pk_f32_fp8((int)ya[0][j], false), h0 = __builtin_amdgcn_cvt_pk_f32_fp8((int)ya[0][j], true);
                const f2t l1 = __builtin_amdgcn_cvt_pk_f32_fp8((int)ya[1][j], false), h1 = __builtin_amdgcn_cvt_pk_f32_fp8((int)ya[1][j], true);
                const f2t l2 = __builtin_amdgcn_cvt_pk_f32_fp8((int)ya[2][j], false), h2 = __builtin_amdgcn_cvt_pk_f32_fp8((int)ya[2][j], true);
                const f2t l3 = __builtin_amdgcn_cvt_pk_f32_fp8((int)ya[3][j], false), h3 = __builtin_amdgcn_cvt_pk_f32_fp8((int)ya[3][j], true);
                const f2t lo = ((l0 * g0 + l1 * g1) + l2 * g2) + l3 * g3, hi = ((h0 * g0 + h1 * g1) + h2 * g2) + h3 * g3;
                o[j].x += lo.x; o[j].y += lo.y; o[j].z += hi.x; o[j].w += hi.y;
                op[64 * j] = o[j]; }
        }
    }
#if PROBE_MASK
    __syncthreads(); STAMP(10);
    if (blockIdx.x == 0 && wave_s == 0 && LANE_ID == 0) { const LAS unsigned* st = (const LAS unsigned*)(L + LDSCTL_OFF + 640); unsigned d = 0;
        for (int k = 0; k < NPHASE; ++k) if ((PROBE_MASK >> k) & 1) d += st[k + 1] - st[k];
        if (PROBE_SUBA >= 0) d = st[16 + PROBE_SUBB] - st[16 + PROBE_SUBA];
        const unsigned long long t0 = __builtin_amdgcn_s_memrealtime(); while (__builtin_amdgcn_s_memrealtime() - t0 < (unsigned long long)d * PROBE_AMP) __builtin_amdgcn_s_sleep(16); }
#endif
#undef IN
#undef SEAM
}

extern "C" void kernel_launch(void* const* d_in, const int* in_sizes, int n_in, void* d_out, int out_size, void* d_ws, size_t ws_size, hipStream_t stream) {
    static int grid = 0;
    if (grid == 0) {
        if (n_in != 28 || out_size != T * D || ws_size < WS_END) { fprintf(stderr, "kernel_launch: unexpected shapes: n_in %d out %d ws %zu (need %zu)\n", n_in, out_size, ws_size, (size_t)WS_END); grid = -1; return; }
        int dev = 0, cus = 0, per_cu = 0;
        if (hipGetDevice(&dev) != hipSuccess || hipDeviceGetAttribute(&cus, hipDeviceAttributeMultiprocessorCount, dev) != hipSuccess) { grid = -1; return; }
        if (hipFuncSetAttribute((const void*)fwd, hipFuncAttributeMaxDynamicSharedMemorySize, LDS_BYTES) != hipSuccess) { fprintf(stderr, "kernel_launch: hipFuncSetAttribute failed\n"); grid = -1; return; }
        if (hipOccupancyMaxActiveBlocksPerMultiprocessor(&per_cu, (const void*)fwd, NTHR, LDS_BYTES) != hipSuccess || per_cu < 1) { fprintf(stderr, "kernel_launch: occupancy query says %d\n", per_cu); }
        (void)hipGetLastError();
        grid = cus;
    }
    if (grid < 0) return;
    if (hipMemsetAsync((char*)d_ws + WS_CTL, 0, CTL_ZERO_BYTES, stream) != hipSuccess) { fprintf(stderr, "kernel_launch: memset failed\n"); return; }
    Args a{};
    for (int i = 0; i < 28; ++i) a.in[i] = (const float*)d_in[i];
    a.out = (float*)d_out; a.ws = (unsigned char*)d_ws;
#if MK_FUSED
    a.ph_lo = 0; a.ph_hi = NPHASE;
    hipLaunchKernelGGL(fwd, dim3(grid), dim3(NTHR), LDS_BYTES, stream, a);
#else
    for (int p = 0; p < NPHASE; ++p) { a.ph_lo = p; a.ph_hi = p + 1; hipLaunchKernelGGL(fwd, dim3(grid), dim3(NTHR), LDS_BYTES, stream, a); }
#endif
    const hipError_t le = hipPeekAtLastError();
    if (le != hipSuccess) fprintf(stderr, "kernel_launch: launch failed: %s\n", hipGetErrorName(le));
}
```
